# Optimizing an MI355X kernel written in HIP

```python
import jax, jax.numpy as jnp
from jax import lax
import numpy as np

D_MODEL = 1024
BATCH = 16
SEQ = 4096
DEPTH = 1

CHUNK = 64
N_META = 16
Q_BLOCK = 128
EPS = 1e-6
GLA_HEADS = 4
GLA_DK = 64
GLA_DV = 128
GLA_GATE_RANK = 16
GLA_TAU = 16.0
GLA_QK = GLA_HEADS * GLA_DK
GLA_VW = GLA_HEADS * GLA_DV
MLA_HEADS = 4
MLA_Q_RANK = 256
MLA_KV_RANK = 128
MLA_NOPE = 128
MLA_ROPE = 64
MLA_V = 128
MLA_OUT = MLA_HEADS * MLA_V
ROPE_BASE = 10000.0
D_MIX = GLA_VW + MLA_OUT
IN_WIDTHS = (GLA_QK, GLA_QK, GLA_VW, GLA_VW, GLA_GATE_RANK, MLA_Q_RANK, MLA_KV_RANK, MLA_ROPE)
D_IN = sum(IN_WIDTHS)
N_GROUPS = 8
EXPERTS_PER_GROUP = 8
N_EXPERTS = N_GROUPS * EXPERTS_PER_GROUP
TOP_K = 2
D_EXPERT = 512
MOE_BLOCK = 128

kernel_name = 'hymba_gla_mla_hier_moe'


def rmsnorm(x, gain):
    x32 = x.astype(jnp.float32)
    y = x32 * lax.rsqrt(jnp.mean(x32 * x32, axis=-1, keepdims=True) + EPS)
    return (y * gain.astype(jnp.float32)).astype(x.dtype)


def split_points():
    pts, acc = [], 0
    for w in IN_WIDTHS[:-1]:
        acc += w
        pts.append(acc)
    return pts


def chunk_ids(length):
    p = jnp.arange(length)
    return jnp.where(p < N_META, 0, 1 + (p - N_META) // CHUNK)


def rope_tables(length):
    pos = jnp.arange(length, dtype=jnp.float32)
    inv = ROPE_BASE ** (-jnp.arange(0, MLA_ROPE, 2, dtype=jnp.float32) / MLA_ROPE)
    ang = pos[:, None] * inv[None, :]
    return jnp.cos(ang), jnp.sin(ang)


def apply_rope(x, cos, sin):
    half = x.shape[-1] // 2
    x1, x2 = x[..., :half].astype(jnp.float32), x[..., half:].astype(jnp.float32)
    return jnp.concatenate([x1 * cos - x2 * sin, x2 * cos + x1 * sin], axis=-1).astype(x.dtype)


def gla_group(q, k, v, r, a_low, w_a2, b_a, out_gain):
    f32 = jnp.float32
    B, L, _ = q.shape
    pad = (-L) % CHUNK
    log_a = jax.nn.log_sigmoid((a_low @ w_a2 + b_a).astype(f32)) / GLA_TAU

    def prep(t, d):
        t = jnp.pad(t.astype(f32), ((0, 0), (pad, 0), (0, 0)))
        n = t.shape[1] // CHUNK
        return t.reshape(B, n, CHUNK, GLA_HEADS, d).transpose(0, 3, 1, 2, 4)

    qc = prep(q, GLA_DK) * (GLA_DK ** -0.5)
    kc = prep(k, GLA_DK)
    vc = prep(v, GLA_DV)
    b = jnp.cumsum(prep(log_a, GLA_DK), axis=3)
    b_last = b[:, :, :, -1:, :]
    q_e = qc * jnp.exp(b)
    causal = jnp.tril(jnp.ones((CHUNK, CHUNK), dtype=bool))
    att = jnp.where(causal, jnp.einsum('bhncd,bhnsd->bhncs', q_e, kc * jnp.exp(-b)), 0.0)
    o = jnp.einsum('bhncs,bhnse->bhnce', att, vc)
    upd = jnp.einsum('bhncd,bhnce->nbhde', kc * jnp.exp(b_last - b), vc)
    decay = jnp.exp(b_last[:, :, :, 0, :]).transpose(2, 0, 1, 3)

    def step(s, inp):
        dec, u = inp
        return dec[..., None] * s + u, s

    s0 = jnp.zeros((B, GLA_HEADS, GLA_DK, GLA_DV), f32)
    _, s_prev = lax.scan(step, s0, (decay, upd))
    o = o + jnp.einsum('bhncd,nbhde->bhnce', q_e, s_prev)
    o = o.transpose(0, 2, 3, 1, 4).reshape(B, -1, GLA_HEADS, GLA_DV)[:, pad:]
    o = o * lax.rsqrt(jnp.mean(o * o, axis=-1, keepdims=True) + EPS)
    o = o.reshape(B, L, GLA_VW) * out_gain.astype(f32)
    return (o * jax.nn.silu(r.astype(f32))).astype(q.dtype)


def mla_group(q_lat, kv_lat, k_rope, q_norm, w_qb, kv_norm, w_kvb):
    B, L, _ = q_lat.shape
    q = (rmsnorm(q_lat, q_norm) @ w_qb).reshape(B, L, MLA_HEADS, MLA_NOPE + MLA_ROPE)
    q_nope, q_rope = q[..., :MLA_NOPE], q[..., MLA_NOPE:]
    kv = (rmsnorm(kv_lat, kv_norm) @ w_kvb).reshape(B, L, MLA_HEADS, MLA_NOPE + MLA_V)
    k_nope, v = kv[..., :MLA_NOPE], kv[..., MLA_NOPE:]
    cos, sin = rope_tables(L)
    q_rope = apply_rope(q_rope, cos[:, None, :], sin[:, None, :])
    k_rope = apply_rope(k_rope, cos, sin)
    key_chunk = chunk_ids(L)
    scale = (MLA_NOPE + MLA_ROPE) ** -0.5

    def attend(args):
        qn, qr, qcid = args
        s = (jnp.einsum('bqhd,bkhd->bhqk', qn, k_nope)
             + jnp.einsum('bqhd,bkd->bhqk', qr, k_rope)).astype(jnp.float32) * scale
        s = jnp.where(key_chunk[None, None, None, :] <= qcid[None, None, :, None], s, -jnp.inf)
        p = jax.nn.softmax(s, axis=-1).astype(v.dtype)
        return jnp.einsum('bhqk,bkhd->bqhd', p, v)

    meta_out = attend((q_nope[:, :N_META], q_rope[:, :N_META], key_chunk[:N_META]))
    nb = (L - N_META) // Q_BLOCK

    def blocks(t):
        return t[:, N_META:].reshape(B, nb, Q_BLOCK, *t.shape[2:]).swapaxes(0, 1)

    blk = lax.map(attend, (blocks(q_nope), blocks(q_rope), key_chunk[N_META:].reshape(nb, Q_BLOCK)))
    blk = blk.swapaxes(0, 1).reshape(B, L - N_META, MLA_HEADS, MLA_V)
    return jnp.concatenate([meta_out, blk], axis=1).reshape(B, L, MLA_OUT)


def hier_moe(u, wg, bg, we, be, w_gate, w_up, w_down):
    f32 = jnp.float32
    B, L, D = u.shape
    t = u.reshape(-1, D)
    n_tok = t.shape[0]
    g_prob = jax.nn.softmax((t @ wg + bg).astype(f32), axis=-1)
    g_p, g_idx = lax.top_k(g_prob, 1)
    e_logits = (t @ we + be).astype(f32).reshape(n_tok, N_GROUPS, EXPERTS_PER_GROUP)
    e_logits = jnp.take_along_axis(e_logits, g_idx[:, :, None], axis=1)[:, 0]
    e_p, e_idx = lax.top_k(jax.nn.softmax(e_logits, axis=-1), TOP_K)
    gates = g_p * e_p / jnp.sum(e_p, axis=-1, keepdims=True)
    expert = g_idx * EXPERTS_PER_GROUP + e_idx
    e_flat = expert.reshape(-1)
    tok_flat = jnp.repeat(jnp.arange(n_tok, dtype=jnp.int32), TOP_K)
    gate_flat = gates.reshape(-1)
    order = jnp.argsort(e_flat)
    e_sorted, tok_sorted, gate_sorted = e_flat[order], tok_flat[order], gate_flat[order]
    counts = jnp.bincount(e_flat, length=N_EXPERTS)
    padded = (counts + MOE_BLOCK - 1) // MOE_BLOCK * MOE_BLOCK
    pad_end = jnp.cumsum(padded)
    pad_start = pad_end - padded
    seg_start = jnp.cumsum(counts) - counts
    n_assign = n_tok * TOP_K
    dest = pad_start[e_sorted] + jnp.arange(n_assign) - seg_start[e_sorted]
    n_blocks = -(-(n_assign + N_EXPERTS * (MOE_BLOCK - 1)) // MOE_BLOCK)
    n_slots = n_blocks * MOE_BLOCK
    slot_tok = jnp.full((n_slots,), n_tok, jnp.int32).at[dest].set(tok_sorted)
    slot_gate = jnp.zeros((n_slots,), f32).at[dest].set(gate_sorted)
    block_expert = jnp.minimum(
        jnp.searchsorted(pad_end, jnp.arange(n_blocks) * MOE_BLOCK, side='right'), N_EXPERTS - 1)
    t_pad = jnp.concatenate([t, jnp.zeros((1, D), t.dtype)], axis=0)
    xs = t_pad[slot_tok].reshape(n_blocks, MOE_BLOCK, D)

    def expert_block(args):
        xb, e = args
        hdn = jax.nn.silu(xb @ w_gate[e]) * (xb @ w_up[e])
        return hdn @ w_down[e]

    ys = lax.map(expert_block, (xs, block_expert)).reshape(n_slots, D)
    out = jnp.zeros((n_tok + 1, D), f32).at[slot_tok].add(ys.astype(f32) * slot_gate[:, None])[:n_tok]
    return out.reshape(B, L, D).astype(u.dtype)


def setup_inputs(seed: int = 0) -> dict:
    key = jax.random.key(seed)
    ks = jax.random.split(key, 24)
    f32 = jnp.float32

    def nrm(k, shape, scale):
        return jax.random.normal(k, shape, f32) * scale

    def gain(k, shape):
        return 1.0 + 0.02 * jax.random.normal(k, shape, f32)

    return {
        'x': nrm(ks[0], (BATCH, SEQ, D_MODEL), 1.0),
        'meta_tokens': nrm(ks[1], (N_META, D_MODEL), 1.0),
        'mix_norm': gain(ks[2], (DEPTH, D_MODEL)),
        'w_in': nrm(ks[3], (DEPTH, D_MODEL, D_IN), D_MODEL ** -0.5),
        'gla_w_a2': nrm(ks[4], (DEPTH, GLA_GATE_RANK, GLA_QK), GLA_GATE_RANK ** -0.5),
        'gla_b_a': nrm(ks[5], (DEPTH, GLA_QK), 0.1),
        'gla_out_norm': gain(ks[6], (DEPTH, GLA_VW)),
        'mla_q_norm': gain(ks[7], (DEPTH, MLA_Q_RANK)),
        'mla_w_qb': nrm(ks[8], (DEPTH, MLA_Q_RANK, MLA_HEADS * (MLA_NOPE + MLA_ROPE)), MLA_Q_RANK ** -0.5),
        'mla_kv_norm': gain(ks[9], (DEPTH, MLA_KV_RANK)),
        'mla_w_kvb': nrm(ks[10], (DEPTH, MLA_KV_RANK, MLA_HEADS * (MLA_NOPE + MLA_V)), MLA_KV_RANK ** -0.5),
        'w_out': nrm(ks[11], (DEPTH, D_MIX, D_MODEL), D_MIX ** -0.5),
        'ffn_norm': gain(ks[12], (DEPTH, D_MODEL)),
        'router_group_w': nrm(ks[13], (DEPTH, D_MODEL, N_GROUPS), D_MODEL ** -0.5),
        'router_group_b': nrm(ks[14], (DEPTH, N_GROUPS), 0.01),
        'router_expert_w': nrm(ks[15], (DEPTH, D_MODEL, N_EXPERTS), D_MODEL ** -0.5),
        'router_expert_b': nrm(ks[16], (DEPTH, N_EXPERTS), 0.01),
        'expert_w_gate': nrm(ks[17], (DEPTH, N_EXPERTS, D_MODEL, D_EXPERT), D_MODEL ** -0.5),
        'expert_w_up': nrm(ks[18], (DEPTH, N_EXPERTS, D_MODEL, D_EXPERT), D_MODEL ** -0.5),
        'expert_w_down': nrm(ks[19], (DEPTH, N_EXPERTS, D_EXPERT, D_MODEL), D_EXPERT ** -0.5),
        'final_norm': gain(ks[20], (D_MODEL,)),
    }


def reference(x, meta_tokens, mix_norm, w_in, gla_w_a2, gla_b_a, gla_out_norm, mla_q_norm, mla_w_qb,
              mla_kv_norm, mla_w_kvb, w_out, ffn_norm, router_group_w, router_group_b, router_expert_w,
              router_expert_b, expert_w_gate, expert_w_up, expert_w_down, final_norm):
    B = x.shape[0]
    meta = jnp.broadcast_to(meta_tokens[None].astype(x.dtype), (B, N_META, x.shape[-1]))
    h = jnp.concatenate([meta, x], axis=1)
    pts = split_points()
    for l in range(DEPTH):
        u = rmsnorm(h, mix_norm[l])
        z = u @ w_in[l]
        q, k, v, r, a_low, q_lat, kv_lat, k_rope = jnp.split(z, pts, axis=-1)
        y_gla = gla_group(q, k, v, r, a_low, gla_w_a2[l], gla_b_a[l], gla_out_norm[l])
        y_mla = mla_group(q_lat, kv_lat, k_rope, mla_q_norm[l], mla_w_qb[l], mla_kv_norm[l], mla_w_kvb[l])
        h = h + jnp.concatenate([y_gla, y_mla], axis=-1) @ w_out[l]
        h = h + hier_moe(rmsnorm(h, ffn_norm[l]), router_group_w[l], router_group_b[l], router_expert_w[l],
                         router_expert_b[l], expert_w_gate[l], expert_w_up[l], expert_w_down[l])
    return rmsnorm(h, final_norm)[:, N_META:]
```

```cpp
#include <hip/hip_runtime.h>
#include <cstdio>
#include <cstdint>

#define DEV __device__ __forceinline__
typedef unsigned short bf16_t;
typedef short bf16x8 __attribute__((ext_vector_type(8)));
typedef float f32x16 __attribute__((ext_vector_type(16)));
typedef float f32x4 __attribute__((ext_vector_type(4)));
typedef unsigned u32x4 __attribute__((ext_vector_type(4)));
typedef unsigned u32x2 __attribute__((ext_vector_type(2)));

constexpr int NB = 16, SEQ = 4096, M = NB * SEQ, D = 1024, NMETA = 16;
constexpr int NZ = 2048;
constexpr int ZQ = 0, ZK = 256, ZV = 512, ZR = 1024, ZQL = 1536, ZKVL = 1792, ZKR = 1920, ZAL = 1984;
constexpr int NE = 64, DE = 512;
constexpr float EPS = 1e-6f;
constexpr int NT = 512, NWAVE = 8, GRID = 256;
constexpr int SLOT_CAP = 151552;

constexpr size_t MiB = 1ull << 20;
constexpr size_t WS_CTL = 0;
constexpr size_t WS_WIN = 1 * MiB;
constexpr size_t WS_WQ = 5 * MiB;
constexpr size_t WS_WK = 5 * MiB + 512 * 1024;
constexpr size_t WS_WV = 5 * MiB + 768 * 1024;
constexpr size_t WS_WOUT = 6 * MiB;
constexpr size_t WS_ROPE = 8 * MiB;
constexpr size_t WS_META = 10 * MiB;
constexpr size_t WS_RS = 11 * MiB;
constexpr size_t WS_TOK = 12 * MiB;
constexpr size_t WS_WGU = 16 * MiB;
constexpr size_t WS_WD = 144 * MiB;
constexpr size_t WS_R1 = 208 * MiB;
constexpr size_t WS_QM = WS_R1, WS_KN = WS_R1 + 96 * MiB, WS_VT = WS_R1 + 160 * MiB, WS_KR = WS_R1 + 224 * MiB;
constexpr size_t WS_H2 = WS_R1;
constexpr size_t WS_R2 = 464 * MiB;
constexpr size_t WS_XN = WS_R2, WS_Y = WS_R2, WS_TN = WS_R2, WS_MY = WS_R2;
constexpr size_t WS_LOGA = 592 * MiB;
constexpr size_t WS_MH = 760 * MiB;
constexpr size_t WS_LIST = 908 * MiB;
constexpr size_t WS_END = 924 * MiB;
constexpr size_t MT_Z = 0;
constexpr size_t MT_KN = 128 * 1024;
constexpr size_t MT_VT = 144 * 1024;
constexpr size_t MT_KR = 160 * 1024;
constexpr size_t MT_S1 = 192 * 1024;
constexpr int CW_CNT = 0;

struct Params { const float* in[21]; float* out; unsigned char* ws; };
enum { I_X = 0, I_META, I_MIXN, I_WIN, I_WA2, I_BA, I_GOUTN, I_QN, I_WQB, I_KVN, I_WKVB, I_WOUT, I_FFN, I_RGW, I_RGB, I_REW, I_REB, I_WG, I_WU, I_WDN, I_FINAL };

DEV unsigned f2bf(float f) { unsigned u = __float_as_uint(f); return (u + 0x7fffu + ((u >> 16) & 1u)) >> 16; }
DEV float bf2f(unsigned h) { return __uint_as_float(h << 16); }
DEV unsigned pk2(float lo, float hi) { return f2bf(lo) | (f2bf(hi) << 16); }
DEV float wave_sum(float v) {
#pragma unroll
    for (int o = 1; o < 64; o <<= 1) v += __shfl_xor(v, o);
    return v;
}
DEV int crow(int r, int hi) { return (r & 3) + 8 * (r >> 2) + 4 * hi; }
DEV int pi23(int i) { return (i & ~12) | ((i & 4) << 1) | ((i & 8) >> 1); }
DEV float logsigmoidf(float x) { return fminf(x, 0.f) - log1pf(__expf(-fabsf(x))); }
DEV float siluf(float x) { return x / (1.f + __expf(-x)); }

DEV void wave_tile(const bf16_t* a0, const bf16_t* a1, const bf16_t* b0, const bf16_t* b1, int K, f32x16& c00, f32x16& c01, f32x16& c10, f32x16& c11) {
    for (int k = 0; k < K; k += 16) {
        const bf16x8 A0 = *(const bf16x8*)(a0 + k), A1 = *(const bf16x8*)(a1 + k), B0 = *(const bf16x8*)(b0 + k), B1 = *(const bf16x8*)(b1 + k);
        c00 = __builtin_amdgcn_mfma_f32_32x32x16_bf16(A0, B0, c00, 0, 0, 0);
        c01 = __builtin_amdgcn_mfma_f32_32x32x16_bf16(A0, B1, c01, 0, 0, 0);
        c10 = __builtin_amdgcn_mfma_f32_32x32x16_bf16(A1, B0, c10, 0, 0, 0);
        c11 = __builtin_amdgcn_mfma_f32_32x32x16_bf16(A1, B1, c11, 0, 0, 0);
    }
}
template <class AF, class BF, class EF>
DEV void gemm_simple(int Mt, int Nt, int K, AF arow, BF brow, EF epi, int gw, int ngw) {
    const int lane = threadIdx.x & 63, r32 = lane & 31, hi = lane >> 5;
    for (int it = gw; it < Mt * Nt; it += ngw) {
        const int tm = it / Nt, tn = it % Nt;
        f32x16 c00 = {}, c01 = {}, c10 = {}, c11 = {};
        wave_tile(arow(tm * 64 + r32) + hi * 8, arow(tm * 64 + 32 + r32) + hi * 8, brow(tn * 64 + r32) + hi * 8, brow(tn * 64 + 32 + r32) + hi * 8, K, c00, c01, c10, c11);
#pragma unroll
        for (int r = 0; r < 16; ++r) {
            const int row = tm * 64 + crow(r, hi), col = tn * 64 + r32;
            epi(row, col, c00[r]); epi(row, col + 32, c01[r]); epi(row + 32, col, c10[r]); epi(row + 32, col + 32, c11[r]);
        }
    }
}

template <class SF>
DEV void transpose_item(SF src, bf16_t* dst, int ldd, int k0, int n0, float* scr, int lane) {
#pragma unroll 8
    for (int i = 0; i < 32; ++i) { const int kk = 2 * i + (lane >> 5); scr[kk * 33 + (lane & 31)] = src(k0 + kk, n0 + (lane & 31)); }
    __builtin_amdgcn_s_waitcnt(0xc07f); asm volatile("" ::: "memory");
    const int c = lane & 7;
#pragma unroll
    for (int j = 0; j < 4; ++j) { const int n = (lane >> 3) + 8 * j; const float* s = scr + (8 * c) * 33 + n;
        u32x4 o; o.x = pk2(s[0], s[33]); o.y = pk2(s[66], s[99]); o.z = pk2(s[132], s[165]); o.w = pk2(s[198], s[231]);
        *(u32x4*)(dst + (size_t)(n0 + n) * ldd + k0 + 8 * c) = o; }
    __builtin_amdgcn_s_waitcnt(0xc07f); asm volatile("" ::: "memory");
}
DEV int zcol_src(int n) {
    if (n < 1536) return n;
    if (n < 1792) return 1552 + (n - 1536);
    if (n < 1920) return 1808 + (n - 1792);
    if (n < 1984) { const int j = n - 1920; return 1936 + (j >> 1) + 32 * (j & 1); }
    if (n < 2000) return 1536 + (n - 1984);
    return -1;
}
DEV void phase0(const Params& P, float* scr_all) {
    const int tid = threadIdx.x, lane = tid & 63, wave = tid >> 6;
    const int gw = blockIdx.x * NWAVE + wave, ngw = gridDim.x * NWAVE;
    float* scr = scr_all + wave * (64 * 33);
    unsigned char* ws = P.ws;
    constexpr int I_IN = 16 * 64, I_Q = 4 * 24, I_K = 4 * 16, I_V = 4 * 16, I_O = 16 * 32, I_GU = 16 * 32, I_DN = 8 * 32;
    constexpr int NITEMS = I_IN + I_Q + I_K + I_V + I_O + NE * I_GU + NE * I_DN;
    const float c2 = 0.07216878364870322f * 1.4426950408889634f;
    for (int it = gw; it < NITEMS; it += ngw) {
        int r = it;
        if (r < I_IN) { const float* W = P.in[I_WIN]; const int kb = r / 64, nb = r % 64;
            transpose_item([&](int k, int n) { const int s = zcol_src(n); return s < 0 ? 0.f : W[(size_t)k * 2000 + s]; }, (bf16_t*)(ws + WS_WIN), 1024, kb * 64, nb * 32, scr, lane); continue; }
        r -= I_IN;
        if (r < I_Q) { const float* W = P.in[I_WQB]; const float* g = P.in[I_QN]; const int kb = r / 24, nb = r % 24;
            transpose_item([&](int k, int n) { int s; if (n < 512) s = (n >> 7) * 192 + (n & 127); else { const int q = n - 512, h = q >> 6, jj = q & 63; s = h * 192 + 128 + (jj >> 1) + 32 * (jj & 1); }
                return W[(size_t)k * 768 + s] * g[k] * c2; }, (bf16_t*)(ws + WS_WQ), 256, kb * 64, nb * 32, scr, lane); continue; }
        r -= I_Q;
        if (r < I_K + I_V) { const bool isv = r >= I_K; if (isv) r -= I_K; const float* W = P.in[I_WKVB]; const float* g = P.in[I_KVN]; const int kb = r / 16, nb = r % 16;
            transpose_item([&](int k, int n) { if (k >= 128) return 0.f; const int s = (n >> 7) * 256 + (isv ? 128 : 0) + (n & 127); return W[(size_t)k * 1024 + s] * g[k]; },
                           (bf16_t*)(ws + (isv ? WS_WV : WS_WK)), 256, kb * 64, nb * 32, scr, lane); continue; }
        r -= I_K + I_V;
        if (r < I_O) { const float* W = P.in[I_WOUT]; const int kb = r / 32, nb = r % 32;
            transpose_item([&](int k, int n) { return W[(size_t)k * 1024 + n]; }, (bf16_t*)(ws + WS_WOUT), 1024, kb * 64, nb * 32, scr, lane); continue; }
        r -= I_O;
        if (r < NE * I_GU) { const int e = r / I_GU, q = r % I_GU, kb = q / 32, nb = q % 32;
            const float* Wg = P.in[I_WG] + (size_t)e * 1024 * 512; const float* Wu = P.in[I_WU] + (size_t)e * 1024 * 512;
            transpose_item([&](int k, int n) { const int hid = (n >> 3) * 4 + (n & 3); return ((n & 4) ? Wu : Wg)[(size_t)k * 512 + hid]; },
                           (bf16_t*)(ws + WS_WGU) + (size_t)e * 1024 * 1024, 1024, kb * 64, nb * 32, scr, lane); continue; }
        r -= NE * I_GU;
        { const int e = r / I_DN, q = r % I_DN, kb = q / 32, nb = q % 32; const float* W = P.in[I_WDN] + (size_t)e * 512 * 1024;
            transpose_item([&](int k, int n) { return W[(size_t)k * 1024 + n]; }, (bf16_t*)(ws + WS_WD) + (size_t)e * 1024 * 512, 512, kb * 64, nb * 32, scr, lane); }
    }
    { const float* g = P.in[I_MIXN]; bf16_t* XN = (bf16_t*)(ws + WS_XN);
      f32x4 gv[4];
#pragma unroll
      for (int j = 0; j < 4; ++j) gv[j] = *(const f32x4*)(g + 256 * j + 4 * lane);
      for (int m = gw; m < M; m += ngw) {
        const f32x4* xr = (const f32x4*)(P.in[I_X] + (size_t)m * D) + lane;
        f32x4 v[4]; float s = 0.f;
#pragma unroll
        for (int j = 0; j < 4; ++j) { v[j] = xr[64 * j]; s += (v[j].x * v[j].x + v[j].y * v[j].y) + (v[j].z * v[j].z + v[j].w * v[j].w); }
        const float rs = rsqrtf(wave_sum(s) * (1.f / D) + EPS);
        unsigned long long* o8 = (unsigned long long*)(XN + (size_t)m * D) + lane;
#pragma unroll
        for (int j = 0; j < 4; ++j) o8[64 * j] = (unsigned long long)pk2(v[j].x * rs * gv[j].x, v[j].y * rs * gv[j].y) | ((unsigned long long)pk2(v[j].z * rs * gv[j].z, v[j].w * rs * gv[j].w) << 32);
      } }
    const int gt = blockIdx.x * NT + tid, ngt = gridDim.x * NT;
    { float2* rt = (float2*)(ws + WS_ROPE);
      for (int i = gt; i < (SEQ + NMETA) * 32; i += ngt) { const int pos = i >> 5, f = i & 31;
        const double inv = pow(10000.0, -(double)(2 * f) / 64.0), ang = (double)pos * inv; rt[i] = make_float2((float)cos(ang), (float)sin(ang)); } }
    { float* mz = (float*)(ws + WS_META + MT_Z); const float* mt = P.in[I_META]; const float* g = P.in[I_MIXN]; const float* W = P.in[I_WIN];
      for (int i = gt; i < NMETA * NZ; i += ngt) { const int row = i / NZ, n = i % NZ; const int s = zcol_src(n);
        float acc = 0.f, ss = 0.f;
        if (s >= 0) for (int k = 0; k < D; ++k) { const float x = mt[row * D + k]; ss += x * x; acc += x * g[k] * W[(size_t)k * 2000 + s]; }
        mz[i] = s >= 0 ? acc * rsqrtf(ss * (1.f / D) + EPS) : 0.f; } }
}

DEV void meta_phase(const Params& P) {
    unsigned char* ws = P.ws; const int gt = blockIdx.x * NT + threadIdx.x, ngt = gridDim.x * NT;
    const float* mz = (const float*)(ws + WS_META + MT_Z);
    bf16_t* KNm = (bf16_t*)(ws + WS_META + MT_KN); bf16_t* VTm = (bf16_t*)(ws + WS_META + MT_VT); bf16_t* KRm = (bf16_t*)(ws + WS_META + MT_KR); float* S1 = (float*)(ws + WS_META + MT_S1);
    const float* Wkv = P.in[I_WKVB]; const float* gk = P.in[I_KVN];
    for (int i = gt; i < NMETA * 1024; i += ngt) { const int row = i >> 10, col = i & 1023; const float* z = mz + row * NZ + ZKVL;
        float ss = 0.f, acc = 0.f; for (int k = 0; k < 128; ++k) { ss += z[k] * z[k]; acc += z[k] * gk[k] * Wkv[(size_t)k * 1024 + col]; }
        acc *= rsqrtf(ss * (1.f / 128.f) + EPS);
        const int h = col >> 8, w = col & 255;
        if (w < 128) KNm[row * 512 + h * 128 + w] = (bf16_t)f2bf(acc); else VTm[(h * 128 + w - 128) * 16 + row] = (bf16_t)f2bf(acc); }
    const float2* rt = (const float2*)(ws + WS_ROPE);
    for (int i = gt; i < NMETA * 32; i += ngt) { const int row = i >> 5, f = i & 31; const float x1 = mz[row * NZ + ZKR + 2 * f], x2 = mz[row * NZ + ZKR + 2 * f + 1]; const float2 cs = rt[row * 32 + f];
        KRm[row * 64 + 2 * f] = (bf16_t)f2bf(x1 * cs.x - x2 * cs.y); KRm[row * 64 + 2 * f + 1] = (bf16_t)f2bf(x2 * cs.x + x1 * cs.y); }
    const float* wa2 = P.in[I_WA2]; const float* ba = P.in[I_BA];
    for (int i = gt; i < 4 * 64 * 128; i += ngt) { const int h = i >> 13, d = (i >> 7) & 63, e = i & 127; float S = 0.f;
        for (int s = 0; s < NMETA; ++s) { const float* z = mz + s * NZ; float x = ba[h * 64 + d];
            for (int r = 0; r < 16; ++r) x += z[ZAL + r] * wa2[r * 256 + h * 64 + d];
            const float a = __expf(logsigmoidf(x) * (1.f / 16.f)); S = a * S + z[ZK + h * 64 + d] * z[ZV + h * 128 + e]; }
        S1[i] = S; }
}
DEV void phase1(const Params& P) {
    unsigned char* ws = P.ws; const int gw = blockIdx.x * NWAVE + (threadIdx.x >> 6), ngw = gridDim.x * NWAVE;
    const bf16_t* XN = (const bf16_t*)(ws + WS_XN); const bf16_t* W = (const bf16_t*)(ws + WS_WIN); bf16_t* Z = (bf16_t*)P.out;
    gemm_simple(M / 64, NZ / 64, D, [&](int r) { return XN + (size_t)r * D; }, [&](int c) { return W + (size_t)c * D; },
                [&](int row, int col, float v) { Z[(size_t)row * NZ + col] = (bf16_t)f2bf(v); }, gw, ngw);
    meta_phase(P);
}
DEV void phase2a(const Params& P) {
    unsigned char* ws = P.ws; const int lane = threadIdx.x & 63; const int gw = blockIdx.x * NWAVE + (threadIdx.x >> 6), ngw = gridDim.x * NWAVE;
    const bf16_t* Z = (const bf16_t*)P.out; float* rsq = (float*)(ws + WS_RS); float* rskv = rsq + M; bf16_t* KR = (bf16_t*)(ws + WS_KR); float* LOGA = (float*)(ws + WS_LOGA);
    const float2* rt = (const float2*)(ws + WS_ROPE); const float* wa2 = P.in[I_WA2]; const float* ba = P.in[I_BA];
    float w[4][16], bb[4];
#pragma unroll
    for (int j = 0; j < 4; ++j) { bb[j] = ba[64 * j + lane];
#pragma unroll
        for (int r = 0; r < 16; ++r) w[j][r] = wa2[r * 256 + 64 * j + lane]; }
    for (int m = gw; m < M; m += ngw) { const bf16_t* z = Z + (size_t)m * NZ;
        float s = 0.f;
#pragma unroll
        for (int j = 0; j < 4; ++j) { const float v = bf2f(z[ZQL + 64 * j + lane]); s += v * v; }
        s = wave_sum(s); float s2 = 0.f;
#pragma unroll
        for (int j = 0; j < 2; ++j) { const float v = bf2f(z[ZKVL + 64 * j + lane]); s2 += v * v; }
        s2 = wave_sum(s2);
        if (lane == 0) { rsq[m] = rsqrtf(s * (1.f / 256.f) + EPS); rskv[m] = rsqrtf(s2 * (1.f / 128.f) + EPS); }
        { const float v = bf2f(z[ZKR + lane]), o = __shfl_xor(v, 1); const float2 cs = rt[(NMETA + (m & (SEQ - 1))) * 32 + (lane >> 1)];
          KR[(size_t)m * 64 + lane] = (bf16_t)f2bf((lane & 1) ? (v * cs.x + o * cs.y) : (v * cs.x - o * cs.y)); }
        float al[16];
#pragma unroll
        for (int r = 0; r < 16; ++r) al[r] = bf2f(z[ZAL + r]);
#pragma unroll
        for (int j = 0; j < 4; ++j) { float x = bb[j];
#pragma unroll
            for (int r = 0; r < 16; ++r) x += al[r] * w[j][r];
            LOGA[(size_t)m * 256 + 64 * j + lane] = logsigmoidf(x) * (1.f / 16.f); }
    }
}
DEV void phase2b(const Params& P) {
    unsigned char* ws = P.ws; const int gw = blockIdx.x * NWAVE + (threadIdx.x >> 6), ngw = gridDim.x * NWAVE;
    const bf16_t* Z = (const bf16_t*)P.out; const float* rsq = (const float*)(ws + WS_RS); const float* rskv = rsq + M;
    const float2* rt = (const float2*)(ws + WS_ROPE);
    { bf16_t* QM = (bf16_t*)(ws + WS_QM); const bf16_t* W = (const bf16_t*)(ws + WS_WQ);
      gemm_simple(M / 64, 768 / 64, 256, [&](int r) { return Z + (size_t)r * NZ + ZQL; }, [&](int c) { return W + (size_t)c * 256; },
                  [&](int row, int col, float v) { v *= rsq[row]; const float o = __shfl_xor(v, 1);
                      if (col >= 512) { const float2 cs = rt[(NMETA + (row & (SEQ - 1))) * 32 + ((col & 63) >> 1)]; v = (col & 1) ? (v * cs.x + o * cs.y) : (v * cs.x - o * cs.y); }
                      QM[(size_t)row * 768 + col] = (bf16_t)f2bf(v); }, gw, ngw); }
    { bf16_t* KN = (bf16_t*)(ws + WS_KN); const bf16_t* W = (const bf16_t*)(ws + WS_WK);
      gemm_simple(M / 64, 512 / 64, 256, [&](int r) { return Z + (size_t)r * NZ + ZKVL; }, [&](int c) { return W + (size_t)c * 256; },
                  [&](int row, int col, float v) { KN[(size_t)row * 512 + col] = (bf16_t)f2bf(v * rskv[row]); }, gw, ngw); }
    { bf16_t* VT = (bf16_t*)(ws + WS_VT); const bf16_t* W = (const bf16_t*)(ws + WS_WV);
      gemm_simple(512 / 64, M / 64, 256, [&](int r) { return W + (size_t)r * 256; }, [&](int c) { return Z + (size_t)c * NZ + ZKVL; },
                  [&](int row, int col, float v) { VT[(size_t)row * M + col] = (bf16_t)f2bf(v * rskv[col]); }, gw, ngw); }
}
DEV void gla_simple(const Params& P) {
    unsigned char* ws = P.ws; const int tid = threadIdx.x;
    const bf16_t* Z = (const bf16_t*)P.out; const float* LOGA = (const float*)(ws + WS_LOGA); const float* S1 = (const float*)(ws + WS_META + MT_S1); bf16_t* Y = (bf16_t*)(ws + WS_Y);
    for (int u = blockIdx.x; u < NB * 4; u += gridDim.x) { const int b = u >> 2, h = u & 3, e = tid >> 2, dq = tid & 3;
        float S[16];
#pragma unroll
        for (int j = 0; j < 16; ++j) S[j] = S1[(h * 64 + dq * 16 + j) * 128 + e];
        for (int t = 0; t < SEQ; ++t) { const size_t m = (size_t)b * SEQ + t; const bf16_t* z = Z + m * NZ;
            const u32x4 q0 = *(const u32x4*)(z + ZQ + h * 64 + dq * 16), q1 = *(const u32x4*)(z + ZQ + h * 64 + dq * 16 + 8);
            const u32x4 k0 = *(const u32x4*)(z + ZK + h * 64 + dq * 16), k1 = *(const u32x4*)(z + ZK + h * 64 + dq * 16 + 8);
            const f32x4* la = (const f32x4*)(LOGA + m * 256 + h * 64 + dq * 16);
            const float v = bf2f(z[ZV + h * 128 + e]);
            const unsigned qq[8] = {q0.x, q0.y, q0.z, q0.w, q1.x, q1.y, q1.z, q1.w}, kk[8] = {k0.x, k0.y, k0.z, k0.w, k1.x, k1.y, k1.z, k1.w};
            float o = 0.f;
#pragma unroll
            for (int j4 = 0; j4 < 4; ++j4) { const f32x4 l4 = la[j4];
#pragma unroll
                for (int jj = 0; jj < 4; ++jj) { const int j = j4 * 4 + jj; const unsigned qw = qq[j >> 1], kw = kk[j >> 1];
                    const float qv = (j & 1) ? __uint_as_float(qw & 0xffff0000u) : __uint_as_float(qw << 16), kv = (j & 1) ? __uint_as_float(kw & 0xffff0000u) : __uint_as_float(kw << 16);
                    S[j] = __expf(l4[jj]) * S[j] + kv * v; o += qv * S[j]; } }
            o += __shfl_xor(o, 1); o += __shfl_xor(o, 2);
            if (dq == 0) Y[m * 1024 + h * 128 + e] = (bf16_t)f2bf(o * 0.125f); }
    }
}
DEV void mla_simple(const Params& P) {
    unsigned char* ws = P.ws; const int lane = threadIdx.x & 63, r32 = lane & 31, hi = lane >> 5; const int gw = blockIdx.x * NWAVE + (threadIdx.x >> 6), ngw = gridDim.x * NWAVE;
    const bf16_t* QM = (const bf16_t*)(ws + WS_QM); const bf16_t* KN = (const bf16_t*)(ws + WS_KN); const bf16_t* VT = (const bf16_t*)(ws + WS_VT); const bf16_t* KR = (const bf16_t*)(ws + WS_KR);
    const bf16_t* KNm = (const bf16_t*)(ws + WS_META + MT_KN); const bf16_t* VTm = (const bf16_t*)(ws + WS_META + MT_VT); const bf16_t* KRm = (const bf16_t*)(ws + WS_META + MT_KR);
    bf16_t* Y = (bf16_t*)(ws + WS_Y);
    const int kperm = pi23(r32);
    for (int w = gw; w < 2048; w += ngw) { const int bh = w >> 5, s5 = w & 31, b = bh >> 2, h = bh & 3;
        for (int ui = 0; ui < 4; ++ui) { const int i = (ui == 0) ? s5 : (ui == 1) ? 63 - s5 : (ui == 2) ? 64 + s5 : 127 - s5;
            const size_t mq = (size_t)b * SEQ + i * 32 + r32;
            bf16x8 qf[12];
#pragma unroll
            for (int s = 0; s < 8; ++s) qf[s] = *(const bf16x8*)(QM + mq * 768 + h * 128 + 16 * s + 8 * hi);
#pragma unroll
            for (int s = 0; s < 4; ++s) qf[8 + s] = *(const bf16x8*)(QM + mq * 768 + 512 + h * 64 + 16 * s + 8 * hi);
            f32x16 O[4] = {}; float mrun = -INFINITY, l = 0.f;
            const int ntile = 2 * (1 + (i >> 1));
            for (int j = -1; j < ntile; ++j) {
                f32x16 S = {};
                if (j < 0) { const bool ok = kperm < NMETA; const bf16x8 zf = {};
#pragma unroll
                    for (int s = 0; s < 8; ++s) { const bf16x8 kf = ok ? *(const bf16x8*)(KNm + kperm * 512 + h * 128 + 16 * s + 8 * hi) : zf; S = __builtin_amdgcn_mfma_f32_32x32x16_bf16(kf, qf[s], S, 0, 0, 0); }
#pragma unroll
                    for (int s = 0; s < 4; ++s) { const bf16x8 kf = ok ? *(const bf16x8*)(KRm + kperm * 64 + 16 * s + 8 * hi) : zf; S = __builtin_amdgcn_mfma_f32_32x32x16_bf16(kf, qf[8 + s], S, 0, 0, 0); }
#pragma unroll
                    for (int r = 0; r < 16; ++r) if (pi23(crow(r, hi)) >= NMETA) S[r] = -INFINITY;
                } else { const size_t mk = (size_t)b * SEQ + j * 32 + kperm;
#pragma unroll
                    for (int s = 0; s < 8; ++s) { const bf16x8 kf = *(const bf16x8*)(KN + mk * 512 + h * 128 + 16 * s + 8 * hi); S = __builtin_amdgcn_mfma_f32_32x32x16_bf16(kf, qf[s], S, 0, 0, 0); }
#pragma unroll
                    for (int s = 0; s < 4; ++s) { const bf16x8 kf = *(const bf16x8*)(KR + mk * 64 + 16 * s + 8 * hi); S = __builtin_amdgcn_mfma_f32_32x32x16_bf16(kf, qf[8 + s], S, 0, 0, 0); }
                }
                float mx = S[0];
#pragma unroll
                for (int r = 1; r < 16; ++r) mx = fmaxf(mx, S[r]);
                mx = fmaxf(mx, __shfl_xor(mx, 32));
                const float mnew = fmaxf(mrun, mx), alpha = exp2f(mrun - mnew); mrun = mnew;
                float ps = 0.f;
#pragma unroll
                for (int r = 0; r < 16; ++r) { S[r] = exp2f(S[r] - mnew); ps += S[r]; }
                l = l * alpha + ps;
#pragma unroll
                for (int d = 0; d < 4; ++d)
#pragma unroll
                    for (int r = 0; r < 16; ++r) O[d][r] *= alpha;
                u32x4 p0, p1;
                p0.x = pk2(S[0], S[1]); p0.y = pk2(S[2], S[3]); p0.z = pk2(S[4], S[5]); p0.w = pk2(S[6], S[7]);
                p1.x = pk2(S[8], S[9]); p1.y = pk2(S[10], S[11]); p1.z = pk2(S[12], S[13]); p1.w = pk2(S[14], S[15]);
                const bf16x8 pf0 = __builtin_bit_cast(bf16x8, p0), pf1 = __builtin_bit_cast(bf16x8, p1);
#pragma unroll
                for (int d = 0; d < 4; ++d) {
                    bf16x8 v0, v1;
                    if (j < 0) { const bf16x8 zf = {}; v0 = (hi == 0 || true) ? *(const bf16x8*)(VTm + (h * 128 + 32 * d + r32) * 16 + 8 * hi) : zf; v1 = zf; }
                    else { const bf16_t* vp = VT + (size_t)(h * 128 + 32 * d + r32) * M + (size_t)b * SEQ + j * 32 + 8 * hi; v0 = *(const bf16x8*)vp; v1 = *(const bf16x8*)(vp + 16); }
                    O[d] = __builtin_amdgcn_mfma_f32_32x32x16_bf16(v0, pf0, O[d], 0, 0, 0);
                    O[d] = __builtin_amdgcn_mfma_f32_32x32x16_bf16(v1, pf1, O[d], 0, 0, 0);
                }
            }
            l += __shfl_xor(l, 32); const float rl = 1.f / l;
#pragma unroll
            for (int d = 0; d < 4; ++d)
#pragma unroll
                for (int r = 0; r < 16; ++r) Y[mq * 1024 + 512 + h * 128 + 32 * d + crow(r, hi)] = (bf16_t)f2bf(O[d][r] * rl);
        }
    }
}
DEV void phase3b(const Params& P) {
    unsigned char* ws = P.ws; const int lane = threadIdx.x & 63; const int gw = blockIdx.x * NWAVE + (threadIdx.x >> 6), ngw = gridDim.x * NWAVE;
    const bf16_t* Z = (const bf16_t*)P.out; bf16_t* Y = (bf16_t*)(ws + WS_Y); const float* g = P.in[I_GOUTN];
    float gv[8];
#pragma unroll
    for (int j = 0; j < 8; ++j) gv[j] = g[8 * lane + j];
    for (int m = gw; m < M; m += ngw) {
        const u32x4 o4 = *(const u32x4*)(Y + (size_t)m * 1024 + 8 * lane), r4 = *(const u32x4*)(Z + (size_t)m * NZ + ZR + 8 * lane);
        const unsigned ow[4] = {o4.x, o4.y, o4.z, o4.w}, rw[4] = {r4.x, r4.y, r4.z, r4.w}; float o[8], r[8]; float s = 0.f;
#pragma unroll
        for (int j = 0; j < 4; ++j) { o[2 * j] = __uint_as_float(ow[j] << 16); o[2 * j + 1] = __uint_as_float(ow[j] & 0xffff0000u); r[2 * j] = __uint_as_float(rw[j] << 16); r[2 * j + 1] = __uint_as_float(rw[j] & 0xffff0000u); }
#pragma unroll
        for (int j = 0; j < 8; ++j) s += o[j] * o[j];
        s += __shfl_xor(s, 1); s += __shfl_xor(s, 2); s += __shfl_xor(s, 4); s += __shfl_xor(s, 8);
        const float rs = rsqrtf(s * (1.f / 128.f) + EPS);
        u32x4 w; float y[8];
#pragma unroll
        for (int j = 0; j < 8; ++j) y[j] = o[j] * rs * gv[j] * siluf(r[j]);
        w.x = pk2(y[0], y[1]); w.y = pk2(y[2], y[3]); w.z = pk2(y[4], y[5]); w.w = pk2(y[6], y[7]);
        *(u32x4*)(Y + (size_t)m * 1024 + 8 * lane) = w;
    }
}
DEV void phase4(const Params& P) {
    unsigned char* ws = P.ws; const int gw = blockIdx.x * NWAVE + (threadIdx.x >> 6), ngw = gridDim.x * NWAVE;
    const bf16_t* Y = (const bf16_t*)(ws + WS_Y); const bf16_t* W = (const bf16_t*)(ws + WS_WOUT); float* H2 = (float*)(ws + WS_H2); const float* x = P.in[I_X];
    gemm_simple(M / 64, D / 64, D, [&](int r) { return Y + (size_t)r * D; }, [&](int c) { return W + (size_t)c * D; },
                [&](int row, int col, float v) { H2[(size_t)row * D + col] = x[(size_t)row * D + col] + v; }, gw, ngw);
}
DEV void phase5(const Params& P, float* scr_all) {
    unsigned char* ws = P.ws; const int lane = threadIdx.x & 63, wave = threadIdx.x >> 6; const int gw = blockIdx.x * NWAVE + wave, ngw = gridDim.x * NWAVE;
    float* trow = scr_all + wave * 4096;
    const float* H2 = (const float*)(ws + WS_H2); bf16_t* TN = (bf16_t*)(ws + WS_TN); const float* g = P.in[I_FFN];
    const float* wg = P.in[I_RGW]; const float* bg = P.in[I_RGB]; const float* we = P.in[I_REW]; const float* be = P.in[I_REB];
    int* cnt = (int*)(ws + WS_CTL) + CW_CNT; int* tokE = (int*)(ws + WS_TOK); int* tokR = tokE + 2 * M; float* tokG = (float*)(tokR + 2 * M); int* list = (int*)(ws + WS_LIST);
    f32x4 gv[4];
#pragma unroll
    for (int j = 0; j < 4; ++j) gv[j] = *(const f32x4*)(g + 256 * j + 4 * lane);
    for (int m0 = gw * 4; m0 < M; m0 += ngw * 4) {
#pragma unroll
        for (int q = 0; q < 4; ++q) { const int m = m0 + q; const f32x4* hr = (const f32x4*)(H2 + (size_t)m * D) + lane; f32x4 v[4]; float s = 0.f;
#pragma unroll
            for (int j = 0; j < 4; ++j) { v[j] = hr[64 * j]; s += (v[j].x * v[j].x + v[j].y * v[j].y) + (v[j].z * v[j].z + v[j].w * v[j].w); }
            const float rs = rsqrtf(wave_sum(s) * (1.f / D) + EPS);
            unsigned long long* o8 = (unsigned long long*)(TN + (size_t)m * D) + lane;
#pragma unroll
            for (int j = 0; j < 4; ++j) { const f32x4 t = {v[j].x * rs * gv[j].x, v[j].y * rs * gv[j].y, v[j].z * rs * gv[j].z, v[j].w * rs * gv[j].w};
                *(f32x4*)(trow + q * 1024 + 256 * j + 4 * lane) = t;
                o8[64 * j] = (unsigned long long)pk2(t.x, t.y) | ((unsigned long long)pk2(t.z, t.w) << 32); } }
        __builtin_amdgcn_s_waitcnt(0xc07f); asm volatile("" ::: "memory");
        float ae[4] = {0.f, 0.f, 0.f, 0.f}, ag[4] = {0.f, 0.f, 0.f, 0.f};
        for (int k = 0; k < D; ++k) { const float w = we[k * 64 + lane];
#pragma unroll
            for (int q = 0; q < 4; ++q) ae[q] += trow[q * 1024 + k] * w; }
        for (int k8 = 0; k8 < D / 8; ++k8) { const int k = k8 * 8 + (lane >> 3); const float w = wg[k * 8 + (lane & 7)];
#pragma unroll
            for (int q = 0; q < 4; ++q) ag[q] += trow[q * 1024 + k] * w; }
#pragma unroll
        for (int q = 0; q < 4; ++q) { ag[q] += __shfl_xor(ag[q], 8); ag[q] += __shfl_xor(ag[q], 16); ag[q] += __shfl_xor(ag[q], 32); ag[q] += bg[lane & 7]; ae[q] += be[lane]; }
#pragma unroll
        for (int q = 0; q < 4; ++q) { const int m = m0 + q;
            float gl[8]; float gmx = -INFINITY; int gi = 0;
#pragma unroll
            for (int i = 0; i < 8; ++i) { gl[i] = __shfl(ag[q], i); if (gl[i] > gmx) { gmx = gl[i]; gi = i; } }
            float gs = 0.f;
#pragma unroll
            for (int i = 0; i < 8; ++i) gs += __expf(gl[i] - gmx);
            const float gp = 1.f / gs;
            float el[8]; float emx = -INFINITY; int e0 = 0;
#pragma unroll
            for (int i = 0; i < 8; ++i) { el[i] = __shfl(ae[q], gi * 8 + i); if (el[i] > emx) { emx = el[i]; e0 = i; } }
            float em2 = -INFINITY; int e1 = 0;
#pragma unroll
            for (int i = 0; i < 8; ++i) if (i != e0 && el[i] > em2) { em2 = el[i]; e1 = i; }
            const float p0 = 1.f, p1 = __expf(em2 - emx); const float g0 = gp * p0 / (p0 + p1), g1 = gp * p1 / (p0 + p1);
            if (lane == 0) { const int E0 = gi * 8 + e0, E1 = gi * 8 + e1; const int r0 = atomicAdd(cnt + E0, 1), r1 = atomicAdd(cnt + E1, 1);
                tokE[2 * m] = E0; tokE[2 * m + 1] = E1; tokR[2 * m] = r0; tokR[2 * m + 1] = r1; tokG[2 * m] = g0; tokG[2 * m + 1] = g1;
                list[(size_t)E0 * M + r0] = m; list[(size_t)E1 * M + r1] = m; } }
        __builtin_amdgcn_s_waitcnt(0xc07f); asm volatile("" ::: "memory");
    }
}
DEV int slot_start_lane(const int* cnt, int lane, int& c_out, int& total) {
    const int c = cnt[lane]; const int pad = (c + 255) & ~255; int inc = pad;
#pragma unroll
    for (int o = 1; o < 64; o <<= 1) { const int t = __shfl_up(inc, o); if (lane >= o) inc += t; }
    total = __shfl(inc, 63); c_out = c; return inc - pad;
}
DEV void phase6(const Params& P) {
    unsigned char* ws = P.ws; const int lane = threadIdx.x & 63, r32 = lane & 31, hi = lane >> 5; const int gw = blockIdx.x * NWAVE + (threadIdx.x >> 6), ngw = gridDim.x * NWAVE;
    const bf16_t* TN = (const bf16_t*)(ws + WS_TN); const bf16_t* W = (const bf16_t*)(ws + WS_WGU); bf16_t* MH = (bf16_t*)(ws + WS_MH);
    const int* cnt = (const int*)(ws + WS_CTL) + CW_CNT; const int* list = (const int*)(ws + WS_LIST);
    int c_l, total; const int st_l = slot_start_lane(cnt, lane, c_l, total);
    const int Nt = 1024 / 64, nrt = total / 64;
    for (int it = gw; it < nrt * Nt; it += ngw) { const int T = it / Nt, tn = it % Nt;
        const unsigned long long bal = __ballot(st_l <= T * 64); const int e = 63 - __builtin_clzll(bal);
        const int st = __shfl(st_l, e), c = __shfl(c_l, e); const int lr = T * 64 - st;
        if (lr >= c) continue;
        const int ra = lr + r32, rb = lr + 32 + r32;
        const int ta = ra < c ? list[(size_t)e * M + ra] : 0, tb = rb < c ? list[(size_t)e * M + rb] : 0;
        const bf16_t* We = W + (size_t)e * 1024 * 1024;
        f32x16 c00 = {}, c01 = {}, c10 = {}, c11 = {};
        wave_tile(TN + (size_t)ta * D + hi * 8, TN + (size_t)tb * D + hi * 8, We + (size_t)(tn * 64 + r32) * D + hi * 8, We + (size_t)(tn * 64 + 32 + r32) * D + hi * 8, D, c00, c01, c10, c11);
#pragma unroll
        for (int r = 0; r < 16; ++r) {
#pragma unroll
            for (int q = 0; q < 4; ++q) { const float v = (q == 0) ? c00[r] : (q == 1) ? c01[r] : (q == 2) ? c10[r] : c11[r];
                const float u = __shfl_down(v, 4); const int row = T * 64 + (q >> 1) * 32 + crow(r, hi), col = tn * 64 + (q & 1) * 32 + r32;
                if ((col & 4) == 0) MH[(size_t)row * DE + (col >> 3) * 4 + (col & 3)] = (bf16_t)f2bf(siluf(v) * u); }
        }
    }
}
DEV void phase7(const Params& P) {
    unsigned char* ws = P.ws; const int lane = threadIdx.x & 63, r32 = lane & 31, hi = lane >> 5; const int gw = blockIdx.x * NWAVE + (threadIdx.x >> 6), ngw = gridDim.x * NWAVE;
    const bf16_t* MH = (const bf16_t*)(ws + WS_MH); const bf16_t* W = (const bf16_t*)(ws + WS_WD); bf16_t* MY = (bf16_t*)(ws + WS_MY);
    const int* cnt = (const int*)(ws + WS_CTL) + CW_CNT;
    int c_l, total; const int st_l = slot_start_lane(cnt, lane, c_l, total);
    const int Nt = 1024 / 64, nrt = total / 64;
    for (int it = gw; it < nrt * Nt; it += ngw) { const int T = it / Nt, tn = it % Nt;
        const unsigned long long bal = __ballot(st_l <= T * 64); const int e = 63 - __builtin_clzll(bal);
        const int st = __shfl(st_l, e), c = __shfl(c_l, e); const int lr = T * 64 - st;
        if (lr >= c) continue;
        const bf16_t* We = W + (size_t)e * 1024 * 512;
        f32x16 c00 = {}, c01 = {}, c10 = {}, c11 = {};
        wave_tile(MH + (size_t)(T * 64 + r32) * DE + hi * 8, MH + (size_t)(T * 64 + 32 + r32) * DE + hi * 8, We + (size_t)(tn * 64 + r32) * DE + hi * 8, We + (size_t)(tn * 64 + 32 + r32) * DE + hi * 8, DE, c00, c01, c10, c11);
#pragma unroll
        for (int r = 0; r < 16; ++r) { const int row = T * 64 + crow(r, hi), col = tn * 64 + r32;
            MY[(size_t)row * D + col] = (bf16_t)f2bf(c00[r]); MY[(size_t)row * D + col + 32] = (bf16_t)f2bf(c01[r]);
            MY[(size_t)(row + 32) * D + col] = (bf16_t)f2bf(c10[r]); MY[(size_t)(row + 32) * D + col + 32] = (bf16_t)f2bf(c11[r]); }
    }
}
DEV void phase8(const Params& P) {
    unsigned char* ws = P.ws; const int lane = threadIdx.x & 63; const int gw = blockIdx.x * NWAVE + (threadIdx.x >> 6), ngw = gridDim.x * NWAVE;
    const float* H2 = (const float*)(ws + WS_H2); const bf16_t* MY = (const bf16_t*)(ws + WS_MY); const float* g = P.in[I_FINAL];
    const int* cnt = (const int*)(ws + WS_CTL) + CW_CNT; const int* tokE = (const int*)(ws + WS_TOK); const int* tokR = tokE + 2 * M; const float* tokG = (const float*)(tokR + 2 * M);
    int c_l, total; const int st_l = slot_start_lane(cnt, lane, c_l, total);
    f32x4 gv[4];
#pragma unroll
    for (int j = 0; j < 4; ++j) gv[j] = *(const f32x4*)(g + 256 * j + 4 * lane);
    for (int m = gw; m < M; m += ngw) {
        const int E0 = tokE[2 * m], E1 = tokE[2 * m + 1]; const size_t s0 = (size_t)__shfl(st_l, E0) + tokR[2 * m], s1 = (size_t)__shfl(st_l, E1) + tokR[2 * m + 1]; const float g0 = tokG[2 * m], g1 = tokG[2 * m + 1];
        const f32x4* hr = (const f32x4*)(H2 + (size_t)m * D) + lane; const u32x2* y0 = (const u32x2*)(MY + s0 * D) + lane; const u32x2* y1 = (const u32x2*)(MY + s1 * D) + lane;
        f32x4 v[4]; float s = 0.f;
#pragma unroll
        for (int j = 0; j < 4; ++j) { v[j] = hr[64 * j]; const u32x2 a = y0[64 * j], b = y1[64 * j];
            v[j].x += g0 * __uint_as_float(a.x << 16) + g1 * __uint_as_float(b.x << 16); v[j].y += g0 * __uint_as_float(a.x & 0xffff0000u) + g1 * __uint_as_float(b.x & 0xffff0000u);
            v[j].z += g0 * __uint_as_float(a.y << 16) + g1 * __uint_as_float(b.y << 16); v[j].w += g0 * __uint_as_float(a.y & 0xffff0000u) + g1 * __uint_as_float(b.y & 0xffff0000u);
            s += (v[j].x * v[j].x + v[j].y * v[j].y) + (v[j].z * v[j].z + v[j].w * v[j].w); }
        const float rs = rsqrtf(wave_sum(s) * (1.f / D) + EPS);
        f32x4* orow = (f32x4*)(P.out + (size_t)m * D) + lane;
#pragma unroll
        for (int j = 0; j < 4; ++j) orow[64 * j] = (f32x4){v[j].x * rs * gv[j].x, v[j].y * rs * gv[j].y, v[j].z * rs * gv[j].z, v[j].w * rs * gv[j].w};
    }
}

template <int PH> __global__ void __launch_bounds__(NT) phase_kernel(Params P) {
    __shared__ __attribute__((aligned(16))) float scr[NWAVE * 4096];
    if (PH == 0) phase0(P, scr);
    if (PH == 1) phase1(P);
    if (PH == 2) phase2a(P);
    if (PH == 3) phase2b(P);
    if (PH == 4) { gla_simple(P); mla_simple(P); }
    if (PH == 5) phase3b(P);
    if (PH == 6) phase4(P);
    if (PH == 7) phase5(P, scr);
    if (PH == 8) phase6(P);
    if (PH == 9) phase7(P);
    if (PH == 10) phase8(P);
}

extern "C" void kernel_launch(void* const* d_in, const int* in_sizes, int n_in, void* d_out, int out_size, void* d_ws, size_t ws_size, hipStream_t stream) {
    if (n_in != 21 || out_size != M * D || ws_size < WS_END) { fprintf(stderr, "kernel_launch: unexpected shapes (n_in %d out %d ws %zu)\n", n_in, out_size, ws_size); return; }
    Params P{};
    for (int i = 0; i < 21; ++i) P.in[i] = (const float*)d_in[i];
    P.out = (float*)d_out; P.ws = (unsigned char*)d_ws;
    hipMemsetAsync((char*)d_ws + WS_CTL, 0, 1 * MiB, stream);
    phase_kernel<0><<<GRID, NT, 0, stream>>>(P);
    phase_kernel<1><<<GRID, NT, 0, stream>>>(P);
    phase_kernel<2><<<GRID, NT, 0, stream>>>(P);
    phase_kernel<3><<<GRID, NT, 0, stream>>>(P);
    phase_kernel<4><<<GRID, NT, 0, stream>>>(P);
    phase_kernel<5><<<GRID, NT, 0, stream>>>(P);
    phase_kernel<6><<<GRID, NT, 0, stream>>>(P);
    phase_kernel<7><<<GRID, NT, 0, stream>>>(P);
    phase_kernel<8><<<GRID, NT, 0, stream>>>(P);
    phase_kernel<9><<<GRID, NT, 0, stream>>>(P);
    phase_kernel<10><<<GRID, NT, 0, stream>>>(P);
}
```

```cpp
#include <hip/hip_runtime.h>
#include <hip/hip_cooperative_groups.h>
namespace cg = cooperative_groups;
#include <cstdio>
#include <cstdint>

#ifndef MLA8
#ifndef XCONV_P3
#define XCONV_P3 1
#endif
#ifndef XCONV_SEL
#define XCONV_SEL 1
#endif
#ifndef PINGPONG
#define PINGPONG 0
#endif
#ifndef SM2
#define SM2 0
#endif
#define MLA8 1
#endif
#define DEV __device__ __forceinline__
typedef unsigned short bf16_t;
typedef short bf16x8 __attribute__((ext_vector_type(8)));
typedef float f32x16 __attribute__((ext_vector_type(16)));
typedef float f32x4 __attribute__((ext_vector_type(4)));
typedef unsigned u32x4 __attribute__((ext_vector_type(4)));
typedef unsigned u32x2 __attribute__((ext_vector_type(2)));

constexpr int NB = 16, SEQ = 4096, M = NB * SEQ, D = 1024, NMETA = 16;
constexpr int NZ = 2048;
constexpr int ZQ = 0, ZK = 256, ZV = 512, ZR = 1024, ZQL = 1536, ZKVL = 1792, ZKR = 1920, ZAL = 1984;
constexpr int NE = 64, DE = 512;
constexpr float EPS = 1e-6f;
constexpr int NT = 512, NWAVE = 8, GRID = 256;
constexpr int SLOT_CAP = 151552;

constexpr size_t MiB = 1ull << 20;
constexpr size_t WS_CTL = 0;
constexpr size_t WS_WIN = 1 * MiB;
constexpr size_t WS_WQ = 5 * MiB;
constexpr size_t WS_WK = 5 * MiB + 512 * 1024;
constexpr size_t WS_WV = 5 * MiB + 768 * 1024;
constexpr size_t WS_WOUT = 6 * MiB;
constexpr size_t WS_ROPE = 8 * MiB;
constexpr size_t WS_META = 10 * MiB;
constexpr size_t WS_RS = 11 * MiB;
constexpr size_t WS_WR = 11 * MiB + 512 * 1024;
constexpr size_t WS_WA2T = 11 * MiB + 768 * 1024;
constexpr size_t WS_TOK = 12 * MiB;
constexpr size_t WS_WGU = 16 * MiB;
constexpr size_t WS_WD = 144 * MiB;
constexpr size_t WS_R1 = 208 * MiB;
constexpr size_t WS_QM = WS_R1, WS_KN = WS_R1 + 96 * MiB, WS_VT = WS_R1 + 160 * MiB, WS_KR = WS_R1 + 224 * MiB;
constexpr size_t WS_H2 = WS_R1;
constexpr size_t WS_D16 = WS_R1, WS_H2B = WS_R1 + 128 * MiB;
constexpr size_t WS_R2 = 464 * MiB;
constexpr size_t WS_XN = WS_R2, WS_Y = WS_R2, WS_TN = WS_R2, WS_MY = WS_R2;
constexpr size_t WS_LOGA = 592 * MiB;
constexpr size_t WS_TN8 = 592 * MiB;
constexpr size_t WS_VTG = 656 * MiB;
constexpr size_t WS_MH = 760 * MiB;
constexpr size_t WS_LIST = 908 * MiB;
constexpr size_t WS_END = 924 * MiB;
constexpr size_t MT_Z = 0;
constexpr size_t MT_KN = 128 * 1024;
constexpr size_t MT_VT = 160 * 1024;
constexpr size_t MT_KR = 192 * 1024;
constexpr size_t MT_S1 = 256 * 1024;
constexpr size_t MT_KN8 = 640 * 1024, MT_VT8 = 672 * 1024, MT_KR8 = 704 * 1024;
constexpr int CW_CNT = 0;
constexpr int CW_MLAQ = 64;
constexpr int CW_BAR = 16384;
constexpr size_t CTL_MZ = 768 * 1024, CTL_RSM = 896 * 1024;
constexpr size_t CTL_SSQ_Q = 256 * 1024, CTL_SSQ_KV = 512 * 1024;

struct Params { const float* in[21]; float* out; unsigned char* ws; };
enum { I_X = 0, I_META, I_MIXN, I_WIN, I_WA2, I_BA, I_GOUTN, I_QN, I_WQB, I_KVN, I_WKVB, I_WOUT, I_FFN, I_RGW, I_RGB, I_REW, I_REB, I_WG, I_WU, I_WDN, I_FINAL };

DEV unsigned pk2(float lo, float hi) { unsigned r; asm("v_cvt_pk_bf16_f32 %0, %1, %2" : "=v"(r) : "v"(lo), "v"(hi)); return r; }
typedef float f32x2_t __attribute__((ext_vector_type(2))); typedef __bf16 bf16x2_t __attribute__((ext_vector_type(2)));
DEV unsigned pk2_mfma(float lo, float hi) { const f32x2_t v = {lo, hi}; const bf16x2_t b = __builtin_convertvector(v, bf16x2_t); return __builtin_bit_cast(unsigned, b); }
DEV unsigned f2bf(float f) { return pk2(f, 0.f) & 0xffffu; }
DEV float bf2f(unsigned h) { return __uint_as_float(h << 16); }
template <int CTRL> DEV float dpp_f(float v) { return __int_as_float(__builtin_amdgcn_mov_dpp(__float_as_int(v), CTRL, 0xf, 0xf, true)); }
template <int K> DEV float sx(float v) {
    if constexpr (K == 1) return dpp_f<0xB1>(v);
    else if constexpr (K == 2) return dpp_f<0x4E>(v);
    else return __int_as_float(__builtin_amdgcn_ds_swizzle(__float_as_int(v), 0x1f | (K << 10)));
}
DEV float half_sum(float v) { auto rr = __builtin_amdgcn_permlane32_swap(__float_as_uint(v), __float_as_uint(v), false, false); return __uint_as_float(rr[0]) + __uint_as_float(rr[1]); }
DEV float half_max(float v) { auto rr = __builtin_amdgcn_permlane32_swap(__float_as_uint(v), __float_as_uint(v), false, false); return fmaxf(__uint_as_float(rr[0]), __uint_as_float(rr[1])); }
DEV float wave_sum(float v) { v += sx<1>(v); v += sx<2>(v); v += sx<4>(v); v += sx<8>(v); v += sx<16>(v); return half_sum(v); }
DEV int rl_i(int v, int l) { return __builtin_amdgcn_readlane(v, l); }
DEV float rl_f(float v, int l) { return __int_as_float(__builtin_amdgcn_readlane(__float_as_int(v), l)); }
constexpr unsigned TIDMAP_OFF = 131072u + 64u;
constexpr unsigned SLOTTAB_OFF = TIDMAP_OFF + 256u;
DEV unsigned hw_wave_key() { return (unsigned)__builtin_amdgcn_s_getreg((5 << 11) | 4) & 63u; }
DEV int tid_fresh() { const unsigned w = *(volatile __attribute__((address_space(3))) unsigned*)(TIDMAP_OFF + 4u * hw_wave_key());
    unsigned l; asm volatile("v_mbcnt_lo_u32_b32 %0, -1, 0\n\tv_mbcnt_hi_u32_b32 %0, -1, %0" : "=v"(l));
    int t = (int)(w * 64u + l); asm volatile("" : "+v"(t)); return t; }
DEV int crow(int r, int hi) { return (r & 3) + 8 * (r >> 2) + 4 * hi; }
DEV int pi23(int i) { return (i & ~12) | ((i & 4) << 1) | ((i & 8) >> 1); }
DEV float logsigmoidf(float x) { return fminf(x, 0.f) - log1pf(__expf(-fabsf(x))); }
DEV float siluf(float x) { return x * __builtin_amdgcn_rcpf(1.f + __expf(-x)); }

DEV void wave_tile(const bf16_t* a0, const bf16_t* a1, const bf16_t* b0, const bf16_t* b1, int K, f32x16& c00, f32x16& c01, f32x16& c10, f32x16& c11) {
    for (int k = 0; k < K; k += 16) {
        const bf16x8 A0 = *(const bf16x8*)(a0 + k), A1 = *(const bf16x8*)(a1 + k), B0 = *(const bf16x8*)(b0 + k), B1 = *(const bf16x8*)(b1 + k);
        c00 = __builtin_amdgcn_mfma_f32_32x32x16_bf16(A0, B0, c00, 0, 0, 0);
        c01 = __builtin_amdgcn_mfma_f32_32x32x16_bf16(A0, B1, c01, 0, 0, 0);
        c10 = __builtin_amdgcn_mfma_f32_32x32x16_bf16(A1, B0, c10, 0, 0, 0);
        c11 = __builtin_amdgcn_mfma_f32_32x32x16_bf16(A1, B1, c11, 0, 0, 0);
    }
}
template <class AF, class BF, class EF>
DEV void gemm_simple(int Mt, int Nt, int K, AF arow, BF brow, EF epi, int gw, int ngw) { const int tid_ = tid_fresh();
    const int lane = tid_ & 63, r32 = lane & 31, hi = lane >> 5;
    for (int it = gw; it < Mt * Nt; it += ngw) {
        const int tm = it / Nt, tn = it % Nt;
        f32x16 c00 = {}, c01 = {}, c10 = {}, c11 = {};
        wave_tile(arow(tm * 64 + r32) + hi * 8, arow(tm * 64 + 32 + r32) + hi * 8, brow(tn * 64 + r32) + hi * 8, brow(tn * 64 + 32 + r32) + hi * 8, K, c00, c01, c10, c11);
#pragma unroll
        for (int r = 0; r < 16; ++r) {
            const int row = tm * 64 + crow(r, hi), col = tn * 64 + r32;
            epi(row, col, c00[r]); epi(row, col + 32, c01[r]); epi(row + 32, col, c10[r]); epi(row + 32, col + 32, c11[r]);
        }
    }
}


#define LAS __attribute__((address_space(3)))
namespace g8 {
constexpr int BM = 256, BK = 64, HALF = 128, HTB = HALF * BK * 2, STAGE_BYTES = 8 * HTB, NXCD = 8, WGM = 8;
DEV int lds_byte(int r, int c) { const int st = (r >> 4) * 2 + (c >> 5), rr = r & 15, cc = c & 31, ob = rr * 64 + cc * 2; return st * 1024 + (ob ^ (((ob >> 9) & 1) << 5)); }
DEV void stage_rc(int b, int& R, int& C) { const int st = b / 1024, sb = b % 1024, swz = sb ^ (((sb >> 9) & 1) << 5); R = (st >> 1) * 16 + swz / 64; C = (st & 1) * 32 + (swz % 64) / 2; }
DEV int perm32(int rho) { const int n = rho >> 4, i = rho & 15; return 8 * (i >> 2) + 4 * n + (i & 3); }
struct Unit { int pm, pn, e; };
typedef f32x4 Acc[2][2][4][2];
typedef int i32x8 __attribute__((ext_vector_type(8)));
typedef int i32x4 __attribute__((ext_vector_type(4)));
DEV f32x4 mfma_any(i32x8 a, i32x8 b, f32x4 c) { return __builtin_amdgcn_mfma_scale_f32_16x16x128_f8f6f4(a, b, c, 0, 0, 0, 0x7f7f7f7f, 0, 0x7f7f7f7f); }
DEV f32x4 mfma_any(bf16x8 a, bf16x8 b, f32x4 c) { return __builtin_amdgcn_mfma_f32_16x16x32_bf16(a, b, c, 0, 0, 0); }
template <bool F8> struct FragSel { typedef bf16x8 T; };
template <> struct FragSel<true> { typedef i32x8 T; };
template <class Epi, class Sched, bool GATHER, bool F8 = false>
DEV void gemm_phase(LAS unsigned char* lds, const int K, const int lda, const int ldb, const Sched& S, const Epi& E) { const int tid_ = tid_fresh();
    const int tid = tid_, wid = __builtin_amdgcn_readfirstlane(tid >> 6), lane = tid & 63, wr = wid >> 2, wc = wid & 3, fr = lane & 15, fq = lane >> 4;
    const int nt = K / BK;
    unsigned voffB, vC0;
    unsigned tkC0 = 0u, tkC1 = 0u, tkN0 = 0u, tkN1 = 0u, cbA = 0u;
    { int R, C; stage_rc(tid * 16, R, C); const int Rb = Epi::PERM ? ((R & ~31) + perm32(R & 31)) : R;
      voffB = (unsigned)(Rb * ldb + C) * 2u; vC0 = (unsigned)(R * lda + C) * 2u; cbA = (unsigned)C * 2u; }
    const unsigned pstepA = (unsigned)(64 * lda * 2), pstepB = (unsigned)(64 * ldb * 2);
    const unsigned kstep = (unsigned)(BK * 2), hstepB = (unsigned)(HALF * ldb * 2), hA = GATHER ? 0u : (unsigned)(HALF * lda * 2);
    const __amdgpu_buffer_rsrc_t rA = __builtin_amdgcn_make_buffer_rsrc((void*)S.A, 0, 0x7ffffff0, 0x00020000), rB = __builtin_amdgcn_make_buffer_rsrc((void*)S.B, 0, 0x7ffffff0, 0x00020000);
    const unsigned ldsw = (unsigned)wid * 1024u;
    int aoff = lds_byte(wr * 64 + fr, F8 ? fq * 16 : fq * 8), boff = lds_byte(wc * 32 + fr, F8 ? fq * 16 : fq * 8) + 4 * HTB;
    asm volatile("" : "+v"(aoff), "+v"(boff));
#define G8_SA(b, h) (((b) * 2 + (h)) * HTB)
#define G8_SB(b, h) ((4 + (b) * 2 + (h)) * HTB)
#define G8_SBR(b, h) (((b) * 2 + (h)) * HTB)
#define G8_STAGE1(bufoff, rs, soff, voff, i) __builtin_amdgcn_raw_ptr_buffer_load_lds(rs, (LAS void*)(lds + (bufoff) + ldsw + (i) * 8192), 16, (int)(voff), (int)(soff), 0, 0)
#define G8_STAGE_B(bufoff, soff) do { G8_STAGE1(bufoff, rB, soff, voffB, 0); G8_STAGE1(bufoff, rB, (soff) + pstepB, voffB, 1); } while (0)
#define G8_LDA(dst, b, h) do { _Pragma("unroll") for (int m = 0; m < 4; ++m) _Pragma("unroll") for (int k = 0; k < NK; ++k) dst[m][k] = *(const LAS FragT*)(lds + aoff + (G8_SA(b, h) + m * 2048 + k * 1024)); } while (0)
#define G8_LDB(dst, b, h) do { _Pragma("unroll") for (int n = 0; n < 2; ++n) _Pragma("unroll") for (int k = 0; k < NK; ++k) dst[n][k] = *(const LAS FragT*)(lds + boff + (G8_SBR(b, h) + n * 2048 + k * 1024)); } while (0)
#define G8_MMA(ai, bj, At, Bt) do { __builtin_amdgcn_s_setprio(1); _Pragma("unroll") for (int m = 0; m < 4; ++m) _Pragma("unroll") for (int n = 0; n < 2; ++n) { \
        _Pragma("unroll") for (int k = 0; k < NK; ++k) acc[ai][bj][m][n] = mfma_any(Bt[n][k], At[m][k], acc[ai][bj][m][n]); } \
        __builtin_amdgcn_s_setprio(0); } while (0)
#define G8_WAIT_V(n) asm volatile("s_waitcnt vmcnt(" #n ")" ::: "memory")
#define G8_WAIT_L(n) asm volatile("s_waitcnt lgkmcnt(" #n ")" ::: "memory")
#define G8_BAR __builtin_amdgcn_s_barrier()
#define G8_SCHED __builtin_amdgcn_sched_barrier(0)
#define G8_AOFF(d0, d1, u) do { const int _t = tid_fresh(); int _R, _C; stage_rc(_t * 16, _R, _C); \
        d0 = (S.atok(u, _R) & 0xffffu) | (S.atok(u, _R + 64) << 16); d1 = (S.atok(u, HALF + _R) & 0xffffu) | (S.atok(u, HALF + _R + 64) << 16); } while (0)
#define G8_STAGE_A(bufoff, soff, tk) do { if constexpr (GATHER) { G8_STAGE1(bufoff, rA, soff, ((tk) & 0xffffu) * (unsigned)S.lda2 + cbA, 0); G8_STAGE1(bufoff, rA, soff, ((tk) >> 16) * (unsigned)S.lda2 + cbA, 1); } \
        else { G8_STAGE1(bufoff, rA, soff, vC0, 0); G8_STAGE1(bufoff, rA, (soff) + pstepA, vC0, 1); } } while (0)
    Unit cur, nxt; int ui = 0;
    if (!S.next(0, cur)) return;
    Acc acc;
#pragma unroll
    for (int a = 0; a < 2; ++a)
#pragma unroll
        for (int b = 0; b < 2; ++b)
#pragma unroll
            for (int m = 0; m < 4; ++m)
#pragma unroll
                for (int n = 0; n < 2; ++n) acc[a][b][m][n] = (f32x4){0.f, 0.f, 0.f, 0.f};
    typedef typename FragSel<F8>::T FragT; constexpr int NK = F8 ? 1 : 2;
    FragT At[4][NK], B0[2][NK], B1[2][NK];
    unsigned cA = S.aoff(cur), cB = S.boff(cur);
    if (GATHER) { G8_AOFF(tkC0, tkC1, cur); }
    G8_STAGE_B(G8_SB(0, 0), cB); G8_STAGE_B(G8_SB(0, 1), cB + hstepB); G8_STAGE_A(G8_SA(0, 0), cA, tkC0); G8_STAGE_A(G8_SA(0, 1), cA + hA, tkC1);
    if (wr == 1) G8_BAR;
    G8_WAIT_V(2); G8_BAR;
    G8_STAGE_B(G8_SB(1, 0), cB + kstep); G8_STAGE_A(G8_SA(1, 0), cA + kstep, tkC0); G8_STAGE_B(G8_SB(1, 1), cB + hstepB + kstep);
    G8_WAIT_V(6); G8_BAR;
    for (;;) {
        const bool has_next = S.next(ui + 1, nxt);
        const unsigned nA = has_next ? S.aoff(nxt) : cA, nB = has_next ? S.boff(nxt) : cB;
#pragma unroll 1
        for (int t = 0; t < nt; t += 2) {
            const bool last = (t == nt - 2);
            if (GATHER && t == (nt >= 4 ? nt - 4 : 0)) {
                if (has_next) { G8_AOFF(tkN0, tkN1, nxt); } else { tkN0 = tkC0; tkN1 = tkC1; } }
            const unsigned a1 = cA + (unsigned)(t + 1) * kstep;
            const unsigned a2 = last ? nA : cA + (unsigned)(t + 2) * kstep, b2 = last ? nB : cB + (unsigned)(t + 2) * kstep;
            const unsigned a3 = a2 + kstep, b3 = b2 + kstep;
            const unsigned s0 = (GATHER && last) ? tkN0 : tkC0, s1 = (GATHER && last) ? tkN1 : tkC1;
            G8_LDB(B0, 0, 0); G8_LDB(B1, 0, 1); G8_SCHED; G8_LDA(At, 0, 0); G8_STAGE_A(G8_SA(1, 1), a1 + hA, tkC1);
            G8_WAIT_V(8); G8_WAIT_L(0); G8_BAR; G8_MMA(0, 0, At, B0); G8_MMA(0, 1, At, B1); G8_BAR; G8_SCHED;
            G8_LDA(At, 0, 1); G8_STAGE_B(G8_SB(0, 0), b2); G8_STAGE_B(G8_SB(0, 1), b2 + hstepB); G8_STAGE_A(G8_SA(0, 0), a2, s0);
            G8_WAIT_V(8); G8_WAIT_L(0); G8_BAR; G8_MMA(1, 0, At, B0); G8_MMA(1, 1, At, B1); G8_BAR; G8_SCHED;
            G8_LDB(B0, 1, 0); G8_LDB(B1, 1, 1); G8_SCHED; G8_LDA(At, 1, 0); G8_STAGE_A(G8_SA(0, 1), a2 + hA, s1);
            G8_WAIT_V(8); G8_WAIT_L(0); G8_BAR; G8_MMA(0, 0, At, B0); G8_MMA(0, 1, At, B1); G8_BAR; G8_SCHED;
            G8_LDA(At, 1, 1); G8_STAGE_B(G8_SB(1, 0), b3); G8_STAGE_B(G8_SB(1, 1), b3 + hstepB); G8_STAGE_A(G8_SA(1, 0), a3, s0);
            G8_WAIT_V(8); G8_WAIT_L(0); G8_BAR; G8_MMA(1, 0, At, B0); G8_MMA(1, 1, At, B1); G8_BAR; G8_SCHED;
        }
        if (wr == 0) G8_BAR;
        { const int te_ = tid_fresh(); E(acc, cur, wr, wc, te_ & 15, (te_ >> 4) & 3); }
        if (!has_next) break;
#pragma unroll
        for (int a = 0; a < 2; ++a)
#pragma unroll
            for (int b = 0; b < 2; ++b)
#pragma unroll
                for (int m = 0; m < 4; ++m)
#pragma unroll
                    for (int n = 0; n < 2; ++n) acc[a][b][m][n] = (f32x4){0.f, 0.f, 0.f, 0.f};
        cur = nxt; cA = nA; cB = nB; ++ui;
        if (GATHER) { tkC0 = tkN0; tkC1 = tkN1; }
        if (wr == 1) G8_BAR;
    }
    G8_WAIT_V(0);
    G8_BAR;
}
struct DenseSched {
    const char* A; const char* B; size_t tstepA, tstepB; int nM, nN, nwg, G, c;
    DEV void init(const void* A_, int lda, const void* B_, int ldb, int Mr, int Nc, int G_, int c_) { A = (const char*)A_; B = (const char*)B_; tstepA = (size_t)BM * lda * 2; tstepB = (size_t)BM * ldb * 2;
        nM = Mr / BM; nN = Nc / BM; nwg = nM * nN; G = G_; c = c_; }
    DEV bool next(int i, Unit& u) const {
        const long L = (long)i * G + c; if (L >= nwg) return false;
        int wgid = (int)L; { const int q = nwg / NXCD, r = nwg % NXCD, xcd = wgid % NXCD, off = wgid / NXCD; wgid = (xcd < r ? xcd * (q + 1) : r * (q + 1) + (xcd - r) * q) + off; }
        const int nig = WGM * nN, gid = wgid / nig, fm = gid * WGM, gsz = (nM - fm) < WGM ? (nM - fm) : WGM;
        u.pm = fm + ((wgid % nig) % gsz); u.pn = (wgid % nig) / gsz; u.e = 0; return true;
    }
    DEV unsigned aoff(const Unit& u) const { return (unsigned)((size_t)u.pm * tstepA); }
    DEV unsigned boff(const Unit& u) const { return (unsigned)((size_t)u.pn * tstepB); }
    DEV unsigned atok(const Unit&, int) const { return 0u; }
    static constexpr int lda2 = 0;
};
DEV unsigned cvt_pk_bf16(float lo, float hi) { unsigned r; asm volatile("v_cvt_pk_bf16_f32 %0, %1, %2" : "=v"(r) : "v"(lo), "v"(hi)); return r; }
DEV u32x4 pack8(const f32x4 v0, const f32x4 v1) { u32x4 w; w.x = cvt_pk_bf16(v0[0], v0[1]); w.y = cvt_pk_bf16(v0[2], v0[3]); w.z = cvt_pk_bf16(v1[0], v1[1]); w.w = cvt_pk_bf16(v1[2], v1[3]); return w; }
}

template <class SF>
DEV void transpose_item(SF src, bf16_t* dst, int ldd, int k0, int n0, float* scr, int lane) {
#pragma unroll 8
    for (int i = 0; i < 32; ++i) { const int kk = 2 * i + (lane >> 5); scr[kk * 33 + (lane & 31)] = src(k0 + kk, n0 + (lane & 31)); }
    __builtin_amdgcn_s_waitcnt(0xc07f); asm volatile("" ::: "memory");
    const int c = lane & 7;
#pragma unroll
    for (int j = 0; j < 4; ++j) { const int n = (lane >> 3) + 8 * j; const float* s = scr + (8 * c) * 33 + n;
        u32x4 o; o.x = pk2(s[0], s[33]); o.y = pk2(s[66], s[99]); o.z = pk2(s[132], s[165]); o.w = pk2(s[198], s[231]);
        *(u32x4*)(dst + (size_t)(n0 + n) * ldd + k0 + 8 * c) = o; }
    __builtin_amdgcn_s_waitcnt(0xc07f); asm volatile("" ::: "memory");
}
DEV unsigned pk4_fp8(float a, float b, float c, float d) { int t = __builtin_amdgcn_cvt_pk_fp8_f32(a, b, 0, false); t = __builtin_amdgcn_cvt_pk_fp8_f32(c, d, t, true); return (unsigned)t; }
DEV unsigned char f2fp8(float f) { return (unsigned char)(__builtin_amdgcn_cvt_pk_fp8_f32(f, 0.f, 0, false) & 0xff); }
template <class RM>
DEV void transpose_tile_reg8(const float* src, int ldn, unsigned char* dst, int ldd, int k0, int n0, RM rowmap, int lane, float sc) {
    const int kq = lane >> 4, nq = lane & 15; f32x4 v[16];
#pragma unroll
    for (int i = 0; i < 16; ++i) v[i] = *(const f32x4*)(src + (size_t)(k0 + 16 * kq + i) * ldn + n0 + 4 * nq) * sc;
#pragma unroll
    for (int j = 0; j < 4; ++j) { u32x4 a; a.x = pk4_fp8(v[0][j], v[1][j], v[2][j], v[3][j]); a.y = pk4_fp8(v[4][j], v[5][j], v[6][j], v[7][j]); a.z = pk4_fp8(v[8][j], v[9][j], v[10][j], v[11][j]); a.w = pk4_fp8(v[12][j], v[13][j], v[14][j], v[15][j]);
        *(u32x4*)(dst + (size_t)rowmap(n0 + 4 * nq + j) * ldd + k0 + 16 * kq) = a; }
}
template <class RM>
DEV void transpose_tile_reg(const float* src, int ldn, bf16_t* dst, int ldd, int k0, int n0, RM rowmap, int lane) {
    const int kq = lane >> 4, nq = lane & 15; f32x4 v[16];
#pragma unroll
    for (int i = 0; i < 16; ++i) v[i] = *(const f32x4*)(src + (size_t)(k0 + 16 * kq + i) * ldn + n0 + 4 * nq);
#pragma unroll
    for (int j = 0; j < 4; ++j) { bf16_t* o = dst + (size_t)rowmap(n0 + 4 * nq + j) * ldd + k0 + 16 * kq;
        u32x4 a, b2; a.x = pk2(v[0][j], v[1][j]); a.y = pk2(v[2][j], v[3][j]); a.z = pk2(v[4][j], v[5][j]); a.w = pk2(v[6][j], v[7][j]);
        b2.x = pk2(v[8][j], v[9][j]); b2.y = pk2(v[10][j], v[11][j]); b2.z = pk2(v[12][j], v[13][j]); b2.w = pk2(v[14][j], v[15][j]);
        *(u32x4*)o = a; *(u32x4*)(o + 8) = b2; }
}
DEV int zcol_src(int n) {
    if (n < 1536) return n;
    if (n < 1792) return 1552 + (n - 1536);
    if (n < 1920) return 1808 + (n - 1792);
    if (n < 1984) { const int j = n - 1920; return 1936 + (j >> 1) + 32 * (j & 1); }
    if (n < 2000) return 1536 + (n - 1984);
    return -1;
}
DEV int wrow_to_zcol(int n) {
    if (n < 512) return n;
    if (n < 1024) return n + 512;
    if (n < 1280) return ZQL + (n - 1024);
    if (n < 1536) return ZKVL + (n - 1280);
    return ZV + (n - 1536);
}
DEV void expert_convert(const Params& P, int gw, int ngw, int lane) {
    unsigned char* ws = P.ws;
    for (int it = gw; it < NE * 384; it += ngw) { const int e = it / 384, q = it % 384;
        if (q < 256) { const bool isu = q >= 128; const int qq = q & 127, kb = qq >> 3, nb = qq & 7; const float* W = P.in[isu ? I_WU : I_WG] + (size_t)e * 1024 * 512;
            transpose_tile_reg8(W, 512, (unsigned char*)(ws + WS_WGU) + (size_t)e * 1024 * 1024, 1024, kb * 64, nb * 64, [&](int hid) { return ((hid >> 2) << 3) + (hid & 3) + (isu ? 4 : 0); }, lane, 32.f); }
        else { const int qq = q - 256, kb = qq >> 4, nb = qq & 15; const float* W = P.in[I_WDN] + (size_t)e * 512 * 1024;
            transpose_tile_reg8(W, 1024, (unsigned char*)(ws + WS_WD) + (size_t)e * 1024 * 512, 512, kb * 64, nb * 64, [&](int n) { return n; }, lane, 32.f); }
    }
}
DEV void phase0(const Params& P, float* scr_all) { const int tid_ = tid_fresh();
    const int tid = tid_, lane = tid & 63, wave = tid >> 6;
    const int gw = blockIdx.x * NWAVE + wave, ngw = gridDim.x * NWAVE;
    float* scr = scr_all + wave * (64 * 33);
    unsigned char* ws = P.ws;
    constexpr int I_IN = 16 * 64, I_Q = 4 * 24, I_K = 4 * 16, I_V = 4 * 16, I_O = 16 * 32, I_GU = 16 * 32, I_DN = 8 * 32;
    constexpr int NITEMS = I_IN + I_Q + I_K + I_V + I_O;
    const float c2 = 0.07216878364870322f * 1.4426950408889634f;
    for (int it = gw; it < NITEMS; it += ngw) {
        int r = it;
        if (r < I_IN) { const float* W = P.in[I_WIN]; const int kb = r / 64, nb = r % 64;
            transpose_item([&](int k, int n) { const int s = zcol_src(wrow_to_zcol(n)); return s < 0 ? 0.f : W[(size_t)k * 2000 + s]; }, (bf16_t*)(ws + WS_WIN), 1024, kb * 64, nb * 32, scr, lane); continue; }
        r -= I_IN;
        if (r < I_Q) { const float* W = P.in[I_WQB]; const float* g = P.in[I_QN]; const int kb = r / 24, nb = r % 24;
            transpose_item([&](int k, int n) { int s; if (n < 512) s = (n >> 7) * 192 + (n & 127); else { const int q = n - 512, h = q >> 6, jj = q & 63; s = h * 192 + 128 + (jj >> 1) + 32 * (jj & 1); }
                return W[(size_t)k * 768 + s] * g[k] * c2; }, (bf16_t*)(ws + WS_WQ), 256, kb * 64, nb * 32, scr, lane); continue; }
        r -= I_Q;
        if (r < I_K + I_V) { const bool isv = r >= I_K; if (isv) r -= I_K; const float* W = P.in[I_WKVB]; const float* g = P.in[I_KVN]; const int kb = r / 16, nb = r % 16;
            transpose_item([&](int k, int n) { if (k >= 128) return 0.f; const int s = (n >> 7) * 256 + (isv ? 128 : 0) + (n & 127); return W[(size_t)k * 1024 + s] * g[k]; },
                           (bf16_t*)(ws + (isv ? WS_WV : WS_WK)), 256, kb * 64, nb * 32, scr, lane); continue; }
        r -= I_K + I_V;
        if (r < I_O) { const float* W = P.in[I_WOUT]; const int kb = r / 32, nb = r % 32;
            transpose_item([&](int k, int n) { return W[(size_t)k * 1024 + n]; }, (bf16_t*)(ws + WS_WOUT), 1024, kb * 64, nb * 32, scr, lane); continue; }
        r -= I_O;
        { }
    }
#if !XCONV_P3
    expert_convert(P, gw, ngw, lane);
#endif
    { const float* g = P.in[I_MIXN]; bf16_t* XN = (bf16_t*)(ws + WS_XN);
      f32x4 gv[4];
#pragma unroll
      for (int j = 0; j < 4; ++j) gv[j] = *(const f32x4*)(g + 256 * j + 4 * lane);
      for (int m0 = gw * 4; m0 < M; m0 += ngw * 4) {
        f32x4 v[4][4];
#pragma unroll
        for (int q = 0; q < 4; ++q)
#pragma unroll
            for (int j = 0; j < 4; ++j) v[q][j] = ((const f32x4*)(P.in[I_X] + (size_t)(m0 + q) * D) + lane)[64 * j];
#pragma unroll
        for (int q = 0; q < 4; ++q) { float s = 0.f;
#pragma unroll
            for (int j = 0; j < 4; ++j) s += (v[q][j].x * v[q][j].x + v[q][j].y * v[q][j].y) + (v[q][j].z * v[q][j].z + v[q][j].w * v[q][j].w);
            const float rs = rsqrtf(wave_sum(s) * (1.f / D) + EPS);
            unsigned long long* o8 = (unsigned long long*)(XN + (size_t)(m0 + q) * D) + lane;
#pragma unroll
            for (int j = 0; j < 4; ++j) o8[64 * j] = (unsigned long long)pk2(v[q][j].x * rs * gv[j].x, v[q][j].y * rs * gv[j].y) | ((unsigned long long)pk2(v[q][j].z * rs * gv[j].z, v[q][j].w * rs * gv[j].w) << 32); }
      } }
    const int gt = blockIdx.x * NT + tid, ngt = gridDim.x * NT;
    { float2* rt = (float2*)(ws + WS_ROPE);
      for (int i = gt; i < (SEQ + NMETA) * 32; i += ngt) { const int pos = i >> 5, f = i & 31;
        const double inv = pow(10000.0, -(double)(2 * f) / 64.0), ang = (double)pos * inv; rt[i] = make_float2((float)cos(ang), (float)sin(ang)); } }
    { bf16_t* wt = (bf16_t*)(ws + WS_WA2T); const float* wa2 = P.in[I_WA2];
      for (int i = gt; i < 256 * 128; i += ngt) { const int n = i >> 7, k = i & 127; wt[i] = (bf16_t)f2bf((k >= 64 && k < 80) ? wa2[(k - 64) * 256 + n] : 0.f); } }
    { bf16_t* wr = (bf16_t*)(ws + WS_WR); const float* wg = P.in[I_RGW]; const float* we = P.in[I_REW];
      for (int i = gt; i < 96 * D; i += ngt) { const int row = i >> 10, k = i & 1023, t = row >> 5, rho = row & 31, hi = (rho >> 2) & 1, r = (rho & 3) + 4 * (rho >> 3);
        float v = 0.f; if (t < 2) v = we[k * 64 + 8 * (4 * t + 2 * hi + (r >> 3)) + (r & 7)]; else if (hi == 0 && r < 8) v = wg[k * 8 + r];
        wr[i] = (bf16_t)f2bf(v * P.in[I_FFN][k]); } }
    { float* mz = (float*)(ws + WS_CTL + CTL_MZ); float* rsm = (float*)(ws + WS_CTL + CTL_RSM); const float* mt = P.in[I_META]; const float* g = P.in[I_MIXN]; const float* W = P.in[I_WIN];
      for (int it = gt; it < 32 * 1024; it += ngt) { const int ks = it >> 10, ci = it & 1023; const int n = ci < 768 ? ZK + ci : ZKVL + (ci - 768); const int s = (ci < 976) ? zcol_src(n) : -1;
        if (s >= 0) { float acc[NMETA];
#pragma unroll
            for (int r = 0; r < NMETA; ++r) acc[r] = 0.f;
#pragma unroll 4
            for (int k = ks * 32; k < ks * 32 + 32; ++k) { const float w = W[(size_t)k * 2000 + s] * g[k];
#pragma unroll
                for (int r = 0; r < NMETA; ++r) acc[r] += mt[r * D + k] * w; }
#pragma unroll
            for (int r = 0; r < NMETA; ++r) atomicAdd(mz + r * NZ + n, acc[r]); } }
      if (gw < NMETA) { float ss = 0.f;
#pragma unroll
        for (int j = 0; j < 16; ++j) { const float x = mt[gw * D + 64 * j + lane]; ss += x * x; }
        ss = wave_sum(ss); if (lane == 0) rsm[gw] = rsqrtf(ss * (1.f / D) + EPS); } }
}

DEV void meta_phase(const Params& P) { const int tid_ = tid_fresh();
    unsigned char* ws = P.ws; const int gt = blockIdx.x * NT + tid_, ngt = gridDim.x * NT;
    const float* mzr = (const float*)(ws + WS_CTL + CTL_MZ); const float* rsm = (const float*)(ws + WS_CTL + CTL_RSM);
    bf16_t* KNm = (bf16_t*)(ws + WS_META + MT_KN); bf16_t* VTm = (bf16_t*)(ws + WS_META + MT_VT); bf16_t* KRm = (bf16_t*)(ws + WS_META + MT_KR); float* S1 = (float*)(ws + WS_META + MT_S1);
    const float* Wkv = P.in[I_WKVB]; const float* gk = P.in[I_KVN];
    for (int i = gt; i < NMETA * 1024; i += ngt) { const int row = i >> 10, col = i & 1023; const float* z = mzr + row * NZ + ZKVL; const float rm = rsm[row];
        float ss = 0.f, acc = 0.f; for (int k = 0; k < 128; ++k) { const float zk = z[k] * rm; ss += zk * zk; acc += zk * gk[k] * Wkv[(size_t)k * 1024 + col]; }
        acc *= rsqrtf(ss * (1.f / 128.f) + EPS);
        const int h = col >> 8, w = col & 255;
        unsigned char* KN8m = ws + WS_META + MT_KN8; unsigned char* VT8m = ws + WS_META + MT_VT8;
        if (w < 128) { KNm[row * 512 + h * 128 + w] = (bf16_t)f2bf(acc); KNm[(row + 16) * 512 + h * 128 + w] = 0; KN8m[row * 512 + h * 128 + w] = f2fp8(acc); KN8m[(row + 16) * 512 + h * 128 + w] = 0; }
        else { VTm[(h * 128 + w - 128) * 32 + row] = (bf16_t)f2bf(acc); VTm[(h * 128 + w - 128) * 32 + 16 + row] = 0; VT8m[(h * 128 + w - 128) * 32 + row] = f2fp8(acc); VT8m[(h * 128 + w - 128) * 32 + 16 + row] = 0; } }
    const float2* rt = (const float2*)(ws + WS_ROPE);
    for (int i = gt; i < NMETA * 32; i += ngt) { const int row = i >> 5, f = i & 31; const float x1 = mzr[row * NZ + ZKR + 2 * f] * rsm[row], x2 = mzr[row * NZ + ZKR + 2 * f + 1] * rsm[row]; const float2 cs = rt[row * 32 + f];
        KRm[row * 64 + 2 * f] = (bf16_t)f2bf(x1 * cs.x - x2 * cs.y); KRm[row * 64 + 2 * f + 1] = (bf16_t)f2bf(x2 * cs.x + x1 * cs.y); KRm[(row + 16) * 64 + 2 * f] = 0; KRm[(row + 16) * 64 + 2 * f + 1] = 0;
        unsigned char* KR8m = ws + WS_META + MT_KR8; KR8m[row * 64 + 2 * f] = f2fp8(x1 * cs.x - x2 * cs.y); KR8m[row * 64 + 2 * f + 1] = f2fp8(x2 * cs.x + x1 * cs.y); KR8m[(row + 16) * 64 + 2 * f] = 0; KR8m[(row + 16) * 64 + 2 * f + 1] = 0; }
    const float* wa2 = P.in[I_WA2]; const float* ba = P.in[I_BA];
    for (int i = gt; i < 4 * 64 * 128; i += ngt) { const int h = i >> 13, d = (i >> 7) & 63, e = i & 127; float S = 0.f;
        for (int s = 0; s < NMETA; ++s) { const float* z = mzr + s * NZ; const float rm = rsm[s]; float x = 0.f;
            for (int r = 0; r < 16; ++r) x += z[ZAL + r] * wa2[r * 256 + h * 64 + d];
            x = x * rm + ba[h * 64 + d];
            const float a = __expf(logsigmoidf(x) * (1.f / 16.f)); S = a * S + (z[ZK + h * 64 + d] * rm) * (z[ZV + h * 128 + e] * rm); }
        S1[i] = S; }
}
DEV void phase1(const Params& P) { const int tid_ = tid_fresh();
    unsigned char* ws = P.ws; const int gw = blockIdx.x * NWAVE + (tid_ >> 6), ngw = gridDim.x * NWAVE;
    const bf16_t* XN = (const bf16_t*)(ws + WS_XN); const bf16_t* W = (const bf16_t*)(ws + WS_WIN); bf16_t* Z = (bf16_t*)P.out;
    gemm_simple(M / 64, NZ / 64, D, [&](int r) { return XN + (size_t)r * D; }, [&](int c) { return W + (size_t)c * D; },
                [&](int row, int col, float v) { Z[(size_t)row * NZ + col] = (bf16_t)f2bf(v); }, gw, ngw);
    meta_phase(P);
}
DEV void phase2a(const Params& P) { const int tid_ = tid_fresh();
    unsigned char* ws = P.ws; const int lane = tid_ & 63; const int gw = blockIdx.x * NWAVE + (tid_ >> 6), ngw = gridDim.x * NWAVE;
    const bf16_t* Z = (const bf16_t*)P.out; float* rsq = (float*)(ws + WS_RS); float* rskv = rsq + M; bf16_t* KR = (bf16_t*)(ws + WS_KR); float* LOGA = (float*)(ws + WS_LOGA);
    const float2* rt = (const float2*)(ws + WS_ROPE); const float* wa2 = P.in[I_WA2]; const float* ba = P.in[I_BA];
    float w[4][16], bb[4];
#pragma unroll
    for (int j = 0; j < 4; ++j) { bb[j] = ba[64 * j + lane];
#pragma unroll
        for (int r = 0; r < 16; ++r) w[j][r] = wa2[r * 256 + 64 * j + lane]; }
    for (int m = gw; m < M; m += ngw) { const bf16_t* z = Z + (size_t)m * NZ;
        float s = 0.f;
#pragma unroll
        for (int j = 0; j < 4; ++j) { const float v = bf2f(z[ZQL + 64 * j + lane]); s += v * v; }
        s = wave_sum(s); float s2 = 0.f;
#pragma unroll
        for (int j = 0; j < 2; ++j) { const float v = bf2f(z[ZKVL + 64 * j + lane]); s2 += v * v; }
        s2 = wave_sum(s2);
        if (lane == 0) { rsq[m] = rsqrtf(s * (1.f / 256.f) + EPS); rskv[m] = rsqrtf(s2 * (1.f / 128.f) + EPS); }
        { const float v = bf2f(z[ZKR + lane]), o = sx<1>(v); const float2 cs = rt[(NMETA + (m & (SEQ - 1))) * 32 + (lane >> 1)];
          KR[(size_t)m * 64 + lane] = (bf16_t)f2bf((lane & 1) ? (v * cs.x + o * cs.y) : (v * cs.x - o * cs.y)); }
        float al[16];
#pragma unroll
        for (int r = 0; r < 16; ++r) al[r] = bf2f(z[ZAL + r]);
#pragma unroll
        for (int j = 0; j < 4; ++j) { float x = bb[j];
#pragma unroll
            for (int r = 0; r < 16; ++r) x += al[r] * w[j][r];
            LOGA[(size_t)m * 256 + 64 * j + lane] = logsigmoidf(x) * (1.f / 16.f); }
    }
}
DEV void phase2b(const Params& P) { const int tid_ = tid_fresh();
    unsigned char* ws = P.ws; const int gw = blockIdx.x * NWAVE + (tid_ >> 6), ngw = gridDim.x * NWAVE;
    const bf16_t* Z = (const bf16_t*)P.out; const float* rsq = (const float*)(ws + WS_RS); const float* rskv = rsq + M;
    const float2* rt = (const float2*)(ws + WS_ROPE);
    { bf16_t* QM = (bf16_t*)(ws + WS_QM); const bf16_t* W = (const bf16_t*)(ws + WS_WQ);
      gemm_simple(M / 64, 768 / 64, 256, [&](int r) { return Z + (size_t)r * NZ + ZQL; }, [&](int c) { return W + (size_t)c * 256; },
                  [&](int row, int col, float v) { v *= rsq[row]; const float o = sx<1>(v);
                      if (col >= 512) { const float2 cs = rt[(NMETA + (row & (SEQ - 1))) * 32 + ((col & 63) >> 1)]; v = (col & 1) ? (v * cs.x + o * cs.y) : (v * cs.x - o * cs.y); }
                      QM[(size_t)row * 768 + col] = (bf16_t)f2bf(v); }, gw, ngw); }
    { bf16_t* KN = (bf16_t*)(ws + WS_KN); const bf16_t* W = (const bf16_t*)(ws + WS_WK);
      gemm_simple(M / 64, 512 / 64, 256, [&](int r) { return Z + (size_t)r * NZ + ZKVL; }, [&](int c) { return W + (size_t)c * 256; },
                  [&](int row, int col, float v) { KN[(size_t)row * 512 + col] = (bf16_t)f2bf(v * rskv[row]); }, gw, ngw); }
    { bf16_t* VT = (bf16_t*)(ws + WS_VT); const bf16_t* W = (const bf16_t*)(ws + WS_WV);
      gemm_simple(512 / 64, M / 64, 256, [&](int r) { return W + (size_t)r * 256; }, [&](int c) { return Z + (size_t)c * NZ + ZKVL; },
                  [&](int row, int col, float v) { VT[(size_t)row * M + col] = (bf16_t)f2bf(v * rskv[col]); }, gw, ngw); }
}
DEV void gla_simple(const Params& P) { const int tid_ = tid_fresh();
    unsigned char* ws = P.ws; const int tid = tid_;
    const bf16_t* Z = (const bf16_t*)P.out; const float* LOGA = (const float*)(ws + WS_LOGA); const float* S1 = (const float*)(ws + WS_META + MT_S1); bf16_t* Y = (bf16_t*)(ws + WS_Y);
    for (int u = blockIdx.x; u < NB * 4; u += gridDim.x) { const int b = u >> 2, h = u & 3, e = tid >> 2, dq = tid & 3;
        float S[16];
#pragma unroll
        for (int j = 0; j < 16; ++j) S[j] = S1[(h * 64 + dq * 16 + j) * 128 + e];
        for (int t = 0; t < SEQ; ++t) { const size_t m = (size_t)b * SEQ + t; const bf16_t* z = Z + m * NZ;
            const u32x4 q0 = *(const u32x4*)(z + ZQ + h * 64 + dq * 16), q1 = *(const u32x4*)(z + ZQ + h * 64 + dq * 16 + 8);
            const u32x4 k0 = *(const u32x4*)(z + ZK + h * 64 + dq * 16), k1 = *(const u32x4*)(z + ZK + h * 64 + dq * 16 + 8);
            const f32x4* la = (const f32x4*)(LOGA + m * 256 + h * 64 + dq * 16);
            const float v = bf2f(z[ZV + h * 128 + e]);
            const unsigned qq[8] = {q0.x, q0.y, q0.z, q0.w, q1.x, q1.y, q1.z, q1.w}, kk[8] = {k0.x, k0.y, k0.z, k0.w, k1.x, k1.y, k1.z, k1.w};
            float o = 0.f;
#pragma unroll
            for (int j4 = 0; j4 < 4; ++j4) { const f32x4 l4 = la[j4];
#pragma unroll
                for (int jj = 0; jj < 4; ++jj) { const int j = j4 * 4 + jj; const unsigned qw = qq[j >> 1], kw = kk[j >> 1];
                    const float qv = (j & 1) ? __uint_as_float(qw & 0xffff0000u) : __uint_as_float(qw << 16), kv = (j & 1) ? __uint_as_float(kw & 0xffff0000u) : __uint_as_float(kw << 16);
                    S[j] = __expf(l4[jj]) * S[j] + kv * v; o += qv * S[j]; } }
            o += sx<1>(o); o += sx<2>(o);
            if (dq == 0) Y[m * 1024 + h * 128 + e] = (bf16_t)f2bf(o * 0.125f); }
    }
}
DEV void gla_fast(const Params& P) {
    typedef float f32x2 __attribute__((ext_vector_type(2)));
    unsigned char* ws = P.ws; const int tid_ = tid_fresh(); const int lane = tid_ & 63, wave = tid_ >> 6, dg = lane & 15, es = lane >> 4;
    const bf16_t* Z = (const bf16_t*)P.out; const float* AEXP = (const float*)(ws + WS_LOGA); const float* S1 = (const float*)(ws + WS_META + MT_S1); bf16_t* Y = (bf16_t*)(ws + WS_Y);
    for (int u = blockIdx.x; u < NB * 16; u += gridDim.x) { const int b = u >> 4, h = (u >> 2) & 3, e = (u & 3) * 32 + wave * 4 + es;
        f32x2 S01, S23;
        S01.x = S1[(h * 64 + dg * 4 + 0) * 128 + e]; S01.y = S1[(h * 64 + dg * 4 + 1) * 128 + e]; S23.x = S1[(h * 64 + dg * 4 + 2) * 128 + e]; S23.y = S1[(h * 64 + dg * 4 + 3) * 128 + e];
        const bf16_t* zq = Z + (size_t)b * SEQ * NZ + ZQ + h * 64 + dg * 4; const bf16_t* zk = Z + (size_t)b * SEQ * NZ + ZK + h * 64 + dg * 4; const bf16_t* zv = Z + (size_t)b * SEQ * NZ + ZV + h * 128 + e;
        const float* ap = AEXP + (size_t)b * SEQ * 256 + h * 64 + dg * 4; bf16_t* yp = Y + (size_t)b * SEQ * 1024 + h * 128 + e;
        u32x2 qA[8], kA[8], qB[8], kB[8]; f32x4 aA[8], aB[8]; unsigned short vA[8], vB[8];
#define GLA_LOAD(q, k, a, v, t0) do { _Pragma("unroll") for (int i = 0; i < 8; ++i) { const size_t t = (size_t)(t0) + i; q[i] = *(const u32x2*)(zq + t * NZ); k[i] = *(const u32x2*)(zk + t * NZ); a[i] = *(const f32x4*)(ap + t * 256); v[i] = zv[t * NZ]; } } while (0)
#define GLA_COMP(q, k, a, v, t0) do { _Pragma("unroll") for (int i = 0; i < 8; ++i) { const float vv = bf2f(v[i]); \
            const f32x2 q01 = {__uint_as_float(q[i].x << 16), __uint_as_float(q[i].x & 0xffff0000u)}, q23 = {__uint_as_float(q[i].y << 16), __uint_as_float(q[i].y & 0xffff0000u)}; \
            const f32x2 k01 = {__uint_as_float(k[i].x << 16), __uint_as_float(k[i].x & 0xffff0000u)}, k23 = {__uint_as_float(k[i].y << 16), __uint_as_float(k[i].y & 0xffff0000u)}; \
            const f32x2 a01 = {a[i][0], a[i][1]}, a23 = {a[i][2], a[i][3]}; \
            S01 = a01 * S01 + k01 * vv; S23 = a23 * S23 + k23 * vv; \
            const f32x2 p = q01 * S01 + q23 * S23; float o = p.x + p.y; \
            o += dpp_f<0x128>(o); o += dpp_f<0x124>(o); o += dpp_f<0x4E>(o); o += dpp_f<0xB1>(o); \
            if (dg == 0) yp[(size_t)((t0) + i) * 1024] = (bf16_t)f2bf(o * 0.125f); } } while (0)
        GLA_LOAD(qA, kA, aA, vA, 0);
        for (int t0 = 0; t0 < SEQ; t0 += 16) {
            GLA_LOAD(qB, kB, aB, vB, t0 + 8);
            GLA_COMP(qA, kA, aA, vA, t0);
            if (t0 + 16 < SEQ) GLA_LOAD(qA, kA, aA, vA, t0 + 16);
            GLA_COMP(qB, kB, aB, vB, t0 + 8);
        }
#undef GLA_LOAD
#undef GLA_COMP
    }
}
DEV void mla_simple(const Params& P) { const int tid_ = tid_fresh();
    unsigned char* ws = P.ws; const int lane = tid_ & 63, r32 = lane & 31, hi = lane >> 5; const int gw = blockIdx.x * NWAVE + (tid_ >> 6), ngw = gridDim.x * NWAVE;
    const bf16_t* QM = (const bf16_t*)(ws + WS_QM); const bf16_t* KN = (const bf16_t*)(ws + WS_KN); const bf16_t* VT = (const bf16_t*)(ws + WS_VT); const bf16_t* KR = (const bf16_t*)(ws + WS_KR);
    const bf16_t* KNm = (const bf16_t*)(ws + WS_META + MT_KN); const bf16_t* VTm = (const bf16_t*)(ws + WS_META + MT_VT); const bf16_t* KRm = (const bf16_t*)(ws + WS_META + MT_KR);
    bf16_t* Y = (bf16_t*)(ws + WS_Y);
    const int kperm = pi23(r32);
    for (int w = gw; w < 2048; w += ngw) { const int bh = w >> 5, s5 = w & 31, b = bh >> 2, h = bh & 3;
        for (int ui = 0; ui < 4; ++ui) { const int i = (ui == 0) ? s5 : (ui == 1) ? 63 - s5 : (ui == 2) ? 64 + s5 : 127 - s5;
            const size_t mq = (size_t)b * SEQ + i * 32 + r32;
            bf16x8 qf[12];
#pragma unroll
            for (int s = 0; s < 8; ++s) qf[s] = *(const bf16x8*)(QM + mq * 768 + h * 128 + 16 * s + 8 * hi);
#pragma unroll
            for (int s = 0; s < 4; ++s) qf[8 + s] = *(const bf16x8*)(QM + mq * 768 + 512 + h * 64 + 16 * s + 8 * hi);
            f32x16 O[4] = {}; float mrun = -INFINITY, l = 0.f;
            const int ntile = 2 * (1 + (i >> 1));
            for (int j = -1; j < ntile; ++j) {
                f32x16 S = {};
                if (j < 0) { const bool ok = kperm < NMETA; const bf16x8 zf = {};
#pragma unroll
                    for (int s = 0; s < 8; ++s) { const bf16x8 kf = ok ? *(const bf16x8*)(KNm + kperm * 512 + h * 128 + 16 * s + 8 * hi) : zf; S = __builtin_amdgcn_mfma_f32_32x32x16_bf16(kf, qf[s], S, 0, 0, 0); }
#pragma unroll
                    for (int s = 0; s < 4; ++s) { const bf16x8 kf = ok ? *(const bf16x8*)(KRm + kperm * 64 + 16 * s + 8 * hi) : zf; S = __builtin_amdgcn_mfma_f32_32x32x16_bf16(kf, qf[8 + s], S, 0, 0, 0); }
#pragma unroll
                    for (int r = 0; r < 16; ++r) if (pi23(crow(r, hi)) >= NMETA) S[r] = -INFINITY;
                } else { const size_t mk = (size_t)b * SEQ + j * 32 + kperm;
#pragma unroll
                    for (int s = 0; s < 8; ++s) { const bf16x8 kf = *(const bf16x8*)(KN + mk * 512 + h * 128 + 16 * s + 8 * hi); S = __builtin_amdgcn_mfma_f32_32x32x16_bf16(kf, qf[s], S, 0, 0, 0); }
#pragma unroll
                    for (int s = 0; s < 4; ++s) { const bf16x8 kf = *(const bf16x8*)(KR + mk * 64 + 16 * s + 8 * hi); S = __builtin_amdgcn_mfma_f32_32x32x16_bf16(kf, qf[8 + s], S, 0, 0, 0); }
                }
                float mx = S[0];
#pragma unroll
                for (int r = 1; r < 16; ++r) mx = fmaxf(mx, S[r]);
                mx = half_max(mx);
                const float mnew = fmaxf(mrun, mx), alpha = exp2f(mrun - mnew); mrun = mnew;
                float ps = 0.f;
#pragma unroll
                for (int r = 0; r < 16; ++r) { S[r] = exp2f(S[r] - mnew); ps += S[r]; }
                l = l * alpha + ps;
#pragma unroll
                for (int d = 0; d < 4; ++d)
#pragma unroll
                    for (int r = 0; r < 16; ++r) O[d][r] *= alpha;
                u32x4 p0, p1;
                p0.x = pk2(S[0], S[1]); p0.y = pk2(S[2], S[3]); p0.z = pk2(S[4], S[5]); p0.w = pk2(S[6], S[7]);
                p1.x = pk2(S[8], S[9]); p1.y = pk2(S[10], S[11]); p1.z = pk2(S[12], S[13]); p1.w = pk2(S[14], S[15]);
                const bf16x8 pf0 = __builtin_bit_cast(bf16x8, p0), pf1 = __builtin_bit_cast(bf16x8, p1);
#pragma unroll
                for (int d = 0; d < 4; ++d) {
                    bf16x8 v0, v1;
                    if (j < 0) { const bf16x8 zf = {}; v0 = *(const bf16x8*)(VTm + (h * 128 + 32 * d + r32) * 32 + 8 * hi); v1 = zf; }
                    else { const bf16_t* vp = VT + (size_t)(h * 128 + 32 * d + r32) * M + (size_t)b * SEQ + j * 32 + 8 * hi; v0 = *(const bf16x8*)vp; v1 = *(const bf16x8*)(vp + 16); }
                    O[d] = __builtin_amdgcn_mfma_f32_32x32x16_bf16(v0, pf0, O[d], 0, 0, 0);
                    O[d] = __builtin_amdgcn_mfma_f32_32x32x16_bf16(v1, pf1, O[d], 0, 0, 0);
                }
            }
            l = half_sum(l); const float rl = 1.f / l;
#pragma unroll
            for (int d = 0; d < 4; ++d)
#pragma unroll
                for (int r = 0; r < 16; ++r) Y[mq * 1024 + 512 + h * 128 + 32 * d + crow(r, hi)] = (bf16_t)f2bf(O[d][r] * rl);
        }
    }
}
DEV void phase3b(const Params& P) { const int tid_ = tid_fresh();
    unsigned char* ws = P.ws; const int lane = tid_ & 63; const int gw = blockIdx.x * NWAVE + (tid_ >> 6), ngw = gridDim.x * NWAVE;
    const bf16_t* Z = (const bf16_t*)P.out; bf16_t* Y = (bf16_t*)(ws + WS_Y); const float* g = P.in[I_GOUTN];
    float gv[8];
#pragma unroll
    for (int j = 0; j < 8; ++j) gv[j] = g[8 * lane + j];
    for (int m = gw; m < M; m += ngw) {
        const u32x4 o4 = *(const u32x4*)(Y + (size_t)m * 1024 + 8 * lane), r4 = *(const u32x4*)(Z + (size_t)m * NZ + ZR + 8 * lane);
        const unsigned ow[4] = {o4.x, o4.y, o4.z, o4.w}, rw[4] = {r4.x, r4.y, r4.z, r4.w}; float o[8], r[8]; float s = 0.f;
#pragma unroll
        for (int j = 0; j < 4; ++j) { o[2 * j] = __uint_as_float(ow[j] << 16); o[2 * j + 1] = __uint_as_float(ow[j] & 0xffff0000u); r[2 * j] = __uint_as_float(rw[j] << 16); r[2 * j + 1] = __uint_as_float(rw[j] & 0xffff0000u); }
#pragma unroll
        for (int j = 0; j < 8; ++j) s += o[j] * o[j];
        s += sx<1>(s); s += sx<2>(s); s += sx<4>(s); s += sx<8>(s);
        const float rs = rsqrtf(s * (1.f / 128.f) + EPS);
        u32x4 w; float y[8];
#pragma unroll
        for (int j = 0; j < 8; ++j) y[j] = o[j] * rs * gv[j] * siluf(r[j]);
        w.x = pk2(y[0], y[1]); w.y = pk2(y[2], y[3]); w.z = pk2(y[4], y[5]); w.w = pk2(y[6], y[7]);
        *(u32x4*)(Y + (size_t)m * 1024 + 8 * lane) = w;
    }
}
DEV void phase4(const Params& P) { const int tid_ = tid_fresh();
    unsigned char* ws = P.ws; const int gw = blockIdx.x * NWAVE + (tid_ >> 6), ngw = gridDim.x * NWAVE;
    const bf16_t* Y = (const bf16_t*)(ws + WS_Y); const bf16_t* W = (const bf16_t*)(ws + WS_WOUT); float* H2 = (float*)(ws + WS_H2); const float* x = P.in[I_X];
    gemm_simple(M / 64, D / 64, D, [&](int r) { return Y + (size_t)r * D; }, [&](int c) { return W + (size_t)c * D; },
                [&](int row, int col, float v) { H2[(size_t)row * D + col] = x[(size_t)row * D + col] + v; }, gw, ngw);
}
DEV void phase5(const Params& P, float* scr_all) { const int tid_ = tid_fresh();
    unsigned char* ws = P.ws; const int lane = tid_ & 63, wave = tid_ >> 6; const int gw = blockIdx.x * NWAVE + wave, ngw = gridDim.x * NWAVE;
    float* trow = scr_all + wave * 4096;
    const float* H2 = (const float*)(ws + WS_H2); bf16_t* TN = (bf16_t*)(ws + WS_TN); const float* g = P.in[I_FFN];
    const float* wg = P.in[I_RGW]; const float* bg = P.in[I_RGB]; const float* we = P.in[I_REW]; const float* be = P.in[I_REB];
    int* cnt = (int*)(ws + WS_CTL) + CW_CNT; int* tokE = (int*)(ws + WS_TOK); int* tokR = tokE + 2 * M; float* tokG = (float*)(tokR + 2 * M); int* list = (int*)(ws + WS_LIST);
    f32x4 gv[4];
#pragma unroll
    for (int j = 0; j < 4; ++j) gv[j] = *(const f32x4*)(g + 256 * j + 4 * lane);
    for (int m0 = gw * 4; m0 < M; m0 += ngw * 4) {
#pragma unroll
        for (int q = 0; q < 4; ++q) { const int m = m0 + q; const f32x4* hr = (const f32x4*)(H2 + (size_t)m * D) + lane; f32x4 v[4]; float s = 0.f;
#pragma unroll
            for (int j = 0; j < 4; ++j) { v[j] = hr[64 * j]; s += (v[j].x * v[j].x + v[j].y * v[j].y) + (v[j].z * v[j].z + v[j].w * v[j].w); }
            const float rs = rsqrtf(wave_sum(s) * (1.f / D) + EPS);
            unsigned long long* o8 = (unsigned long long*)(TN + (size_t)m * D) + lane;
#pragma unroll
            for (int j = 0; j < 4; ++j) { const f32x4 t = {v[j].x * rs * gv[j].x, v[j].y * rs * gv[j].y, v[j].z * rs * gv[j].z, v[j].w * rs * gv[j].w};
                *(f32x4*)(trow + q * 1024 + 256 * j + 4 * lane) = t;
                o8[64 * j] = (unsigned long long)pk2(t.x, t.y) | ((unsigned long long)pk2(t.z, t.w) << 32); } }
        __builtin_amdgcn_s_waitcnt(0xc07f); asm volatile("" ::: "memory");
        float ae[4] = {0.f, 0.f, 0.f, 0.f}, ag[4] = {0.f, 0.f, 0.f, 0.f};
        for (int k = 0; k < D; ++k) { const float w = we[k * 64 + lane];
#pragma unroll
            for (int q = 0; q < 4; ++q) ae[q] += trow[q * 1024 + k] * w; }
        for (int k8 = 0; k8 < D / 8; ++k8) { const int k = k8 * 8 + (lane >> 3); const float w = wg[k * 8 + (lane & 7)];
#pragma unroll
            for (int q = 0; q < 4; ++q) ag[q] += trow[q * 1024 + k] * w; }
#pragma unroll
        for (int q = 0; q < 4; ++q) { ag[q] += sx<8>(ag[q]); ag[q] += sx<16>(ag[q]); ag[q] = half_sum(ag[q]); ag[q] += bg[lane & 7]; ae[q] += be[lane]; }
#pragma unroll
        for (int q = 0; q < 4; ++q) { const int m = m0 + q;
            float gl[8]; float gmx = -INFINITY; int gi = 0;
#pragma unroll
            for (int i = 0; i < 8; ++i) { gl[i] = rl_f(ag[q], i); if (gl[i] > gmx) { gmx = gl[i]; gi = i; } }
            float gs = 0.f;
#pragma unroll
            for (int i = 0; i < 8; ++i) gs += __expf(gl[i] - gmx);
            const float gp = 1.f / gs;
            const int gis = __builtin_amdgcn_readfirstlane(gi); float el[8]; float emx = -INFINITY; int e0 = 0;
#pragma unroll
            for (int i = 0; i < 8; ++i) { el[i] = rl_f(ae[q], gis * 8 + i); if (el[i] > emx) { emx = el[i]; e0 = i; } }
            float em2 = -INFINITY; int e1 = 0;
#pragma unroll
            for (int i = 0; i < 8; ++i) if (i != e0 && el[i] > em2) { em2 = el[i]; e1 = i; }
            const float p0 = 1.f, p1 = __expf(em2 - emx); const float g0 = gp * p0 / (p0 + p1), g1 = gp * p1 / (p0 + p1);
            if (lane == 0) { const int E0 = gi * 8 + e0, E1 = gi * 8 + e1; const int r0 = atomicAdd(cnt + E0, 1), r1 = atomicAdd(cnt + E1, 1);
                tokE[2 * m] = E0; tokE[2 * m + 1] = E1; tokR[2 * m] = r0; tokR[2 * m + 1] = r1; tokG[2 * m] = g0; tokG[2 * m + 1] = g1;
                list[(size_t)E0 * M + r0] = m; list[(size_t)E1 * M + r1] = m; } }
        __builtin_amdgcn_s_waitcnt(0xc07f); asm volatile("" ::: "memory");
    }
}
DEV void route_emit(int m, int E0, int E1, float g0, float g1, int* cnt, int* tokE, int* tokR, float* tokG, int* list) {
    const int r0 = atomicAdd(cnt + E0, 1), r1 = atomicAdd(cnt + E1, 1);
    tokE[2 * m] = E0; tokE[2 * m + 1] = E1; tokR[2 * m] = r0; tokR[2 * m + 1] = r1; tokG[2 * m] = g0; tokG[2 * m + 1] = g1;
    list[(size_t)E0 * M + r0] = m; list[(size_t)E1 * M + r1] = m;
}
DEV void phase5_fast(const Params& P) {
    constexpr float TAU = 0.015f;
    unsigned char* ws = P.ws; const int tid_ = tid_fresh(); const int lane = tid_ & 63, r32 = lane & 31, hi = lane >> 5; const int gw = blockIdx.x * NWAVE + (tid_ >> 6), ngw = gridDim.x * NWAVE;
    const float* X = P.in[I_X]; const bf16_t* D16 = (const bf16_t*)(ws + WS_D16); bf16_t* H2B = (bf16_t*)(ws + WS_H2B); unsigned char* TN8 = (unsigned char*)(ws + WS_TN8); const float* g = P.in[I_FFN]; const bf16_t* WR = (const bf16_t*)(ws + WS_WR);
    const float* wg = P.in[I_RGW]; const float* bg = P.in[I_RGB]; const float* we = P.in[I_REW]; const float* be = P.in[I_REB];
    int* cnt = (int*)(ws + WS_CTL) + CW_CNT; int* tokE = (int*)(ws + WS_TOK); int* tokR = tokE + 2 * M; float* tokG = (float*)(tokR + 2 * M); int* list = (int*)(ws + WS_LIST);
    f32x4 gv[4];
#pragma unroll
    for (int j = 0; j < 4; ++j) gv[j] = *(const f32x4*)(g + 256 * j + 4 * lane);
    for (int blk = gw; blk < M / 32; blk += ngw) { const int m0 = blk * 32; float rsk = 0.f;
        for (int q0 = 0; q0 < 32; q0 += 4) {
            f32x4 v[4][4];
#pragma unroll
            for (int q = 0; q < 4; ++q)
#pragma unroll
                for (int j = 0; j < 4; ++j) { const size_t off = (size_t)(m0 + q0 + q) * D + 256 * j + 4 * lane; const u32x2 dd = *(const u32x2*)(D16 + off); const f32x4 xx = *(const f32x4*)(X + off);
                    v[q][j] = (f32x4){xx.x + __uint_as_float(dd.x << 16), xx.y + __uint_as_float(dd.x & 0xffff0000u), xx.z + __uint_as_float(dd.y << 16), xx.w + __uint_as_float(dd.y & 0xffff0000u)}; }
#pragma unroll
            for (int q = 0; q < 4; ++q) { float s = 0.f;
                { unsigned long long* h8 = (unsigned long long*)(H2B + (size_t)(m0 + q0 + q) * D) + lane;
#pragma unroll
                  for (int j = 0; j < 4; ++j) h8[64 * j] = (unsigned long long)pk2(v[q][j].x, v[q][j].y) | ((unsigned long long)pk2(v[q][j].z, v[q][j].w) << 32); }
#pragma unroll
                for (int j = 0; j < 4; ++j) s += (v[q][j].x * v[q][j].x + v[q][j].y * v[q][j].y) + (v[q][j].z * v[q][j].z + v[q][j].w * v[q][j].w);
                const float rs = rsqrtf(wave_sum(s) * (1.f / D) + EPS); rsk = (q0 + q == r32) ? rs : rsk;
                unsigned* t8 = (unsigned*)(TN8 + (size_t)(m0 + q0 + q) * D) + lane;
#pragma unroll
                for (int j = 0; j < 4; ++j) { const float t0 = v[q][j].x * rs * gv[j].x, t1 = v[q][j].y * rs * gv[j].y, t2 = v[q][j].z * rs * gv[j].z, t3 = v[q][j].w * rs * gv[j].w;
                    t8[64 * j] = pk4_fp8(t0, t1, t2, t3); } }
        }
        asm volatile("s_waitcnt vmcnt(0)" ::: "memory");
        f32x16 a0 = {}, a1 = {}, a2 = {};
        { const bf16_t* tb = H2B + (size_t)(m0 + r32) * D + 8 * hi; const bf16_t* wa = WR + (size_t)r32 * D + 8 * hi;
#pragma unroll 4
          for (int k = 0; k < D; k += 16) { const bf16x8 bf = *(const bf16x8*)(tb + k);
              a0 = __builtin_amdgcn_mfma_f32_32x32x16_bf16(*(const bf16x8*)(wa + k), bf, a0, 0, 0, 0);
              a1 = __builtin_amdgcn_mfma_f32_32x32x16_bf16(*(const bf16x8*)(wa + 32 * D + k), bf, a1, 0, 0, 0);
              a2 = __builtin_amdgcn_mfma_f32_32x32x16_bf16(*(const bf16x8*)(wa + 64 * D + k), bf, a2, 0, 0, 0); } }
#pragma unroll
        for (int r = 0; r < 16; ++r) { a0[r] *= rsk; a1[r] *= rsk; a2[r] *= rsk; }
        const int m = m0 + r32;
        float gl[8]; float gmx = -INFINITY, gm2 = -INFINITY; int gi = 0;
#pragma unroll
        for (int i = 0; i < 8; ++i) { auto rr = __builtin_amdgcn_permlane32_swap(__float_as_uint(a2[i]), __float_as_uint(a2[i]), false, false); gl[i] = __uint_as_float(rr[0]) + bg[i]; }
#pragma unroll
        for (int i = 0; i < 8; ++i) { if (gl[i] > gmx) { gm2 = gmx; gmx = gl[i]; gi = i; } else if (gl[i] > gm2) gm2 = gl[i]; }
        float gs = 0.f;
#pragma unroll
        for (int i = 0; i < 8; ++i) gs += __expf(gl[i] - gmx);
        const float gp = 1.f / gs;
        const bool t1 = (gi >> 2) != 0, up = (gi & 1) != 0; const bool owner = hi == ((gi >> 1) & 1);
        float el[8]; float emx = -INFINITY, em2 = -INFINITY, em3 = -INFINITY; int e0 = 0, e1 = 0;
#pragma unroll
        for (int j = 0; j < 8; ++j) { const float lo = t1 ? a1[j] : a0[j], hv = t1 ? a1[8 + j] : a0[8 + j]; el[j] = (up ? hv : lo) + be[gi * 8 + j]; }
#pragma unroll
        for (int j = 0; j < 8; ++j) { const float x = el[j];
            if (x > emx) { em3 = em2; em2 = emx; e1 = e0; emx = x; e0 = j; } else if (x > em2) { em3 = em2; em2 = x; e1 = j; } else if (x > em3) em3 = x; }
        const bool flagged = owner && (fminf(gmx - gm2, em2 - em3) < TAU);
        if (owner && !flagged) { const float p1 = __expf(em2 - emx); route_emit(m, gi * 8 + e0, gi * 8 + e1, gp / (1.f + p1), gp * p1 / (1.f + p1), cnt, tokE, tokR, tokG, list); }
        unsigned long long fm = __ballot(flagged);
        while (fm) { const int fl = __builtin_ctzll(fm); fm &= fm - 1; const int mt = m0 + (fl & 31);
            f32x4 t[4]; float s = 0.f;
#pragma unroll
            for (int j = 0; j < 4; ++j) { const size_t off = (size_t)mt * D + 256 * j + 4 * lane; const u32x2 dd = *(const u32x2*)(D16 + off); const f32x4 xx = *(const f32x4*)(X + off);
                t[j] = (f32x4){xx.x + __uint_as_float(dd.x << 16), xx.y + __uint_as_float(dd.x & 0xffff0000u), xx.z + __uint_as_float(dd.y << 16), xx.w + __uint_as_float(dd.y & 0xffff0000u)};
                s += (t[j].x * t[j].x + t[j].y * t[j].y) + (t[j].z * t[j].z + t[j].w * t[j].w); }
            const float rs = rsqrtf(wave_sum(s) * (1.f / D) + EPS);
#pragma unroll
            for (int j = 0; j < 4; ++j) t[j] = (f32x4){t[j].x * rs * gv[j].x, t[j].y * rs * gv[j].y, t[j].z * rs * gv[j].z, t[j].w * rs * gv[j].w};
            float xg[8] = {0.f, 0.f, 0.f, 0.f, 0.f, 0.f, 0.f, 0.f};
#pragma unroll
            for (int j = 0; j < 4; ++j)
#pragma unroll
                for (int c = 0; c < 4; ++c) { const int k = 256 * j + 4 * lane + c; const f32x4 w0 = *(const f32x4*)(wg + k * 8), w1 = *(const f32x4*)(wg + k * 8 + 4); const float tv = t[j][c];
                    xg[0] += tv * w0[0]; xg[1] += tv * w0[1]; xg[2] += tv * w0[2]; xg[3] += tv * w0[3]; xg[4] += tv * w1[0]; xg[5] += tv * w1[1]; xg[6] += tv * w1[2]; xg[7] += tv * w1[3]; }
            float gmx2 = -INFINITY; int gi2 = 0;
#pragma unroll
            for (int i = 0; i < 8; ++i) { xg[i] = wave_sum(xg[i]) + bg[i]; if (xg[i] > gmx2) { gmx2 = xg[i]; gi2 = i; } }
            float gs2 = 0.f;
#pragma unroll
            for (int i = 0; i < 8; ++i) gs2 += __expf(xg[i] - gmx2);
            gi2 = __builtin_amdgcn_readfirstlane(gi2);
            float xe[8] = {0.f, 0.f, 0.f, 0.f, 0.f, 0.f, 0.f, 0.f};
#pragma unroll
            for (int j = 0; j < 4; ++j)
#pragma unroll
                for (int c = 0; c < 4; ++c) { const int k = 256 * j + 4 * lane + c; const f32x4 w0 = *(const f32x4*)(we + k * 64 + gi2 * 8), w1 = *(const f32x4*)(we + k * 64 + gi2 * 8 + 4); const float tv = t[j][c];
                    xe[0] += tv * w0[0]; xe[1] += tv * w0[1]; xe[2] += tv * w0[2]; xe[3] += tv * w0[3]; xe[4] += tv * w1[0]; xe[5] += tv * w1[1]; xe[6] += tv * w1[2]; xe[7] += tv * w1[3]; }
            float x1 = -INFINITY, x2 = -INFINITY; int f0 = 0, f1 = 0;
#pragma unroll
            for (int i = 0; i < 8; ++i) { xe[i] = wave_sum(xe[i]) + be[gi2 * 8 + i]; }
#pragma unroll
            for (int i = 0; i < 8; ++i) if (xe[i] > x1) { x1 = xe[i]; f0 = i; }
#pragma unroll
            for (int i = 0; i < 8; ++i) if (i != f0 && xe[i] > x2) { x2 = xe[i]; f1 = i; }
            if (lane == 0) { const float gp2 = 1.f / gs2, p1 = __expf(x2 - x1); route_emit(mt, gi2 * 8 + f0, gi2 * 8 + f1, gp2 / (1.f + p1), gp2 * p1 / (1.f + p1), cnt, tokE, tokR, tokG, list); }
        }
    }
}
DEV int slot_start_lane(const int* cnt, int lane, int& c_out, int& total) {
    int st = 0, tot = 0, cm = 0;
    for (int i = 0; i < NE; ++i) { const int c = cnt[i]; const int pad = (c + 255) & ~255; if (i < lane) st += pad; if (i == lane) cm = c; tot += pad; }
    total = __builtin_amdgcn_readfirstlane(tot); c_out = cm; return st;
}
DEV void phase6(const Params& P) { const int tid_ = tid_fresh();
    unsigned char* ws = P.ws; const int lane = tid_ & 63, r32 = lane & 31, hi = lane >> 5; const int gw = blockIdx.x * NWAVE + (tid_ >> 6), ngw = gridDim.x * NWAVE;
    const bf16_t* TN = (const bf16_t*)(ws + WS_TN); const bf16_t* W = (const bf16_t*)(ws + WS_WGU); bf16_t* MH = (bf16_t*)(ws + WS_MH);
    const int* cnt = (const int*)(ws + WS_CTL) + CW_CNT; const int* list = (const int*)(ws + WS_LIST);
    int c_l, total; const int st_l = slot_start_lane(cnt, lane, c_l, total);
    const int Nt = 1024 / 64, nrt = total / 64;
    for (int it = gw; it < nrt * Nt; it += ngw) { const int T = it / Nt, tn = it % Nt;
        const unsigned long long bal = __ballot(st_l <= T * 64); const int e = __builtin_amdgcn_readfirstlane(63 - __builtin_clzll(bal));
        const int st = rl_i(st_l, e), c = rl_i(c_l, e); const int lr = T * 64 - st;
        if (lr >= c) continue;
        const int ra = lr + r32, rb = lr + 32 + r32;
        const int ta = ra < c ? list[(size_t)e * M + ra] : 0, tb = rb < c ? list[(size_t)e * M + rb] : 0;
        const bf16_t* We = W + (size_t)e * 1024 * 1024;
        f32x16 c00 = {}, c01 = {}, c10 = {}, c11 = {};
        wave_tile(TN + (size_t)ta * D + hi * 8, TN + (size_t)tb * D + hi * 8, We + (size_t)(tn * 64 + r32) * D + hi * 8, We + (size_t)(tn * 64 + 32 + r32) * D + hi * 8, D, c00, c01, c10, c11);
#pragma unroll
        for (int r = 0; r < 16; ++r) {
#pragma unroll
            for (int q = 0; q < 4; ++q) { const float v = (q == 0) ? c00[r] : (q == 1) ? c01[r] : (q == 2) ? c10[r] : c11[r];
                const float u = __shfl_down(v, 4); const int row = T * 64 + (q >> 1) * 32 + crow(r, hi), col = tn * 64 + (q & 1) * 32 + r32;
                if ((col & 4) == 0) MH[(size_t)row * DE + (col >> 3) * 4 + (col & 3)] = (bf16_t)f2bf(siluf(v) * u); }
        }
    }
}
DEV void phase7(const Params& P) { const int tid_ = tid_fresh();
    unsigned char* ws = P.ws; const int lane = tid_ & 63, r32 = lane & 31, hi = lane >> 5; const int gw = blockIdx.x * NWAVE + (tid_ >> 6), ngw = gridDim.x * NWAVE;
    const bf16_t* MH = (const bf16_t*)(ws + WS_MH); const bf16_t* W = (const bf16_t*)(ws + WS_WD); bf16_t* MY = (bf16_t*)(ws + WS_MY);
    const int* cnt = (const int*)(ws + WS_CTL) + CW_CNT;
    int c_l, total; const int st_l = slot_start_lane(cnt, lane, c_l, total);
    const int Nt = 1024 / 64, nrt = total / 64;
    for (int it = gw; it < nrt * Nt; it += ngw) { const int T = it / Nt, tn = it % Nt;
        const unsigned long long bal = __ballot(st_l <= T * 64); const int e = __builtin_amdgcn_readfirstlane(63 - __builtin_clzll(bal));
        const int st = rl_i(st_l, e), c = rl_i(c_l, e); const int lr = T * 64 - st;
        if (lr >= c) continue;
        const bf16_t* We = W + (size_t)e * 1024 * 512;
        f32x16 c00 = {}, c01 = {}, c10 = {}, c11 = {};
        wave_tile(MH + (size_t)(T * 64 + r32) * DE + hi * 8, MH + (size_t)(T * 64 + 32 + r32) * DE + hi * 8, We + (size_t)(tn * 64 + r32) * DE + hi * 8, We + (size_t)(tn * 64 + 32 + r32) * DE + hi * 8, DE, c00, c01, c10, c11);
#pragma unroll
        for (int r = 0; r < 16; ++r) { const int row = T * 64 + crow(r, hi), col = tn * 64 + r32;
            MY[(size_t)row * D + col] = (bf16_t)f2bf(c00[r]); MY[(size_t)row * D + col + 32] = (bf16_t)f2bf(c01[r]);
            MY[(size_t)(row + 32) * D + col] = (bf16_t)f2bf(c10[r]); MY[(size_t)(row + 32) * D + col + 32] = (bf16_t)f2bf(c11[r]); }
    }
}
DEV void phase8(const Params& P) { const int tid_ = tid_fresh();
    unsigned char* ws = P.ws; const int lane = tid_ & 63; const int gw = blockIdx.x * NWAVE + (tid_ >> 6), ngw = gridDim.x * NWAVE;
    const bf16_t* H2B = (const bf16_t*)(ws + WS_H2B); const unsigned char* MY = (const unsigned char*)(ws + WS_MY); const float* g = P.in[I_FINAL];
    const int* cnt = (const int*)(ws + WS_CTL) + CW_CNT; const int* tokE = (const int*)(ws + WS_TOK); const int* tokR = tokE + 2 * M; const float* tokG = (const float*)(tokR + 2 * M);
    int c_l, total; const int st_l = slot_start_lane(cnt, lane, c_l, total);
    f32x4 gv[4];
#pragma unroll
    for (int j = 0; j < 4; ++j) gv[j] = *(const f32x4*)(g + 256 * j + 4 * lane);
    for (int m0 = gw * 4; m0 < M; m0 += ngw * 4) {
        u32x2 hh[4][4]; unsigned ya[4][4], yb[4][4]; float g0[4], g1[4];
#pragma unroll
        for (int q = 0; q < 4; ++q) { const int m = m0 + q;
            const int E0 = __builtin_amdgcn_readfirstlane(tokE[2 * m]), E1 = __builtin_amdgcn_readfirstlane(tokE[2 * m + 1]);
            const size_t s0 = (size_t)rl_i(st_l, E0) + tokR[2 * m], s1 = (size_t)rl_i(st_l, E1) + tokR[2 * m + 1]; g0[q] = tokG[2 * m] * (1.f / 16.f); g1[q] = tokG[2 * m + 1] * (1.f / 16.f);
            const u32x2* hr = (const u32x2*)(H2B + (size_t)m * D) + lane; const unsigned* y0 = (const unsigned*)(MY + s0 * D) + lane; const unsigned* y1 = (const unsigned*)(MY + s1 * D) + lane;
#pragma unroll
            for (int j = 0; j < 4; ++j) { hh[q][j] = hr[64 * j]; ya[q][j] = y0[64 * j]; yb[q][j] = y1[64 * j]; } }
#pragma unroll
        for (int q = 0; q < 4; ++q) { f32x4 v[4]; float s = 0.f;
#pragma unroll
            for (int j = 0; j < 4; ++j) { const u32x2 h2 = hh[q][j]; const int a = (int)ya[q][j], b = (int)yb[q][j];
                v[j].x = __uint_as_float(h2.x << 16) + g0[q] * __builtin_amdgcn_cvt_f32_fp8(a, 0) + g1[q] * __builtin_amdgcn_cvt_f32_fp8(b, 0);
                v[j].y = __uint_as_float(h2.x & 0xffff0000u) + g0[q] * __builtin_amdgcn_cvt_f32_fp8(a, 1) + g1[q] * __builtin_amdgcn_cvt_f32_fp8(b, 1);
                v[j].z = __uint_as_float(h2.y << 16) + g0[q] * __builtin_amdgcn_cvt_f32_fp8(a, 2) + g1[q] * __builtin_amdgcn_cvt_f32_fp8(b, 2);
                v[j].w = __uint_as_float(h2.y & 0xffff0000u) + g0[q] * __builtin_amdgcn_cvt_f32_fp8(a, 3) + g1[q] * __builtin_amdgcn_cvt_f32_fp8(b, 3);
                s += (v[j].x * v[j].x + v[j].y * v[j].y) + (v[j].z * v[j].z + v[j].w * v[j].w); }
            const float rs = rsqrtf(wave_sum(s) * (1.f / D) + EPS);
            f32x4* orow = (f32x4*)(P.out + (size_t)(m0 + q) * D) + lane;
#pragma unroll
            for (int j = 0; j < 4; ++j) orow[64 * j] = (f32x4){v[j].x * rs * gv[j].x, v[j].y * rs * gv[j].y, v[j].z * rs * gv[j].z, v[j].w * rs * gv[j].w}; }
    }
}


#ifndef FAST
#define FAST 0x7f
#endif
namespace g8 {
struct EpiZ { static constexpr bool PERM = true; bf16_t* Z; float* ssq_q; float* ssq_kv;
    DEV void operator()(const Acc& acc, const Unit& u, int wr, int wc, int fr, int fq) const {
        const int zt = u.pn < 2 ? u.pn : u.pn + 2;
        const int row0 = u.pm * BM + wr * 64 + fr, col0 = zt * BM + wc * 32 + 8 * fq;
#pragma unroll
        for (int ai = 0; ai < 2; ++ai)
#pragma unroll
            for (int m = 0; m < 4; ++m) { const int row = row0 + ai * HALF + m * 16; bf16_t* rp = Z + (size_t)row * NZ + col0;
#pragma unroll
                for (int bj = 0; bj < 2; ++bj) *(u32x4*)(rp + bj * HALF) = pack8(acc[ai][bj][m][0], acc[ai][bj][m][1]);
                if (u.pn >= 4) { float s = 0.f;
#pragma unroll
                    for (int bj = 0; bj < 2; ++bj) if (u.pn == 4 || bj == 0) {
#pragma unroll
                        for (int n = 0; n < 2; ++n) { const f32x4 v = acc[ai][bj][m][n]; s += (v[0] * v[0] + v[1] * v[1]) + (v[2] * v[2] + v[3] * v[3]); } }
                    s += sx<16>(s); s = half_sum(s);
                    if (fq == 0) atomicAdd((u.pn == 4 ? ssq_q : ssq_kv) + row, s); }
                asm volatile("" ::: "memory"); }
    } };
struct EpiQ { static constexpr bool PERM = true; bf16_t* QM; const float* ssq_q; const float2* rope;
    DEV void operator()(const Acc& acc, const Unit& u, int wr, int wc, int fr, int fq) const {
        const int row0 = u.pm * BM + wr * 64 + fr, col0 = u.pn * BM + wc * 32 + 8 * fq;
#pragma unroll
        for (int ai = 0; ai < 2; ++ai)
#pragma unroll
            for (int m = 0; m < 4; ++m) { const int row = row0 + ai * HALF + m * 16; const float rs = rsqrtf(ssq_q[row] * (1.f / 256.f) + EPS); bf16_t* rp = QM + (size_t)row * 768 + col0;
#pragma unroll
                for (int bj = 0; bj < 2; ++bj) { f32x4 v0 = acc[ai][bj][m][0] * rs, v1 = acc[ai][bj][m][1] * rs;
                    if (u.pn == 2) { const int f0 = (wc & 1) * 16 + 4 * fq; const f32x4* cp = (const f32x4*)(rope + (size_t)(NMETA + (row & (SEQ - 1))) * 32 + f0); const f32x4 ca = cp[0], cb = cp[1];
                        const f32x4 r0 = {v0[0] * ca[0] - v0[1] * ca[1], v0[1] * ca[0] + v0[0] * ca[1], v0[2] * ca[2] - v0[3] * ca[3], v0[3] * ca[2] + v0[2] * ca[3]};
                        const f32x4 r1 = {v1[0] * cb[0] - v1[1] * cb[1], v1[1] * cb[0] + v1[0] * cb[1], v1[2] * cb[2] - v1[3] * cb[3], v1[3] * cb[2] + v1[2] * cb[3]}; v0 = r0; v1 = r1; }
                    *(u32x4*)(rp + bj * HALF) = pack8(v0, v1); }
                asm volatile("" ::: "memory"); }
    } };
struct EpiK { static constexpr bool PERM = true; bf16_t* KN; const float* ssq_kv;
    DEV void operator()(const Acc& acc, const Unit& u, int wr, int wc, int fr, int fq) const {
        const int row0 = u.pm * BM + wr * 64 + fr, col0 = u.pn * BM + wc * 32 + 8 * fq;
#pragma unroll
        for (int ai = 0; ai < 2; ++ai)
#pragma unroll
            for (int m = 0; m < 4; ++m) { const int row = row0 + ai * HALF + m * 16; const float rs = rsqrtf(ssq_kv[row] * (1.f / 128.f) + EPS); bf16_t* rp = KN + (size_t)row * 512 + col0;
#pragma unroll
                for (int bj = 0; bj < 2; ++bj) *(u32x4*)(rp + bj * HALF) = pack8(acc[ai][bj][m][0] * rs, acc[ai][bj][m][1] * rs);
                asm volatile("" ::: "memory"); }
    } };
struct EpiVT { static constexpr bool PERM = true; bf16_t* VT; const float* ssq_kv;
    DEV void operator()(const Acc& acc, const Unit& u, int wr, int wc, int fr, int fq) const {
        const int row0 = u.pm * BM + wr * 64 + fr, col0 = u.pn * BM + wc * 32 + 8 * fq;
        f32x4 rs[2][2];
#pragma unroll
        for (int bj = 0; bj < 2; ++bj)
#pragma unroll
            for (int n = 0; n < 2; ++n) { const f32x4 q = *(const f32x4*)(ssq_kv + col0 + bj * HALF + 4 * n);
                rs[bj][n] = (f32x4){rsqrtf(q[0] * (1.f / 128.f) + EPS), rsqrtf(q[1] * (1.f / 128.f) + EPS), rsqrtf(q[2] * (1.f / 128.f) + EPS), rsqrtf(q[3] * (1.f / 128.f) + EPS)}; }
#pragma unroll
        for (int ai = 0; ai < 2; ++ai)
#pragma unroll
            for (int m = 0; m < 4; ++m) { const int row = row0 + ai * HALF + m * 16; bf16_t* rp = VT + (size_t)row * M + col0;
#pragma unroll
                for (int bj = 0; bj < 2; ++bj) *(u32x4*)(rp + bj * HALF) = pack8(acc[ai][bj][m][0] * rs[bj][0], acc[ai][bj][m][1] * rs[bj][1]); }
    } };
struct EpiQ8 { static constexpr bool PERM = true; unsigned char* QM; const float* ssq_q; const float2* rope;
    DEV void operator()(const Acc& acc, const Unit& u, int wr, int wc, int fr, int fq) const {
        const int row0 = u.pm * BM + wr * 64 + fr, col0 = u.pn * BM + wc * 32 + 8 * fq;
        float rs[8];
#pragma unroll
        for (int i = 0; i < 8; ++i) rs[i] = ssq_q[row0 + (i >> 2) * HALF + (i & 3) * 16];
#pragma unroll
        for (int i = 0; i < 8; ++i) rs[i] = 16.f * rsqrtf(rs[i] * (1.f / 256.f) + EPS);
#pragma unroll
        for (int ai = 0; ai < 2; ++ai) {
            f32x4 ca[4], cb[4];
            if (u.pn == 2) { const int f0 = (wc & 1) * 16 + 4 * fq;
#pragma unroll
                for (int m = 0; m < 4; ++m) { const int row = row0 + ai * HALF + m * 16; const f32x4* cp = (const f32x4*)(rope + (size_t)(NMETA + (row & (SEQ - 1))) * 32 + f0); ca[m] = cp[0]; cb[m] = cp[1]; } }
#pragma unroll
            for (int m = 0; m < 4; ++m) { const int row = row0 + ai * HALF + m * 16; const float r_ = rs[ai * 4 + m]; unsigned char* rp = QM + (size_t)row * 768 + col0;
#pragma unroll
                for (int bj = 0; bj < 2; ++bj) { f32x4 v0 = acc[ai][bj][m][0] * r_, v1 = acc[ai][bj][m][1] * r_;
                    if (u.pn == 2) {
                        const f32x4 r0 = {v0[0] * ca[m][0] - v0[1] * ca[m][1], v0[1] * ca[m][0] + v0[0] * ca[m][1], v0[2] * ca[m][2] - v0[3] * ca[m][3], v0[3] * ca[m][2] + v0[2] * ca[m][3]};
                        const f32x4 r1 = {v1[0] * cb[m][0] - v1[1] * cb[m][1], v1[1] * cb[m][0] + v1[0] * cb[m][1], v1[2] * cb[m][2] - v1[3] * cb[m][3], v1[3] * cb[m][2] + v1[2] * cb[m][3]}; v0 = r0; v1 = r1; }
                    u32x2 w; w.x = pk4_fp8(v0[0], v0[1], v0[2], v0[3]); w.y = pk4_fp8(v1[0], v1[1], v1[2], v1[3]); *(u32x2*)(rp + bj * HALF) = w; } }
            asm volatile("" ::: "memory"); }
    } };
struct EpiK8 { static constexpr bool PERM = true; unsigned char* KN; const float* ssq_kv;
    DEV void operator()(const Acc& acc, const Unit& u, int wr, int wc, int fr, int fq) const {
        const int row0 = u.pm * BM + wr * 64 + fr, col0 = u.pn * BM + wc * 32 + 8 * fq;
        float rs[8];
#pragma unroll
        for (int i = 0; i < 8; ++i) rs[i] = ssq_kv[row0 + (i >> 2) * HALF + (i & 3) * 16];
#pragma unroll
        for (int i = 0; i < 8; ++i) rs[i] = rsqrtf(rs[i] * (1.f / 128.f) + EPS);
#pragma unroll
        for (int ai = 0; ai < 2; ++ai)
#pragma unroll
            for (int m = 0; m < 4; ++m) { const int row = row0 + ai * HALF + m * 16; const float r_ = rs[ai * 4 + m]; unsigned char* rp = KN + (size_t)row * 512 + col0;
#pragma unroll
                for (int bj = 0; bj < 2; ++bj) { const f32x4 v0 = acc[ai][bj][m][0] * r_, v1 = acc[ai][bj][m][1] * r_; u32x2 w; w.x = pk4_fp8(v0[0], v0[1], v0[2], v0[3]); w.y = pk4_fp8(v1[0], v1[1], v1[2], v1[3]); *(u32x2*)(rp + bj * HALF) = w; } }
    } };
struct EpiVT8 { static constexpr bool PERM = true; unsigned char* VT; const float* ssq_kv;
    DEV void operator()(const Acc& acc, const Unit& u, int wr, int wc, int fr, int fq) const {
        const int row0 = u.pm * BM + wr * 64 + fr, col0 = u.pn * BM + wc * 32 + 8 * fq;
        f32x4 rs[2][2];
#pragma unroll
        for (int bj = 0; bj < 2; ++bj)
#pragma unroll
            for (int n = 0; n < 2; ++n) { const f32x4 q = *(const f32x4*)(ssq_kv + col0 + bj * HALF + 4 * n);
                rs[bj][n] = (f32x4){rsqrtf(q[0] * (1.f / 128.f) + EPS), rsqrtf(q[1] * (1.f / 128.f) + EPS), rsqrtf(q[2] * (1.f / 128.f) + EPS), rsqrtf(q[3] * (1.f / 128.f) + EPS)}; }
#pragma unroll
        for (int ai = 0; ai < 2; ++ai)
#pragma unroll
            for (int m = 0; m < 4; ++m) { const int row = row0 + ai * HALF + m * 16; unsigned char* rp = VT + (size_t)row * M + col0;
#pragma unroll
                for (int bj = 0; bj < 2; ++bj) { const f32x4 v0 = acc[ai][bj][m][0] * rs[bj][0], v1 = acc[ai][bj][m][1] * rs[bj][1]; u32x2 w; w.x = pk4_fp8(v0[0], v0[1], v0[2], v0[3]); w.y = pk4_fp8(v1[0], v1[1], v1[2], v1[3]); *(u32x2*)(rp + bj * HALF) = w; } }
    } };
struct EpiH2 { static constexpr bool PERM = false; float* H2; const float* x;
    DEV void operator()(const Acc& acc, const Unit& u, int wr, int wc, int fr, int fq) const {
        const int row0 = u.pm * BM + wr * 64 + fr, col0 = u.pn * BM + wc * 32 + 4 * fq;
#pragma unroll
        for (int ai = 0; ai < 2; ++ai)
#pragma unroll
            for (int m = 0; m < 4; ++m) { const size_t off = (size_t)(row0 + ai * HALF + m * 16) * D + col0;
#pragma unroll
                for (int bj = 0; bj < 2; ++bj)
#pragma unroll
                    for (int n = 0; n < 2; ++n) *(f32x4*)(H2 + off + bj * HALF + n * 16) = *(const f32x4*)(x + off + bj * HALF + n * 16) + acc[ai][bj][m][n];
                if (m & 1) asm volatile("" ::: "memory"); }
    } };
struct EpiGU { static constexpr bool PERM = true; bf16_t* MH;
    DEV void operator()(const Acc& acc, const Unit& u, int wr, int wc, int fr, int fq) const {
        const int row0 = u.pm * BM + wr * 64 + fr, hid0 = u.pn * 128 + wc * 16 + 4 * fq;
#pragma unroll
        for (int ai = 0; ai < 2; ++ai)
#pragma unroll
            for (int m = 0; m < 4; ++m) { bf16_t* rp = MH + (size_t)(row0 + ai * HALF + m * 16) * DE + hid0;
#pragma unroll
                for (int bj = 0; bj < 2; ++bj) { const f32x4 g = acc[ai][bj][m][0], up = acc[ai][bj][m][1];
                    u32x2 w; w.x = cvt_pk_bf16(siluf(g[0]) * up[0], siluf(g[1]) * up[1]); w.y = cvt_pk_bf16(siluf(g[2]) * up[2], siluf(g[3]) * up[3]);
                    *(u32x2*)(rp + bj * 64) = w; } }
    } };
struct EpiD { static constexpr bool PERM = true; bf16_t* MY; size_t ld;
    DEV void operator()(const Acc& acc, const Unit& u, int wr, int wc, int fr, int fq) const {
        const int row0 = u.pm * BM + wr * 64 + fr, col0 = u.pn * BM + wc * 32 + 8 * fq;
#pragma unroll
        for (int ai = 0; ai < 2; ++ai)
#pragma unroll
            for (int m = 0; m < 4; ++m) { bf16_t* rp = MY + (size_t)(row0 + ai * HALF + m * 16) * ld + col0;
#pragma unroll
                for (int bj = 0; bj < 2; ++bj) *(u32x4*)(rp + bj * HALF) = pack8(acc[ai][bj][m][0], acc[ai][bj][m][1]); }
    } };
struct EpiLOGA { static constexpr bool PERM = true; float* LOGA; const float* ba;
    DEV void operator()(const Acc& acc, const Unit& u, int wr, int wc, int fr, int fq) const {
        const int row0 = u.pm * BM + wr * 64 + fr, col0 = wc * 32 + 8 * fq;
        f32x4 bv[2][2];
#pragma unroll
        for (int bj = 0; bj < 2; ++bj)
#pragma unroll
            for (int n = 0; n < 2; ++n) bv[bj][n] = *(const f32x4*)(ba + col0 + bj * HALF + 4 * n);
#pragma unroll
        for (int ai = 0; ai < 2; ++ai)
#pragma unroll
            for (int m = 0; m < 4; ++m) { float* rp = LOGA + (size_t)(row0 + ai * HALF + m * 16) * 256 + col0;
#pragma unroll
                for (int bj = 0; bj < 2; ++bj)
#pragma unroll
                    for (int n = 0; n < 2; ++n) { const f32x4 v = acc[ai][bj][m][n]; f32x4 o;
#pragma unroll
                        for (int c = 0; c < 4; ++c) { const float x = v[c] + bv[bj][n][c]; o[c] = (fminf(x, 0.f) - 0.6931471805599453f * __builtin_amdgcn_logf(1.f + __expf(-fabsf(x)))) * (1.f / 16.f); }
                        *(f32x4*)(rp + bj * HALF + 4 * n) = o; }
                asm volatile("" ::: "memory"); }
    } };
struct EpiGU8 { static constexpr bool PERM = true; unsigned char* MH;
    DEV void operator()(const Acc& acc, const Unit& u, int wr, int wc, int fr, int fq) const {
        const int row0 = u.pm * BM + wr * 64 + fr, hid0 = u.pn * 128 + wc * 16 + 4 * fq;
#pragma unroll
        for (int ai = 0; ai < 2; ++ai)
#pragma unroll
            for (int m = 0; m < 4; ++m) { unsigned char* rp = MH + (size_t)(row0 + ai * HALF + m * 16) * DE + hid0;
#pragma unroll
                for (int bj = 0; bj < 2; ++bj) { const f32x4 g = acc[ai][bj][m][0] * (1.f / 32.f), up = acc[ai][bj][m][1] * (8.f / 32.f);
                    *(unsigned*)(rp + bj * 64) = pk4_fp8(siluf(g[0]) * up[0], siluf(g[1]) * up[1], siluf(g[2]) * up[2], siluf(g[3]) * up[3]); }
                asm volatile("" ::: "memory"); }
    } };
struct EpiD8 { static constexpr bool PERM = true; unsigned char* MY; float osc;
    DEV void operator()(const Acc& acc, const Unit& u, int wr, int wc, int fr, int fq) const {
        const int row0 = u.pm * BM + wr * 64 + fr, col0 = u.pn * BM + wc * 32 + 8 * fq;
#pragma unroll
        for (int ai = 0; ai < 2; ++ai)
#pragma unroll
            for (int m = 0; m < 4; ++m) { unsigned char* rp = MY + (size_t)(row0 + ai * HALF + m * 16) * D + col0;
#pragma unroll
                for (int bj = 0; bj < 2; ++bj) { const f32x4 a = acc[ai][bj][m][0] * osc, b = acc[ai][bj][m][1] * osc; u32x2 w;
                    int t = __builtin_amdgcn_cvt_pk_fp8_f32(a[0], a[1], 0, false); t = __builtin_amdgcn_cvt_pk_fp8_f32(a[2], a[3], t, true); w.x = (unsigned)t;
                    t = __builtin_amdgcn_cvt_pk_fp8_f32(b[0], b[1], 0, false); t = __builtin_amdgcn_cvt_pk_fp8_f32(b[2], b[3], t, true); w.y = (unsigned)t;
                    *(u32x2*)(rp + bj * HALF) = w; }
                asm volatile("" ::: "memory"); }
    } };
struct MoeSched {
    const char* A; const char* B; size_t estepB, tstepB, tstepA; const int* list; int nunits, G, c, lda2;
    DEV static int st_of(int e) { return *(volatile LAS int*)(SLOTTAB_OFF + 4u * (unsigned)e); }
    DEV static int cn_of(int e) { return *(volatile LAS int*)(SLOTTAB_OFF + 256u + 4u * (unsigned)e); }
    DEV bool next(int i, Unit& u) const {
        const int L = i * G + c; if (L >= nunits) return false;
        u.pm = L >> 2; u.pn = L & 3; unsigned l_; asm volatile("v_mbcnt_lo_u32_b32 %0, -1, 0\n\tv_mbcnt_hi_u32_b32 %0, -1, %0" : "=v"(l_));
        const unsigned long long bal = __ballot(st_of((int)l_) <= u.pm * BM); u.e = __builtin_amdgcn_readfirstlane(63 - __builtin_clzll(bal)); return true;
    }
    DEV unsigned aoff(const Unit& u) const { return (unsigned)((size_t)u.pm * tstepA); }
    DEV unsigned boff(const Unit& u) const { return (unsigned)((size_t)u.e * estepB + (size_t)u.pn * tstepB); }
    DEV unsigned atok(const Unit& u, int r) const { const int st = st_of(u.e), cn = cn_of(u.e); const int lr = u.pm * BM - st + r;
        return (unsigned)(lr < cn ? list[u.e * M + lr] : 0); }
};
}
DEV int vcu_of(int bx, int G) { return (G % 8 == 0) ? (bx % 8) * (G / 8) + bx / 8 : bx; }
namespace mla {
constexpr int KSLOT = 24576, OFF_KR = 16384, VRING = 3 * KSLOT, VSLOT = 16384;
constexpr float THR = 8.f;
DEV void blds(__amdgpu_buffer_rsrc_t r, unsigned voff, unsigned soff, LAS unsigned char* l) { __builtin_amdgcn_raw_ptr_buffer_load_lds(r, (LAS void*)l, 16, (int)voff, (int)soff, 0, 0); }
DEV void unit(const Params& P, LAS unsigned char* lds, int b, int h, int qb, int tid) {
    asm volatile("" : "+v"(tid));
    unsigned char* ws = P.ws; const int lane = tid & 63, r32 = lane & 31, hi = lane >> 5; const int wave = __builtin_amdgcn_readfirstlane(tid >> 6);
    const bf16_t* QM = (const bf16_t*)(ws + WS_QM); const char* KN = (const char*)(ws + WS_KN); const char* VT = (const char*)(ws + WS_VT); const char* KR = (const char*)(ws + WS_KR);
    const bf16_t* KNm = (const bf16_t*)(ws + WS_META + MT_KN); const bf16_t* VTm = (const bf16_t*)(ws + WS_META + MT_VT); const bf16_t* KRm = (const bf16_t*)(ws + WS_META + MT_KR);
    bf16_t* Y = (bf16_t*)(ws + WS_Y);
    const int NTL = 4 * qb + 4, nact = 4 * qb + (wave >> 1) + 1;
    unsigned okn[2], ovt[2], okr;
#pragma unroll
    for (int i = 0; i < 2; ++i) { const int p = 2 * wave + i;
        { const int row = 4 * p + (lane >> 4), c = (lane & 15) ^ (row & 15); okn[i] = (unsigned)(((size_t)(b * SEQ + row) * 512 + h * 128 + c * 8) * 2); }
        { const int row = 8 * p + (lane >> 3), c = (lane & 7) ^ ((row >> 1) & 7); ovt[i] = (unsigned)(((size_t)(h * 128 + row) * M + (size_t)b * SEQ + c * 8) * 2); } }
    { const int row = 8 * wave + (lane >> 3), c = (lane & 7) ^ ((row >> 1) & 7); okr = (unsigned)(((size_t)(b * SEQ + row) * 64 + c * 8) * 2); }
    const unsigned wl = (unsigned)wave * 2048u;
    const __amdgpu_buffer_rsrc_t rKN = __builtin_amdgcn_make_buffer_rsrc((void*)KN, 0, 64 << 20, 0x00020000), rKR = __builtin_amdgcn_make_buffer_rsrc((void*)KR, 0, 8 << 20, 0x00020000),
                                 rVT = __builtin_amdgcn_make_buffer_rsrc((void*)VT, 0, 64 << 20, 0x00020000);
#define MLA_ISSUE_K(j, slot) do { LAS unsigned char* sb_ = lds + (slot) * KSLOT; const unsigned jk_ = (unsigned)(j) * (64u * 512u * 2u), jr_ = (unsigned)(j) * (64u * 64u * 2u); \
        blds(rKN, okn[0], jk_, sb_ + wl); blds(rKN, okn[1], jk_, sb_ + wl + 1024); blds(rKR, okr, jr_, sb_ + OFF_KR + (wl >> 1)); } while (0)
#define MLA_ISSUE_V(j, slot) do { LAS unsigned char* sb_ = lds + VRING + (slot) * VSLOT; const unsigned jv_ = (unsigned)(j) * 128u; \
        blds(rVT, ovt[0], jv_, sb_ + wl); blds(rVT, ovt[1], jv_, sb_ + wl + 1024); } while (0)
    asm volatile("s_waitcnt vmcnt(0)" ::: "memory"); __builtin_amdgcn_s_barrier();
    MLA_ISSUE_K(0, 0); MLA_ISSUE_V(0, 0); MLA_ISSUE_K(1, 1);
    const size_t mq = (size_t)b * SEQ + qb * 256 + wave * 32 + r32;
    bf16x8 qf[12];
#pragma unroll
    for (int s = 0; s < 8; ++s) qf[s] = *(const bf16x8*)(QM + mq * 768 + h * 128 + 16 * s + 8 * hi);
#pragma unroll
    for (int s = 0; s < 4; ++s) qf[8 + s] = *(const bf16x8*)(QM + mq * 768 + 512 + h * 64 + 16 * s + 8 * hi);
    f32x16 O[4] = {}; float mrun = -INFINITY, l = 0.f;
    const int kperm = pi23(r32);
    const int xk = (kperm & 15) ^ hi, xr = ((kperm >> 1) & 7) ^ hi, xv = ((r32 >> 1) & 7) ^ hi;
    const int kn_b = kperm * 256, kr_b = OFF_KR + kperm * 128, vt_b = r32 * 128;
#define MLA_SOFTMAX(S0, S1) do { \
        float mx = fmaxf(S0[0], S1[0]); \
        _Pragma("unroll") for (int r = 1; r < 16; ++r) mx = fmaxf(mx, fmaxf(S0[r], S1[r])); \
        mx = half_max(mx); \
        if (__any(mx > mrun + THR)) { const float mnew = fmaxf(mrun, mx), alpha = __builtin_amdgcn_exp2f(mrun - mnew); mrun = mnew; l *= alpha; \
            _Pragma("unroll") for (int d = 0; d < 4; ++d) _Pragma("unroll") for (int r = 0; r < 16; ++r) O[d][r] *= alpha; } \
        float ps = 0.f; \
        _Pragma("unroll") for (int r = 0; r < 16; ++r) { S0[r] = __builtin_amdgcn_exp2f(S0[r] - mrun); S1[r] = __builtin_amdgcn_exp2f(S1[r] - mrun); ps += S0[r] + S1[r]; } \
        l += ps; \
        { u32x4 w; w.x = g8::cvt_pk_bf16(S0[0], S0[1]); w.y = g8::cvt_pk_bf16(S0[2], S0[3]); w.z = g8::cvt_pk_bf16(S0[4], S0[5]); w.w = g8::cvt_pk_bf16(S0[6], S0[7]); pf[0] = __builtin_bit_cast(bf16x8, w); \
          w.x = g8::cvt_pk_bf16(S0[8], S0[9]); w.y = g8::cvt_pk_bf16(S0[10], S0[11]); w.z = g8::cvt_pk_bf16(S0[12], S0[13]); w.w = g8::cvt_pk_bf16(S0[14], S0[15]); pf[1] = __builtin_bit_cast(bf16x8, w); \
          w.x = g8::cvt_pk_bf16(S1[0], S1[1]); w.y = g8::cvt_pk_bf16(S1[2], S1[3]); w.z = g8::cvt_pk_bf16(S1[4], S1[5]); w.w = g8::cvt_pk_bf16(S1[6], S1[7]); pf[2] = __builtin_bit_cast(bf16x8, w); \
          w.x = g8::cvt_pk_bf16(S1[8], S1[9]); w.y = g8::cvt_pk_bf16(S1[10], S1[11]); w.z = g8::cvt_pk_bf16(S1[12], S1[13]); w.w = g8::cvt_pk_bf16(S1[14], S1[15]); pf[3] = __builtin_bit_cast(bf16x8, w); } \
    } while (0)
#define MLA_PV(VLOAD) do { \
        _Pragma("unroll") for (int d = 0; d < 4; ++d) { _Pragma("unroll") for (int sp = 0; sp < 4; ++sp) { const bf16x8 vf = VLOAD(d, sp); O[d] = __builtin_amdgcn_mfma_f32_32x32x16_bf16(vf, pf[sp], O[d], 0, 0, 0); } } \
        __builtin_amdgcn_sched_group_barrier(0x100, 8, 1); \
        _Pragma("unroll") for (int i_ = 0; i_ < 4; ++i_) { __builtin_amdgcn_sched_group_barrier(0x8, 2, 1); __builtin_amdgcn_sched_group_barrier(0x100, 2, 1); } \
        __builtin_amdgcn_sched_group_barrier(0x8, 8, 1); \
    } while (0)
    bf16x8 pf[4];
    { f32x16 S0 = {}, S1; const bf16x8 zf = {};
#pragma unroll
      for (int s = 0; s < 8; ++s) { const bf16x8 kf = *(const bf16x8*)(KNm + kperm * 512 + h * 128 + 16 * s + 8 * hi); S0 = __builtin_amdgcn_mfma_f32_32x32x16_bf16(kf, qf[s], S0, 0, 0, 0); }
#pragma unroll
      for (int s = 0; s < 4; ++s) { const bf16x8 kf = *(const bf16x8*)(KRm + kperm * 64 + 16 * s + 8 * hi); S0 = __builtin_amdgcn_mfma_f32_32x32x16_bf16(kf, qf[8 + s], S0, 0, 0, 0); }
#pragma unroll
      for (int r = 0; r < 16; ++r) { if (pi23(crow(r, hi)) >= NMETA) S0[r] = -INFINITY; S1[r] = -INFINITY; }
#define MLA_VMETA(d, sp) ((sp) == 0 ? *(const bf16x8*)(VTm + (h * 128 + 32 * (d) + r32) * 32 + 8 * hi) : zf)
      MLA_SOFTMAX(S0, S1); MLA_PV(MLA_VMETA);
    }
#define MLA_QK(S0, S1, kslot) do { LAS const unsigned char* sb = lds + (kslot) * KSLOT; int xk_ = xk, xr_ = xr; asm volatile("" : "+v"(xk_), "+v"(xr_));   \
        _Pragma("unroll") for (int r = 0; r < 16; ++r) { S0[r] = 0.f; S1[r] = 0.f; } \
        _Pragma("unroll") for (int s = 0; s < 8; ++s) { const int co = ((2 * s) ^ xk_) << 4; const bf16x8 k0 = *(LAS const bf16x8*)(sb + kn_b + co), k1 = *(LAS const bf16x8*)(sb + kn_b + 32 * 256 + co); \
            S0 = __builtin_amdgcn_mfma_f32_32x32x16_bf16(k0, qf[s], S0, 0, 0, 0); S1 = __builtin_amdgcn_mfma_f32_32x32x16_bf16(k1, qf[s], S1, 0, 0, 0); } \
        _Pragma("unroll") for (int s = 0; s < 4; ++s) { const int co = ((2 * s) ^ xr_) << 4; const bf16x8 k0 = *(LAS const bf16x8*)(sb + kr_b + co), k1 = *(LAS const bf16x8*)(sb + kr_b + 32 * 128 + co); \
            S0 = __builtin_amdgcn_mfma_f32_32x32x16_bf16(k0, qf[8 + s], S0, 0, 0, 0); S1 = __builtin_amdgcn_mfma_f32_32x32x16_bf16(k1, qf[8 + s], S1, 0, 0, 0); } \
        __builtin_amdgcn_sched_group_barrier(0x100, 8, 0); \
        _Pragma("unroll") for (int i_ = 0; i_ < 8; ++i_) { __builtin_amdgcn_sched_group_barrier(0x8, 2, 0); __builtin_amdgcn_sched_group_barrier(0x100, 2, 0); } \
        __builtin_amdgcn_sched_group_barrier(0x8, 8, 0); } while (0)
#define MLA_VLDS(d, sp) (*(LAS const bf16x8*)(vb + vt_b + (d) * (32 * 128) + (((2 * (sp)) ^ xv_) << 4)))
    { const bool late = wave >= 4; int ks = 0;
      for (int j = 0; j < NTL; ++j) {
        if (j + 1 < NTL) asm volatile("s_waitcnt vmcnt(3)" ::: "memory"); else asm volatile("s_waitcnt vmcnt(0)" ::: "memory");
        __builtin_amdgcn_s_barrier(); asm volatile("" ::: "memory");
        if (j + 1 < NTL) MLA_ISSUE_V(j + 1, ks == 2 ? 0 : ks + 1);
        if (j + 2 < NTL) MLA_ISSUE_K(j + 2, ks == 0 ? 2 : ks - 1);
        if (late && j >= 1 && j - 1 < nact) { LAS const unsigned char* vb = lds + VRING + (ks == 0 ? 2 : ks - 1) * VSLOT; int xv_ = xv; asm volatile("" : "+v"(xv_)); MLA_PV(MLA_VLDS); }
        if (j < nact) { f32x16 S0, S1; MLA_QK(S0, S1, ks); MLA_SOFTMAX(S0, S1);
            if (!late) { LAS const unsigned char* vb = lds + VRING + ks * VSLOT; int xv_ = xv; asm volatile("" : "+v"(xv_)); MLA_PV(MLA_VLDS); } }
        ks = ks == 2 ? 0 : ks + 1;
      }
      if (late && NTL - 1 < nact) { LAS const unsigned char* vb = lds + VRING + (ks == 0 ? 2 : ks - 1) * VSLOT; int xv_ = xv; asm volatile("" : "+v"(xv_)); MLA_PV(MLA_VLDS); } }
    l = half_sum(l); const float rl = 1.f / l;
    { int te = tid; asm volatile("" : "+v"(te));
      bf16_t* yr = Y + ((size_t)b * SEQ + qb * 256 + wave * 32 + (te & 31)) * 1024 + 512 + h * 128 + 4 * ((te >> 5) & 1);
#pragma unroll
      for (int d = 0; d < 4; ++d)
#pragma unroll
        for (int g = 0; g < 4; ++g) { u32x2 w; w.x = g8::cvt_pk_bf16(O[d][4 * g] * rl, O[d][4 * g + 1] * rl); w.y = g8::cvt_pk_bf16(O[d][4 * g + 2] * rl, O[d][4 * g + 3] * rl);
            *(u32x2*)(yr + 32 * d + 8 * g) = w; } }
#undef MLA_ISSUE_K
#undef MLA_ISSUE_V
#undef MLA_QK
#undef MLA_SOFTMAX
#undef MLA_PV
#undef MLA_VMETA
#undef MLA_VLDS
}
}
namespace mla8 {
typedef int i32x8 __attribute__((ext_vector_type(8)));
typedef int i32x4 __attribute__((ext_vector_type(4)));
constexpr int KSLOT = 12288, OFF_KR = 8192, VRING = 3 * KSLOT, VSLOT = 8192;
constexpr float THR = 8.f, INVQS = 1.f / 16.f;
DEV int pip(int i) { return (i & 3) | (((i >> 3) & 3) << 2) | (((i >> 2) & 1) << 4); }
DEV f32x16 mfma8(i32x8 a, i32x8 b, f32x16 c) { return __builtin_amdgcn_mfma_scale_f32_32x32x64_f8f6f4(a, b, c, 0, 0, 0, 0x7f7f7f7f, 0, 0x7f7f7f7f); }
DEV i32x8 cat(i32x4 a, i32x4 b) { return (i32x8){a[0], a[1], a[2], a[3], b[0], b[1], b[2], b[3]}; }
DEV void unit(const Params& P, LAS unsigned char* lds, int b, int h, int qb, int tid) {
    asm volatile("" : "+v"(tid));
    unsigned char* ws = P.ws; const int lane = tid & 63, r32 = lane & 31, hi = lane >> 5; const int wave = __builtin_amdgcn_readfirstlane(tid >> 6);
    const unsigned char* QM = ws + WS_QM; const unsigned char* KN = ws + WS_KN; const unsigned char* VT = ws + WS_VT; const unsigned char* KR = ws + WS_KR;
    const unsigned char* KNm = ws + WS_META + MT_KN8; const unsigned char* VTm = ws + WS_META + MT_VT8; const unsigned char* KRm = ws + WS_META + MT_KR8;
    bf16_t* Y = (bf16_t*)(ws + WS_Y);
    const int NTL = 4 * qb + 4, nact = 4 * qb + (wave >> 1) + 1;
    unsigned okn, okr, ovt;
    { const int row = 8 * wave + (lane >> 3), c = (lane & 7) ^ ((row >> 1) & 7); okn = (unsigned)((size_t)(b * SEQ + row) * 512 + h * 128 + c * 16); }
    { const int row = 16 * (wave & 3) + (lane >> 2), c = (lane & 3) ^ ((row >> 2) & 3); okr = (unsigned)((size_t)(b * SEQ + row) * 64 + c * 16); }
    { const int row = 16 * wave + (lane >> 2), c = (lane & 3) ^ ((row >> 2) & 3); ovt = (unsigned)((size_t)(h * 128 + row) * M + (size_t)b * SEQ + c * 16); }
    const unsigned wl = (unsigned)wave * 1024u, wl3 = (unsigned)(wave & 3) * 1024u;
    const __amdgpu_buffer_rsrc_t rKN = __builtin_amdgcn_make_buffer_rsrc((void*)KN, 0, 32 << 20, 0x00020000), rKR = __builtin_amdgcn_make_buffer_rsrc((void*)KR, 0, 4 << 20, 0x00020000),
                                 rVT = __builtin_amdgcn_make_buffer_rsrc((void*)VT, 0, 32 << 20, 0x00020000);
#define M8_ISSUE_K(j, slot) do { LAS unsigned char* sb_ = lds + (slot) * KSLOT; mla::blds(rKN, okn, (unsigned)(j) * (64u * 512u), sb_ + wl); mla::blds(rKR, okr, (unsigned)(j) * (64u * 64u), sb_ + OFF_KR + wl3); } while (0)
#define M8_ISSUE_V(j, slot) do { mla::blds(rVT, ovt, (unsigned)(j) * 64u, lds + VRING + (slot) * VSLOT + wl); } while (0)
    asm volatile("s_waitcnt vmcnt(0)" ::: "memory"); __builtin_amdgcn_s_barrier();
    M8_ISSUE_K(0, 0); M8_ISSUE_V(0, 0); M8_ISSUE_K(1, 1);
    i32x8 qf[3];
    { const unsigned char* qp = QM + ((size_t)b * SEQ + qb * 256 + wave * 32 + r32) * 768;
      qf[0] = *(const i32x8*)(qp + h * 128 + 32 * hi); qf[1] = *(const i32x8*)(qp + h * 128 + 64 + 32 * hi); qf[2] = *(const i32x8*)(qp + 512 + h * 64 + 32 * hi); }
    f32x16 O[4] = {}; float mrun = -INFINITY, l = 0.f;
    const int kperm = pip(r32);
    const int xk = (kperm >> 1) & 7, xr = (kperm >> 2) & 3, xv = (r32 >> 2) & 3;
    const int kn_b = kperm * 128, kr_b = OFF_KR + kperm * 64, vt_b = r32 * 64;
    i32x8 pb;
#define M8_SOFTMAX(S0, S1) do { \
        float mx = fmaxf(S0[0], S1[0]); \
        _Pragma("unroll") for (int r = 1; r < 16; ++r) mx = fmaxf(mx, fmaxf(S0[r], S1[r])); \
        mx = half_max(mx) * INVQS; \
        if (__any(mx > mrun + THR)) { const float mnew = fmaxf(mrun, mx), alpha = __builtin_amdgcn_exp2f(mrun - mnew); mrun = mnew; l *= alpha; \
            _Pragma("unroll") for (int d = 0; d < 4; ++d) _Pragma("unroll") for (int r = 0; r < 16; ++r) O[d][r] *= alpha; } \
        float ps = 0.f; \
        _Pragma("unroll") for (int r = 0; r < 16; ++r) { S0[r] = __builtin_amdgcn_exp2f(S0[r] * INVQS - mrun); S1[r] = __builtin_amdgcn_exp2f(S1[r] * INVQS - mrun); ps += S0[r] + S1[r]; } \
        l += ps; \
        pb[0] = (int)pk4_fp8(S0[0], S0[1], S0[2], S0[3]); pb[1] = (int)pk4_fp8(S0[4], S0[5], S0[6], S0[7]); pb[2] = (int)pk4_fp8(S0[8], S0[9], S0[10], S0[11]); pb[3] = (int)pk4_fp8(S0[12], S0[13], S0[14], S0[15]); \
        pb[4] = (int)pk4_fp8(S1[0], S1[1], S1[2], S1[3]); pb[5] = (int)pk4_fp8(S1[4], S1[5], S1[6], S1[7]); pb[6] = (int)pk4_fp8(S1[8], S1[9], S1[10], S1[11]); pb[7] = (int)pk4_fp8(S1[12], S1[13], S1[14], S1[15]); \
    } while (0)
#define M8_SOFTMAX2(S0, S1) do { \
        _Pragma("unroll") for (int r = 0; r < 16; ++r) { S0[r] = __builtin_fmaf(S0[r], INVQS, -mrun); S1[r] = __builtin_fmaf(S1[r], INVQS, -mrun); } \
        float mxa = fmaxf(fmaxf(S0[0], S0[1]), S0[2]), mxb = fmaxf(fmaxf(S1[0], S1[1]), S1[2]); \
        _Pragma("unroll") for (int r = 3; r < 15; r += 2) { mxa = fmaxf(fmaxf(mxa, S0[r]), S0[r + 1]); mxb = fmaxf(fmaxf(mxb, S1[r]), S1[r + 1]); } \
        float mx = half_max(fmaxf(fmaxf(mxa, S0[15]), fmaxf(mxb, S1[15]))); \
        if (__any(mx > THR)) { const float d = fmaxf(mx, 0.f), alpha = __builtin_amdgcn_exp2f(-d); mrun += d; l *= alpha; \
            _Pragma("unroll") for (int r = 0; r < 16; ++r) { S0[r] -= d; S1[r] -= d; } \
            _Pragma("unroll") for (int d_ = 0; d_ < 4; ++d_) _Pragma("unroll") for (int r = 0; r < 16; ++r) O[d_][r] *= alpha; } \
        float ps = 0.f; \
        _Pragma("unroll") for (int r = 0; r < 16; ++r) { S0[r] = __builtin_amdgcn_exp2f(S0[r]); S1[r] = __builtin_amdgcn_exp2f(S1[r]); ps += S0[r] + S1[r]; } \
        l += ps; \
        pb[0] = (int)pk4_fp8(S0[0], S0[1], S0[2], S0[3]); pb[1] = (int)pk4_fp8(S0[4], S0[5], S0[6], S0[7]); pb[2] = (int)pk4_fp8(S0[8], S0[9], S0[10], S0[11]); pb[3] = (int)pk4_fp8(S0[12], S0[13], S0[14], S0[15]); \
        pb[4] = (int)pk4_fp8(S1[0], S1[1], S1[2], S1[3]); pb[5] = (int)pk4_fp8(S1[4], S1[5], S1[6], S1[7]); pb[6] = (int)pk4_fp8(S1[8], S1[9], S1[10], S1[11]); pb[7] = (int)pk4_fp8(S1[12], S1[13], S1[14], S1[15]); \
    } while (0)
    { f32x16 S0 = {}, S1;
      S0 = mfma8(*(const i32x8*)(KNm + kperm * 512 + h * 128 + 32 * hi), qf[0], S0);
      S0 = mfma8(*(const i32x8*)(KNm + kperm * 512 + h * 128 + 64 + 32 * hi), qf[1], S0);
      S0 = mfma8(*(const i32x8*)(KRm + kperm * 64 + 32 * hi), qf[2], S0);
#pragma unroll
      for (int r = 0; r < 16; ++r) { if (hi) S0[r] = -INFINITY; S1[r] = -INFINITY; }
      M8_SOFTMAX(S0, S1);
      const i32x4 z4 = {0, 0, 0, 0};
#pragma unroll
      for (int d = 0; d < 4; ++d) { const i32x8 vf = cat(*(const i32x4*)(VTm + (h * 128 + 32 * d + r32) * 32 + 16 * hi), z4); O[d] = mfma8(vf, pb, O[d]); } }
#define M8_QK(S0, S1, kslot) do { LAS const unsigned char* sb = lds + (kslot) * KSLOT; int xk_ = xk, xr_ = xr; asm volatile("" : "+v"(xk_), "+v"(xr_)); \
        _Pragma("unroll") for (int r = 0; r < 16; ++r) { S0[r] = 0.f; S1[r] = 0.f; } \
        _Pragma("unroll") for (int s = 0; s < 2; ++s) { const int co = ((4 * s + 2 * hi) ^ xk_) << 4; \
            const i32x8 k0 = cat(*(LAS const i32x4*)(sb + kn_b + co), *(LAS const i32x4*)(sb + kn_b + (co ^ 16))), k1 = cat(*(LAS const i32x4*)(sb + kn_b + 32 * 128 + co), *(LAS const i32x4*)(sb + kn_b + 32 * 128 + (co ^ 16))); \
            S0 = mfma8(k0, qf[s], S0); S1 = mfma8(k1, qf[s], S1); } \
        { const int co = ((2 * hi) ^ xr_) << 4; \
            const i32x8 k0 = cat(*(LAS const i32x4*)(sb + kr_b + co), *(LAS const i32x4*)(sb + kr_b + (co ^ 16))), k1 = cat(*(LAS const i32x4*)(sb + kr_b + 32 * 64 + co), *(LAS const i32x4*)(sb + kr_b + 32 * 64 + (co ^ 16))); \
            S0 = mfma8(k0, qf[2], S0); S1 = mfma8(k1, qf[2], S1); } } while (0)
#define M8_PV(vslot) do { LAS const unsigned char* vb = lds + VRING + (vslot) * VSLOT; int xv_ = xv; asm volatile("" : "+v"(xv_)); const int c0 = (hi ^ xv_) << 4, c1 = ((2 + hi) ^ xv_) << 4; \
        _Pragma("unroll") for (int d = 0; d < 4; ++d) { const i32x8 vf = cat(*(LAS const i32x4*)(vb + vt_b + d * (32 * 64) + c0), *(LAS const i32x4*)(vb + vt_b + d * (32 * 64) + c1)); O[d] = mfma8(vf, pb, O[d]); } } while (0)
#if PINGPONG
#define M8_HALF_A(jj, ks_) do { if ((jj) + 1 < NTL) asm volatile("s_waitcnt vmcnt(3)" ::: "memory"); else asm volatile("s_waitcnt vmcnt(0)" ::: "memory"); \
        __builtin_amdgcn_s_barrier(); asm volatile("" ::: "memory"); \
        if ((jj) + 1 < NTL) M8_ISSUE_V((jj) + 1, (ks_) == 2 ? 0 : (ks_) + 1); \
        if ((jj) + 2 < NTL) M8_ISSUE_K((jj) + 2, (ks_) == 0 ? 2 : (ks_) - 1); } while (0)
#define M8_HALF_B() do { asm volatile("" ::: "memory"); __builtin_amdgcn_s_barrier(); asm volatile("" ::: "memory"); } while (0)
    if (wave < 4) { int ks = 0;
      for (int j = 0; j <= NTL; ++j) { const int kp = ks == 0 ? 2 : ks - 1;
        M8_HALF_A(j, ks);
        f32x16 S0, S1;
        if (j < nact) M8_QK(S0, S1, ks);
        if (j >= 1 && j - 1 < nact) M8_PV(kp);
        M8_HALF_B();
        if (j < nact) M8_SOFTMAX(S0, S1);
        ks = ks == 2 ? 0 : ks + 1; } }
    else { int ks = 0;
      M8_HALF_A(0, 0);
      for (int j = 0; j <= NTL; ++j) { const int kp = ks == 0 ? 2 : ks - 1;
        M8_HALF_B();
        if (j >= 1 && j - 1 < nact) M8_PV(kp);
        f32x16 S0, S1;
        if (j < nact) M8_QK(S0, S1, ks);
        if (j == NTL) break;
        ks = ks == 2 ? 0 : ks + 1;
        M8_HALF_A(j + 1, ks);
        if (j < nact) M8_SOFTMAX(S0, S1); } }
#undef M8_HALF_A
#undef M8_HALF_B
#else
    { const bool late = wave >= 4; int ks = 0;
      for (int j = 0; j < NTL; ++j) {
        if (j + 1 < NTL) asm volatile("s_waitcnt vmcnt(2)" ::: "memory"); else asm volatile("s_waitcnt vmcnt(0)" ::: "memory");
        __builtin_amdgcn_s_barrier(); asm volatile("" ::: "memory");
        if (j + 1 < NTL) M8_ISSUE_V(j + 1, ks == 2 ? 0 : ks + 1);
        if (j + 2 < NTL) M8_ISSUE_K(j + 2, ks == 0 ? 2 : ks - 1);
        if (late && j >= 1 && j - 1 < nact) M8_PV(ks == 0 ? 2 : ks - 1);
        if (j < nact) { f32x16 S0, S1; M8_QK(S0, S1, ks); if (SM2) M8_SOFTMAX2(S0, S1); else M8_SOFTMAX(S0, S1); if (!late) M8_PV(ks); }
        ks = ks == 2 ? 0 : ks + 1;
      }
      if (late && NTL - 1 < nact) M8_PV(ks == 0 ? 2 : ks - 1); }
#endif
    l = half_sum(l); const float rl = 1.f / l;
    { int te = tid; asm volatile("" : "+v"(te));
      bf16_t* yr = Y + ((size_t)b * SEQ + qb * 256 + wave * 32 + (te & 31)) * 1024 + 512 + h * 128 + 4 * ((te >> 5) & 1);
#pragma unroll
      for (int d = 0; d < 4; ++d)
#pragma unroll
        for (int g = 0; g < 4; ++g) { u32x2 w; w.x = g8::cvt_pk_bf16(O[d][4 * g] * rl, O[d][4 * g + 1] * rl); w.y = g8::cvt_pk_bf16(O[d][4 * g + 2] * rl, O[d][4 * g + 3] * rl);
            *(u32x2*)(yr + 32 * d + 8 * g) = w; } }
#undef M8_ISSUE_K
#undef M8_ISSUE_V
#undef M8_SOFTMAX
#undef M8_SOFTMAX2
#undef M8_QK
#undef M8_PV
}
}
DEV void mla_fast(const Params& P, LAS unsigned char* lds) {
    const int tid = tid_fresh(); const int G = gridDim.x;
    for (int v = vcu_of(blockIdx.x, G); v < 256; v += G) { const int bh = v >> 2, s = v & 3;
        for (int ui = 0; ui < 4; ++ui) { const int qb = (ui == 0) ? s : (ui == 1) ? 7 - s : (ui == 2) ? 8 + s : 15 - s; mla::unit(P, lds, bh >> 2, bh & 3, qb, tid); } }
    asm volatile("s_waitcnt vmcnt(0)" ::: "memory"); __builtin_amdgcn_s_barrier();
}
namespace gla {
constexpr int L_QE = 0, L_KD = 9216, L_KDT = 18432, L_VT = 27648, L_ST = 46080  , STB = 18432, L_D = 82944, L_RED = 83200, L_G = 84224;
DEV int sw128(int row, int chunk) { return row * 144 + chunk * 16; }
template <int CTRL, int RM> DEV float dppz(float v) { return __int_as_float(__builtin_amdgcn_update_dpp(0, __float_as_int(v), CTRL, RM, 0xf, false)); }
DEV float wave_scan(float x) {
    x += __int_as_float(__builtin_amdgcn_update_dpp(0, __float_as_int(x), 0x111, 0xf, 0xf, true));
    x += __int_as_float(__builtin_amdgcn_update_dpp(0, __float_as_int(x), 0x112, 0xf, 0xf, true));
    x += __int_as_float(__builtin_amdgcn_update_dpp(0, __float_as_int(x), 0x114, 0xf, 0xf, true));
    x += __int_as_float(__builtin_amdgcn_update_dpp(0, __float_as_int(x), 0x118, 0xf, 0xf, true));
    x += dppz<0x142, 0xa>(x);
    x += dppz<0x143, 0xc>(x);
    return x;
}
DEV void item(const Params& P, LAS unsigned char* lds, int b, int h, int tid) {
    unsigned char* ws = P.ws; const int lane = tid & 63, r32 = lane & 31, hi = lane >> 5; const int wave = __builtin_amdgcn_readfirstlane(tid >> 6), ie = wave >> 1, ih = wave & 1;
    const bf16_t* Z = (const bf16_t*)P.out; const float* LOGA = (const float*)(ws + WS_LOGA); const bf16_t* VTG = (const bf16_t*)(ws + WS_VTG); bf16_t* Y = (bf16_t*)(ws + WS_Y);
    const float* S1 = (const float*)(ws + WS_META + MT_S1); const float* gain = P.in[I_GOUTN];
    __syncthreads();
    f32x16 accS;
#pragma unroll
    for (int r = 0; r < 16; ++r) { const int e = 32 * ie + crow(r, hi), d = 32 * ih + r32; accS[r] = S1[(h * 64 + d) * 128 + e];
        *(LAS bf16_t*)(lds + L_ST + sw128(e, d >> 3) + (d & 7) * 2) = (bf16_t)f2bf(accS[r]); }
    const size_t m0 = (size_t)b * SEQ;
    const char* Zb = (const char*)Z + m0 * NZ * 2; const char* Lb = (const char*)LOGA + m0 * 256 * 4; const char* Vb = (const char*)VTG + ((size_t)h * 128 * M + m0) * 2;
    const unsigned oq = (unsigned)(lane * NZ + ZQ + h * 64 + 8 * wave) * 2u, ok = (unsigned)(lane * NZ + ZK + h * 64 + 8 * wave) * 2u, ola = (unsigned)(lane * 256 + h * 64 + 8 * wave) * 4u;
    const unsigned ovt = (unsigned)(((size_t)(tid >> 2) * M + 16 * (tid & 3)) * 2), org = (unsigned)((32 * ih + r32) * NZ + ZR + h * 128 + 32 * ie + 4 * hi) * 2u;
#define GLA_LD(q_, k_, a0_, a1_, v0_, v1_, n_) do { const char* zc_ = Zb + (size_t)(n_) * 64 * NZ * 2; const char* lc_ = Lb + (size_t)(n_) * 64 * 256 * 4; const char* vc_ = Vb + (size_t)(n_) * 64 * 2; \
        q_ = *(const u32x4*)(zc_ + oq); k_ = *(const u32x4*)(zc_ + ok); a0_ = *(const f32x4*)(lc_ + ola); a1_ = *(const f32x4*)(lc_ + ola + 16); v0_ = *(const u32x4*)(vc_ + ovt); v1_ = *(const u32x4*)(vc_ + ovt + 16); } while (0)
#define GLA_LDRG(r_, n_) do { const char* zc_ = Zb + (size_t)(n_) * 64 * NZ * 2; _Pragma("unroll") for (int g = 0; g < 4; ++g) r_[g] = *(const u32x2*)(zc_ + org + 16 * g); } while (0)
    u32x4 qv, kv, vt0, vt1, qv2, kv2, vt02, vt12; f32x4 la0, la1, la02, la12; u32x2 rg[4], rgn[4];
    GLA_LD(qv, kv, la0, la1, vt0, vt1, 0); GLA_LD(qv2, kv2, la02, la12, vt02, vt12, 1); GLA_LDRG(rg, 0);
    if (tid < 128) *(LAS float*)(lds + L_G + 4 * tid) = gain[h * 128 + tid];
    const int kperm = pi23(r32);
    int par = 0;
    for (int n = 0; n < 64; n += 2) {
        { float bq[8] = {la0[0], la0[1], la0[2], la0[3], la1[0], la1[1], la1[2], la1[3]}; const unsigned qw[4] = {qv.x, qv.y, qv.z, qv.w}, kw[4] = {kv.x, kv.y, kv.z, kv.w};
          u32x4 qo, ko; unsigned qo_[4], ko_[4];
#pragma unroll
          for (int i = 0; i < 8; ++i) bq[i] = wave_scan(bq[i]);
          float e1[8], kd[8], qe[8];
#pragma unroll
          for (int i = 0; i < 8; ++i) { e1[i] = __expf(bq[i]); const float e2 = __builtin_amdgcn_rcpf(e1[i]);
              const float qf_ = (i & 1) ? __uint_as_float(qw[i >> 1] & 0xffff0000u) : __uint_as_float(qw[i >> 1] << 16), kf_ = (i & 1) ? __uint_as_float(kw[i >> 1] & 0xffff0000u) : __uint_as_float(kw[i >> 1] << 16);
              qe[i] = qf_ * e1[i] * 0.125f; kd[i] = kf_ * e2; }
#pragma unroll
          for (int i = 0; i < 4; ++i) { qo_[i] = pk2(qe[2 * i], qe[2 * i + 1]); ko_[i] = pk2(kd[2 * i], kd[2 * i + 1]); }
          qo.x = qo_[0]; qo.y = qo_[1]; qo.z = qo_[2]; qo.w = qo_[3]; ko.x = ko_[0]; ko.y = ko_[1]; ko.z = ko_[2]; ko.w = ko_[3];
          *(LAS u32x4*)(lds + L_QE + sw128(lane, wave)) = qo; *(LAS u32x4*)(lds + L_KD + sw128(lane, wave)) = ko;
#pragma unroll
          for (int i = 0; i < 8; ++i) { const int d = 8 * wave + i; *(LAS bf16_t*)(lds + L_KDT + sw128(d, lane >> 3) + (lane & 7) * 2) = (bf16_t)f2bf(kd[i]);
              const float dl = rl_f(e1[i], 63); if (lane == 0) *(LAS float*)(lds + L_D + 4 * d) = dl; }
          { const int e = tid >> 2, c0 = 2 * (tid & 3); *(LAS u32x4*)(lds + L_VT + sw128(e, c0)) = vt0; *(LAS u32x4*)(lds + L_VT + sw128(e, c0 + 1)) = vt1; } }
        __syncthreads();
        if (n + 2 < 64) GLA_LD(qv, kv, la0, la1, vt0, vt1, n + 2);
        if (n + 1 < 64) GLA_LDRG(rgn, n + 1);
        const size_t mtok = m0 + (size_t)n * 64 + 32 * ih + r32;
        bf16x8 qf[4], vf[4];
#pragma unroll
        for (int ks = 0; ks < 4; ++ks) { qf[ks] = *(LAS const bf16x8*)(lds + L_QE + sw128(32 * ih + r32, 2 * ks + hi)); vf[ks] = *(LAS const bf16x8*)(lds + L_VT + sw128(32 * ie + r32, 2 * ks + hi)); }
        f32x16 o = {};
#pragma unroll
        for (int ts = 0; ts < 2; ++ts) if (ts <= ih) {
            f32x16 at = {};
#pragma unroll
            for (int ks = 0; ks < 4; ++ks) { const bf16x8 kf = *(LAS const bf16x8*)(lds + L_KD + sw128(32 * ts + kperm, 2 * ks + hi)); at = __builtin_amdgcn_mfma_f32_32x32x16_bf16(kf, qf[ks], at, 0, 0, 0); }
            if (ts == ih) {
#pragma unroll
                for (int r = 0; r < 16; ++r) if (pi23(crow(r, hi)) > r32) at[r] = 0.f; }
            u32x4 w0, w1; w0.x = pk2_mfma(at[0], at[1]); w0.y = pk2_mfma(at[2], at[3]); w0.z = pk2_mfma(at[4], at[5]); w0.w = pk2_mfma(at[6], at[7]);
            w1.x = pk2_mfma(at[8], at[9]); w1.y = pk2_mfma(at[10], at[11]); w1.z = pk2_mfma(at[12], at[13]); w1.w = pk2_mfma(at[14], at[15]);
            o = __builtin_amdgcn_mfma_f32_32x32x16_bf16(vf[2 * ts], __builtin_bit_cast(bf16x8, w0), o, 0, 0, 0);
            o = __builtin_amdgcn_mfma_f32_32x32x16_bf16(vf[2 * ts + 1], __builtin_bit_cast(bf16x8, w1), o, 0, 0, 0);
        }
#pragma unroll
        for (int ks = 0; ks < 4; ++ks) { const bf16x8 sf = *(LAS const bf16x8*)(lds + L_ST + par * STB + sw128(32 * ie + r32, 2 * ks + hi)); o = __builtin_amdgcn_mfma_f32_32x32x16_bf16(sf, qf[ks], o, 0, 0, 0); }
#pragma unroll
        for (int ks = 0; ks < 4; ++ks) { const bf16x8 tf = *(LAS const bf16x8*)(lds + L_KDT + sw128(32 * ih + r32, 2 * ks + hi)); accS = __builtin_amdgcn_mfma_f32_32x32x16_bf16(vf[ks], tf, accS, 0, 0, 0); }
        { const float dl = *(LAS const float*)(lds + L_D + 4 * (32 * ih + r32));
#pragma unroll
          for (int r = 0; r < 16; ++r) { accS[r] *= dl; const int e = 32 * ie + crow(r, hi), d = 32 * ih + r32;
              *(LAS bf16_t*)(lds + L_ST + (par ^ 1) * STB + sw128(e, d >> 3) + (d & 7) * 2) = (bf16_t)f2bf(accS[r]); } }
        { float ss = 0.f;
#pragma unroll
          for (int r = 0; r < 16; ++r) ss += o[r] * o[r];
          ss = half_sum(ss); if (hi == 0) *(LAS float*)(lds + L_RED + (wave * 32 + r32) * 4) = ss; }
        __syncthreads();
        { float tot = 0.f;
#pragma unroll
          for (int q = 0; q < 4; ++q) tot += *(LAS const float*)(lds + L_RED + ((2 * q + ih) * 32 + r32) * 4);
          const float rs = rsqrtf(tot * (1.f / 128.f) + EPS);
#pragma unroll
          for (int g = 0; g < 4; ++g) { const float r0 = __uint_as_float(rg[g].x << 16), r1 = __uint_as_float(rg[g].x & 0xffff0000u), r2 = __uint_as_float(rg[g].y << 16), r3 = __uint_as_float(rg[g].y & 0xffff0000u);
              const f32x4 gn = *(LAS const f32x4*)(lds + L_G + 4 * (32 * ie + 8 * g + 4 * hi));
              u32x2 w; w.x = g8::cvt_pk_bf16(o[4 * g] * rs * gn[0] * siluf(r0), o[4 * g + 1] * rs * gn[1] * siluf(r1));
              w.y = g8::cvt_pk_bf16(o[4 * g + 2] * rs * gn[2] * siluf(r2), o[4 * g + 3] * rs * gn[3] * siluf(r3));
              *(u32x2*)(Y + mtok * 1024 + h * 128 + 32 * ie + 8 * g + 4 * hi) = w; } }

        par ^= 1;
        { const int n1 = n + 1;
        { float bq[8] = {la02[0], la02[1], la02[2], la02[3], la12[0], la12[1], la12[2], la12[3]}; const unsigned qw[4] = {qv2.x, qv2.y, qv2.z, qv2.w}, kw[4] = {kv2.x, kv2.y, kv2.z, kv2.w};
          u32x4 qo, ko; unsigned qo_[4], ko_[4];
#pragma unroll
          for (int i = 0; i < 8; ++i) bq[i] = wave_scan(bq[i]);
          float e1[8], kd[8], qe[8];
#pragma unroll
          for (int i = 0; i < 8; ++i) { e1[i] = __expf(bq[i]); const float e2 = __builtin_amdgcn_rcpf(e1[i]);
              const float qf_ = (i & 1) ? __uint_as_float(qw[i >> 1] & 0xffff0000u) : __uint_as_float(qw[i >> 1] << 16), kf_ = (i & 1) ? __uint_as_float(kw[i >> 1] & 0xffff0000u) : __uint_as_float(kw[i >> 1] << 16);
              qe[i] = qf_ * e1[i] * 0.125f; kd[i] = kf_ * e2; }
#pragma unroll
          for (int i = 0; i < 4; ++i) { qo_[i] = pk2(qe[2 * i], qe[2 * i + 1]); ko_[i] = pk2(kd[2 * i], kd[2 * i + 1]); }
          qo.x = qo_[0]; qo.y = qo_[1]; qo.z = qo_[2]; qo.w = qo_[3]; ko.x = ko_[0]; ko.y = ko_[1]; ko.z = ko_[2]; ko.w = ko_[3];
          *(LAS u32x4*)(lds + L_QE + sw128(lane, wave)) = qo; *(LAS u32x4*)(lds + L_KD + sw128(lane, wave)) = ko;
#pragma unroll
          for (int i = 0; i < 8; ++i) { const int d = 8 * wave + i; *(LAS bf16_t*)(lds + L_KDT + sw128(d, lane >> 3) + (lane & 7) * 2) = (bf16_t)f2bf(kd[i]);
              const float dl = rl_f(e1[i], 63); if (lane == 0) *(LAS float*)(lds + L_D + 4 * d) = dl; }
          { const int e = tid >> 2, c0 = 2 * (tid & 3); *(LAS u32x4*)(lds + L_VT + sw128(e, c0)) = vt02; *(LAS u32x4*)(lds + L_VT + sw128(e, c0 + 1)) = vt12; } }
        __syncthreads();
        if (n1 + 2 < 64) GLA_LD(qv2, kv2, la02, la12, vt02, vt12, n1 + 2);
        if (n1 + 1 < 64) GLA_LDRG(rg, n1 + 1);
        const size_t mtok = m0 + (size_t)n1 * 64 + 32 * ih + r32;
        bf16x8 qf[4], vf[4];
#pragma unroll
        for (int ks = 0; ks < 4; ++ks) { qf[ks] = *(LAS const bf16x8*)(lds + L_QE + sw128(32 * ih + r32, 2 * ks + hi)); vf[ks] = *(LAS const bf16x8*)(lds + L_VT + sw128(32 * ie + r32, 2 * ks + hi)); }
        f32x16 o = {};
#pragma unroll
        for (int ts = 0; ts < 2; ++ts) if (ts <= ih) {
            f32x16 at = {};
#pragma unroll
            for (int ks = 0; ks < 4; ++ks) { const bf16x8 kf = *(LAS const bf16x8*)(lds + L_KD + sw128(32 * ts + kperm, 2 * ks + hi)); at = __builtin_amdgcn_mfma_f32_32x32x16_bf16(kf, qf[ks], at, 0, 0, 0); }
            if (ts == ih) {
#pragma unroll
                for (int r = 0; r < 16; ++r) if (pi23(crow(r, hi)) > r32) at[r] = 0.f; }
            u32x4 w0, w1; w0.x = pk2_mfma(at[0], at[1]); w0.y = pk2_mfma(at[2], at[3]); w0.z = pk2_mfma(at[4], at[5]); w0.w = pk2_mfma(at[6], at[7]);
            w1.x = pk2_mfma(at[8], at[9]); w1.y = pk2_mfma(at[10], at[11]); w1.z = pk2_mfma(at[12], at[13]); w1.w = pk2_mfma(at[14], at[15]);
            o = __builtin_amdgcn_mfma_f32_32x32x16_bf16(vf[2 * ts], __builtin_bit_cast(bf16x8, w0), o, 0, 0, 0);
            o = __builtin_amdgcn_mfma_f32_32x32x16_bf16(vf[2 * ts + 1], __builtin_bit_cast(bf16x8, w1), o, 0, 0, 0);
        }
#pragma unroll
        for (int ks = 0; ks < 4; ++ks) { const bf16x8 sf = *(LAS const bf16x8*)(lds + L_ST + par * STB + sw128(32 * ie + r32, 2 * ks + hi)); o = __builtin_amdgcn_mfma_f32_32x32x16_bf16(sf, qf[ks], o, 0, 0, 0); }
#pragma unroll
        for (int ks = 0; ks < 4; ++ks) { const bf16x8 tf = *(LAS const bf16x8*)(lds + L_KDT + sw128(32 * ih + r32, 2 * ks + hi)); accS = __builtin_amdgcn_mfma_f32_32x32x16_bf16(vf[ks], tf, accS, 0, 0, 0); }
        { const float dl = *(LAS const float*)(lds + L_D + 4 * (32 * ih + r32));
#pragma unroll
          for (int r = 0; r < 16; ++r) { accS[r] *= dl; const int e = 32 * ie + crow(r, hi), d = 32 * ih + r32;
              *(LAS bf16_t*)(lds + L_ST + (par ^ 1) * STB + sw128(e, d >> 3) + (d & 7) * 2) = (bf16_t)f2bf(accS[r]); } }
        { float ss = 0.f;
#pragma unroll
          for (int r = 0; r < 16; ++r) ss += o[r] * o[r];
          ss = half_sum(ss); if (hi == 0) *(LAS float*)(lds + L_RED + (wave * 32 + r32) * 4) = ss; }
        __syncthreads();
        { float tot = 0.f;
#pragma unroll
          for (int q = 0; q < 4; ++q) tot += *(LAS const float*)(lds + L_RED + ((2 * q + ih) * 32 + r32) * 4);
          const float rs = rsqrtf(tot * (1.f / 128.f) + EPS);
#pragma unroll
          for (int g = 0; g < 4; ++g) { const float r0 = __uint_as_float(rgn[g].x << 16), r1 = __uint_as_float(rgn[g].x & 0xffff0000u), r2 = __uint_as_float(rgn[g].y << 16), r3 = __uint_as_float(rgn[g].y & 0xffff0000u);
              const f32x4 gn = *(LAS const f32x4*)(lds + L_G + 4 * (32 * ie + 8 * g + 4 * hi));
              u32x2 w; w.x = g8::cvt_pk_bf16(o[4 * g] * rs * gn[0] * siluf(r0), o[4 * g + 1] * rs * gn[1] * siluf(r1));
              w.y = g8::cvt_pk_bf16(o[4 * g + 2] * rs * gn[2] * siluf(r2), o[4 * g + 3] * rs * gn[3] * siluf(r3));
              *(u32x2*)(Y + mtok * 1024 + h * 128 + 32 * ie + 8 * g + 4 * hi) = w; } }

        par ^= 1; }
    }
}
}
DEV void phase3_fast(const Params& P, LAS unsigned char* lds) {
    const int tid = tid_fresh(); const int G = gridDim.x; const int vcu = vcu_of(blockIdx.x, G);
    int* qhead = (int*)(P.ws + WS_CTL) + CW_MLAQ;
    for (int it = vcu; it < 256; it += G) if ((it & 3) == 0) gla::item(P, lds, it >> 4, (it >> 2) & 3, tid);
#if XCONV_P3
    for (int it = vcu; it < 256; it += G) if ((it & 7) == XCONV_SEL) expert_convert(P, (it >> 3) * NWAVE + (tid >> 6), 32 * NWAVE, tid & 63);
#endif
    for (;;) {
        __syncthreads();
        if (tid == 0) *(LAS int*)(lds + 131072 + 16) = atomicAdd(qhead, 1);
        __syncthreads();
        const int idx = __builtin_amdgcn_readfirstlane(*(LAS const int*)(lds + 131072 + 16));
        if (idx >= 1024) break;
        const int qb = 15 - (idx >> 6), bh = idx & 63;
        if (MLA8) mla8::unit(P, lds, bh >> 2, bh & 3, qb, tid); else mla::unit(P, lds, bh >> 2, bh & 3, qb, tid);
    }
    asm volatile("s_waitcnt vmcnt(0)" ::: "memory"); __builtin_amdgcn_s_barrier();
}
DEV void phase1_fast(const Params& P, LAS unsigned char* lds) {
    unsigned char* ws = P.ws;
    { g8::DenseSched S; S.init(ws + WS_XN, D, ws + WS_WIN, D, M, 1536, gridDim.x, blockIdx.x);
      g8::EpiZ E{(bf16_t*)P.out, (float*)(ws + WS_CTL + CTL_SSQ_Q), (float*)(ws + WS_CTL + CTL_SSQ_KV)};
      g8::gemm_phase<g8::EpiZ, g8::DenseSched, false>(lds, D, D, D, S, E); }
    { g8::DenseSched S; S.init(ws + WS_WIN + (size_t)1536 * D * 2, D, ws + WS_XN, D, 512, M, gridDim.x, blockIdx.x);
      g8::EpiD E{(bf16_t*)(ws + WS_VTG), (size_t)M};
      g8::gemm_phase<g8::EpiD, g8::DenseSched, false>(lds, D, D, D, S, E); }
    meta_phase(P);
}
DEV void phase2_rows(const Params& P) { const int tid_ = tid_fresh();
    unsigned char* ws = P.ws; const int lane = tid_ & 63; const int gw = blockIdx.x * NWAVE + (tid_ >> 6), ngw = gridDim.x * NWAVE;
    const bf16_t* Z = (const bf16_t*)P.out; bf16_t* KR = (bf16_t*)(ws + WS_KR); float* LOGA = (float*)(ws + WS_LOGA);
    const float2* rt = (const float2*)(ws + WS_ROPE); const float* wa2 = P.in[I_WA2]; const float* ba = P.in[I_BA];
    float w[4][16], bb[4];
#pragma unroll
    for (int j = 0; j < 4; ++j) { bb[j] = ba[64 * j + lane];
#pragma unroll
        for (int r = 0; r < 16; ++r) w[j][r] = wa2[r * 256 + 64 * j + lane]; }
    for (int m = gw; m < M; m += ngw) { const bf16_t* z = Z + (size_t)m * NZ;
        { const float v = bf2f(z[ZKR + lane]), o = sx<1>(v); const float2 cs = rt[(NMETA + (m & (SEQ - 1))) * 32 + (lane >> 1)];
          const float kr_ = (lane & 1) ? (v * cs.x + o * cs.y) : (v * cs.x - o * cs.y);
          if (MLA8) { const int b8 = __builtin_amdgcn_cvt_pk_fp8_f32(kr_, 0.f, 0, false) & 0xff;
              const int w8 = __builtin_amdgcn_mov_dpp(b8, 0x00, 0xf, 0xf, true) | (__builtin_amdgcn_mov_dpp(b8, 0x55, 0xf, 0xf, true) << 8) | (__builtin_amdgcn_mov_dpp(b8, 0xAA, 0xf, 0xf, true) << 16) | (__builtin_amdgcn_mov_dpp(b8, 0xFF, 0xf, 0xf, true) << 24);
              if ((lane & 3) == 0) *(int*)((unsigned char*)KR + (size_t)m * 64 + lane) = w8; }
          else KR[(size_t)m * 64 + lane] = (bf16_t)f2bf(kr_); }
        float al[16];
#pragma unroll
        for (int r = 0; r < 16; ++r) al[r] = bf2f(z[ZAL + r]);
#pragma unroll
        for (int j = 0; j < 4; ++j) { float x = bb[j];
#pragma unroll
            for (int r = 0; r < 16; ++r) x += al[r] * w[j][r];
            LOGA[(size_t)m * 256 + 64 * j + lane] = logsigmoidf(x) * (1.f / 16.f); }
    }
}
DEV void kr8_rows(const Params& P) { const int tid_ = tid_fresh();
    unsigned char* ws = P.ws; const int lane = tid_ & 63; const int gw = blockIdx.x * NWAVE + (tid_ >> 6), ngw = gridDim.x * NWAVE;
    const bf16_t* Z = (const bf16_t*)P.out; unsigned char* KR = ws + WS_KR; const float2* rt = (const float2*)(ws + WS_ROPE);
    for (int blk = gw; blk < M / 32; blk += ngw) {
        u32x4 zz[4]; f32x4 c0[4], c1[4];
#pragma unroll
        for (int q = 0; q < 4; ++q) { const int m = blk * 32 + q * 8 + (lane >> 3), c8 = lane & 7;
            zz[q] = *(const u32x4*)(Z + (size_t)m * NZ + ZKR + 8 * c8);
            const f32x4* cp = (const f32x4*)(rt + (NMETA + (m & (SEQ - 1))) * 32 + 4 * c8); c0[q] = cp[0]; c1[q] = cp[1]; }
#pragma unroll
        for (int q = 0; q < 4; ++q) { const int m = blk * 32 + q * 8 + (lane >> 3), c8 = lane & 7;
            const unsigned zw[4] = {zz[q].x, zz[q].y, zz[q].z, zz[q].w}; const float cs[8] = {c0[q][0], c0[q][1], c0[q][2], c0[q][3], c1[q][0], c1[q][1], c1[q][2], c1[q][3]};
            float o[8];
#pragma unroll
            for (int i = 0; i < 4; ++i) { const float a = __uint_as_float(zw[i] << 16), b = __uint_as_float(zw[i] & 0xffff0000u), c = cs[2 * i], s = cs[2 * i + 1];
                o[2 * i] = a * c - b * s; o[2 * i + 1] = b * c + a * s; }
            u32x2 w; w.x = pk4_fp8(o[0], o[1], o[2], o[3]); w.y = pk4_fp8(o[4], o[5], o[6], o[7]);
            *(u32x2*)(KR + (size_t)m * 64 + 8 * c8) = w; }
    }
}
DEV void phase2_fast(const Params& P, LAS unsigned char* lds) {
    unsigned char* ws = P.ws; const bf16_t* Z = (const bf16_t*)P.out; const float* ssq_q = (const float*)(ws + WS_CTL + CTL_SSQ_Q); const float* ssq_kv = (const float*)(ws + WS_CTL + CTL_SSQ_KV);
#if !defined(X2) || (X2 & 1)
    { g8::DenseSched S; S.init(Z + ZQL, NZ, ws + WS_WQ, 256, M, 768, gridDim.x, blockIdx.x);
      if (MLA8) { g8::EpiQ8 E{(unsigned char*)(ws + WS_QM), ssq_q, (const float2*)(ws + WS_ROPE)}; g8::gemm_phase<g8::EpiQ8, g8::DenseSched, false>(lds, 256, NZ, 256, S, E); }
      else { g8::EpiQ E{(bf16_t*)(ws + WS_QM), ssq_q, (const float2*)(ws + WS_ROPE)}; g8::gemm_phase<g8::EpiQ, g8::DenseSched, false>(lds, 256, NZ, 256, S, E); } }
#endif
#if !defined(X2) || (X2 & 2)
    { g8::DenseSched S; S.init(Z + ZKVL, NZ, ws + WS_WK, 256, M, 512, gridDim.x, blockIdx.x);
      if (MLA8) { g8::EpiK8 E{(unsigned char*)(ws + WS_KN), ssq_kv}; g8::gemm_phase<g8::EpiK8, g8::DenseSched, false>(lds, 256, NZ, 256, S, E); }
      else { g8::EpiK E{(bf16_t*)(ws + WS_KN), ssq_kv}; g8::gemm_phase<g8::EpiK, g8::DenseSched, false>(lds, 256, NZ, 256, S, E); } }
#endif
#if !defined(X2) || (X2 & 4)
    { g8::DenseSched S; S.init(ws + WS_WV, 256, Z + ZKVL, NZ, 512, M, gridDim.x, blockIdx.x);
      if (MLA8) { g8::EpiVT8 E{(unsigned char*)(ws + WS_VT), ssq_kv}; g8::gemm_phase<g8::EpiVT8, g8::DenseSched, false>(lds, 256, 256, NZ, S, E); }
      else { g8::EpiVT E{(bf16_t*)(ws + WS_VT), ssq_kv}; g8::gemm_phase<g8::EpiVT, g8::DenseSched, false>(lds, 256, 256, NZ, S, E); } }
#endif
    if (MLA8) {
        g8::DenseSched S; S.init(Z + ZKR, NZ, ws + WS_WA2T, 128, M, 256, gridDim.x, blockIdx.x);
        g8::EpiLOGA E{(float*)(ws + WS_LOGA), P.in[I_BA]}; g8::gemm_phase<g8::EpiLOGA, g8::DenseSched, false>(lds, 128, NZ, 128, S, E);
        kr8_rows(P);
    } else phase2_rows(P);
}
DEV void phase4_fast(const Params& P, LAS unsigned char* lds) {
    unsigned char* ws = P.ws;
    g8::DenseSched S; S.init(ws + WS_Y, D, ws + WS_WOUT, D, M, D, gridDim.x, blockIdx.x);
    g8::EpiD E{(bf16_t*)(ws + WS_D16), (size_t)D};
    g8::gemm_phase<g8::EpiD, g8::DenseSched, false>(lds, D, D, D, S, E);
}
DEV void phase6_fast(const Params& P, LAS unsigned char* lds) { const int tid_ = tid_fresh();
    unsigned char* ws = P.ws; const int lane = tid_ & 63;
    int c_l, total; const int st_l = slot_start_lane((const int*)(ws + WS_CTL) + CW_CNT, lane, c_l, total);
    if (tid_ < 64) { *(volatile LAS int*)(SLOTTAB_OFF + 4u * (unsigned)lane) = st_l; *(volatile LAS int*)(SLOTTAB_OFF + 256u + 4u * (unsigned)lane) = c_l; }
    __syncthreads();
    g8::MoeSched S{(const char*)(ws + WS_TN8), (const char*)(ws + WS_WGU), (size_t)1024 * 1024, (size_t)256 * 1024, 0, (const int*)(ws + WS_LIST), (total / 256) * 4, (int)gridDim.x, vcu_of(blockIdx.x, gridDim.x), D};
    g8::EpiGU8 E{(unsigned char*)(ws + WS_MH)};
    g8::gemm_phase<g8::EpiGU8, g8::MoeSched, true, true>(lds, D / 2, D / 2, D / 2, S, E);
}
DEV void phase7_fast(const Params& P, LAS unsigned char* lds) { const int tid_ = tid_fresh();
    unsigned char* ws = P.ws; const int lane = tid_ & 63;
    int c_l, total; const int st_l = slot_start_lane((const int*)(ws + WS_CTL) + CW_CNT, lane, c_l, total);
    if (tid_ < 64) { *(volatile LAS int*)(SLOTTAB_OFF + 4u * (unsigned)lane) = st_l; *(volatile LAS int*)(SLOTTAB_OFF + 256u + 4u * (unsigned)lane) = c_l; }
    __syncthreads();
    g8::MoeSched S{(const char*)(ws + WS_MH), (const char*)(ws + WS_WD), (size_t)1024 * 512, (size_t)256 * 512, (size_t)256 * 512, nullptr, (total / 256) * 4, (int)gridDim.x, vcu_of(blockIdx.x, gridDim.x), DE};
    g8::EpiD8 E{(unsigned char*)(ws + WS_MY), 16.f / (8.f * 32.f)};
    g8::gemm_phase<g8::EpiD8, g8::MoeSched, false, true>(lds, DE / 2, DE / 2, DE / 2, S, E);
}

#define XB_TMO      128
#define XB_XCNT(j)  (256  + 64 * (j))
#define XB_XSUB(j)  (1280 + 64 * (j))
#define XB_XGEN(j)  (2304 + 64 * (j))
#define XB_TOP      3328
#define XB_TOPGEN   3392
#define XCD_BAR_WORDS 3456
#define XB_SPIN_CAP (1u << 22)
DEV unsigned xb_ld(unsigned* p)              { return __hip_atomic_load(p, __ATOMIC_RELAXED, __HIP_MEMORY_SCOPE_AGENT); }
DEV unsigned xb_add(unsigned* p, unsigned v) { return __hip_atomic_fetch_add(p, v, __ATOMIC_RELAXED, __HIP_MEMORY_SCOPE_AGENT); }
DEV unsigned xb_xcc_id() { return (unsigned)__builtin_amdgcn_s_getreg((3 << 11) | 20) & 0xFu; }
#define XB_SPIN(cond, bar) do { unsigned _sp = 0; while (cond) { __builtin_amdgcn_s_sleep(1); \
    if ((++_sp & 255u) == 0u) { if (xb_ld(&(bar)[XB_TMO])) break; if (_sp > XB_SPIN_CAP) { atomicAdd(&(bar)[XB_TMO], 1u); break; } } } } while (0)
struct XcdBarrier { unsigned* bar; unsigned x; volatile LAS unsigned* st; };
DEV XcdBarrier xcd_barrier_post(unsigned* bar, volatile LAS unsigned* st) {
    XcdBarrier b; b.bar = bar; b.x = xb_xcc_id(); b.st = st;
    if (threadIdx.x == 0) (void)xb_add(&bar[XB_XCNT(b.x)], 1u);
    return b;
}
DEV void xcd_barrier_complete(unsigned* bar, unsigned x, unsigned& nloc, unsigned& nx) {
    const unsigned G = gridDim.x * gridDim.y * gridDim.z;
    unsigned sum, cnt, mine, sp = 0u;
    for (;;) {
        sum = 0u; cnt = 0u; mine = 0u;
#pragma unroll
        for (unsigned j = 0; j < 16; ++j) { const unsigned c = xb_ld(&bar[XB_XCNT(j)]); sum += c; cnt += (c > 0u) ? 1u : 0u; mine = (j == x) ? c : mine; }
        if (sum == G) break;
        __builtin_amdgcn_s_sleep(1);
        if ((++sp & 255u) == 0u) { if (xb_ld(&bar[XB_TMO])) break; if (sp > XB_SPIN_CAP) { atomicAdd(&bar[XB_TMO], 1u); break; } }
    }
    nloc = mine > 0u ? mine : 1u; nx = cnt > 0u ? cnt : 1u;
}
DEV void xcd_barrier(const XcdBarrier& b) {
    asm volatile("s_waitcnt vmcnt(0)" ::: "memory");
    __syncthreads();
    if (tid_fresh() == 0) {
        unsigned* bar = b.bar;
        __builtin_amdgcn_s_waitcnt(0);
        unsigned nloc = b.st[0], nx = b.st[1];
        if (nloc == 0u) { xcd_barrier_complete(bar, b.x, nloc, nx); b.st[0] = nloc; b.st[1] = nx; }
        const unsigned old = xb_add(&bar[XB_XSUB(b.x)], 1u);
        const unsigned gen = old / nloc;
        if (old + 1u == (gen + 1u) * nloc) {
            __builtin_amdgcn_fence(__ATOMIC_RELEASE, "agent");
            asm volatile("s_waitcnt vmcnt(0)" ::: "memory");
            const unsigned og = xb_add(&bar[XB_TOP], 1u);
            const unsigned tg = og / nx;
            if (og + 1u == (tg + 1u) * nx) xb_add(&bar[XB_TOPGEN], 1u);
            else XB_SPIN(xb_ld(&bar[XB_TOPGEN]) == tg, bar);
            __builtin_amdgcn_fence(__ATOMIC_ACQUIRE, "agent");
            xb_add(&bar[XB_XGEN(b.x)], 1u);
            asm volatile("s_waitcnt vmcnt(0)" ::: "memory");
        } else {
            XB_SPIN(xb_ld(&bar[XB_XGEN(b.x)]) == gen, bar);
            __builtin_amdgcn_fence(__ATOMIC_ACQUIRE, "agent");
            asm volatile("s_waitcnt vmcnt(0)" ::: "memory");
        }
    }
    __syncthreads();
}

__global__ void __launch_bounds__(NT) mega_kernel(Params P) {
    __shared__ __attribute__((aligned(16))) float scr[NWAVE * 4096 + 16 + 64 + 128];
    LAS unsigned char* lds = (LAS unsigned char*)scr;
    volatile LAS unsigned* MISC = (volatile LAS unsigned*)(lds + NWAVE * 4096 * 4);
    if (threadIdx.x < 16) MISC[threadIdx.x] = 0u;
    if ((threadIdx.x & 63) == 0) *(volatile LAS unsigned*)(TIDMAP_OFF + 4u * hw_wave_key()) = threadIdx.x >> 6;
    __syncthreads();
    XcdBarrier xbar = xcd_barrier_post((unsigned*)(P.ws + WS_CTL) + CW_BAR, MISC);
#define GSYNC() xcd_barrier(xbar)
#ifndef DUP
#define DUP 0
#endif
    phase0(P, scr); if (DUP & 1) phase0(P, scr);           GSYNC();
    if (FAST & 1) phase1_fast(P, lds); else phase1(P);
    GSYNC();
    if (FAST & 2) phase2_fast(P, lds); else { phase2a(P); GSYNC(); phase2b(P); }
    if (DUP & 2) phase2_fast(P, lds);
    GSYNC();
    phase3_fast(P, lds);
    if (DUP & 4) phase3_fast(P, lds);
    GSYNC();
    if (FAST & 4) phase4_fast(P, lds); else phase4(P);
    if (DUP & 16) phase4_fast(P, lds);
    GSYNC();
    if (FAST & 64) phase5_fast(P); else phase5(P, scr);
    GSYNC();
    if (FAST & 8) phase6_fast(P, lds); else phase6(P);
    if (DUP & 32) phase6_fast(P, lds);
    GSYNC();
    if (FAST & 16) phase7_fast(P, lds); else phase7(P);
    if (DUP & 64) phase7_fast(P, lds);
    GSYNC();
    phase8(P); if (DUP & 128) phase8(P);
}

extern "C" void kernel_launch(void* const* d_in, const int* in_sizes, int n_in, void* d_out, int out_size, void* d_ws, size_t ws_size, hipStream_t stream) {
    if (n_in != 21 || out_size != M * D || ws_size < WS_END) { fprintf(stderr, "kernel_launch: unexpected shapes (n_in %d out %d ws %zu)\n", n_in, out_size, ws_size); return; }
    static int grid_blocks = 0;
    if (!grid_blocks) {
        int dev = 0, cus = 0, per_cu = 0;
        (void)hipGetDevice(&dev);
        (void)hipDeviceGetAttribute(&cus, hipDeviceAttributeMultiprocessorCount, dev);
        (void)hipOccupancyMaxActiveBlocksPerMultiprocessor(&per_cu, mega_kernel, NT, 0);
        if (per_cu < 1) { fprintf(stderr, "kernel_launch: occupancy query says %d blocks per CU\n", per_cu); per_cu = 1; }
        grid_blocks = cus;
    }
    Params P{};
    for (int i = 0; i < 21; ++i) P.in[i] = (const float*)d_in[i];
    P.out = (float*)d_out; P.ws = (unsigned char*)d_ws;
    (void)hipMemsetAsync((char*)d_ws + WS_CTL, 0, 1 * MiB, stream);
    mega_kernel<<<dim3(grid_blocks), dim3(NT), 0, stream>>>(P);
}
```

```cpp
#include <hip/hip_runtime.h>
#include <hip/hip_cooperative_groups.h>
namespace cg = cooperative_groups;
#include <cstdio>
#include <cstdint>

#ifndef MLA8
#ifndef XCONV_P3
#define XCONV_P3 1
#endif
#ifndef XCONV_SEL
#define XCONV_SEL 1
#endif
#ifndef PINGPONG
#define PINGPONG 0
#endif
#ifndef SM2
#define SM2 0
#endif
#define MLA8 1
#endif
#define DEV __device__ __forceinline__
typedef unsigned short bf16_t;
typedef short bf16x8 __attribute__((ext_vector_type(8)));
typedef float f32x16 __attribute__((ext_vector_type(16)));
typedef float f32x4 __attribute__((ext_vector_type(4)));
typedef unsigned u32x4 __attribute__((ext_vector_type(4)));
typedef unsigned u32x2 __attribute__((ext_vector_type(2)));

constexpr int NB = 16, SEQ = 4096, M = NB * SEQ, D = 1024, NMETA = 16;
constexpr int NZ = 2048;
constexpr int ZQ = 0, ZK = 256, ZV = 512, ZR = 1024, ZQL = 1536, ZKVL = 1792, ZKR = 1920, ZAL = 1984;
constexpr int NE = 64, DE = 512;
constexpr float EPS = 1e-6f;
constexpr int NT = 512, NWAVE = 8, GRID = 256;
constexpr int SLOT_CAP = 151552;

constexpr size_t MiB = 1ull << 20;
constexpr size_t WS_CTL = 0;
constexpr size_t WS_WIN = 1 * MiB;
constexpr size_t WS_WQ = 5 * MiB;
constexpr size_t WS_WK = 5 * MiB + 512 * 1024;
constexpr size_t WS_WV = 5 * MiB + 768 * 1024;
constexpr size_t WS_WOUT = 6 * MiB;
constexpr size_t WS_ROPE = 8 * MiB;
constexpr size_t WS_META = 10 * MiB;
constexpr size_t WS_RS = 11 * MiB;
constexpr size_t WS_WR = 11 * MiB + 512 * 1024;
constexpr size_t WS_WA2T = 11 * MiB + 768 * 1024;
constexpr size_t WS_TOK = 12 * MiB;
constexpr size_t WS_WGU = 16 * MiB;
constexpr size_t WS_WD = 144 * MiB;
constexpr size_t WS_R1 = 208 * MiB;
constexpr size_t WS_QM = WS_R1, WS_KN = WS_R1 + 96 * MiB, WS_VT = WS_R1 + 160 * MiB, WS_KR = WS_R1 + 224 * MiB;
constexpr size_t WS_H2 = WS_R1;
constexpr size_t WS_D16 = WS_R1, WS_H2B = WS_R1 + 128 * MiB;
constexpr size_t WS_R2 = 464 * MiB;
constexpr size_t WS_XN = WS_R2, WS_Y = WS_R2, WS_TN = WS_R2, WS_MY = WS_R2;
constexpr size_t WS_LOGA = 592 * MiB;
constexpr size_t WS_TN8 = 592 * MiB;
constexpr size_t WS_VTG = 656 * MiB;
constexpr size_t WS_MH = 760 * MiB;
constexpr size_t WS_LIST = 908 * MiB;
constexpr size_t WS_END = 924 * MiB;
constexpr size_t MT_Z = 0;
constexpr size_t MT_KN = 128 * 1024;
constexpr size_t MT_VT = 160 * 1024;
constexpr size_t MT_KR = 192 * 1024;
constexpr size_t MT_S1 = 256 * 1024;
constexpr size_t MT_KN8 = 640 * 1024, MT_VT8 = 672 * 1024, MT_KR8 = 704 * 1024;
constexpr int CW_CNT = 0;
constexpr int CW_MLAQ = 64;
constexpr int CW_BAR = 16384;
constexpr size_t CTL_MZ = 768 * 1024, CTL_RSM = 896 * 1024;
constexpr size_t CTL_SSQ_Q = 256 * 1024, CTL_SSQ_KV = 512 * 1024;

struct Params { const float* in[21]; float* out; unsigned char* ws; };
enum { I_X = 0, I_META, I_MIXN, I_WIN, I_WA2, I_BA, I_GOUTN, I_QN, I_WQB, I_KVN, I_WKVB, I_WOUT, I_FFN, I_RGW, I_RGB, I_REW, I_REB, I_WG, I_WU, I_WDN, I_FINAL };

DEV unsigned pk2(float lo, float hi) { unsigned r; asm("v_cvt_pk_bf16_f32 %0, %1, %2" : "=v"(r) : "v"(lo), "v"(hi)); return r; }
typedef float f32x2_t __attribute__((ext_vector_type(2))); typedef __bf16 bf16x2_t __attribute__((ext_vector_type(2)));
DEV unsigned pk2_mfma(float lo, float hi) { const f32x2_t v = {lo, hi}; const bf16x2_t b = __builtin_convertvector(v, bf16x2_t); return __builtin_bit_cast(unsigned, b); }
DEV unsigned f2bf(float f) { return pk2(f, 0.f) & 0xffffu; }
DEV float bf2f(unsigned h) { return __uint_as_float(h << 16); }
template <int CTRL> DEV float dpp_f(float v) { return __int_as_float(__builtin_amdgcn_mov_dpp(__float_as_int(v), CTRL, 0xf, 0xf, true)); }
template <int K> DEV float sx(float v) {
    if constexpr (K == 1) return dpp_f<0xB1>(v);
    else if constexpr (K == 2) return dpp_f<0x4E>(v);
    else return __int_as_float(__builtin_amdgcn_ds_swizzle(__float_as_int(v), 0x1f | (K << 10)));
}
DEV float half_sum(float v) { auto rr = __builtin_amdgcn_permlane32_swap(__float_as_uint(v), __float_as_uint(v), false, false); return __uint_as_float(rr[0]) + __uint_as_float(rr[1]); }
DEV float half_max(float v) { auto rr = __builtin_amdgcn_permlane32_swap(__float_as_uint(v), __float_as_uint(v), false, false); return fmaxf(__uint_as_float(rr[0]), __uint_as_float(rr[1])); }
DEV float wave_sum(float v) { v += sx<1>(v); v += sx<2>(v); v += sx<4>(v); v += sx<8>(v); v += sx<16>(v); return half_sum(v); }
DEV int rl_i(int v, int l) { return __builtin_amdgcn_readlane(v, l); }
DEV float rl_f(float v, int l) { return __int_as_float(__builtin_amdgcn_readlane(__float_as_int(v), l)); }
constexpr unsigned TIDMAP_OFF = 131072u + 64u;
constexpr unsigned SLOTTAB_OFF = TIDMAP_OFF + 256u;
DEV unsigned hw_wave_key() { return (unsigned)__builtin_amdgcn_s_getreg((5 << 11) | 4) & 63u; }
DEV int tid_fresh() { const unsigned w = *(volatile __attribute__((address_space(3))) unsigned*)(TIDMAP_OFF + 4u * hw_wave_key());
    unsigned l; asm volatile("v_mbcnt_lo_u32_b32 %0, -1, 0\n\tv_mbcnt_hi_u32_b32 %0, -1, %0" : "=v"(l));
    int t = (int)(w * 64u + l); asm volatile("" : "+v"(t)); return t; }
DEV int crow(int r, int hi) { return (r & 3) + 8 * (r >> 2) + 4 * hi; }
DEV int pi23(int i) { return (i & ~12) | ((i & 4) << 1) | ((i & 8) >> 1); }
DEV float logsigmoidf(float x) { return fminf(x, 0.f) - log1pf(__expf(-fabsf(x))); }
DEV float siluf(float x) { return x * __builtin_amdgcn_rcpf(1.f + __expf(-x)); }

DEV void wave_tile(const bf16_t* a0, const bf16_t* a1, const bf16_t* b0, const bf16_t* b1, int K, f32x16& c00, f32x16& c01, f32x16& c10, f32x16& c11) {
    for (int k = 0; k < K; k += 16) {
        const bf16x8 A0 = *(const bf16x8*)(a0 + k), A1 = *(const bf16x8*)(a1 + k), B0 = *(const bf16x8*)(b0 + k), B1 = *(const bf16x8*)(b1 + k);
        c00 = __builtin_amdgcn_mfma_f32_32x32x16_bf16(A0, B0, c00, 0, 0, 0);
        c01 = __builtin_amdgcn_mfma_f32_32x32x16_bf16(A0, B1, c01, 0, 0, 0);
        c10 = __builtin_amdgcn_mfma_f32_32x32x16_bf16(A1, B0, c10, 0, 0, 0);
        c11 = __builtin_amdgcn_mfma_f32_32x32x16_bf16(A1, B1, c11, 0, 0, 0);
    }
}
template <class AF, class BF, class EF>
DEV void gemm_simple(int Mt, int Nt, int K, AF arow, BF brow, EF epi, int gw, int ngw) { const int tid_ = tid_fresh();
    const int lane = tid_ & 63, r32 = lane & 31, hi = lane >> 5;
    for (int it = gw; it < Mt * Nt; it += ngw) {
        const int tm = it / Nt, tn = it % Nt;
        f32x16 c00 = {}, c01 = {}, c10 = {}, c11 = {};
        wave_tile(arow(tm * 64 + r32) + hi * 8, arow(tm * 64 + 32 + r32) + hi * 8, brow(tn * 64 + r32) + hi * 8, brow(tn * 64 + 32 + r32) + hi * 8, K, c00, c01, c10, c11);
#pragma unroll
        for (int r = 0; r < 16; ++r) {
            const int row = tm * 64 + crow(r, hi), col = tn * 64 + r32;
            epi(row, col, c00[r]); epi(row, col + 32, c01[r]); epi(row + 32, col, c10[r]); epi(row + 32, col + 32, c11[r]);
        }
    }
}


#define LAS __attribute__((address_space(3)))
namespace g8 {
constexpr int BM = 256, BK = 64, HALF = 128, HTB = HALF * BK * 2, STAGE_BYTES = 8 * HTB, NXCD = 8, WGM = 8;
DEV int lds_byte(int r, int c) { const int st = (r >> 4) * 2 + (c >> 5), rr = r & 15, cc = c & 31, ob = rr * 64 + cc * 2; return st * 1024 + (ob ^ (((ob >> 9) & 1) << 5)); }
DEV void stage_rc(int b, int& R, int& C) { const int st = b / 1024, sb = b % 1024, swz = sb ^ (((sb >> 9) & 1) << 5); R = (st >> 1) * 16 + swz / 64; C = (st & 1) * 32 + (swz % 64) / 2; }
DEV int perm32(int rho) { const int n = rho >> 4, i = rho & 15; return 8 * (i >> 2) + 4 * n + (i & 3); }
struct Unit { int pm, pn, e; };
typedef f32x4 Acc[2][2][4][2];
typedef int i32x8 __attribute__((ext_vector_type(8)));
typedef int i32x4 __attribute__((ext_vector_type(4)));
DEV f32x4 mfma_any(i32x8 a, i32x8 b, f32x4 c) { return __builtin_amdgcn_mfma_scale_f32_16x16x128_f8f6f4(a, b, c, 0, 0, 0, 0x7f7f7f7f, 0, 0x7f7f7f7f); }
DEV f32x4 mfma_any(bf16x8 a, bf16x8 b, f32x4 c) { return __builtin_amdgcn_mfma_f32_16x16x32_bf16(a, b, c, 0, 0, 0); }
template <bool F8> struct FragSel { typedef bf16x8 T; };
template <> struct FragSel<true> { typedef i32x8 T; };
template <class Epi, class Sched, bool GATHER, bool F8 = false>
DEV void gemm_phase(LAS unsigned char* lds, const int K, const int lda, const int ldb, const Sched& S, const Epi& E) { const int tid_ = tid_fresh();
    const int tid = tid_, wid = __builtin_amdgcn_readfirstlane(tid >> 6), lane = tid & 63, wr = wid >> 2, wc = wid & 3, fr = lane & 15, fq = lane >> 4;
    const int nt = K / BK;
    unsigned voffB, vC0;
    unsigned tkC0 = 0u, tkC1 = 0u, tkN0 = 0u, tkN1 = 0u, cbA = 0u;
    { int R, C; stage_rc(tid * 16, R, C); const int Rb = Epi::PERM ? ((R & ~31) + perm32(R & 31)) : R;
      voffB = (unsigned)(Rb * ldb + C) * 2u; vC0 = (unsigned)(R * lda + C) * 2u; cbA = (unsigned)C * 2u; }
    const unsigned pstepA = (unsigned)(64 * lda * 2), pstepB = (unsigned)(64 * ldb * 2);
    const unsigned kstep = (unsigned)(BK * 2), hstepB = (unsigned)(HALF * ldb * 2), hA = GATHER ? 0u : (unsigned)(HALF * lda * 2);
    const __amdgpu_buffer_rsrc_t rA = __builtin_amdgcn_make_buffer_rsrc((void*)S.A, 0, 0x7ffffff0, 0x00020000), rB = __builtin_amdgcn_make_buffer_rsrc((void*)S.B, 0, 0x7ffffff0, 0x00020000);
    const unsigned ldsw = (unsigned)wid * 1024u;
    int aoff = lds_byte(wr * 64 + fr, F8 ? fq * 16 : fq * 8), boff = lds_byte(wc * 32 + fr, F8 ? fq * 16 : fq * 8) + 4 * HTB;
    asm volatile("" : "+v"(aoff), "+v"(boff));
#define G8_SA(b, h) (((b) * 2 + (h)) * HTB)
#define G8_SB(b, h) ((4 + (b) * 2 + (h)) * HTB)
#define G8_SBR(b, h) (((b) * 2 + (h)) * HTB)
#define G8_STAGE1(bufoff, rs, soff, voff, i) __builtin_amdgcn_raw_ptr_buffer_load_lds(rs, (LAS void*)(lds + (bufoff) + ldsw + (i) * 8192), 16, (int)(voff), (int)(soff), 0, 0)
#define G8_STAGE_B(bufoff, soff) do { G8_STAGE1(bufoff, rB, soff, voffB, 0); G8_STAGE1(bufoff, rB, (soff) + pstepB, voffB, 1); } while (0)
#define G8_LDA(dst, b, h) do { _Pragma("unroll") for (int m = 0; m < 4; ++m) _Pragma("unroll") for (int k = 0; k < NK; ++k) dst[m][k] = *(const LAS FragT*)(lds + aoff + (G8_SA(b, h) + m * 2048 + k * 1024)); } while (0)
#define G8_LDB(dst, b, h) do { _Pragma("unroll") for (int n = 0; n < 2; ++n) _Pragma("unroll") for (int k = 0; k < NK; ++k) dst[n][k] = *(const LAS FragT*)(lds + boff + (G8_SBR(b, h) + n * 2048 + k * 1024)); } while (0)
#define G8_MMA(ai, bj, At, Bt) do { __builtin_amdgcn_s_setprio(1); _Pragma("unroll") for (int m = 0; m < 4; ++m) _Pragma("unroll") for (int n = 0; n < 2; ++n) { \
        _Pragma("unroll") for (int k = 0; k < NK; ++k) acc[ai][bj][m][n] = mfma_any(Bt[n][k], At[m][k], acc[ai][bj][m][n]); } \
        __builtin_amdgcn_s_setprio(0); } while (0)
#define G8_WAIT_V(n) asm volatile("s_waitcnt vmcnt(" #n ")" ::: "memory")
#define G8_WAIT_L(n) asm volatile("s_waitcnt lgkmcnt(" #n ")" ::: "memory")
#define G8_BAR __builtin_amdgcn_s_barrier()
#define G8_SCHED __builtin_amdgcn_sched_barrier(0)
#define G8_AOFF(d0, d1, u) do { const int _t = tid_fresh(); int _R, _C; stage_rc(_t * 16, _R, _C); \
        d0 = (S.atok(u, _R) & 0xffffu) | (S.atok(u, _R + 64) << 16); d1 = (S.atok(u, HALF + _R) & 0xffffu) | (S.atok(u, HALF + _R + 64) << 16); } while (0)
#define G8_STAGE_A(bufoff, soff, tk) do { if constexpr (GATHER) { G8_STAGE1(bufoff, rA, soff, ((tk) & 0xffffu) * (unsigned)S.lda2 + cbA, 0); G8_STAGE1(bufoff, rA, soff, ((tk) >> 16) * (unsigned)S.lda2 + cbA, 1); } \
        else { G8_STAGE1(bufoff, rA, soff, vC0, 0); G8_STAGE1(bufoff, rA, (soff) + pstepA, vC0, 1); } } while (0)
    Unit cur, nxt; int ui = 0;
    if (!S.next(0, cur)) return;
    Acc acc;
#pragma unroll
    for (int a = 0; a < 2; ++a)
#pragma unroll
        for (int b = 0; b < 2; ++b)
#pragma unroll
            for (int m = 0; m < 4; ++m)
#pragma unroll
                for (int n = 0; n < 2; ++n) acc[a][b][m][n] = (f32x4){0.f, 0.f, 0.f, 0.f};
    typedef typename FragSel<F8>::T FragT; constexpr int NK = F8 ? 1 : 2;
    FragT At[4][NK], B0[2][NK], B1[2][NK];
    unsigned cA = S.aoff(cur), cB = S.boff(cur);
    if (GATHER) { G8_AOFF(tkC0, tkC1, cur); }
    G8_STAGE_B(G8_SB(0, 0), cB); G8_STAGE_B(G8_SB(0, 1), cB + hstepB); G8_STAGE_A(G8_SA(0, 0), cA, tkC0); G8_STAGE_A(G8_SA(0, 1), cA + hA, tkC1);
    if (wr == 1) G8_BAR;
    G8_WAIT_V(2); G8_BAR;
    G8_STAGE_B(G8_SB(1, 0), cB + kstep); G8_STAGE_A(G8_SA(1, 0), cA + kstep, tkC0); G8_STAGE_B(G8_SB(1, 1), cB + hstepB + kstep);
    G8_WAIT_V(6); G8_BAR;
    for (;;) {
        const bool has_next = S.next(ui + 1, nxt);
        const unsigned nA = has_next ? S.aoff(nxt) : cA, nB = has_next ? S.boff(nxt) : cB;
#pragma unroll 1
        for (int t = 0; t < nt; t += 2) {
            const bool last = (t == nt - 2);
            if (GATHER && t == (nt >= 4 ? nt - 4 : 0)) {
                if (has_next) { G8_AOFF(tkN0, tkN1, nxt); } else { tkN0 = tkC0; tkN1 = tkC1; } }
            const unsigned a1 = cA + (unsigned)(t + 1) * kstep;
            const unsigned a2 = last ? nA : cA + (unsigned)(t + 2) * kstep, b2 = last ? nB : cB + (unsigned)(t + 2) * kstep;
            const unsigned a3 = a2 + kstep, b3 = b2 + kstep;
            const unsigned s0 = (GATHER && last) ? tkN0 : tkC0, s1 = (GATHER && last) ? tkN1 : tkC1;
            G8_LDB(B0, 0, 0); G8_LDB(B1, 0, 1); G8_SCHED; G8_LDA(At, 0, 0); G8_STAGE_A(G8_SA(1, 1), a1 + hA, tkC1);
            G8_WAIT_V(8); G8_WAIT_L(0); G8_BAR; G8_MMA(0, 0, At, B0); G8_MMA(0, 1, At, B1); G8_BAR; G8_SCHED;
            G8_LDA(At, 0, 1); G8_STAGE_B(G8_SB(0, 0), b2); G8_STAGE_B(G8_SB(0, 1), b2 + hstepB); G8_STAGE_A(G8_SA(0, 0), a2, s0);
            G8_WAIT_V(8); G8_WAIT_L(0); G8_BAR; G8_MMA(1, 0, At, B0); G8_MMA(1, 1, At, B1); G8_BAR; G8_SCHED;
            G8_LDB(B0, 1, 0); G8_LDB(B1, 1, 1); G8_SCHED; G8_LDA(At, 1, 0); G8_STAGE_A(G8_SA(0, 1), a2 + hA, s1);
            G8_WAIT_V(8); G8_WAIT_L(0); G8_BAR; G8_MMA(0, 0, At, B0); G8_MMA(0, 1, At, B1); G8_BAR; G8_SCHED;
            G8_LDA(At, 1, 1); G8_STAGE_B(G8_SB(1, 0), b3); G8_STAGE_B(G8_SB(1, 1), b3 + hstepB); G8_STAGE_A(G8_SA(1, 0), a3, s0);
            G8_WAIT_V(8); G8_WAIT_L(0); G8_BAR; G8_MMA(1, 0, At, B0); G8_MMA(1, 1, At, B1); G8_BAR; G8_SCHED;
        }
        if (wr == 0) G8_BAR;
        { const int te_ = tid_fresh(); E(acc, cur, wr, wc, te_ & 15, (te_ >> 4) & 3); }
        if (!has_next) break;
#pragma unroll
        for (int a = 0; a < 2; ++a)
#pragma unroll
            for (int b = 0; b < 2; ++b)
#pragma unroll
                for (int m = 0; m < 4; ++m)
#pragma unroll
                    for (int n = 0; n < 2; ++n) acc[a][b][m][n] = (f32x4){0.f, 0.f, 0.f, 0.f};
        cur = nxt; cA = nA; cB = nB; ++ui;
        if (GATHER) { tkC0 = tkN0; tkC1 = tkN1; }
        if (wr == 1) G8_BAR;
    }
    G8_WAIT_V(0);
    G8_BAR;
}
struct DenseSched {
    const char* A; const char* B; size_t tstepA, tstepB; int nM, nN, nwg, G, c;
    DEV void init(const void* A_, int lda, const void* B_, int ldb, int Mr, int Nc, int G_, int c_) { A = (const char*)A_; B = (const char*)B_; tstepA = (size_t)BM * lda * 2; tstepB = (size_t)BM * ldb * 2;
        nM = Mr / BM; nN = Nc / BM; nwg = nM * nN; G = G_; c = c_; }
    DEV bool next(int i, Unit& u) const {
        const long L = (long)i * G + c; if (L >= nwg) return false;
        int wgid = (int)L; { const int q = nwg / NXCD, r = nwg % NXCD, xcd = wgid % NXCD, off = wgid / NXCD; wgid = (xcd < r ? xcd * (q + 1) : r * (q + 1) + (xcd - r) * q) + off; }
        const int nig = WGM * nN, gid = wgid / nig, fm = gid * WGM, gsz = (nM - fm) < WGM ? (nM - fm) : WGM;
        u.pm = fm + ((wgid % nig) % gsz); u.pn = (wgid % nig) / gsz; u.e = 0; return true;
    }
    DEV unsigned aoff(const Unit& u) const { return (unsigned)((size_t)u.pm * tstepA); }
    DEV unsigned boff(const Unit& u) const { return (unsigned)((size_t)u.pn * tstepB); }
    DEV unsigned atok(const Unit&, int) const { return 0u; }
    static constexpr int lda2 = 0;
};
DEV unsigned cvt_pk_bf16(float lo, float hi) { unsigned r; asm volatile("v_cvt_pk_bf16_f32 %0, %1, %2" : "=v"(r) : "v"(lo), "v"(hi)); return r; }
DEV u32x4 pack8(const f32x4 v0, const f32x4 v1) { u32x4 w; w.x = cvt_pk_bf16(v0[0], v0[1]); w.y = cvt_pk_bf16(v0[2], v0[3]); w.z = cvt_pk_bf16(v1[0], v1[1]); w.w = cvt_pk_bf16(v1[2], v1[3]); return w; }
}

template <class SF>
DEV void transpose_item(SF src, bf16_t* dst, int ldd, int k0, int n0, float* scr, int lane) {
#pragma unroll 8
    for (int i = 0; i < 32; ++i) { const int kk = 2 * i + (lane >> 5); scr[kk * 33 + (lane & 31)] = src(k0 + kk, n0 + (lane & 31)); }
    __builtin_amdgcn_s_waitcnt(0xc07f); asm volatile("" ::: "memory");
    const int c = lane & 7;
#pragma unroll
    for (int j = 0; j < 4; ++j) { const int n = (lane >> 3) + 8 * j; const float* s = scr + (8 * c) * 33 + n;
        u32x4 o; o.x = pk2(s[0], s[33]); o.y = pk2(s[66], s[99]); o.z = pk2(s[132], s[165]); o.w = pk2(s[198], s[231]);
        *(u32x4*)(dst + (size_t)(n0 + n) * ldd + k0 + 8 * c) = o; }
    __builtin_amdgcn_s_waitcnt(0xc07f); asm volatile("" ::: "memory");
}
DEV unsigned pk4_fp8(float a, float b, float c, float d) { int t = __builtin_amdgcn_cvt_pk_fp8_f32(a, b, 0, false); t = __builtin_amdgcn_cvt_pk_fp8_f32(c, d, t, true); return (unsigned)t; }
DEV unsigned char f2fp8(float f) { return (unsigned char)(__builtin_amdgcn_cvt_pk_fp8_f32(f, 0.f, 0, false) & 0xff); }
template <class RM>
DEV void transpose_tile_reg8(const float* src, int ldn, unsigned char* dst, int ldd, int k0, int n0, RM rowmap, int lane, float sc) {
    const int kq = lane >> 4, nq = lane & 15; f32x4 v[16];
#pragma unroll
    for (int i = 0; i < 16; ++i) v[i] = *(const f32x4*)(src + (size_t)(k0 + 16 * kq + i) * ldn + n0 + 4 * nq) * sc;
#pragma unroll
    for (int j = 0; j < 4; ++j) { u32x4 a; a.x = pk4_fp8(v[0][j], v[1][j], v[2][j], v[3][j]); a.y = pk4_fp8(v[4][j], v[5][j], v[6][j], v[7][j]); a.z = pk4_fp8(v[8][j], v[9][j], v[10][j], v[11][j]); a.w = pk4_fp8(v[12][j], v[13][j], v[14][j], v[15][j]);
        *(u32x4*)(dst + (size_t)rowmap(n0 + 4 * nq + j) * ldd + k0 + 16 * kq) = a; }
}
template <class RM>
DEV void transpose_tile_reg(const float* src, int ldn, bf16_t* dst, int ldd, int k0, int n0, RM rowmap, int lane) {
    const int kq = lane >> 4, nq = lane & 15; f32x4 v[16];
#pragma unroll
    for (int i = 0; i < 16; ++i) v[i] = *(const f32x4*)(src + (size_t)(k0 + 16 * kq + i) * ldn + n0 + 4 * nq);
#pragma unroll
    for (int j = 0; j < 4; ++j) { bf16_t* o = dst + (size_t)rowmap(n0 + 4 * nq + j) * ldd + k0 + 16 * kq;
        u32x4 a, b2; a.x = pk2(v[0][j], v[1][j]); a.y = pk2(v[2][j], v[3][j]); a.z = pk2(v[4][j], v[5][j]); a.w = pk2(v[6][j], v[7][j]);
        b2.x = pk2(v[8][j], v[9][j]); b2.y = pk2(v[10][j], v[11][j]); b2.z = pk2(v[12][j], v[13][j]); b2.w = pk2(v[14][j], v[15][j]);
        *(u32x4*)o = a; *(u32x4*)(o + 8) = b2; }
}
DEV int zcol_src(int n) {
    if (n < 1536) return n;
    if (n < 1792) return 1552 + (n - 1536);
    if (n < 1920) return 1808 + (n - 1792);
    if (n < 1984) { const int j = n - 1920; return 1936 + (j >> 1) + 32 * (j & 1); }
    if (n < 2000) return 1536 + (n - 1984);
    return -1;
}
DEV int wrow_to_zcol(int n) {
    if (n < 512) return n;
    if (n < 1024) return n + 512;
    if (n < 1280) return ZQL + (n - 1024);
    if (n < 1536) return ZKVL + (n - 1280);
    return ZV + (n - 1536);
}
DEV void expert_convert(const Params& P, int gw, int ngw, int lane) {
    unsigned char* ws = P.ws;
    for (int it = gw; it < NE * 384; it += ngw) { const int e = it / 384, q = it % 384;
        if (q < 256) { const bool isu = q >= 128; const int qq = q & 127, kb = qq >> 3, nb = qq & 7; const float* W = P.in[isu ? I_WU : I_WG] + (size_t)e * 1024 * 512;
            transpose_tile_reg8(W, 512, (unsigned char*)(ws + WS_WGU) + (size_t)e * 1024 * 1024, 1024, kb * 64, nb * 64, [&](int hid) { return ((hid >> 2) << 3) + (hid & 3) + (isu ? 4 : 0); }, lane, 32.f); }
        else { const int qq = q - 256, kb = qq >> 4, nb = qq & 15; const float* W = P.in[I_WDN] + (size_t)e * 512 * 1024;
            transpose_tile_reg8(W, 1024, (unsigned char*)(ws + WS_WD) + (size_t)e * 1024 * 512, 512, kb * 64, nb * 64, [&](int n) { return n; }, lane, 32.f); }
    }
}
DEV void phase0(const Params& P, float* scr_all) { const int tid_ = tid_fresh();
    const int tid = tid_, lane = tid & 63, wave = tid >> 6;
    const int gw = blockIdx.x * NWAVE + wave, ngw = gridDim.x * NWAVE;
    float* scr = scr_all + wave * (64 * 33);
    unsigned char* ws = P.ws;
    constexpr int I_IN = 16 * 64, I_Q = 4 * 24, I_K = 4 * 16, I_V = 4 * 16, I_O = 16 * 32, I_GU = 16 * 32, I_DN = 8 * 32;
    constexpr int NITEMS = I_IN + I_Q + I_K + I_V + I_O;
    const float c2 = 0.07216878364870322f * 1.4426950408889634f;
    for (int it = gw; it < NITEMS; it += ngw) {
        int r = it;
        if (r < I_IN) { const float* W = P.in[I_WIN]; const int kb = r / 64, nb = r % 64;
            transpose_item([&](int k, int n) { const int s = zcol_src(wrow_to_zcol(n)); return s < 0 ? 0.f : W[(size_t)k * 2000 + s]; }, (bf16_t*)(ws + WS_WIN), 1024, kb * 64, nb * 32, scr, lane); continue; }
        r -= I_IN;
        if (r < I_Q) { const float* W = P.in[I_WQB]; const float* g = P.in[I_QN]; const int kb = r / 24, nb = r % 24;
            transpose_item([&](int k, int n) { int s; if (n < 512) s = (n >> 7) * 192 + (n & 127); else { const int q = n - 512, h = q >> 6, jj = q & 63; s = h * 192 + 128 + (jj >> 1) + 32 * (jj & 1); }
                return W[(size_t)k * 768 + s] * g[k] * c2; }, (bf16_t*)(ws + WS_WQ), 256, kb * 64, nb * 32, scr, lane); continue; }
        r -= I_Q;
        if (r < I_K + I_V) { const bool isv = r >= I_K; if (isv) r -= I_K; const float* W = P.in[I_WKVB]; const float* g = P.in[I_KVN]; const int kb = r / 16, nb = r % 16;
            transpose_item([&](int k, int n) { if (k >= 128) return 0.f; const int s = (n >> 7) * 256 + (isv ? 128 : 0) + (n & 127); return W[(size_t)k * 1024 + s] * g[k]; },
                           (bf16_t*)(ws + (isv ? WS_WV : WS_WK)), 256, kb * 64, nb * 32, scr, lane); continue; }
        r -= I_K + I_V;
        if (r < I_O) { const float* W = P.in[I_WOUT]; const int kb = r / 32, nb = r % 32;
            transpose_item([&](int k, int n) { return W[(size_t)k * 1024 + n]; }, (bf16_t*)(ws + WS_WOUT), 1024, kb * 64, nb * 32, scr, lane); continue; }
        r -= I_O;
        { }
    }
#if !XCONV_P3
    expert_convert(P, gw, ngw, lane);
#endif
    { const float* g = P.in[I_MIXN]; bf16_t* XN = (bf16_t*)(ws + WS_XN);
      f32x4 gv[4];
#pragma unroll
      for (int j = 0; j < 4; ++j) gv[j] = *(const f32x4*)(g + 256 * j + 4 * lane);
      for (int m0 = gw * 4; m0 < M; m0 += ngw * 4) {
        f32x4 v[4][4];
#pragma unroll
        for (int q = 0; q < 4; ++q)
#pragma unroll
            for (int j = 0; j < 4; ++j) v[q][j] = ((const f32x4*)(P.in[I_X] + (size_t)(m0 + q) * D) + lane)[64 * j];
#pragma unroll
        for (int q = 0; q < 4; ++q) { float s = 0.f;
#pragma unroll
            for (int j = 0; j < 4; ++j) s += (v[q][j].x * v[q][j].x + v[q][j].y * v[q][j].y) + (v[q][j].z * v[q][j].z + v[q][j].w * v[q][j].w);
            const float rs = rsqrtf(wave_sum(s) * (1.f / D) + EPS);
            unsigned long long* o8 = (unsigned long long*)(XN + (size_t)(m0 + q) * D) + lane;
#pragma unroll
            for (int j = 0; j < 4; ++j) o8[64 * j] = (unsigned long long)pk2(v[q][j].x * rs * gv[j].x, v[q][j].y * rs * gv[j].y) | ((unsigned long long)pk2(v[q][j].z * rs * gv[j].z, v[q][j].w * rs * gv[j].w) << 32); }
      } }
    const int gt = blockIdx.x * NT + tid, ngt = gridDim.x * NT;
    { float2* rt = (float2*)(ws + WS_ROPE);
      for (int i = gt; i < (SEQ + NMETA) * 32; i += ngt) { const int pos = i >> 5, f = i & 31;
        const double inv = pow(10000.0, -(double)(2 * f) / 64.0), ang = (double)pos * inv; rt[i] = make_float2((float)cos(ang), (float)sin(ang)); } }
    { bf16_t* wt = (bf16_t*)(ws + WS_WA2T); const float* wa2 = P.in[I_WA2];
      for (int i = gt; i < 256 * 128; i += ngt) { const int n = i >> 7, k = i & 127; wt[i] = (bf16_t)f2bf((k >= 64 && k < 80) ? wa2[(k - 64) * 256 + n] : 0.f); } }
    { bf16_t* wr = (bf16_t*)(ws + WS_WR); const float* wg = P.in[I_RGW]; const float* we = P.in[I_REW];
      for (int i = gt; i < 96 * D; i += ngt) { const int row = i >> 10, k = i & 1023, t = row >> 5, rho = row & 31, hi = (rho >> 2) & 1, r = (rho & 3) + 4 * (rho >> 3);
        float v = 0.f; if (t < 2) v = we[k * 64 + 8 * (4 * t + 2 * hi + (r >> 3)) + (r & 7)]; else if (hi == 0 && r < 8) v = wg[k * 8 + r];
        wr[i] = (bf16_t)f2bf(v * P.in[I_FFN][k]); } }
    { float* mz = (float*)(ws + WS_CTL + CTL_MZ); float* rsm = (float*)(ws + WS_CTL + CTL_RSM); const float* mt = P.in[I_META]; const float* g = P.in[I_MIXN]; const float* W = P.in[I_WIN];
      for (int it = gt; it < 32 * 1024; it += ngt) { const int ks = it >> 10, ci = it & 1023; const int n = ci < 768 ? ZK + ci : ZKVL + (ci - 768); const int s = (ci < 976) ? zcol_src(n) : -1;
        if (s >= 0) { float acc[NMETA];
#pragma unroll
            for (int r = 0; r < NMETA; ++r) acc[r] = 0.f;
#pragma unroll 4
            for (int k = ks * 32; k < ks * 32 + 32; ++k) { const float w = W[(size_t)k * 2000 + s] * g[k];
#pragma unroll
                for (int r = 0; r < NMETA; ++r) acc[r] += mt[r * D + k] * w; }
#pragma unroll
            for (int r = 0; r < NMETA; ++r) atomicAdd(mz + r * NZ + n, acc[r]); } }
      if (gw < NMETA) { float ss = 0.f;
#pragma unroll
        for (int j = 0; j < 16; ++j) { const float x = mt[gw * D + 64 * j + lane]; ss += x * x; }
        ss = wave_sum(ss); if (lane == 0) rsm[gw] = rsqrtf(ss * (1.f / D) + EPS); } }
}

DEV void meta_phase(const Params& P) { const int tid_ = tid_fresh();
    unsigned char* ws = P.ws; const int gt = blockIdx.x * NT + tid_, ngt = gridDim.x * NT;
    const float* mzr = (const float*)(ws + WS_CTL + CTL_MZ); const float* rsm = (const float*)(ws + WS_CTL + CTL_RSM);
    bf16_t* KNm = (bf16_t*)(ws + WS_META + MT_KN); bf16_t* VTm = (bf16_t*)(ws + WS_META + MT_VT); bf16_t* KRm = (bf16_t*)(ws + WS_META + MT_KR); float* S1 = (float*)(ws + WS_META + MT_S1);
    const float* Wkv = P.in[I_WKVB]; const float* gk = P.in[I_KVN];
    for (int i = gt; i < NMETA * 1024; i += ngt) { const int row = i >> 10, col = i & 1023; const float* z = mzr + row * NZ + ZKVL; const float rm = rsm[row];
        float ss = 0.f, acc = 0.f;
#pragma unroll 16
        for (int k = 0; k < 128; ++k) { const float zk = z[k] * rm; ss += zk * zk; acc += zk * gk[k] * Wkv[(size_t)k * 1024 + col]; }
        acc *= rsqrtf(ss * (1.f / 128.f) + EPS);
        const int h = col >> 8, w = col & 255;
        unsigned char* KN8m = ws + WS_META + MT_KN8; unsigned char* VT8m = ws + WS_META + MT_VT8;
        if (w < 128) { KNm[row * 512 + h * 128 + w] = (bf16_t)f2bf(acc); KNm[(row + 16) * 512 + h * 128 + w] = 0; KN8m[row * 512 + h * 128 + w] = f2fp8(acc); KN8m[(row + 16) * 512 + h * 128 + w] = 0; }
        else { VTm[(h * 128 + w - 128) * 32 + row] = (bf16_t)f2bf(acc); VTm[(h * 128 + w - 128) * 32 + 16 + row] = 0; VT8m[(h * 128 + w - 128) * 32 + row] = f2fp8(acc); VT8m[(h * 128 + w - 128) * 32 + 16 + row] = 0; } }
    const float2* rt = (const float2*)(ws + WS_ROPE);
    for (int i = gt; i < NMETA * 32; i += ngt) { const int row = i >> 5, f = i & 31; const float x1 = mzr[row * NZ + ZKR + 2 * f] * rsm[row], x2 = mzr[row * NZ + ZKR + 2 * f + 1] * rsm[row]; const float2 cs = rt[row * 32 + f];
        KRm[row * 64 + 2 * f] = (bf16_t)f2bf(x1 * cs.x - x2 * cs.y); KRm[row * 64 + 2 * f + 1] = (bf16_t)f2bf(x2 * cs.x + x1 * cs.y); KRm[(row + 16) * 64 + 2 * f] = 0; KRm[(row + 16) * 64 + 2 * f + 1] = 0;
        unsigned char* KR8m = ws + WS_META + MT_KR8; KR8m[row * 64 + 2 * f] = f2fp8(x1 * cs.x - x2 * cs.y); KR8m[row * 64 + 2 * f + 1] = f2fp8(x2 * cs.x + x1 * cs.y); KR8m[(row + 16) * 64 + 2 * f] = 0; KR8m[(row + 16) * 64 + 2 * f + 1] = 0; }
    const float* wa2 = P.in[I_WA2]; const float* ba = P.in[I_BA];
    for (int i = gt; i < 4 * 64 * 128; i += ngt) { const int h = i >> 13, d = (i >> 7) & 63, e = i & 127; float S = 0.f;
        for (int s = 0; s < NMETA; ++s) { const float* z = mzr + s * NZ; const float rm = rsm[s]; float x = 0.f;
            for (int r = 0; r < 16; ++r) x += z[ZAL + r] * wa2[r * 256 + h * 64 + d];
            x = x * rm + ba[h * 64 + d];
            const float a = __expf((fminf(x, 0.f) - __logf(1.f + __expf(-fabsf(x)))) * (1.f / 16.f)); S = a * S + (z[ZK + h * 64 + d] * rm) * (z[ZV + h * 128 + e] * rm); }
        S1[i] = S; }
}
DEV void phase1(const Params& P) { const int tid_ = tid_fresh();
    unsigned char* ws = P.ws; const int gw = blockIdx.x * NWAVE + (tid_ >> 6), ngw = gridDim.x * NWAVE;
    const bf16_t* XN = (const bf16_t*)(ws + WS_XN); const bf16_t* W = (const bf16_t*)(ws + WS_WIN); bf16_t* Z = (bf16_t*)P.out;
    gemm_simple(M / 64, NZ / 64, D, [&](int r) { return XN + (size_t)r * D; }, [&](int c) { return W + (size_t)c * D; },
                [&](int row, int col, float v) { Z[(size_t)row * NZ + col] = (bf16_t)f2bf(v); }, gw, ngw);
    meta_phase(P);
}
DEV void phase2a(const Params& P) { const int tid_ = tid_fresh();
    unsigned char* ws = P.ws; const int lane = tid_ & 63; const int gw = blockIdx.x * NWAVE + (tid_ >> 6), ngw = gridDim.x * NWAVE;
    const bf16_t* Z = (const bf16_t*)P.out; float* rsq = (float*)(ws + WS_RS); float* rskv = rsq + M; bf16_t* KR = (bf16_t*)(ws + WS_KR); float* LOGA = (float*)(ws + WS_LOGA);
    const float2* rt = (const float2*)(ws + WS_ROPE); const float* wa2 = P.in[I_WA2]; const float* ba = P.in[I_BA];
    float w[4][16], bb[4];
#pragma unroll
    for (int j = 0; j < 4; ++j) { bb[j] = ba[64 * j + lane];
#pragma unroll
        for (int r = 0; r < 16; ++r) w[j][r] = wa2[r * 256 + 64 * j + lane]; }
    for (int m = gw; m < M; m += ngw) { const bf16_t* z = Z + (size_t)m * NZ;
        float s = 0.f;
#pragma unroll
        for (int j = 0; j < 4; ++j) { const float v = bf2f(z[ZQL + 64 * j + lane]); s += v * v; }
        s = wave_sum(s); float s2 = 0.f;
#pragma unroll
        for (int j = 0; j < 2; ++j) { const float v = bf2f(z[ZKVL + 64 * j + lane]); s2 += v * v; }
        s2 = wave_sum(s2);
        if (lane == 0) { rsq[m] = rsqrtf(s * (1.f / 256.f) + EPS); rskv[m] = rsqrtf(s2 * (1.f / 128.f) + EPS); }
        { const float v = bf2f(z[ZKR + lane]), o = sx<1>(v); const float2 cs = rt[(NMETA + (m & (SEQ - 1))) * 32 + (lane >> 1)];
          KR[(size_t)m * 64 + lane] = (bf16_t)f2bf((lane & 1) ? (v * cs.x + o * cs.y) : (v * cs.x - o * cs.y)); }
        float al[16];
#pragma unroll
        for (int r = 0; r < 16; ++r) al[r] = bf2f(z[ZAL + r]);
#pragma unroll
        for (int j = 0; j < 4; ++j) { float x = bb[j];
#pragma unroll
            for (int r = 0; r < 16; ++r) x += al[r] * w[j][r];
            LOGA[(size_t)m * 256 + 64 * j + lane] = logsigmoidf(x) * (1.f / 16.f); }
    }
}
DEV void phase2b(const Params& P) { const int tid_ = tid_fresh();
    unsigned char* ws = P.ws; const int gw = blockIdx.x * NWAVE + (tid_ >> 6), ngw = gridDim.x * NWAVE;
    const bf16_t* Z = (const bf16_t*)P.out; const float* rsq = (const float*)(ws + WS_RS); const float* rskv = rsq + M;
    const float2* rt = (const float2*)(ws + WS_ROPE);
    { bf16_t* QM = (bf16_t*)(ws + WS_QM); const bf16_t* W = (const bf16_t*)(ws + WS_WQ);
      gemm_simple(M / 64, 768 / 64, 256, [&](int r) { return Z + (size_t)r * NZ + ZQL; }, [&](int c) { return W + (size_t)c * 256; },
                  [&](int row, int col, float v) { v *= rsq[row]; const float o = sx<1>(v);
                      if (col >= 512) { const float2 cs = rt[(NMETA + (row & (SEQ - 1))) * 32 + ((col & 63) >> 1)]; v = (col & 1) ? (v * cs.x + o * cs.y) : (v * cs.x - o * cs.y); }
                      QM[(size_t)row * 768 + col] = (bf16_t)f2bf(v); }, gw, ngw); }
    { bf16_t* KN = (bf16_t*)(ws + WS_KN); const bf16_t* W = (const bf16_t*)(ws + WS_WK);
      gemm_simple(M / 64, 512 / 64, 256, [&](int r) { return Z + (size_t)r * NZ + ZKVL; }, [&](int c) { return W + (size_t)c * 256; },
                  [&](int row, int col, float v) { KN[(size_t)row * 512 + col] = (bf16_t)f2bf(v * rskv[row]); }, gw, ngw); }
    { bf16_t* VT = (bf16_t*)(ws + WS_VT); const bf16_t* W = (const bf16_t*)(ws + WS_WV);
      gemm_simple(512 / 64, M / 64, 256, [&](int r) { return W + (size_t)r * 256; }, [&](int c) { return Z + (size_t)c * NZ + ZKVL; },
                  [&](int row, int col, float v) { VT[(size_t)row * M + col] = (bf16_t)f2bf(v * rskv[col]); }, gw, ngw); }
}
DEV void gla_simple(const Params& P) { const int tid_ = tid_fresh();
    unsigned char* ws = P.ws; const int tid = tid_;
    const bf16_t* Z = (const bf16_t*)P.out; const float* LOGA = (const float*)(ws + WS_LOGA); const float* S1 = (const float*)(ws + WS_META + MT_S1); bf16_t* Y = (bf16_t*)(ws + WS_Y);
    for (int u = blockIdx.x; u < NB * 4; u += gridDim.x) { const int b = u >> 2, h = u & 3, e = tid >> 2, dq = tid & 3;
        float S[16];
#pragma unroll
        for (int j = 0; j < 16; ++j) S[j] = S1[(h * 64 + dq * 16 + j) * 128 + e];
        for (int t = 0; t < SEQ; ++t) { const size_t m = (size_t)b * SEQ + t; const bf16_t* z = Z + m * NZ;
            const u32x4 q0 = *(const u32x4*)(z + ZQ + h * 64 + dq * 16), q1 = *(const u32x4*)(z + ZQ + h * 64 + dq * 16 + 8);
            const u32x4 k0 = *(const u32x4*)(z + ZK + h * 64 + dq * 16), k1 = *(const u32x4*)(z + ZK + h * 64 + dq * 16 + 8);
            const f32x4* la = (const f32x4*)(LOGA + m * 256 + h * 64 + dq * 16);
            const float v = bf2f(z[ZV + h * 128 + e]);
            const unsigned qq[8] = {q0.x, q0.y, q0.z, q0.w, q1.x, q1.y, q1.z, q1.w}, kk[8] = {k0.x, k0.y, k0.z, k0.w, k1.x, k1.y, k1.z, k1.w};
            float o = 0.f;
#pragma unroll
            for (int j4 = 0; j4 < 4; ++j4) { const f32x4 l4 = la[j4];
#pragma unroll
                for (int jj = 0; jj < 4; ++jj) { const int j = j4 * 4 + jj; const unsigned qw = qq[j >> 1], kw = kk[j >> 1];
                    const float qv = (j & 1) ? __uint_as_float(qw & 0xffff0000u) : __uint_as_float(qw << 16), kv = (j & 1) ? __uint_as_float(kw & 0xffff0000u) : __uint_as_float(kw << 16);
                    S[j] = __expf(l4[jj]) * S[j] + kv * v; o += qv * S[j]; } }
            o += sx<1>(o); o += sx<2>(o);
            if (dq == 0) Y[m * 1024 + h * 128 + e] = (bf16_t)f2bf(o * 0.125f); }
    }
}
DEV void gla_fast(const Params& P) {
    typedef float f32x2 __attribute__((ext_vector_type(2)));
    unsigned char* ws = P.ws; const int tid_ = tid_fresh(); const int lane = tid_ & 63, wave = tid_ >> 6, dg = lane & 15, es = lane >> 4;
    const bf16_t* Z = (const bf16_t*)P.out; const float* AEXP = (const float*)(ws + WS_LOGA); const float* S1 = (const float*)(ws + WS_META + MT_S1); bf16_t* Y = (bf16_t*)(ws + WS_Y);
    for (int u = blockIdx.x; u < NB * 16; u += gridDim.x) { const int b = u >> 4, h = (u >> 2) & 3, e = (u & 3) * 32 + wave * 4 + es;
        f32x2 S01, S23;
        S01.x = S1[(h * 64 + dg * 4 + 0) * 128 + e]; S01.y = S1[(h * 64 + dg * 4 + 1) * 128 + e]; S23.x = S1[(h * 64 + dg * 4 + 2) * 128 + e]; S23.y = S1[(h * 64 + dg * 4 + 3) * 128 + e];
        const bf16_t* zq = Z + (size_t)b * SEQ * NZ + ZQ + h * 64 + dg * 4; const bf16_t* zk = Z + (size_t)b * SEQ * NZ + ZK + h * 64 + dg * 4; const bf16_t* zv = Z + (size_t)b * SEQ * NZ + ZV + h * 128 + e;
        const float* ap = AEXP + (size_t)b * SEQ * 256 + h * 64 + dg * 4; bf16_t* yp = Y + (size_t)b * SEQ * 1024 + h * 128 + e;
        u32x2 qA[8], kA[8], qB[8], kB[8]; f32x4 aA[8], aB[8]; unsigned short vA[8], vB[8];
#define GLA_LOAD(q, k, a, v, t0) do { _Pragma("unroll") for (int i = 0; i < 8; ++i) { const size_t t = (size_t)(t0) + i; q[i] = *(const u32x2*)(zq + t * NZ); k[i] = *(const u32x2*)(zk + t * NZ); a[i] = *(const f32x4*)(ap + t * 256); v[i] = zv[t * NZ]; } } while (0)
#define GLA_COMP(q, k, a, v, t0) do { _Pragma("unroll") for (int i = 0; i < 8; ++i) { const float vv = bf2f(v[i]); \
            const f32x2 q01 = {__uint_as_float(q[i].x << 16), __uint_as_float(q[i].x & 0xffff0000u)}, q23 = {__uint_as_float(q[i].y << 16), __uint_as_float(q[i].y & 0xffff0000u)}; \
            const f32x2 k01 = {__uint_as_float(k[i].x << 16), __uint_as_float(k[i].x & 0xffff0000u)}, k23 = {__uint_as_float(k[i].y << 16), __uint_as_float(k[i].y & 0xffff0000u)}; \
            const f32x2 a01 = {a[i][0], a[i][1]}, a23 = {a[i][2], a[i][3]}; \
            S01 = a01 * S01 + k01 * vv; S23 = a23 * S23 + k23 * vv; \
            const f32x2 p = q01 * S01 + q23 * S23; float o = p.x + p.y; \
            o += dpp_f<0x128>(o); o += dpp_f<0x124>(o); o += dpp_f<0x4E>(o); o += dpp_f<0xB1>(o); \
            if (dg == 0) yp[(size_t)((t0) + i) * 1024] = (bf16_t)f2bf(o * 0.125f); } } while (0)
        GLA_LOAD(qA, kA, aA, vA, 0);
        for (int t0 = 0; t0 < SEQ; t0 += 16) {
            GLA_LOAD(qB, kB, aB, vB, t0 + 8);
            GLA_COMP(qA, kA, aA, vA, t0);
            if (t0 + 16 < SEQ) GLA_LOAD(qA, kA, aA, vA, t0 + 16);
            GLA_COMP(qB, kB, aB, vB, t0 + 8);
        }
#undef GLA_LOAD
#undef GLA_COMP
    }
}
DEV void mla_simple(const Params& P) { const int tid_ = tid_fresh();
    unsigned char* ws = P.ws; const int lane = tid_ & 63, r32 = lane & 31, hi = lane >> 5; const int gw = blockIdx.x * NWAVE + (tid_ >> 6), ngw = gridDim.x * NWAVE;
    const bf16_t* QM = (const bf16_t*)(ws + WS_QM); const bf16_t* KN = (const bf16_t*)(ws + WS_KN); const bf16_t* VT = (const bf16_t*)(ws + WS_VT); const bf16_t* KR = (const bf16_t*)(ws + WS_KR);
    const bf16_t* KNm = (const bf16_t*)(ws + WS_META + MT_KN); const bf16_t* VTm = (const bf16_t*)(ws + WS_META + MT_VT); const bf16_t* KRm = (const bf16_t*)(ws + WS_META + MT_KR);
    bf16_t* Y = (bf16_t*)(ws + WS_Y);
    const int kperm = pi23(r32);
    for (int w = gw; w < 2048; w += ngw) { const int bh = w >> 5, s5 = w & 31, b = bh >> 2, h = bh & 3;
        for (int ui = 0; ui < 4; ++ui) { const int i = (ui == 0) ? s5 : (ui == 1) ? 63 - s5 : (ui == 2) ? 64 + s5 : 127 - s5;
            const size_t mq = (size_t)b * SEQ + i * 32 + r32;
            bf16x8 qf[12];
#pragma unroll
            for (int s = 0; s < 8; ++s) qf[s] = *(const bf16x8*)(QM + mq * 768 + h * 128 + 16 * s + 8 * hi);
#pragma unroll
            for (int s = 0; s < 4; ++s) qf[8 + s] = *(const bf16x8*)(QM + mq * 768 + 512 + h * 64 + 16 * s + 8 * hi);
            f32x16 O[4] = {}; float mrun = -INFINITY, l = 0.f;
            const int ntile = 2 * (1 + (i >> 1));
            for (int j = -1; j < ntile; ++j) {
                f32x16 S = {};
                if (j < 0) { const bool ok = kperm < NMETA; const bf16x8 zf = {};
#pragma unroll
                    for (int s = 0; s < 8; ++s) { const bf16x8 kf = ok ? *(const bf16x8*)(KNm + kperm * 512 + h * 128 + 16 * s + 8 * hi) : zf; S = __builtin_amdgcn_mfma_f32_32x32x16_bf16(kf, qf[s], S, 0, 0, 0); }
#pragma unroll
                    for (int s = 0; s < 4; ++s) { const bf16x8 kf = ok ? *(const bf16x8*)(KRm + kperm * 64 + 16 * s + 8 * hi) : zf; S = __builtin_amdgcn_mfma_f32_32x32x16_bf16(kf, qf[8 + s], S, 0, 0, 0); }
#pragma unroll
                    for (int r = 0; r < 16; ++r) if (pi23(crow(r, hi)) >= NMETA) S[r] = -INFINITY;
                } else { const size_t mk = (size_t)b * SEQ + j * 32 + kperm;
#pragma unroll
                    for (int s = 0; s < 8; ++s) { const bf16x8 kf = *(const bf16x8*)(KN + mk * 512 + h * 128 + 16 * s + 8 * hi); S = __builtin_amdgcn_mfma_f32_32x32x16_bf16(kf, qf[s], S, 0, 0, 0); }
#pragma unroll
                    for (int s = 0; s < 4; ++s) { const bf16x8 kf = *(const bf16x8*)(KR + mk * 64 + 16 * s + 8 * hi); S = __builtin_amdgcn_mfma_f32_32x32x16_bf16(kf, qf[8 + s], S, 0, 0, 0); }
                }
                float mx = S[0];
#pragma unroll
                for (int r = 1; r < 16; ++r) mx = fmaxf(mx, S[r]);
                mx = half_max(mx);
                const float mnew = fmaxf(mrun, mx), alpha = exp2f(mrun - mnew); mrun = mnew;
                float ps = 0.f;
#pragma unroll
                for (int r = 0; r < 16; ++r) { S[r] = exp2f(S[r] - mnew); ps += S[r]; }
                l = l * alpha + ps;
#pragma unroll
                for (int d = 0; d < 4; ++d)
#pragma unroll
                    for (int r = 0; r < 16; ++r) O[d][r] *= alpha;
                u32x4 p0, p1;
                p0.x = pk2(S[0], S[1]); p0.y = pk2(S[2], S[3]); p0.z = pk2(S[4], S[5]); p0.w = pk2(S[6], S[7]);
                p1.x = pk2(S[8], S[9]); p1.y = pk2(S[10], S[11]); p1.z = pk2(S[12], S[13]); p1.w = pk2(S[14], S[15]);
                const bf16x8 pf0 = __builtin_bit_cast(bf16x8, p0), pf1 = __builtin_bit_cast(bf16x8, p1);
#pragma unroll
                for (int d = 0; d < 4; ++d) {
                    bf16x8 v0, v1;
                    if (j < 0) { const bf16x8 zf = {}; v0 = *(const bf16x8*)(VTm + (h * 128 + 32 * d + r32) * 32 + 8 * hi); v1 = zf; }
                    else { const bf16_t* vp = VT + (size_t)(h * 128 + 32 * d + r32) * M + (size_t)b * SEQ + j * 32 + 8 * hi; v0 = *(const bf16x8*)vp; v1 = *(const bf16x8*)(vp + 16); }
                    O[d] = __builtin_amdgcn_mfma_f32_32x32x16_bf16(v0, pf0, O[d], 0, 0, 0);
                    O[d] = __builtin_amdgcn_mfma_f32_32x32x16_bf16(v1, pf1, O[d], 0, 0, 0);
                }
            }
            l = half_sum(l); const float rl = 1.f / l;
#pragma unroll
            for (int d = 0; d < 4; ++d)
#pragma unroll
                for (int r = 0; r < 16; ++r) Y[mq * 1024 + 512 + h * 128 + 32 * d + crow(r, hi)] = (bf16_t)f2bf(O[d][r] * rl);
        }
    }
}
DEV void phase3b(const Params& P) { const int tid_ = tid_fresh();
    unsigned char* ws = P.ws; const int lane = tid_ & 63; const int gw = blockIdx.x * NWAVE + (tid_ >> 6), ngw = gridDim.x * NWAVE;
    const bf16_t* Z = (const bf16_t*)P.out; bf16_t* Y = (bf16_t*)(ws + WS_Y); const float* g = P.in[I_GOUTN];
    float gv[8];
#pragma unroll
    for (int j = 0; j < 8; ++j) gv[j] = g[8 * lane + j];
    for (int m = gw; m < M; m += ngw) {
        const u32x4 o4 = *(const u32x4*)(Y + (size_t)m * 1024 + 8 * lane), r4 = *(const u32x4*)(Z + (size_t)m * NZ + ZR + 8 * lane);
        const unsigned ow[4] = {o4.x, o4.y, o4.z, o4.w}, rw[4] = {r4.x, r4.y, r4.z, r4.w}; float o[8], r[8]; float s = 0.f;
#pragma unroll
        for (int j = 0; j < 4; ++j) { o[2 * j] = __uint_as_float(ow[j] << 16); o[2 * j + 1] = __uint_as_float(ow[j] & 0xffff0000u); r[2 * j] = __uint_as_float(rw[j] << 16); r[2 * j + 1] = __uint_as_float(rw[j] & 0xffff0000u); }
#pragma unroll
        for (int j = 0; j < 8; ++j) s += o[j] * o[j];
        s += sx<1>(s); s += sx<2>(s); s += sx<4>(s); s += sx<8>(s);
        const float rs = rsqrtf(s * (1.f / 128.f) + EPS);
        u32x4 w; float y[8];
#pragma unroll
        for (int j = 0; j < 8; ++j) y[j] = o[j] * rs * gv[j] * siluf(r[j]);
        w.x = pk2(y[0], y[1]); w.y = pk2(y[2], y[3]); w.z = pk2(y[4], y[5]); w.w = pk2(y[6], y[7]);
        *(u32x4*)(Y + (size_t)m * 1024 + 8 * lane) = w;
    }
}
DEV void phase4(const Params& P) { const int tid_ = tid_fresh();
    unsigned char* ws = P.ws; const int gw = blockIdx.x * NWAVE + (tid_ >> 6), ngw = gridDim.x * NWAVE;
    const bf16_t* Y = (const bf16_t*)(ws + WS_Y); const bf16_t* W = (const bf16_t*)(ws + WS_WOUT); float* H2 = (float*)(ws + WS_H2); const float* x = P.in[I_X];
    gemm_simple(M / 64, D / 64, D, [&](int r) { return Y + (size_t)r * D; }, [&](int c) { return W + (size_t)c * D; },
                [&](int row, int col, float v) { H2[(size_t)row * D + col] = x[(size_t)row * D + col] + v; }, gw, ngw);
}
DEV void phase5(const Params& P, float* scr_all) { const int tid_ = tid_fresh();
    unsigned char* ws = P.ws; const int lane = tid_ & 63, wave = tid_ >> 6; const int gw = blockIdx.x * NWAVE + wave, ngw = gridDim.x * NWAVE;
    float* trow = scr_all + wave * 4096;
    const float* H2 = (const float*)(ws + WS_H2); bf16_t* TN = (bf16_t*)(ws + WS_TN); const float* g = P.in[I_FFN];
    const float* wg = P.in[I_RGW]; const float* bg = P.in[I_RGB]; const float* we = P.in[I_REW]; const float* be = P.in[I_REB];
    int* cnt = (int*)(ws + WS_CTL) + CW_CNT; int* tokE = (int*)(ws + WS_TOK); int* tokR = tokE + 2 * M; float* tokG = (float*)(tokR + 2 * M); int* list = (int*)(ws + WS_LIST);
    f32x4 gv[4];
#pragma unroll
    for (int j = 0; j < 4; ++j) gv[j] = *(const f32x4*)(g + 256 * j + 4 * lane);
    for (int m0 = gw * 4; m0 < M; m0 += ngw * 4) {
#pragma unroll
        for (int q = 0; q < 4; ++q) { const int m = m0 + q; const f32x4* hr = (const f32x4*)(H2 + (size_t)m * D) + lane; f32x4 v[4]; float s = 0.f;
#pragma unroll
            for (int j = 0; j < 4; ++j) { v[j] = hr[64 * j]; s += (v[j].x * v[j].x + v[j].y * v[j].y) + (v[j].z * v[j].z + v[j].w * v[j].w); }
            const float rs = rsqrtf(wave_sum(s) * (1.f / D) + EPS);
            unsigned long long* o8 = (unsigned long long*)(TN + (size_t)m * D) + lane;
#pragma unroll
            for (int j = 0; j < 4; ++j) { const f32x4 t = {v[j].x * rs * gv[j].x, v[j].y * rs * gv[j].y, v[j].z * rs * gv[j].z, v[j].w * rs * gv[j].w};
                *(f32x4*)(trow + q * 1024 + 256 * j + 4 * lane) = t;
                o8[64 * j] = (unsigned long long)pk2(t.x, t.y) | ((unsigned long long)pk2(t.z, t.w) << 32); } }
        __builtin_amdgcn_s_waitcnt(0xc07f); asm volatile("" ::: "memory");
        float ae[4] = {0.f, 0.f, 0.f, 0.f}, ag[4] = {0.f, 0.f, 0.f, 0.f};
        for (int k = 0; k < D; ++k) { const float w = we[k * 64 + lane];
#pragma unroll
            for (int q = 0; q < 4; ++q) ae[q] += trow[q * 1024 + k] * w; }
        for (int k8 = 0; k8 < D / 8; ++k8) { const int k = k8 * 8 + (lane >> 3); const float w = wg[k * 8 + (lane & 7)];
#pragma unroll
            for (int q = 0; q < 4; ++q) ag[q] += trow[q * 1024 + k] * w; }
#pragma unroll
        for (int q = 0; q < 4; ++q) { ag[q] += sx<8>(ag[q]); ag[q] += sx<16>(ag[q]); ag[q] = half_sum(ag[q]); ag[q] += bg[lane & 7]; ae[q] += be[lane]; }
#pragma unroll
        for (int q = 0; q < 4; ++q) { const int m = m0 + q;
            float gl[8]; float gmx = -INFINITY; int gi = 0;
#pragma unroll
            for (int i = 0; i < 8; ++i) { gl[i] = rl_f(ag[q], i); if (gl[i] > gmx) { gmx = gl[i]; gi = i; } }
            float gs = 0.f;
#pragma unroll
            for (int i = 0; i < 8; ++i) gs += __expf(gl[i] - gmx);
            const float gp = 1.f / gs;
            const int gis = __builtin_amdgcn_readfirstlane(gi); float el[8]; float emx = -INFINITY; int e0 = 0;
#pragma unroll
            for (int i = 0; i < 8; ++i) { el[i] = rl_f(ae[q], gis * 8 + i); if (el[i] > emx) { emx = el[i]; e0 = i; } }
            float em2 = -INFINITY; int e1 = 0;
#pragma unroll
            for (int i = 0; i < 8; ++i) if (i != e0 && el[i] > em2) { em2 = el[i]; e1 = i; }
            const float p0 = 1.f, p1 = __expf(em2 - emx); const float g0 = gp * p0 / (p0 + p1), g1 = gp * p1 / (p0 + p1);
            if (lane == 0) { const int E0 = gi * 8 + e0, E1 = gi * 8 + e1; const int r0 = atomicAdd(cnt + E0, 1), r1 = atomicAdd(cnt + E1, 1);
                tokE[2 * m] = E0; tokE[2 * m + 1] = E1; tokR[2 * m] = r0; tokR[2 * m + 1] = r1; tokG[2 * m] = g0; tokG[2 * m + 1] = g1;
                list[(size_t)E0 * M + r0] = m; list[(size_t)E1 * M + r1] = m; } }
        __builtin_amdgcn_s_waitcnt(0xc07f); asm volatile("" ::: "memory");
    }
}
DEV void route_emit(int m, int E0, int E1, float g0, float g1, int* cnt, int* tokE, int* tokR, float* tokG, int* list) {
    const int r0 = atomicAdd(cnt + E0, 1), r1 = atomicAdd(cnt + E1, 1);
    tokE[2 * m] = E0; tokE[2 * m + 1] = E1; tokR[2 * m] = r0; tokR[2 * m + 1] = r1; tokG[2 * m] = g0; tokG[2 * m + 1] = g1;
    list[(size_t)E0 * M + r0] = m; list[(size_t)E1 * M + r1] = m;
}
DEV void phase5_fast(const Params& P) {
    constexpr float TAU = 0.015f;
    unsigned char* ws = P.ws; const int tid_ = tid_fresh(); const int lane = tid_ & 63, r32 = lane & 31, hi = lane >> 5; const int gw = blockIdx.x * NWAVE + (tid_ >> 6), ngw = gridDim.x * NWAVE;
    const float* X = P.in[I_X]; const bf16_t* D16 = (const bf16_t*)(ws + WS_D16); bf16_t* H2B = (bf16_t*)(ws + WS_H2B); unsigned char* TN8 = (unsigned char*)(ws + WS_TN8); const float* g = P.in[I_FFN]; const bf16_t* WR = (const bf16_t*)(ws + WS_WR);
    const float* wg = P.in[I_RGW]; const float* bg = P.in[I_RGB]; const float* we = P.in[I_REW]; const float* be = P.in[I_REB];
    int* cnt = (int*)(ws + WS_CTL) + CW_CNT; int* tokE = (int*)(ws + WS_TOK); int* tokR = tokE + 2 * M; float* tokG = (float*)(tokR + 2 * M); int* list = (int*)(ws + WS_LIST);
    f32x4 gv[4];
#pragma unroll
    for (int j = 0; j < 4; ++j) gv[j] = *(const f32x4*)(g + 256 * j + 4 * lane);
    for (int blk = gw; blk < M / 32; blk += ngw) { const int m0 = blk * 32; float rsk = 0.f;
        for (int q0 = 0; q0 < 32; q0 += 4) {
            f32x4 v[4][4];
#pragma unroll
            for (int q = 0; q < 4; ++q)
#pragma unroll
                for (int j = 0; j < 4; ++j) { const size_t off = (size_t)(m0 + q0 + q) * D + 256 * j + 4 * lane; const u32x2 dd = *(const u32x2*)(D16 + off); const f32x4 xx = *(const f32x4*)(X + off);
                    v[q][j] = (f32x4){xx.x + __uint_as_float(dd.x << 16), xx.y + __uint_as_float(dd.x & 0xffff0000u), xx.z + __uint_as_float(dd.y << 16), xx.w + __uint_as_float(dd.y & 0xffff0000u)}; }
#pragma unroll
            for (int q = 0; q < 4; ++q) { float s = 0.f;
                { unsigned long long* h8 = (unsigned long long*)(H2B + (size_t)(m0 + q0 + q) * D) + lane;
#pragma unroll
                  for (int j = 0; j < 4; ++j) h8[64 * j] = (unsigned long long)pk2(v[q][j].x, v[q][j].y) | ((unsigned long long)pk2(v[q][j].z, v[q][j].w) << 32); }
#pragma unroll
                for (int j = 0; j < 4; ++j) s += (v[q][j].x * v[q][j].x + v[q][j].y * v[q][j].y) + (v[q][j].z * v[q][j].z + v[q][j].w * v[q][j].w);
                const float rs = rsqrtf(wave_sum(s) * (1.f / D) + EPS); rsk = (q0 + q == r32) ? rs : rsk;
                unsigned* t8 = (unsigned*)(TN8 + (size_t)(m0 + q0 + q) * D) + lane;
#pragma unroll
                for (int j = 0; j < 4; ++j) { const float t0 = v[q][j].x * rs * gv[j].x, t1 = v[q][j].y * rs * gv[j].y, t2 = v[q][j].z * rs * gv[j].z, t3 = v[q][j].w * rs * gv[j].w;
                    t8[64 * j] = pk4_fp8(t0, t1, t2, t3); } }
        }
        asm volatile("s_waitcnt vmcnt(0)" ::: "memory");
        f32x16 a0 = {}, a1 = {}, a2 = {};
        { const bf16_t* tb = H2B + (size_t)(m0 + r32) * D + 8 * hi; const bf16_t* wa = WR + (size_t)r32 * D + 8 * hi;
#pragma unroll 4
          for (int k = 0; k < D; k += 16) { const bf16x8 bf = *(const bf16x8*)(tb + k);
              a0 = __builtin_amdgcn_mfma_f32_32x32x16_bf16(*(const bf16x8*)(wa + k), bf, a0, 0, 0, 0);
              a1 = __builtin_amdgcn_mfma_f32_32x32x16_bf16(*(const bf16x8*)(wa + 32 * D + k), bf, a1, 0, 0, 0);
              a2 = __builtin_amdgcn_mfma_f32_32x32x16_bf16(*(const bf16x8*)(wa + 64 * D + k), bf, a2, 0, 0, 0); } }
#pragma unroll
        for (int r = 0; r < 16; ++r) { a0[r] *= rsk; a1[r] *= rsk; a2[r] *= rsk; }
        const int m = m0 + r32;
        float gl[8]; float gmx = -INFINITY, gm2 = -INFINITY; int gi = 0;
#pragma unroll
        for (int i = 0; i < 8; ++i) { auto rr = __builtin_amdgcn_permlane32_swap(__float_as_uint(a2[i]), __float_as_uint(a2[i]), false, false); gl[i] = __uint_as_float(rr[0]) + bg[i]; }
#pragma unroll
        for (int i = 0; i < 8; ++i) { if (gl[i] > gmx) { gm2 = gmx; gmx = gl[i]; gi = i; } else if (gl[i] > gm2) gm2 = gl[i]; }
        float gs = 0.f;
#pragma unroll
        for (int i = 0; i < 8; ++i) gs += __expf(gl[i] - gmx);
        const float gp = 1.f / gs;
        const bool t1 = (gi >> 2) != 0, up = (gi & 1) != 0; const bool owner = hi == ((gi >> 1) & 1);
        float el[8]; float emx = -INFINITY, em2 = -INFINITY, em3 = -INFINITY; int e0 = 0, e1 = 0;
#pragma unroll
        for (int j = 0; j < 8; ++j) { const float lo = t1 ? a1[j] : a0[j], hv = t1 ? a1[8 + j] : a0[8 + j]; el[j] = (up ? hv : lo) + be[gi * 8 + j]; }
#pragma unroll
        for (int j = 0; j < 8; ++j) { const float x = el[j];
            if (x > emx) { em3 = em2; em2 = emx; e1 = e0; emx = x; e0 = j; } else if (x > em2) { em3 = em2; em2 = x; e1 = j; } else if (x > em3) em3 = x; }
        const bool flagged = owner && (fminf(gmx - gm2, em2 - em3) < TAU);
        if (owner && !flagged) { const float p1 = __expf(em2 - emx); route_emit(m, gi * 8 + e0, gi * 8 + e1, gp / (1.f + p1), gp * p1 / (1.f + p1), cnt, tokE, tokR, tokG, list); }
        unsigned long long fm = __ballot(flagged);
        while (fm) { const int fl = __builtin_ctzll(fm); fm &= fm - 1; const int mt = m0 + (fl & 31);
            f32x4 t[4]; float s = 0.f;
#pragma unroll
            for (int j = 0; j < 4; ++j) { const size_t off = (size_t)mt * D + 256 * j + 4 * lane; const u32x2 dd = *(const u32x2*)(D16 + off); const f32x4 xx = *(const f32x4*)(X + off);
                t[j] = (f32x4){xx.x + __uint_as_float(dd.x << 16), xx.y + __uint_as_float(dd.x & 0xffff0000u), xx.z + __uint_as_float(dd.y << 16), xx.w + __uint_as_float(dd.y & 0xffff0000u)};
                s += (t[j].x * t[j].x + t[j].y * t[j].y) + (t[j].z * t[j].z + t[j].w * t[j].w); }
            const float rs = rsqrtf(wave_sum(s) * (1.f / D) + EPS);
#pragma unroll
            for (int j = 0; j < 4; ++j) t[j] = (f32x4){t[j].x * rs * gv[j].x, t[j].y * rs * gv[j].y, t[j].z * rs * gv[j].z, t[j].w * rs * gv[j].w};
            float xg[8] = {0.f, 0.f, 0.f, 0.f, 0.f, 0.f, 0.f, 0.f};
#pragma unroll
            for (int j = 0; j < 4; ++j)
#pragma unroll
                for (int c = 0; c < 4; ++c) { const int k = 256 * j + 4 * lane + c; const f32x4 w0 = *(const f32x4*)(wg + k * 8), w1 = *(const f32x4*)(wg + k * 8 + 4); const float tv = t[j][c];
                    xg[0] += tv * w0[0]; xg[1] += tv * w0[1]; xg[2] += tv * w0[2]; xg[3] += tv * w0[3]; xg[4] += tv * w1[0]; xg[5] += tv * w1[1]; xg[6] += tv * w1[2]; xg[7] += tv * w1[3]; }
            float gmx2 = -INFINITY; int gi2 = 0;
#pragma unroll
            for (int i = 0; i < 8; ++i) { xg[i] = wave_sum(xg[i]) + bg[i]; if (xg[i] > gmx2) { gmx2 = xg[i]; gi2 = i; } }
            float gs2 = 0.f;
#pragma unroll
            for (int i = 0; i < 8; ++i) gs2 += __expf(xg[i] - gmx2);
            gi2 = __builtin_amdgcn_readfirstlane(gi2);
            float xe[8] = {0.f, 0.f, 0.f, 0.f, 0.f, 0.f, 0.f, 0.f};
#pragma unroll
            for (int j = 0; j < 4; ++j)
#pragma unroll
                for (int c = 0; c < 4; ++c) { const int k = 256 * j + 4 * lane + c; const f32x4 w0 = *(const f32x4*)(we + k * 64 + gi2 * 8), w1 = *(const f32x4*)(we + k * 64 + gi2 * 8 + 4); const float tv = t[j][c];
                    xe[0] += tv * w0[0]; xe[1] += tv * w0[1]; xe[2] += tv * w0[2]; xe[3] += tv * w0[3]; xe[4] += tv * w1[0]; xe[5] += tv * w1[1]; xe[6] += tv * w1[2]; xe[7] += tv * w1[3]; }
            float x1 = -INFINITY, x2 = -INFINITY; int f0 = 0, f1 = 0;
#pragma unroll
            for (int i = 0; i < 8; ++i) { xe[i] = wave_sum(xe[i]) + be[gi2 * 8 + i]; }
#pragma unroll
            for (int i = 0; i < 8; ++i) if (xe[i] > x1) { x1 = xe[i]; f0 = i; }
#pragma unroll
            for (int i = 0; i < 8; ++i) if (i != f0 && xe[i] > x2) { x2 = xe[i]; f1 = i; }
            if (lane == 0) { const float gp2 = 1.f / gs2, p1 = __expf(x2 - x1); route_emit(mt, gi2 * 8 + f0, gi2 * 8 + f1, gp2 / (1.f + p1), gp2 * p1 / (1.f + p1), cnt, tokE, tokR, tokG, list); }
        }
    }
}
DEV int slot_start_lane(const int* cnt, int lane, int& c_out, int& total) {
    int st = 0, tot = 0, cm = 0;
    for (int i = 0; i < NE; ++i) { const int c = cnt[i]; const int pad = (c + 255) & ~255; if (i < lane) st += pad; if (i == lane) cm = c; tot += pad; }
    total = __builtin_amdgcn_readfirstlane(tot); c_out = cm; return st;
}
DEV void phase6(const Params& P) { const int tid_ = tid_fresh();
    unsigned char* ws = P.ws; const int lane = tid_ & 63, r32 = lane & 31, hi = lane >> 5; const int gw = blockIdx.x * NWAVE + (tid_ >> 6), ngw = gridDim.x * NWAVE;
    const bf16_t* TN = (const bf16_t*)(ws + WS_TN); const bf16_t* W = (const bf16_t*)(ws + WS_WGU); bf16_t* MH = (bf16_t*)(ws + WS_MH);
    const int* cnt = (const int*)(ws + WS_CTL) + CW_CNT; const int* list = (const int*)(ws + WS_LIST);
    int c_l, total; const int st_l = slot_start_lane(cnt, lane, c_l, total);
    const int Nt = 1024 / 64, nrt = total / 64;
    for (int it = gw; it < nrt * Nt; it += ngw) { const int T = it / Nt, tn = it % Nt;
        const unsigned long long bal = __ballot(st_l <= T * 64); const int e = __builtin_amdgcn_readfirstlane(63 - __builtin_clzll(bal));
        const int st = rl_i(st_l, e), c = rl_i(c_l, e); const int lr = T * 64 - st;
        if (lr >= c) continue;
        const int ra = lr + r32, rb = lr + 32 + r32;
        const int ta = ra < c ? list[(size_t)e * M + ra] : 0, tb = rb < c ? list[(size_t)e * M + rb] : 0;
        const bf16_t* We = W + (size_t)e * 1024 * 1024;
        f32x16 c00 = {}, c01 = {}, c10 = {}, c11 = {};
        wave_tile(TN + (size_t)ta * D + hi * 8, TN + (size_t)tb * D + hi * 8, We + (size_t)(tn * 64 + r32) * D + hi * 8, We + (size_t)(tn * 64 + 32 + r32) * D + hi * 8, D, c00, c01, c10, c11);
#pragma unroll
        for (int r = 0; r < 16; ++r) {
#pragma unroll
            for (int q = 0; q < 4; ++q) { const float v = (q == 0) ? c00[r] : (q == 1) ? c01[r] : (q == 2) ? c10[r] : c11[r];
                const float u = __shfl_down(v, 4); const int row = T * 64 + (q >> 1) * 32 + crow(r, hi), col = tn * 64 + (q & 1) * 32 + r32;
                if ((col & 4) == 0) MH[(size_t)row * DE + (col >> 3) * 4 + (col & 3)] = (bf16_t)f2bf(siluf(v) * u); }
        }
    }
}
DEV void phase7(const Params& P) { const int tid_ = tid_fresh();
    unsigned char* ws = P.ws; const int lane = tid_ & 63, r32 = lane & 31, hi = lane >> 5; const int gw = blockIdx.x * NWAVE + (tid_ >> 6), ngw = gridDim.x * NWAVE;
    const bf16_t* MH = (const bf16_t*)(ws + WS_MH); const bf16_t* W = (const bf16_t*)(ws + WS_WD); bf16_t* MY = (bf16_t*)(ws + WS_MY);
    const int* cnt = (const int*)(ws + WS_CTL) + CW_CNT;
    int c_l, total; const int st_l = slot_start_lane(cnt, lane, c_l, total);
    const int Nt = 1024 / 64, nrt = total / 64;
    for (int it = gw; it < nrt * Nt; it += ngw) { const int T = it / Nt, tn = it % Nt;
        const unsigned long long bal = __ballot(st_l <= T * 64); const int e = __builtin_amdgcn_readfirstlane(63 - __builtin_clzll(bal));
        const int st = rl_i(st_l, e), c = rl_i(c_l, e); const int lr = T * 64 - st;
        if (lr >= c) continue;
        const bf16_t* We = W + (size_t)e * 1024 * 512;
        f32x16 c00 = {}, c01 = {}, c10 = {}, c11 = {};
        wave_tile(MH + (size_t)(T * 64 + r32) * DE + hi * 8, MH + (size_t)(T * 64 + 32 + r32) * DE + hi * 8, We + (size_t)(tn * 64 + r32) * DE + hi * 8, We + (size_t)(tn * 64 + 32 + r32) * DE + hi * 8, DE, c00, c01, c10, c11);
#pragma unroll
        for (int r = 0; r < 16; ++r) { const int row = T * 64 + crow(r, hi), col = tn * 64 + r32;
            MY[(size_t)row * D + col] = (bf16_t)f2bf(c00[r]); MY[(size_t)row * D + col + 32] = (bf16_t)f2bf(c01[r]);
            MY[(size_t)(row + 32) * D + col] = (bf16_t)f2bf(c10[r]); MY[(size_t)(row + 32) * D + col + 32] = (bf16_t)f2bf(c11[r]); }
    }
}
DEV void phase8(const Params& P) { const int tid_ = tid_fresh();
    unsigned char* ws = P.ws; const int lane = tid_ & 63; const int gw = blockIdx.x * NWAVE + (tid_ >> 6), ngw = gridDim.x * NWAVE;
    const bf16_t* H2B = (const bf16_t*)(ws + WS_H2B); const unsigned char* MY = (const unsigned char*)(ws + WS_MY); const float* g = P.in[I_FINAL];
    const int* cnt = (const int*)(ws + WS_CTL) + CW_CNT; const int* tokE = (const int*)(ws + WS_TOK); const int* tokR = tokE + 2 * M; const float* tokG = (const float*)(tokR + 2 * M);
    int c_l, total; const int st_l = slot_start_lane(cnt, lane, c_l, total);
    f32x4 gv[4];
#pragma unroll
    for (int j = 0; j < 4; ++j) gv[j] = *(const f32x4*)(g + 256 * j + 4 * lane);
    for (int m0 = gw * 4; m0 < M; m0 += ngw * 4) {
        u32x2 hh[4][4]; unsigned ya[4][4], yb[4][4]; float g0[4], g1[4];
#pragma unroll
        for (int q = 0; q < 4; ++q) { const int m = m0 + q;
            const int E0 = __builtin_amdgcn_readfirstlane(tokE[2 * m]), E1 = __builtin_amdgcn_readfirstlane(tokE[2 * m + 1]);
            const size_t s0 = (size_t)rl_i(st_l, E0) + tokR[2 * m], s1 = (size_t)rl_i(st_l, E1) + tokR[2 * m + 1]; g0[q] = tokG[2 * m] * (1.f / 16.f); g1[q] = tokG[2 * m + 1] * (1.f / 16.f);
            const u32x2* hr = (const u32x2*)(H2B + (size_t)m * D) + lane; const unsigned* y0 = (const unsigned*)(MY + s0 * D) + lane; const unsigned* y1 = (const unsigned*)(MY + s1 * D) + lane;
#pragma unroll
            for (int j = 0; j < 4; ++j) { hh[q][j] = hr[64 * j]; ya[q][j] = y0[64 * j]; yb[q][j] = y1[64 * j]; } }
#pragma unroll
        for (int q = 0; q < 4; ++q) { f32x4 v[4]; float s = 0.f;
#pragma unroll
            for (int j = 0; j < 4; ++j) { const u32x2 h2 = hh[q][j]; const int a = (int)ya[q][j], b = (int)yb[q][j];
                v[j].x = __uint_as_float(h2.x << 16) + g0[q] * __builtin_amdgcn_cvt_f32_fp8(a, 0) + g1[q] * __builtin_amdgcn_cvt_f32_fp8(b, 0);
                v[j].y = __uint_as_float(h2.x & 0xffff0000u) + g0[q] * __builtin_amdgcn_cvt_f32_fp8(a, 1) + g1[q] * __builtin_amdgcn_cvt_f32_fp8(b, 1);
                v[j].z = __uint_as_float(h2.y << 16) + g0[q] * __builtin_amdgcn_cvt_f32_fp8(a, 2) + g1[q] * __builtin_amdgcn_cvt_f32_fp8(b, 2);
                v[j].w = __uint_as_float(h2.y & 0xffff0000u) + g0[q] * __builtin_amdgcn_cvt_f32_fp8(a, 3) + g1[q] * __builtin_amdgcn_cvt_f32_fp8(b, 3);
                s += (v[j].x * v[j].x + v[j].y * v[j].y) + (v[j].z * v[j].z + v[j].w * v[j].w); }
            const float rs = rsqrtf(wave_sum(s) * (1.f / D) + EPS);
            f32x4* orow = (f32x4*)(P.out + (size_t)(m0 + q) * D) + lane;
#pragma unroll
            for (int j = 0; j < 4; ++j) orow[64 * j] = (f32x4){v[j].x * rs * gv[j].x, v[j].y * rs * gv[j].y, v[j].z * rs * gv[j].z, v[j].w * rs * gv[j].w}; }
    }
}


#ifndef FAST
#define FAST 0x7f
#endif
namespace g8 {
struct EpiZ { static constexpr bool PERM = true; bf16_t* Z; float* ssq_q; float* ssq_kv;
    DEV void operator()(const Acc& acc, const Unit& u, int wr, int wc, int fr, int fq) const {
        const int zt = u.pn < 2 ? u.pn : u.pn + 2;
        const int row0 = u.pm * BM + wr * 64 + fr, col0 = zt * BM + wc * 32 + 8 * fq;
#pragma unroll
        for (int ai = 0; ai < 2; ++ai)
#pragma unroll
            for (int m = 0; m < 4; ++m) { const int row = row0 + ai * HALF + m * 16; bf16_t* rp = Z + (size_t)row * NZ + col0;
#pragma unroll
                for (int bj = 0; bj < 2; ++bj) *(u32x4*)(rp + bj * HALF) = pack8(acc[ai][bj][m][0], acc[ai][bj][m][1]);
                if (u.pn >= 4) { float s = 0.f;
#pragma unroll
                    for (int bj = 0; bj < 2; ++bj) if (u.pn == 4 || bj == 0) {
#pragma unroll
                        for (int n = 0; n < 2; ++n) { const f32x4 v = acc[ai][bj][m][n]; s += (v[0] * v[0] + v[1] * v[1]) + (v[2] * v[2] + v[3] * v[3]); } }
                    s += sx<16>(s); s = half_sum(s);
                    if (fq == 0) atomicAdd((u.pn == 4 ? ssq_q : ssq_kv) + row, s); }
                asm volatile("" ::: "memory"); }
    } };
struct EpiQ { static constexpr bool PERM = true; bf16_t* QM; const float* ssq_q; const float2* rope;
    DEV void operator()(const Acc& acc, const Unit& u, int wr, int wc, int fr, int fq) const {
        const int row0 = u.pm * BM + wr * 64 + fr, col0 = u.pn * BM + wc * 32 + 8 * fq;
#pragma unroll
        for (int ai = 0; ai < 2; ++ai)
#pragma unroll
            for (int m = 0; m < 4; ++m) { const int row = row0 + ai * HALF + m * 16; const float rs = rsqrtf(ssq_q[row] * (1.f / 256.f) + EPS); bf16_t* rp = QM + (size_t)row * 768 + col0;
#pragma unroll
                for (int bj = 0; bj < 2; ++bj) { f32x4 v0 = acc[ai][bj][m][0] * rs, v1 = acc[ai][bj][m][1] * rs;
                    if (u.pn == 2) { const int f0 = (wc & 1) * 16 + 4 * fq; const f32x4* cp = (const f32x4*)(rope + (size_t)(NMETA + (row & (SEQ - 1))) * 32 + f0); const f32x4 ca = cp[0], cb = cp[1];
                        const f32x4 r0 = {v0[0] * ca[0] - v0[1] * ca[1], v0[1] * ca[0] + v0[0] * ca[1], v0[2] * ca[2] - v0[3] * ca[3], v0[3] * ca[2] + v0[2] * ca[3]};
                        const f32x4 r1 = {v1[0] * cb[0] - v1[1] * cb[1], v1[1] * cb[0] + v1[0] * cb[1], v1[2] * cb[2] - v1[3] * cb[3], v1[3] * cb[2] + v1[2] * cb[3]}; v0 = r0; v1 = r1; }
                    *(u32x4*)(rp + bj * HALF) = pack8(v0, v1); }
                asm volatile("" ::: "memory"); }
    } };
struct EpiK { static constexpr bool PERM = true; bf16_t* KN; const float* ssq_kv;
    DEV void operator()(const Acc& acc, const Unit& u, int wr, int wc, int fr, int fq) const {
        const int row0 = u.pm * BM + wr * 64 + fr, col0 = u.pn * BM + wc * 32 + 8 * fq;
#pragma unroll
        for (int ai = 0; ai < 2; ++ai)
#pragma unroll
            for (int m = 0; m < 4; ++m) { const int row = row0 + ai * HALF + m * 16; const float rs = rsqrtf(ssq_kv[row] * (1.f / 128.f) + EPS); bf16_t* rp = KN + (size_t)row * 512 + col0;
#pragma unroll
                for (int bj = 0; bj < 2; ++bj) *(u32x4*)(rp + bj * HALF) = pack8(acc[ai][bj][m][0] * rs, acc[ai][bj][m][1] * rs);
                asm volatile("" ::: "memory"); }
    } };
struct EpiVT { static constexpr bool PERM = true; bf16_t* VT; const float* ssq_kv;
    DEV void operator()(const Acc& acc, const Unit& u, int wr, int wc, int fr, int fq) const {
        const int row0 = u.pm * BM + wr * 64 + fr, col0 = u.pn * BM + wc * 32 + 8 * fq;
        f32x4 rs[2][2];
#pragma unroll
        for (int bj = 0; bj < 2; ++bj)
#pragma unroll
            for (int n = 0; n < 2; ++n) { const f32x4 q = *(const f32x4*)(ssq_kv + col0 + bj * HALF + 4 * n);
                rs[bj][n] = (f32x4){rsqrtf(q[0] * (1.f / 128.f) + EPS), rsqrtf(q[1] * (1.f / 128.f) + EPS), rsqrtf(q[2] * (1.f / 128.f) + EPS), rsqrtf(q[3] * (1.f / 128.f) + EPS)}; }
#pragma unroll
        for (int ai = 0; ai < 2; ++ai)
#pragma unroll
            for (int m = 0; m < 4; ++m) { const int row = row0 + ai * HALF + m * 16; bf16_t* rp = VT + (size_t)row * M + col0;
#pragma unroll
                for (int bj = 0; bj < 2; ++bj) *(u32x4*)(rp + bj * HALF) = pack8(acc[ai][bj][m][0] * rs[bj][0], acc[ai][bj][m][1] * rs[bj][1]); }
    } };
struct EpiQ8 { static constexpr bool PERM = true; unsigned char* QM; const float* ssq_q; const float2* rope;
    DEV void operator()(const Acc& acc, const Unit& u, int wr, int wc, int fr, int fq) const {
        const int row0 = u.pm * BM + wr * 64 + fr, col0 = u.pn * BM + wc * 32 + 8 * fq;
        float rs[8];
#pragma unroll
        for (int i = 0; i < 8; ++i) rs[i] = ssq_q[row0 + (i >> 2) * HALF + (i & 3) * 16];
#pragma unroll
        for (int i = 0; i < 8; ++i) rs[i] = 16.f * rsqrtf(rs[i] * (1.f / 256.f) + EPS);
#pragma unroll
        for (int ai = 0; ai < 2; ++ai) {
            f32x4 ca[4], cb[4];
            if (u.pn == 2) { const int f0 = (wc & 1) * 16 + 4 * fq;
#pragma unroll
                for (int m = 0; m < 4; ++m) { const int row = row0 + ai * HALF + m * 16; const f32x4* cp = (const f32x4*)(rope + (size_t)(NMETA + (row & (SEQ - 1))) * 32 + f0); ca[m] = cp[0]; cb[m] = cp[1]; } }
#pragma unroll
            for (int m = 0; m < 4; ++m) { const int row = row0 + ai * HALF + m * 16; const float r_ = rs[ai * 4 + m]; unsigned char* rp = QM + (size_t)row * 768 + col0;
#pragma unroll
                for (int bj = 0; bj < 2; ++bj) { f32x4 v0 = acc[ai][bj][m][0] * r_, v1 = acc[ai][bj][m][1] * r_;
                    if (u.pn == 2) {
                        const f32x4 r0 = {v0[0] * ca[m][0] - v0[1] * ca[m][1], v0[1] * ca[m][0] + v0[0] * ca[m][1], v0[2] * ca[m][2] - v0[3] * ca[m][3], v0[3] * ca[m][2] + v0[2] * ca[m][3]};
                        const f32x4 r1 = {v1[0] * cb[m][0] - v1[1] * cb[m][1], v1[1] * cb[m][0] + v1[0] * cb[m][1], v1[2] * cb[m][2] - v1[3] * cb[m][3], v1[3] * cb[m][2] + v1[2] * cb[m][3]}; v0 = r0; v1 = r1; }
                    u32x2 w; w.x = pk4_fp8(v0[0], v0[1], v0[2], v0[3]); w.y = pk4_fp8(v1[0], v1[1], v1[2], v1[3]); *(u32x2*)(rp + bj * HALF) = w; } }
            asm volatile("" ::: "memory"); }
    } };
struct EpiK8 { static constexpr bool PERM = true; unsigned char* KN; const float* ssq_kv;
    DEV void operator()(const Acc& acc, const Unit& u, int wr, int wc, int fr, int fq) const {
        const int row0 = u.pm * BM + wr * 64 + fr, col0 = u.pn * BM + wc * 32 + 8 * fq;
        float rs[8];
#pragma unroll
        for (int i = 0; i < 8; ++i) rs[i] = ssq_kv[row0 + (i >> 2) * HALF + (i & 3) * 16];
#pragma unroll
        for (int i = 0; i < 8; ++i) rs[i] = rsqrtf(rs[i] * (1.f / 128.f) + EPS);
#pragma unroll
        for (int ai = 0; ai < 2; ++ai)
#pragma unroll
            for (int m = 0; m < 4; ++m) { const int row = row0 + ai * HALF + m * 16; const float r_ = rs[ai * 4 + m]; unsigned char* rp = KN + (size_t)row * 512 + col0;
#pragma unroll
                for (int bj = 0; bj < 2; ++bj) { const f32x4 v0 = acc[ai][bj][m][0] * r_, v1 = acc[ai][bj][m][1] * r_; u32x2 w; w.x = pk4_fp8(v0[0], v0[1], v0[2], v0[3]); w.y = pk4_fp8(v1[0], v1[1], v1[2], v1[3]); *(u32x2*)(rp + bj * HALF) = w; } }
    } };
struct EpiVT8 { static constexpr bool PERM = true; unsigned char* VT; const float* ssq_kv;
    DEV void operator()(const Acc& acc, const Unit& u, int wr, int wc, int fr, int fq) const {
        const int row0 = u.pm * BM + wr * 64 + fr, col0 = u.pn * BM + wc * 32 + 8 * fq;
        f32x4 rs[2][2];
#pragma unroll
        for (int bj = 0; bj < 2; ++bj)
#pragma unroll
            for (int n = 0; n < 2; ++n) { const f32x4 q = *(const f32x4*)(ssq_kv + col0 + bj * HALF + 4 * n);
                rs[bj][n] = (f32x4){rsqrtf(q[0] * (1.f / 128.f) + EPS), rsqrtf(q[1] * (1.f / 128.f) + EPS), rsqrtf(q[2] * (1.f / 128.f) + EPS), rsqrtf(q[3] * (1.f / 128.f) + EPS)}; }
#pragma unroll
        for (int ai = 0; ai < 2; ++ai)
#pragma unroll
            for (int m = 0; m < 4; ++m) { const int row = row0 + ai * HALF + m * 16; unsigned char* rp = VT + (size_t)row * M + col0;
#pragma unroll
                for (int bj = 0; bj < 2; ++bj) { const f32x4 v0 = acc[ai][bj][m][0] * rs[bj][0], v1 = acc[ai][bj][m][1] * rs[bj][1]; u32x2 w; w.x = pk4_fp8(v0[0], v0[1], v0[2], v0[3]); w.y = pk4_fp8(v1[0], v1[1], v1[2], v1[3]); *(u32x2*)(rp + bj * HALF) = w; } }
    } };
struct EpiH2 { static constexpr bool PERM = false; float* H2; const float* x;
    DEV void operator()(const Acc& acc, const Unit& u, int wr, int wc, int fr, int fq) const {
        const int row0 = u.pm * BM + wr * 64 + fr, col0 = u.pn * BM + wc * 32 + 4 * fq;
#pragma unroll
        for (int ai = 0; ai < 2; ++ai)
#pragma unroll
            for (int m = 0; m < 4; ++m) { const size_t off = (size_t)(row0 + ai * HALF + m * 16) * D + col0;
#pragma unroll
                for (int bj = 0; bj < 2; ++bj)
#pragma unroll
                    for (int n = 0; n < 2; ++n) *(f32x4*)(H2 + off + bj * HALF + n * 16) = *(const f32x4*)(x + off + bj * HALF + n * 16) + acc[ai][bj][m][n];
                if (m & 1) asm volatile("" ::: "memory"); }
    } };
struct EpiGU { static constexpr bool PERM = true; bf16_t* MH;
    DEV void operator()(const Acc& acc, const Unit& u, int wr, int wc, int fr, int fq) const {
        const int row0 = u.pm * BM + wr * 64 + fr, hid0 = u.pn * 128 + wc * 16 + 4 * fq;
#pragma unroll
        for (int ai = 0; ai < 2; ++ai)
#pragma unroll
            for (int m = 0; m < 4; ++m) { bf16_t* rp = MH + (size_t)(row0 + ai * HALF + m * 16) * DE + hid0;
#pragma unroll
                for (int bj = 0; bj < 2; ++bj) { const f32x4 g = acc[ai][bj][m][0], up = acc[ai][bj][m][1];
                    u32x2 w; w.x = cvt_pk_bf16(siluf(g[0]) * up[0], siluf(g[1]) * up[1]); w.y = cvt_pk_bf16(siluf(g[2]) * up[2], siluf(g[3]) * up[3]);
                    *(u32x2*)(rp + bj * 64) = w; } }
    } };
struct EpiD { static constexpr bool PERM = true; bf16_t* MY; size_t ld;
    DEV void operator()(const Acc& acc, const Unit& u, int wr, int wc, int fr, int fq) const {
        const int row0 = u.pm * BM + wr * 64 + fr, col0 = u.pn * BM + wc * 32 + 8 * fq;
#pragma unroll
        for (int ai = 0; ai < 2; ++ai)
#pragma unroll
            for (int m = 0; m < 4; ++m) { bf16_t* rp = MY + (size_t)(row0 + ai * HALF + m * 16) * ld + col0;
#pragma unroll
                for (int bj = 0; bj < 2; ++bj) *(u32x4*)(rp + bj * HALF) = pack8(acc[ai][bj][m][0], acc[ai][bj][m][1]); }
    } };
struct EpiLOGA { static constexpr bool PERM = true; float* LOGA; const float* ba;
    DEV void operator()(const Acc& acc, const Unit& u, int wr, int wc, int fr, int fq) const {
        const int row0 = u.pm * BM + wr * 64 + fr, col0 = wc * 32 + 8 * fq;
        f32x4 bv[2][2];
#pragma unroll
        for (int bj = 0; bj < 2; ++bj)
#pragma unroll
            for (int n = 0; n < 2; ++n) bv[bj][n] = *(const f32x4*)(ba + col0 + bj * HALF + 4 * n);
#pragma unroll
        for (int ai = 0; ai < 2; ++ai)
#pragma unroll
            for (int m = 0; m < 4; ++m) { float* rp = LOGA + (size_t)(row0 + ai * HALF + m * 16) * 256 + col0;
#pragma unroll
                for (int bj = 0; bj < 2; ++bj)
#pragma unroll
                    for (int n = 0; n < 2; ++n) { const f32x4 v = acc[ai][bj][m][n]; f32x4 o;
#pragma unroll
                        for (int c = 0; c < 4; ++c) { const float x = v[c] + bv[bj][n][c]; o[c] = (fminf(x, 0.f) - __logf(1.f + __expf(-fabsf(x)))) * (1.f / 16.f); }
                        *(f32x4*)(rp + bj * HALF + 4 * n) = o; }
                asm volatile("" ::: "memory"); }
    } };
struct EpiGU8 { static constexpr bool PERM = true; unsigned char* MH;
    DEV void operator()(const Acc& acc, const Unit& u, int wr, int wc, int fr, int fq) const {
        const int row0 = u.pm * BM + wr * 64 + fr, hid0 = u.pn * 128 + wc * 16 + 4 * fq;
#pragma unroll
        for (int ai = 0; ai < 2; ++ai)
#pragma unroll
            for (int m = 0; m < 4; ++m) { unsigned char* rp = MH + (size_t)(row0 + ai * HALF + m * 16) * DE + hid0;
#pragma unroll
                for (int bj = 0; bj < 2; ++bj) { const f32x4 g = acc[ai][bj][m][0] * (1.f / 32.f), up = acc[ai][bj][m][1] * (8.f / 32.f);
                    *(unsigned*)(rp + bj * 64) = pk4_fp8(siluf(g[0]) * up[0], siluf(g[1]) * up[1], siluf(g[2]) * up[2], siluf(g[3]) * up[3]); }
                asm volatile("" ::: "memory"); }
    } };
struct EpiD8 { static constexpr bool PERM = true; unsigned char* MY; float osc;
    DEV void operator()(const Acc& acc, const Unit& u, int wr, int wc, int fr, int fq) const {
        const int row0 = u.pm * BM + wr * 64 + fr, col0 = u.pn * BM + wc * 32 + 8 * fq;
#pragma unroll
        for (int ai = 0; ai < 2; ++ai)
#pragma unroll
            for (int m = 0; m < 4; ++m) { unsigned char* rp = MY + (size_t)(row0 + ai * HALF + m * 16) * D + col0;
#pragma unroll
                for (int bj = 0; bj < 2; ++bj) { const f32x4 a = acc[ai][bj][m][0] * osc, b = acc[ai][bj][m][1] * osc; u32x2 w;
                    int t = __builtin_amdgcn_cvt_pk_fp8_f32(a[0], a[1], 0, false); t = __builtin_amdgcn_cvt_pk_fp8_f32(a[2], a[3], t, true); w.x = (unsigned)t;
                    t = __builtin_amdgcn_cvt_pk_fp8_f32(b[0], b[1], 0, false); t = __builtin_amdgcn_cvt_pk_fp8_f32(b[2], b[3], t, true); w.y = (unsigned)t;
                    *(u32x2*)(rp + bj * HALF) = w; }
                asm volatile("" ::: "memory"); }
    } };
struct MoeSched {
    const char* A; const char* B; size_t estepB, tstepB, tstepA; const int* list; int nunits, G, c, lda2;
    DEV static int st_of(int e) { return *(volatile LAS int*)(SLOTTAB_OFF + 4u * (unsigned)e); }
    DEV static int cn_of(int e) { return *(volatile LAS int*)(SLOTTAB_OFF + 256u + 4u * (unsigned)e); }
    DEV bool next(int i, Unit& u) const {
        const int L = i * G + c; if (L >= nunits) return false;
        u.pm = L >> 2; u.pn = L & 3; unsigned l_; asm volatile("v_mbcnt_lo_u32_b32 %0, -1, 0\n\tv_mbcnt_hi_u32_b32 %0, -1, %0" : "=v"(l_));
        const unsigned long long bal = __ballot(st_of((int)l_) <= u.pm * BM); u.e = __builtin_amdgcn_readfirstlane(63 - __builtin_clzll(bal)); return true;
    }
    DEV unsigned aoff(const Unit& u) const { return (unsigned)((size_t)u.pm * tstepA); }
    DEV unsigned boff(const Unit& u) const { return (unsigned)((size_t)u.e * estepB + (size_t)u.pn * tstepB); }
    DEV unsigned atok(const Unit& u, int r) const { const int st = st_of(u.e), cn = cn_of(u.e); const int lr = u.pm * BM - st + r;
        return (unsigned)(lr < cn ? list[u.e * M + lr] : 0); }
};
}
DEV int vcu_of(int bx, int G) { return (G % 8 == 0) ? (bx % 8) * (G / 8) + bx / 8 : bx; }
namespace mla {
constexpr int KSLOT = 24576, OFF_KR = 16384, VRING = 3 * KSLOT, VSLOT = 16384;
constexpr float THR = 8.f;
DEV void blds(__amdgpu_buffer_rsrc_t r, unsigned voff, unsigned soff, LAS unsigned char* l) { __builtin_amdgcn_raw_ptr_buffer_load_lds(r, (LAS void*)l, 16, (int)voff, (int)soff, 0, 0); }
DEV void unit(const Params& P, LAS unsigned char* lds, int b, int h, int qb, int tid) {
    asm volatile("" : "+v"(tid));
    unsigned char* ws = P.ws; const int lane = tid & 63, r32 = lane & 31, hi = lane >> 5; const int wave = __builtin_amdgcn_readfirstlane(tid >> 6);
    const bf16_t* QM = (const bf16_t*)(ws + WS_QM); const char* KN = (const char*)(ws + WS_KN); const char* VT = (const char*)(ws + WS_VT); const char* KR = (const char*)(ws + WS_KR);
    const bf16_t* KNm = (const bf16_t*)(ws + WS_META + MT_KN); const bf16_t* VTm = (const bf16_t*)(ws + WS_META + MT_VT); const bf16_t* KRm = (const bf16_t*)(ws + WS_META + MT_KR);
    bf16_t* Y = (bf16_t*)(ws + WS_Y);
    const int NTL = 4 * qb + 4, nact = 4 * qb + (wave >> 1) + 1;
    unsigned okn[2], ovt[2], okr;
#pragma unroll
    for (int i = 0; i < 2; ++i) { const int p = 2 * wave + i;
        { const int row = 4 * p + (lane >> 4), c = (lane & 15) ^ (row & 15); okn[i] = (unsigned)(((size_t)(b * SEQ + row) * 512 + h * 128 + c * 8) * 2); }
        { const int row = 8 * p + (lane >> 3), c = (lane & 7) ^ ((row >> 1) & 7); ovt[i] = (unsigned)(((size_t)(h * 128 + row) * M + (size_t)b * SEQ + c * 8) * 2); } }
    { const int row = 8 * wave + (lane >> 3), c = (lane & 7) ^ ((row >> 1) & 7); okr = (unsigned)(((size_t)(b * SEQ + row) * 64 + c * 8) * 2); }
    const unsigned wl = (unsigned)wave * 2048u;
    const __amdgpu_buffer_rsrc_t rKN = __builtin_amdgcn_make_buffer_rsrc((void*)KN, 0, 64 << 20, 0x00020000), rKR = __builtin_amdgcn_make_buffer_rsrc((void*)KR, 0, 8 << 20, 0x00020000),
                                 rVT = __builtin_amdgcn_make_buffer_rsrc((void*)VT, 0, 64 << 20, 0x00020000);
#define MLA_ISSUE_K(j, slot) do { LAS unsigned char* sb_ = lds + (slot) * KSLOT; const unsigned jk_ = (unsigned)(j) * (64u * 512u * 2u), jr_ = (unsigned)(j) * (64u * 64u * 2u); \
        blds(rKN, okn[0], jk_, sb_ + wl); blds(rKN, okn[1], jk_, sb_ + wl + 1024); blds(rKR, okr, jr_, sb_ + OFF_KR + (wl >> 1)); } while (0)
#define MLA_ISSUE_V(j, slot) do { LAS unsigned char* sb_ = lds + VRING + (slot) * VSLOT; const unsigned jv_ = (unsigned)(j) * 128u; \
        blds(rVT, ovt[0], jv_, sb_ + wl); blds(rVT, ovt[1], jv_, sb_ + wl + 1024); } while (0)
    asm volatile("s_waitcnt vmcnt(0)" ::: "memory"); __builtin_amdgcn_s_barrier();
    MLA_ISSUE_K(0, 0); MLA_ISSUE_V(0, 0); MLA_ISSUE_K(1, 1);
    const size_t mq = (size_t)b * SEQ + qb * 256 + wave * 32 + r32;
    bf16x8 qf[12];
#pragma unroll
    for (int s = 0; s < 8; ++s) qf[s] = *(const bf16x8*)(QM + mq * 768 + h * 128 + 16 * s + 8 * hi);
#pragma unroll
    for (int s = 0; s < 4; ++s) qf[8 + s] = *(const bf16x8*)(QM + mq * 768 + 512 + h * 64 + 16 * s + 8 * hi);
    f32x16 O[4] = {}; float mrun = -INFINITY, l = 0.f;
    const int kperm = pi23(r32);
    const int xk = (kperm & 15) ^ hi, xr = ((kperm >> 1) & 7) ^ hi, xv = ((r32 >> 1) & 7) ^ hi;
    const int kn_b = kperm * 256, kr_b = OFF_KR + kperm * 128, vt_b = r32 * 128;
#define MLA_SOFTMAX(S0, S1) do { \
        float mx = fmaxf(S0[0], S1[0]); \
        _Pragma("unroll") for (int r = 1; r < 16; ++r) mx = fmaxf(mx, fmaxf(S0[r], S1[r])); \
        mx = half_max(mx); \
        if (__any(mx > mrun + THR)) { const float mnew = fmaxf(mrun, mx), alpha = __builtin_amdgcn_exp2f(mrun - mnew); mrun = mnew; l *= alpha; \
            _Pragma("unroll") for (int d = 0; d < 4; ++d) _Pragma("unroll") for (int r = 0; r < 16; ++r) O[d][r] *= alpha; } \
        float ps = 0.f; \
        _Pragma("unroll") for (int r = 0; r < 16; ++r) { S0[r] = __builtin_amdgcn_exp2f(S0[r] - mrun); S1[r] = __builtin_amdgcn_exp2f(S1[r] - mrun); ps += S0[r] + S1[r]; } \
        l += ps; \
        { u32x4 w; w.x = g8::cvt_pk_bf16(S0[0], S0[1]); w.y = g8::cvt_pk_bf16(S0[2], S0[3]); w.z = g8::cvt_pk_bf16(S0[4], S0[5]); w.w = g8::cvt_pk_bf16(S0[6], S0[7]); pf[0] = __builtin_bit_cast(bf16x8, w); \
          w.x = g8::cvt_pk_bf16(S0[8], S0[9]); w.y = g8::cvt_pk_bf16(S0[10], S0[11]); w.z = g8::cvt_pk_bf16(S0[12], S0[13]); w.w = g8::cvt_pk_bf16(S0[14], S0[15]); pf[1] = __builtin_bit_cast(bf16x8, w); \
          w.x = g8::cvt_pk_bf16(S1[0], S1[1]); w.y = g8::cvt_pk_bf16(S1[2], S1[3]); w.z = g8::cvt_pk_bf16(S1[4], S1[5]); w.w = g8::cvt_pk_bf16(S1[6], S1[7]); pf[2] = __builtin_bit_cast(bf16x8, w); \
          w.x = g8::cvt_pk_bf16(S1[8], S1[9]); w.y = g8::cvt_pk_bf16(S1[10], S1[11]); w.z = g8::cvt_pk_bf16(S1[12], S1[13]); w.w = g8::cvt_pk_bf16(S1[14], S1[15]); pf[3] = __builtin_bit_cast(bf16x8, w); } \
    } while (0)
#define MLA_PV(VLOAD) do { \
        _Pragma("unroll") for (int d = 0; d < 4; ++d) { _Pragma("unroll") for (int sp = 0; sp < 4; ++sp) { const bf16x8 vf = VLOAD(d, sp); O[d] = __builtin_amdgcn_mfma_f32_32x32x16_bf16(vf, pf[sp], O[d], 0, 0, 0); } } \
        __builtin_amdgcn_sched_group_barrier(0x100, 8, 1); \
        _Pragma("unroll") for (int i_ = 0; i_ < 4; ++i_) { __builtin_amdgcn_sched_group_barrier(0x8, 2, 1); __builtin_amdgcn_sched_group_barrier(0x100, 2, 1); } \
        __builtin_amdgcn_sched_group_barrier(0x8, 8, 1); \
    } while (0)
    bf16x8 pf[4];
    { f32x16 S0 = {}, S1; const bf16x8 zf = {};
#pragma unroll
      for (int s = 0; s < 8; ++s) { const bf16x8 kf = *(const bf16x8*)(KNm + kperm * 512 + h * 128 + 16 * s + 8 * hi); S0 = __builtin_amdgcn_mfma_f32_32x32x16_bf16(kf, qf[s], S0, 0, 0, 0); }
#pragma unroll
      for (int s = 0; s < 4; ++s) { const bf16x8 kf = *(const bf16x8*)(KRm + kperm * 64 + 16 * s + 8 * hi); S0 = __builtin_amdgcn_mfma_f32_32x32x16_bf16(kf, qf[8 + s], S0, 0, 0, 0); }
#pragma unroll
      for (int r = 0; r < 16; ++r) { if (pi23(crow(r, hi)) >= NMETA) S0[r] = -INFINITY; S1[r] = -INFINITY; }
#define MLA_VMETA(d, sp) ((sp) == 0 ? *(const bf16x8*)(VTm + (h * 128 + 32 * (d) + r32) * 32 + 8 * hi) : zf)
      MLA_SOFTMAX(S0, S1); MLA_PV(MLA_VMETA);
    }
#define MLA_QK(S0, S1, kslot) do { LAS const unsigned char* sb = lds + (kslot) * KSLOT; int xk_ = xk, xr_ = xr; asm volatile("" : "+v"(xk_), "+v"(xr_));   \
        _Pragma("unroll") for (int r = 0; r < 16; ++r) { S0[r] = 0.f; S1[r] = 0.f; } \
        _Pragma("unroll") for (int s = 0; s < 8; ++s) { const int co = ((2 * s) ^ xk_) << 4; const bf16x8 k0 = *(LAS const bf16x8*)(sb + kn_b + co), k1 = *(LAS const bf16x8*)(sb + kn_b + 32 * 256 + co); \
            S0 = __builtin_amdgcn_mfma_f32_32x32x16_bf16(k0, qf[s], S0, 0, 0, 0); S1 = __builtin_amdgcn_mfma_f32_32x32x16_bf16(k1, qf[s], S1, 0, 0, 0); } \
        _Pragma("unroll") for (int s = 0; s < 4; ++s) { const int co = ((2 * s) ^ xr_) << 4; const bf16x8 k0 = *(LAS const bf16x8*)(sb + kr_b + co), k1 = *(LAS const bf16x8*)(sb + kr_b + 32 * 128 + co); \
            S0 = __builtin_amdgcn_mfma_f32_32x32x16_bf16(k0, qf[8 + s], S0, 0, 0, 0); S1 = __builtin_amdgcn_mfma_f32_32x32x16_bf16(k1, qf[8 + s], S1, 0, 0, 0); } \
        __builtin_amdgcn_sched_group_barrier(0x100, 8, 0); \
        _Pragma("unroll") for (int i_ = 0; i_ < 8; ++i_) { __builtin_amdgcn_sched_group_barrier(0x8, 2, 0); __builtin_amdgcn_sched_group_barrier(0x100, 2, 0); } \
        __builtin_amdgcn_sched_group_barrier(0x8, 8, 0); } while (0)
#define MLA_VLDS(d, sp) (*(LAS const bf16x8*)(vb + vt_b + (d) * (32 * 128) + (((2 * (sp)) ^ xv_) << 4)))
    { const bool late = wave >= 4; int ks = 0;
      for (int j = 0; j < NTL; ++j) {
        if (j + 1 < NTL) asm volatile("s_waitcnt vmcnt(3)" ::: "memory"); else asm volatile("s_waitcnt vmcnt(0)" ::: "memory");
        __builtin_amdgcn_s_barrier(); asm volatile("" ::: "memory");
        if (j + 1 < NTL) MLA_ISSUE_V(j + 1, ks == 2 ? 0 : ks + 1);
        if (j + 2 < NTL) MLA_ISSUE_K(j + 2, ks == 0 ? 2 : ks - 1);
        if (late && j >= 1 && j - 1 < nact) { LAS const unsigned char* vb = lds + VRING + (ks == 0 ? 2 : ks - 1) * VSLOT; int xv_ = xv; asm volatile("" : "+v"(xv_)); MLA_PV(MLA_VLDS); }
        if (j < nact) { f32x16 S0, S1; MLA_QK(S0, S1, ks); MLA_SOFTMAX(S0, S1);
            if (!late) { LAS const unsigned char* vb = lds + VRING + ks * VSLOT; int xv_ = xv; asm volatile("" : "+v"(xv_)); MLA_PV(MLA_VLDS); } }
        ks = ks == 2 ? 0 : ks + 1;
      }
      if (late && NTL - 1 < nact) { LAS const unsigned char* vb = lds + VRING + (ks == 0 ? 2 : ks - 1) * VSLOT; int xv_ = xv; asm volatile("" : "+v"(xv_)); MLA_PV(MLA_VLDS); } }
    l = half_sum(l); const float rl = 1.f / l;
    { int te = tid; asm volatile("" : "+v"(te));
      bf16_t* yr = Y + ((size_t)b * SEQ + qb * 256 + wave * 32 + (te & 31)) * 1024 + 512 + h * 128 + 4 * ((te >> 5) & 1);
#pragma unroll
      for (int d = 0; d < 4; ++d)
#pragma unroll
        for (int g = 0; g < 4; ++g) { u32x2 w; w.x = g8::cvt_pk_bf16(O[d][4 * g] * rl, O[d][4 * g + 1] * rl); w.y = g8::cvt_pk_bf16(O[d][4 * g + 2] * rl, O[d][4 * g + 3] * rl);
            *(u32x2*)(yr + 32 * d + 8 * g) = w; } }
#undef MLA_ISSUE_K
#undef MLA_ISSUE_V
#undef MLA_QK
#undef MLA_SOFTMAX
#undef MLA_PV
#undef MLA_VMETA
#undef MLA_VLDS
}
}
namespace mla8 {
typedef int i32x8 __attribute__((ext_vector_type(8)));
typedef int i32x4 __attribute__((ext_vector_type(4)));
constexpr int KSLOT = 12288, OFF_KR = 8192, VRING = 3 * KSLOT, VSLOT = 8192;
constexpr float THR = 8.f, INVQS = 1.f / 16.f;
DEV int pip(int i) { return (i & 3) | (((i >> 3) & 3) << 2) | (((i >> 2) & 1) << 4); }
DEV f32x16 mfma8(i32x8 a, i32x8 b, f32x16 c) { return __builtin_amdgcn_mfma_scale_f32_32x32x64_f8f6f4(a, b, c, 0, 0, 0, 0x7f7f7f7f, 0, 0x7f7f7f7f); }
DEV i32x8 cat(i32x4 a, i32x4 b) { return (i32x8){a[0], a[1], a[2], a[3], b[0], b[1], b[2], b[3]}; }
DEV void unit(const Params& P, LAS unsigned char* lds, int b, int h, int qb, int tid) {
    asm volatile("" : "+v"(tid));
    unsigned char* ws = P.ws; const int lane = tid & 63, r32 = lane & 31, hi = lane >> 5; const int wave = __builtin_amdgcn_readfirstlane(tid >> 6);
    const unsigned char* QM = ws + WS_QM; const unsigned char* KN = ws + WS_KN; const unsigned char* VT = ws + WS_VT; const unsigned char* KR = ws + WS_KR;
    const unsigned char* KNm = ws + WS_META + MT_KN8; const unsigned char* VTm = ws + WS_META + MT_VT8; const unsigned char* KRm = ws + WS_META + MT_KR8;
    bf16_t* Y = (bf16_t*)(ws + WS_Y);
    const int NTL = 4 * qb + 4, nact = 4 * qb + (wave >> 1) + 1;
    unsigned okn, okr, ovt;
    { const int row = 8 * wave + (lane >> 3), c = (lane & 7) ^ ((row >> 1) & 7); okn = (unsigned)((size_t)(b * SEQ + row) * 512 + h * 128 + c * 16); }
    { const int row = 16 * (wave & 3) + (lane >> 2), c = (lane & 3) ^ ((row >> 2) & 3); okr = (unsigned)((size_t)(b * SEQ + row) * 64 + c * 16); }
    { const int row = 16 * wave + (lane >> 2), c = (lane & 3) ^ ((row >> 2) & 3); ovt = (unsigned)((size_t)(h * 128 + row) * M + (size_t)b * SEQ + c * 16); }
    const unsigned wl = (unsigned)wave * 1024u, wl3 = (unsigned)(wave & 3) * 1024u;
    const __amdgpu_buffer_rsrc_t rKN = __builtin_amdgcn_make_buffer_rsrc((void*)KN, 0, 32 << 20, 0x00020000), rKR = __builtin_amdgcn_make_buffer_rsrc((void*)KR, 0, 4 << 20, 0x00020000),
                                 rVT = __builtin_amdgcn_make_buffer_rsrc((void*)VT, 0, 32 << 20, 0x00020000);
#define M8_ISSUE_K(j, slot) do { LAS unsigned char* sb_ = lds + (slot) * KSLOT; mla::blds(rKN, okn, (unsigned)(j) * (64u * 512u), sb_ + wl); mla::blds(rKR, okr, (unsigned)(j) * (64u * 64u), sb_ + OFF_KR + wl3); } while (0)
#define M8_ISSUE_V(j, slot) do { mla::blds(rVT, ovt, (unsigned)(j) * 64u, lds + VRING + (slot) * VSLOT + wl); } while (0)
    asm volatile("s_waitcnt vmcnt(0)" ::: "memory"); __builtin_amdgcn_s_barrier();
    M8_ISSUE_K(0, 0); M8_ISSUE_V(0, 0); M8_ISSUE_K(1, 1);
    i32x8 qf[3];
    { const unsigned char* qp = QM + ((size_t)b * SEQ + qb * 256 + wave * 32 + r32) * 768;
      qf[0] = *(const i32x8*)(qp + h * 128 + 32 * hi); qf[1] = *(const i32x8*)(qp + h * 128 + 64 + 32 * hi); qf[2] = *(const i32x8*)(qp + 512 + h * 64 + 32 * hi); }
    f32x16 O[4] = {}; float mrun = -INFINITY, l = 0.f;
    const int kperm = pip(r32);
    const int xk = (kperm >> 1) & 7, xr = (kperm >> 2) & 3, xv = (r32 >> 2) & 3;
    const int kn_b = kperm * 128, kr_b = OFF_KR + kperm * 64, vt_b = r32 * 64;
    i32x8 pb;
#define M8_SOFTMAX(S0, S1) do { \
        float mx = fmaxf(S0[0], S1[0]); \
        _Pragma("unroll") for (int r = 1; r < 16; ++r) mx = fmaxf(mx, fmaxf(S0[r], S1[r])); \
        mx = half_max(mx) * INVQS; \
        if (__any(mx > mrun + THR)) { const float mnew = fmaxf(mrun, mx), alpha = __builtin_amdgcn_exp2f(mrun - mnew); mrun = mnew; l *= alpha; \
            _Pragma("unroll") for (int d = 0; d < 4; ++d) _Pragma("unroll") for (int r = 0; r < 16; ++r) O[d][r] *= alpha; } \
        float ps = 0.f; \
        _Pragma("unroll") for (int r = 0; r < 16; ++r) { S0[r] = __builtin_amdgcn_exp2f(S0[r] * INVQS - mrun); S1[r] = __builtin_amdgcn_exp2f(S1[r] * INVQS - mrun); ps += S0[r] + S1[r]; } \
        l += ps; \
        pb[0] = (int)pk4_fp8(S0[0], S0[1], S0[2], S0[3]); pb[1] = (int)pk4_fp8(S0[4], S0[5], S0[6], S0[7]); pb[2] = (int)pk4_fp8(S0[8], S0[9], S0[10], S0[11]); pb[3] = (int)pk4_fp8(S0[12], S0[13], S0[14], S0[15]); \
        pb[4] = (int)pk4_fp8(S1[0], S1[1], S1[2], S1[3]); pb[5] = (int)pk4_fp8(S1[4], S1[5], S1[6], S1[7]); pb[6] = (int)pk4_fp8(S1[8], S1[9], S1[10], S1[11]); pb[7] = (int)pk4_fp8(S1[12], S1[13], S1[14], S1[15]); \
    } while (0)
#define M8_SOFTMAX2(S0, S1) do { \
        _Pragma("unroll") for (int r = 0; r < 16; ++r) { S0[r] = __builtin_fmaf(S0[r], INVQS, -mrun); S1[r] = __builtin_fmaf(S1[r], INVQS, -mrun); } \
        float mxa = fmaxf(fmaxf(S0[0], S0[1]), S0[2]), mxb = fmaxf(fmaxf(S1[0], S1[1]), S1[2]); \
        _Pragma("unroll") for (int r = 3; r < 15; r += 2) { mxa = fmaxf(fmaxf(mxa, S0[r]), S0[r + 1]); mxb = fmaxf(fmaxf(mxb, S1[r]), S1[r + 1]); } \
        float mx = half_max(fmaxf(fmaxf(mxa, S0[15]), fmaxf(mxb, S1[15]))); \
        if (__any(mx > THR)) { const float d = fmaxf(mx, 0.f), alpha = __builtin_amdgcn_exp2f(-d); mrun += d; l *= alpha; \
            _Pragma("unroll") for (int r = 0; r < 16; ++r) { S0[r] -= d; S1[r] -= d; } \
            _Pragma("unroll") for (int d_ = 0; d_ < 4; ++d_) _Pragma("unroll") for (int r = 0; r < 16; ++r) O[d_][r] *= alpha; } \
        float ps = 0.f; \
        _Pragma("unroll") for (int r = 0; r < 16; ++r) { S0[r] = __builtin_amdgcn_exp2f(S0[r]); S1[r] = __builtin_amdgcn_exp2f(S1[r]); ps += S0[r] + S1[r]; } \
        l += ps; \
        pb[0] = (int)pk4_fp8(S0[0], S0[1], S0[2], S0[3]); pb[1] = (int)pk4_fp8(S0[4], S0[5], S0[6], S0[7]); pb[2] = (int)pk4_fp8(S0[8], S0[9], S0[10], S0[11]); pb[3] = (int)pk4_fp8(S0[12], S0[13], S0[14], S0[15]); \
        pb[4] = (int)pk4_fp8(S1[0], S1[1], S1[2], S1[3]); pb[5] = (int)pk4_fp8(S1[4], S1[5], S1[6], S1[7]); pb[6] = (int)pk4_fp8(S1[8], S1[9], S1[10], S1[11]); pb[7] = (int)pk4_fp8(S1[12], S1[13], S1[14], S1[15]); \
    } while (0)
    { f32x16 S0 = {}, S1;
      S0 = mfma8(*(const i32x8*)(KNm + kperm * 512 + h * 128 + 32 * hi), qf[0], S0);
      S0 = mfma8(*(const i32x8*)(KNm + kperm * 512 + h * 128 + 64 + 32 * hi), qf[1], S0);
      S0 = mfma8(*(const i32x8*)(KRm + kperm * 64 + 32 * hi), qf[2], S0);
#pragma unroll
      for (int r = 0; r < 16; ++r) { if (hi) S0[r] = -INFINITY; S1[r] = -INFINITY; }
      M8_SOFTMAX(S0, S1);
      const i32x4 z4 = {0, 0, 0, 0};
#pragma unroll
      for (int d = 0; d < 4; ++d) { const i32x8 vf = cat(*(const i32x4*)(VTm + (h * 128 + 32 * d + r32) * 32 + 16 * hi), z4); O[d] = mfma8(vf, pb, O[d]); } }
#define M8_QK(S0, S1, kslot) do { LAS const unsigned char* sb = lds + (kslot) * KSLOT; int xk_ = xk, xr_ = xr; asm volatile("" : "+v"(xk_), "+v"(xr_)); \
        _Pragma("unroll") for (int r = 0; r < 16; ++r) { S0[r] = 0.f; S1[r] = 0.f; } \
        _Pragma("unroll") for (int s = 0; s < 2; ++s) { const int co = ((4 * s + 2 * hi) ^ xk_) << 4; \
            const i32x8 k0 = cat(*(LAS const i32x4*)(sb + kn_b + co), *(LAS const i32x4*)(sb + kn_b + (co ^ 16))), k1 = cat(*(LAS const i32x4*)(sb + kn_b + 32 * 128 + co), *(LAS const i32x4*)(sb + kn_b + 32 * 128 + (co ^ 16))); \
            S0 = mfma8(k0, qf[s], S0); S1 = mfma8(k1, qf[s], S1); } \
        { const int co = ((2 * hi) ^ xr_) << 4; \
            const i32x8 k0 = cat(*(LAS const i32x4*)(sb + kr_b + co), *(LAS const i32x4*)(sb + kr_b + (co ^ 16))), k1 = cat(*(LAS const i32x4*)(sb + kr_b + 32 * 64 + co), *(LAS const i32x4*)(sb + kr_b + 32 * 64 + (co ^ 16))); \
            S0 = mfma8(k0, qf[2], S0); S1 = mfma8(k1, qf[2], S1); } } while (0)
#define M8_PV(vslot) do { LAS const unsigned char* vb = lds + VRING + (vslot) * VSLOT; int xv_ = xv; asm volatile("" : "+v"(xv_)); const int c0 = (hi ^ xv_) << 4, c1 = ((2 + hi) ^ xv_) << 4; \
        _Pragma("unroll") for (int d = 0; d < 4; ++d) { const i32x8 vf = cat(*(LAS const i32x4*)(vb + vt_b + d * (32 * 64) + c0), *(LAS const i32x4*)(vb + vt_b + d * (32 * 64) + c1)); O[d] = mfma8(vf, pb, O[d]); } } while (0)
#if PINGPONG
#define M8_HALF_A(jj, ks_) do { if ((jj) + 1 < NTL) asm volatile("s_waitcnt vmcnt(3)" ::: "memory"); else asm volatile("s_waitcnt vmcnt(0)" ::: "memory"); \
        __builtin_amdgcn_s_barrier(); asm volatile("" ::: "memory"); \
        if ((jj) + 1 < NTL) M8_ISSUE_V((jj) + 1, (ks_) == 2 ? 0 : (ks_) + 1); \
        if ((jj) + 2 < NTL) M8_ISSUE_K((jj) + 2, (ks_) == 0 ? 2 : (ks_) - 1); } while (0)
#define M8_HALF_B() do { asm volatile("" ::: "memory"); __builtin_amdgcn_s_barrier(); asm volatile("" ::: "memory"); } while (0)
    if (wave < 4) { int ks = 0;
      for (int j = 0; j <= NTL; ++j) { const int kp = ks == 0 ? 2 : ks - 1;
        M8_HALF_A(j, ks);
        f32x16 S0, S1;
        if (j < nact) M8_QK(S0, S1, ks);
        if (j >= 1 && j - 1 < nact) M8_PV(kp);
        M8_HALF_B();
        if (j < nact) M8_SOFTMAX(S0, S1);
        ks = ks == 2 ? 0 : ks + 1; } }
    else { int ks = 0;
      M8_HALF_A(0, 0);
      for (int j = 0; j <= NTL; ++j) { const int kp = ks == 0 ? 2 : ks - 1;
        M8_HALF_B();
        if (j >= 1 && j - 1 < nact) M8_PV(kp);
        f32x16 S0, S1;
        if (j < nact) M8_QK(S0, S1, ks);
        if (j == NTL) break;
        ks = ks == 2 ? 0 : ks + 1;
        M8_HALF_A(j + 1, ks);
        if (j < nact) M8_SOFTMAX(S0, S1); } }
#undef M8_HALF_A
#undef M8_HALF_B
#else
    { const bool late = wave >= 4; int ks = 0;
      for (int j = 0; j < NTL; ++j) {
        if (j + 1 < NTL) asm volatile("s_waitcnt vmcnt(2)" ::: "memory"); else asm volatile("s_waitcnt vmcnt(0)" ::: "memory");
        __builtin_amdgcn_s_barrier(); asm volatile("" ::: "memory");
        if (j + 1 < NTL) M8_ISSUE_V(j + 1, ks == 2 ? 0 : ks + 1);
        if (j + 2 < NTL) M8_ISSUE_K(j + 2, ks == 0 ? 2 : ks - 1);
        if (late && j >= 1 && j - 1 < nact) M8_PV(ks == 0 ? 2 : ks - 1);
        if (j < nact) { f32x16 S0, S1; M8_QK(S0, S1, ks); if (SM2) M8_SOFTMAX2(S0, S1); else M8_SOFTMAX(S0, S1); if (!late) M8_PV(ks); }
        ks = ks == 2 ? 0 : ks + 1;
      }
      if (late && NTL - 1 < nact) M8_PV(ks == 0 ? 2 : ks - 1); }
#endif
    l = half_sum(l); const float rl = 1.f / l;
    { int te = tid; asm volatile("" : "+v"(te));
      bf16_t* yr = Y + ((size_t)b * SEQ + qb * 256 + wave * 32 + (te & 31)) * 1024 + 512 + h * 128 + 4 * ((te >> 5) & 1);
#pragma unroll
      for (int d = 0; d < 4; ++d)
#pragma unroll
        for (int g = 0; g < 4; ++g) { u32x2 w; w.x = g8::cvt_pk_bf16(O[d][4 * g] * rl, O[d][4 * g + 1] * rl); w.y = g8::cvt_pk_bf16(O[d][4 * g + 2] * rl, O[d][4 * g + 3] * rl);
            *(u32x2*)(yr + 32 * d + 8 * g) = w; } }
#undef M8_ISSUE_K
#undef M8_ISSUE_V
#undef M8_SOFTMAX
#undef M8_SOFTMAX2
#undef M8_QK
#undef M8_PV
}
}
DEV void mla_fast(const Params& P, LAS unsigned char* lds) {
    const int tid = tid_fresh(); const int G = gridDim.x;
    for (int v = vcu_of(blockIdx.x, G); v < 256; v += G) { const int bh = v >> 2, s = v & 3;
        for (int ui = 0; ui < 4; ++ui) { const int qb = (ui == 0) ? s : (ui == 1) ? 7 - s : (ui == 2) ? 8 + s : 15 - s; mla::unit(P, lds, bh >> 2, bh & 3, qb, tid); } }
    asm volatile("s_waitcnt vmcnt(0)" ::: "memory"); __builtin_amdgcn_s_barrier();
}
namespace gla {
constexpr int L_QE = 0, L_KD = 9216, L_KDT = 18432, L_VT = 27648, L_ST = 46080  , STB = 18432, L_D = 82944, L_RED = 83200, L_G = 84224;
DEV int sw128(int row, int chunk) { return row * 144 + chunk * 16; }
template <int CTRL, int RM> DEV float dppz(float v) { return __int_as_float(__builtin_amdgcn_update_dpp(0, __float_as_int(v), CTRL, RM, 0xf, false)); }
DEV float wave_scan(float x) {
    x += __int_as_float(__builtin_amdgcn_update_dpp(0, __float_as_int(x), 0x111, 0xf, 0xf, true));
    x += __int_as_float(__builtin_amdgcn_update_dpp(0, __float_as_int(x), 0x112, 0xf, 0xf, true));
    x += __int_as_float(__builtin_amdgcn_update_dpp(0, __float_as_int(x), 0x114, 0xf, 0xf, true));
    x += __int_as_float(__builtin_amdgcn_update_dpp(0, __float_as_int(x), 0x118, 0xf, 0xf, true));
    x += dppz<0x142, 0xa>(x);
    x += dppz<0x143, 0xc>(x);
    return x;
}
DEV void item(const Params& P, LAS unsigned char* lds, int b, int h, int tid) {
    unsigned char* ws = P.ws; const int lane = tid & 63, r32 = lane & 31, hi = lane >> 5; const int wave = __builtin_amdgcn_readfirstlane(tid >> 6), ie = wave >> 1, ih = wave & 1;
    const bf16_t* Z = (const bf16_t*)P.out; const float* LOGA = (const float*)(ws + WS_LOGA); const bf16_t* VTG = (const bf16_t*)(ws + WS_VTG); bf16_t* Y = (bf16_t*)(ws + WS_Y);
    const float* S1 = (const float*)(ws + WS_META + MT_S1); const float* gain = P.in[I_GOUTN];
    __syncthreads();
    f32x16 accS;
#pragma unroll
    for (int r = 0; r < 16; ++r) { const int e = 32 * ie + crow(r, hi), d = 32 * ih + r32; accS[r] = S1[(h * 64 + d) * 128 + e];
        *(LAS bf16_t*)(lds + L_ST + sw128(e, d >> 3) + (d & 7) * 2) = (bf16_t)f2bf(accS[r]); }
    const size_t m0 = (size_t)b * SEQ;
    const char* Zb = (const char*)Z + m0 * NZ * 2; const char* Lb = (const char*)LOGA + m0 * 256 * 4; const char* Vb = (const char*)VTG + ((size_t)h * 128 * M + m0) * 2;
    const unsigned oq = (unsigned)(lane * NZ + ZQ + h * 64 + 8 * wave) * 2u, ok = (unsigned)(lane * NZ + ZK + h * 64 + 8 * wave) * 2u, ola = (unsigned)(lane * 256 + h * 64 + 8 * wave) * 4u;
    const unsigned ovt = (unsigned)(((size_t)(tid >> 2) * M + 16 * (tid & 3)) * 2), org = (unsigned)((32 * ih + r32) * NZ + ZR + h * 128 + 32 * ie + 4 * hi) * 2u;
#define GLA_LD(q_, k_, a0_, a1_, v0_, v1_, n_) do { const char* zc_ = Zb + (size_t)(n_) * 64 * NZ * 2; const char* lc_ = Lb + (size_t)(n_) * 64 * 256 * 4; const char* vc_ = Vb + (size_t)(n_) * 64 * 2; \
        q_ = *(const u32x4*)(zc_ + oq); k_ = *(const u32x4*)(zc_ + ok); a0_ = *(const f32x4*)(lc_ + ola); a1_ = *(const f32x4*)(lc_ + ola + 16); v0_ = *(const u32x4*)(vc_ + ovt); v1_ = *(const u32x4*)(vc_ + ovt + 16); } while (0)
#define GLA_LDRG(r_, n_) do { const char* zc_ = Zb + (size_t)(n_) * 64 * NZ * 2; _Pragma("unroll") for (int g = 0; g < 4; ++g) r_[g] = *(const u32x2*)(zc_ + org + 16 * g); } while (0)
    u32x4 qv, kv, vt0, vt1, qv2, kv2, vt02, vt12; f32x4 la0, la1, la02, la12; u32x2 rg[4], rgn[4];
    GLA_LD(qv, kv, la0, la1, vt0, vt1, 0); GLA_LD(qv2, kv2, la02, la12, vt02, vt12, 1); GLA_LDRG(rg, 0);
    if (tid < 128) *(LAS float*)(lds + L_G + 4 * tid) = gain[h * 128 + tid];
    const int kperm = pi23(r32);
    int par = 0;
    for (int n = 0; n < 64; n += 2) {
        { float bq[8] = {la0[0], la0[1], la0[2], la0[3], la1[0], la1[1], la1[2], la1[3]}; const unsigned qw[4] = {qv.x, qv.y, qv.z, qv.w}, kw[4] = {kv.x, kv.y, kv.z, kv.w};
          u32x4 qo, ko; unsigned qo_[4], ko_[4];
#pragma unroll
          for (int i = 0; i < 8; ++i) bq[i] = wave_scan(bq[i]);
          float e1[8], kd[8], qe[8];
#pragma unroll
          for (int i = 0; i < 8; ++i) { e1[i] = __expf(bq[i]); const float e2 = __builtin_amdgcn_rcpf(e1[i]);
              const float qf_ = (i & 1) ? __uint_as_float(qw[i >> 1] & 0xffff0000u) : __uint_as_float(qw[i >> 1] << 16), kf_ = (i & 1) ? __uint_as_float(kw[i >> 1] & 0xffff0000u) : __uint_as_float(kw[i >> 1] << 16);
              qe[i] = qf_ * e1[i] * 0.125f; kd[i] = kf_ * e2; }
#pragma unroll
          for (int i = 0; i < 4; ++i) { qo_[i] = pk2(qe[2 * i], qe[2 * i + 1]); ko_[i] = pk2(kd[2 * i], kd[2 * i + 1]); }
          qo.x = qo_[0]; qo.y = qo_[1]; qo.z = qo_[2]; qo.w = qo_[3]; ko.x = ko_[0]; ko.y = ko_[1]; ko.z = ko_[2]; ko.w = ko_[3];
          *(LAS u32x4*)(lds + L_QE + sw128(lane, wave)) = qo; *(LAS u32x4*)(lds + L_KD + sw128(lane, wave)) = ko;
#pragma unroll
          for (int i = 0; i < 8; ++i) { const int d = 8 * wave + i; *(LAS bf16_t*)(lds + L_KDT + sw128(d, lane >> 3) + (lane & 7) * 2) = (bf16_t)f2bf(kd[i]);
              const float dl = rl_f(e1[i], 63); if (lane == 0) *(LAS float*)(lds + L_D + 4 * d) = dl; }
          { const int e = tid >> 2, c0 = 2 * (tid & 3); *(LAS u32x4*)(lds + L_VT + sw128(e, c0)) = vt0; *(LAS u32x4*)(lds + L_VT + sw128(e, c0 + 1)) = vt1; } }
        __syncthreads();
        if (n + 2 < 64) GLA_LD(qv, kv, la0, la1, vt0, vt1, n + 2);
        if (n + 1 < 64) GLA_LDRG(rgn, n + 1);
        const size_t mtok = m0 + (size_t)n * 64 + 32 * ih + r32;
        bf16x8 qf[4], vf[4];
#pragma unroll
        for (int ks = 0; ks < 4; ++ks) { qf[ks] = *(LAS const bf16x8*)(lds + L_QE + sw128(32 * ih + r32, 2 * ks + hi)); vf[ks] = *(LAS const bf16x8*)(lds + L_VT + sw128(32 * ie + r32, 2 * ks + hi)); }
        f32x16 o = {};
#pragma unroll
        for (int ts = 0; ts < 2; ++ts) if (ts <= ih) {
            f32x16 at = {};
#pragma unroll
            for (int ks = 0; ks < 4; ++ks) { const bf16x8 kf = *(LAS const bf16x8*)(lds + L_KD + sw128(32 * ts + kperm, 2 * ks + hi)); at = __builtin_amdgcn_mfma_f32_32x32x16_bf16(kf, qf[ks], at, 0, 0, 0); }
            if (ts == ih) {
#pragma unroll
                for (int r = 0; r < 16; ++r) if (pi23(crow(r, hi)) > r32) at[r] = 0.f; }
            u32x4 w0, w1; w0.x = pk2_mfma(at[0], at[1]); w0.y = pk2_mfma(at[2], at[3]); w0.z = pk2_mfma(at[4], at[5]); w0.w = pk2_mfma(at[6], at[7]);
            w1.x = pk2_mfma(at[8], at[9]); w1.y = pk2_mfma(at[10], at[11]); w1.z = pk2_mfma(at[12], at[13]); w1.w = pk2_mfma(at[14], at[15]);
            o = __builtin_amdgcn_mfma_f32_32x32x16_bf16(vf[2 * ts], __builtin_bit_cast(bf16x8, w0), o, 0, 0, 0);
            o = __builtin_amdgcn_mfma_f32_32x32x16_bf16(vf[2 * ts + 1], __builtin_bit_cast(bf16x8, w1), o, 0, 0, 0);
        }
#pragma unroll
        for (int ks = 0; ks < 4; ++ks) { const bf16x8 sf = *(LAS const bf16x8*)(lds + L_ST + par * STB + sw128(32 * ie + r32, 2 * ks + hi)); o = __builtin_amdgcn_mfma_f32_32x32x16_bf16(sf, qf[ks], o, 0, 0, 0); }
#pragma unroll
        for (int ks = 0; ks < 4; ++ks) { const bf16x8 tf = *(LAS const bf16x8*)(lds + L_KDT + sw128(32 * ih + r32, 2 * ks + hi)); accS = __builtin_amdgcn_mfma_f32_32x32x16_bf16(vf[ks], tf, accS, 0, 0, 0); }
        { const float dl = *(LAS const float*)(lds + L_D + 4 * (32 * ih + r32));
#pragma unroll
          for (int r = 0; r < 16; ++r) { accS[r] *= dl; const int e = 32 * ie + crow(r, hi), d = 32 * ih + r32;
              *(LAS bf16_t*)(lds + L_ST + (par ^ 1) * STB + sw128(e, d >> 3) + (d & 7) * 2) = (bf16_t)f2bf(accS[r]); } }
        { float ss = 0.f;
#pragma unroll
          for (int r = 0; r < 16; ++r) ss += o[r] * o[r];
          ss = half_sum(ss); if (hi == 0) *(LAS float*)(lds + L_RED + (wave * 32 + r32) * 4) = ss; }
        __syncthreads();
        { float tot = 0.f;
#pragma unroll
          for (int q = 0; q < 4; ++q) tot += *(LAS const float*)(lds + L_RED + ((2 * q + ih) * 32 + r32) * 4);
          const float rs = rsqrtf(tot * (1.f / 128.f) + EPS);
#pragma unroll
          for (int g = 0; g < 4; ++g) { const float r0 = __uint_as_float(rg[g].x << 16), r1 = __uint_as_float(rg[g].x & 0xffff0000u), r2 = __uint_as_float(rg[g].y << 16), r3 = __uint_as_float(rg[g].y & 0xffff0000u);
              const f32x4 gn = *(LAS const f32x4*)(lds + L_G + 4 * (32 * ie + 8 * g + 4 * hi));
              u32x2 w; w.x = g8::cvt_pk_bf16(o[4 * g] * rs * gn[0] * siluf(r0), o[4 * g + 1] * rs * gn[1] * siluf(r1));
              w.y = g8::cvt_pk_bf16(o[4 * g + 2] * rs * gn[2] * siluf(r2), o[4 * g + 3] * rs * gn[3] * siluf(r3));
              *(u32x2*)(Y + mtok * 1024 + h * 128 + 32 * ie + 8 * g + 4 * hi) = w; } }

        par ^= 1;
        { const int n1 = n + 1;
        { float bq[8] = {la02[0], la02[1], la02[2], la02[3], la12[0], la12[1], la12[2], la12[3]}; const unsigned qw[4] = {qv2.x, qv2.y, qv2.z, qv2.w}, kw[4] = {kv2.x, kv2.y, kv2.z, kv2.w};
          u32x4 qo, ko; unsigned qo_[4], ko_[4];
#pragma unroll
          for (int i = 0; i < 8; ++i) bq[i] = wave_scan(bq[i]);
          float e1[8], kd[8], qe[8];
#pragma unroll
          for (int i = 0; i < 8; ++i) { e1[i] = __expf(bq[i]); const float e2 = __builtin_amdgcn_rcpf(e1[i]);
              const float qf_ = (i & 1) ? __uint_as_float(qw[i >> 1] & 0xffff0000u) : __uint_as_float(qw[i >> 1] << 16), kf_ = (i & 1) ? __uint_as_float(kw[i >> 1] & 0xffff0000u) : __uint_as_float(kw[i >> 1] << 16);
              qe[i] = qf_ * e1[i] * 0.125f; kd[i] = kf_ * e2; }
#pragma unroll
          for (int i = 0; i < 4; ++i) { qo_[i] = pk2(qe[2 * i], qe[2 * i + 1]); ko_[i] = pk2(kd[2 * i], kd[2 * i + 1]); }
          qo.x = qo_[0]; qo.y = qo_[1]; qo.z = qo_[2]; qo.w = qo_[3]; ko.x = ko_[0]; ko.y = ko_[1]; ko.z = ko_[2]; ko.w = ko_[3];
          *(LAS u32x4*)(lds + L_QE + sw128(lane, wave)) = qo; *(LAS u32x4*)(lds + L_KD + sw128(lane, wave)) = ko;
#pragma unroll
          for (int i = 0; i < 8; ++i) { const int d = 8 * wave + i; *(LAS bf16_t*)(lds + L_KDT + sw128(d, lane >> 3) + (lane & 7) * 2) = (bf16_t)f2bf(kd[i]);
              const float dl = rl_f(e1[i], 63); if (lane == 0) *(LAS float*)(lds + L_D + 4 * d) = dl; }
          { const int e = tid >> 2, c0 = 2 * (tid & 3); *(LAS u32x4*)(lds + L_VT + sw128(e, c0)) = vt02; *(LAS u32x4*)(lds + L_VT + sw128(e, c0 + 1)) = vt12; } }
        __syncthreads();
        if (n1 + 2 < 64) GLA_LD(qv2, kv2, la02, la12, vt02, vt12, n1 + 2);
        if (n1 + 1 < 64) GLA_LDRG(rg, n1 + 1);
        const size_t mtok = m0 + (size_t)n1 * 64 + 32 * ih + r32;
        bf16x8 qf[4], vf[4];
#pragma unroll
        for (int ks = 0; ks < 4; ++ks) { qf[ks] = *(LAS const bf16x8*)(lds + L_QE + sw128(32 * ih + r32, 2 * ks + hi)); vf[ks] = *(LAS const bf16x8*)(lds + L_VT + sw128(32 * ie + r32, 2 * ks + hi)); }
        f32x16 o = {};
#pragma unroll
        for (int ts = 0; ts < 2; ++ts) if (ts <= ih) {
            f32x16 at = {};
#pragma unroll
            for (int ks = 0; ks < 4; ++ks) { const bf16x8 kf = *(LAS const bf16x8*)(lds + L_KD + sw128(32 * ts + kperm, 2 * ks + hi)); at = __builtin_amdgcn_mfma_f32_32x32x16_bf16(kf, qf[ks], at, 0, 0, 0); }
            if (ts == ih) {
#pragma unroll
                for (int r = 0; r < 16; ++r) if (pi23(crow(r, hi)) > r32) at[r] = 0.f; }
            u32x4 w0, w1; w0.x = pk2_mfma(at[0], at[1]); w0.y = pk2_mfma(at[2], at[3]); w0.z = pk2_mfma(at[4], at[5]); w0.w = pk2_mfma(at[6], at[7]);
            w1.x = pk2_mfma(at[8], at[9]); w1.y = pk2_mfma(at[10], at[11]); w1.z = pk2_mfma(at[12], at[13]); w1.w = pk2_mfma(at[14], at[15]);
            o = __builtin_amdgcn_mfma_f32_32x32x16_bf16(vf[2 * ts], __builtin_bit_cast(bf16x8, w0), o, 0, 0, 0);
            o = __builtin_amdgcn_mfma_f32_32x32x16_bf16(vf[2 * ts + 1], __builtin_bit_cast(bf16x8, w1), o, 0, 0, 0);
        }
#pragma unroll
        for (int ks = 0; ks < 4; ++ks) { const bf16x8 sf = *(LAS const bf16x8*)(lds + L_ST + par * STB + sw128(32 * ie + r32, 2 * ks + hi)); o = __builtin_amdgcn_mfma_f32_32x32x16_bf16(sf, qf[ks], o, 0, 0, 0); }
#pragma unroll
        for (int ks = 0; ks < 4; ++ks) { const bf16x8 tf = *(LAS const bf16x8*)(lds + L_KDT + sw128(32 * ih + r32, 2 * ks + hi)); accS = __builtin_amdgcn_mfma_f32_32x32x16_bf16(vf[ks], tf, accS, 0, 0, 0); }
        { const float dl = *(LAS const float*)(lds + L_D + 4 * (32 * ih + r32));
#pragma unroll
          for (int r = 0; r < 16; ++r) { accS[r] *= dl; const int e = 32 * ie + crow(r, hi), d = 32 * ih + r32;
              *(LAS bf16_t*)(lds + L_ST + (par ^ 1) * STB + sw128(e, d >> 3) + (d & 7) * 2) = (bf16_t)f2bf(accS[r]); } }
        { float ss = 0.f;
#pragma unroll
          for (int r = 0; r < 16; ++r) ss += o[r] * o[r];
          ss = half_sum(ss); if (hi == 0) *(LAS float*)(lds + L_RED + (wave * 32 + r32) * 4) = ss; }
        __syncthreads();
        { float tot = 0.f;
#pragma unroll
          for (int q = 0; q < 4; ++q) tot += *(LAS const float*)(lds + L_RED + ((2 * q + ih) * 32 + r32) * 4);
          const float rs = rsqrtf(tot * (1.f / 128.f) + EPS);
#pragma unroll
          for (int g = 0; g < 4; ++g) { const float r0 = __uint_as_float(rgn[g].x << 16), r1 = __uint_as_float(rgn[g].x & 0xffff0000u), r2 = __uint_as_float(rgn[g].y << 16), r3 = __uint_as_float(rgn[g].y & 0xffff0000u);
              const f32x4 gn = *(LAS const f32x4*)(lds + L_G + 4 * (32 * ie + 8 * g + 4 * hi));
              u32x2 w; w.x = g8::cvt_pk_bf16(o[4 * g] * rs * gn[0] * siluf(r0), o[4 * g + 1] * rs * gn[1] * siluf(r1));
              w.y = g8::cvt_pk_bf16(o[4 * g + 2] * rs * gn[2] * siluf(r2), o[4 * g + 3] * rs * gn[3] * siluf(r3));
              *(u32x2*)(Y + mtok * 1024 + h * 128 + 32 * ie + 8 * g + 4 * hi) = w; } }

        par ^= 1; }
    }
}
}
DEV void phase3_fast(const Params& P, LAS unsigned char* lds) {
    const int tid = tid_fresh(); const int G = gridDim.x; const int vcu = vcu_of(blockIdx.x, G);
    int* qhead = (int*)(P.ws + WS_CTL) + CW_MLAQ;
    for (int it = vcu; it < 256; it += G) if ((it & 3) == 0) gla::item(P, lds, it >> 4, (it >> 2) & 3, tid);
#if XCONV_P3
    for (int it = vcu; it < 256; it += G) if ((it & 7) == XCONV_SEL) expert_convert(P, (it >> 3) * NWAVE + (tid >> 6), 32 * NWAVE, tid & 63);
#endif
    for (;;) {
        __syncthreads();
        if (tid == 0) *(LAS int*)(lds + 131072 + 16) = atomicAdd(qhead, 1);
        __syncthreads();
        const int idx = __builtin_amdgcn_readfirstlane(*(LAS const int*)(lds + 131072 + 16));
        if (idx >= 1024) break;
        const int qb = 15 - (idx >> 6), bh = idx & 63;
        if (MLA8) mla8::unit(P, lds, bh >> 2, bh & 3, qb, tid); else mla::unit(P, lds, bh >> 2, bh & 3, qb, tid);
    }
    asm volatile("s_waitcnt vmcnt(0)" ::: "memory"); __builtin_amdgcn_s_barrier();
}
DEV void phase1_fast(const Params& P, LAS unsigned char* lds) {
    unsigned char* ws = P.ws;
    { g8::DenseSched S; S.init(ws + WS_XN, D, ws + WS_WIN, D, M, 1536, gridDim.x, blockIdx.x);
      g8::EpiZ E{(bf16_t*)P.out, (float*)(ws + WS_CTL + CTL_SSQ_Q), (float*)(ws + WS_CTL + CTL_SSQ_KV)};
      g8::gemm_phase<g8::EpiZ, g8::DenseSched, false>(lds, D, D, D, S, E); }
    { g8::DenseSched S; S.init(ws + WS_WIN + (size_t)1536 * D * 2, D, ws + WS_XN, D, 512, M, gridDim.x, blockIdx.x);
      g8::EpiD E{(bf16_t*)(ws + WS_VTG), (size_t)M};
      g8::gemm_phase<g8::EpiD, g8::DenseSched, false>(lds, D, D, D, S, E); }
    meta_phase(P);
}
DEV void phase2_rows(const Params& P) { const int tid_ = tid_fresh();
    unsigned char* ws = P.ws; const int lane = tid_ & 63; const int gw = blockIdx.x * NWAVE + (tid_ >> 6), ngw = gridDim.x * NWAVE;
    const bf16_t* Z = (const bf16_t*)P.out; bf16_t* KR = (bf16_t*)(ws + WS_KR); float* LOGA = (float*)(ws + WS_LOGA);
    const float2* rt = (const float2*)(ws + WS_ROPE); const float* wa2 = P.in[I_WA2]; const float* ba = P.in[I_BA];
    float w[4][16], bb[4];
#pragma unroll
    for (int j = 0; j < 4; ++j) { bb[j] = ba[64 * j + lane];
#pragma unroll
        for (int r = 0; r < 16; ++r) w[j][r] = wa2[r * 256 + 64 * j + lane]; }
    for (int m = gw; m < M; m += ngw) { const bf16_t* z = Z + (size_t)m * NZ;
        { const float v = bf2f(z[ZKR + lane]), o = sx<1>(v); const float2 cs = rt[(NMETA + (m & (SEQ - 1))) * 32 + (lane >> 1)];
          const float kr_ = (lane & 1) ? (v * cs.x + o * cs.y) : (v * cs.x - o * cs.y);
          if (MLA8) { const int b8 = __builtin_amdgcn_cvt_pk_fp8_f32(kr_, 0.f, 0, false) & 0xff;
              const int w8 = __builtin_amdgcn_mov_dpp(b8, 0x00, 0xf, 0xf, true) | (__builtin_amdgcn_mov_dpp(b8, 0x55, 0xf, 0xf, true) << 8) | (__builtin_amdgcn_mov_dpp(b8, 0xAA, 0xf, 0xf, true) << 16) | (__builtin_amdgcn_mov_dpp(b8, 0xFF, 0xf, 0xf, true) << 24);
              if ((lane & 3) == 0) *(int*)((unsigned char*)KR + (size_t)m * 64 + lane) = w8; }
          else KR[(size_t)m * 64 + lane] = (bf16_t)f2bf(kr_); }
        float al[16];
#pragma unroll
        for (int r = 0; r < 16; ++r) al[r] = bf2f(z[ZAL + r]);
#pragma unroll
        for (int j = 0; j < 4; ++j) { float x = bb[j];
#pragma unroll
            for (int r = 0; r < 16; ++r) x += al[r] * w[j][r];
            LOGA[(size_t)m * 256 + 64 * j + lane] = logsigmoidf(x) * (1.f / 16.f); }
    }
}
DEV void kr8_rows(const Params& P) { const int tid_ = tid_fresh();
    unsigned char* ws = P.ws; const int lane = tid_ & 63; const int gw = blockIdx.x * NWAVE + (tid_ >> 6), ngw = gridDim.x * NWAVE;
    const bf16_t* Z = (const bf16_t*)P.out; unsigned char* KR = ws + WS_KR; const float2* rt = (const float2*)(ws + WS_ROPE);
    for (int blk = gw; blk < M / 32; blk += ngw) {
        u32x4 zz[4]; f32x4 c0[4], c1[4];
#pragma unroll
        for (int q = 0; q < 4; ++q) { const int m = blk * 32 + q * 8 + (lane >> 3), c8 = lane & 7;
            zz[q] = *(const u32x4*)(Z + (size_t)m * NZ + ZKR + 8 * c8);
            const f32x4* cp = (const f32x4*)(rt + (NMETA + (m & (SEQ - 1))) * 32 + 4 * c8); c0[q] = cp[0]; c1[q] = cp[1]; }
#pragma unroll
        for (int q = 0; q < 4; ++q) { const int m = blk * 32 + q * 8 + (lane >> 3), c8 = lane & 7;
            const unsigned zw[4] = {zz[q].x, zz[q].y, zz[q].z, zz[q].w}; const float cs[8] = {c0[q][0], c0[q][1], c0[q][2], c0[q][3], c1[q][0], c1[q][1], c1[q][2], c1[q][3]};
            float o[8];
#pragma unroll
            for (int i = 0; i < 4; ++i) { const float a = __uint_as_float(zw[i] << 16), b = __uint_as_float(zw[i] & 0xffff0000u), c = cs[2 * i], s = cs[2 * i + 1];
                o[2 * i] = a * c - b * s; o[2 * i + 1] = b * c + a * s; }
            u32x2 w; w.x = pk4_fp8(o[0], o[1], o[2], o[3]); w.y = pk4_fp8(o[4], o[5], o[6], o[7]);
            *(u32x2*)(KR + (size_t)m * 64 + 8 * c8) = w; }
    }
}
DEV void phase2_fast(const Params& P, LAS unsigned char* lds) {
    unsigned char* ws = P.ws; const bf16_t* Z = (const bf16_t*)P.out; const float* ssq_q = (const float*)(ws + WS_CTL + CTL_SSQ_Q); const float* ssq_kv = (const float*)(ws + WS_CTL + CTL_SSQ_KV);
#if !defined(X2) || (X2 & 1)
    { g8::DenseSched S; S.init(Z + ZQL, NZ, ws + WS_WQ, 256, M, 768, gridDim.x, blockIdx.x);
      if (MLA8) { g8::EpiQ8 E{(unsigned char*)(ws + WS_QM), ssq_q, (const float2*)(ws + WS_ROPE)}; g8::gemm_phase<g8::EpiQ8, g8::DenseSched, false>(lds, 256, NZ, 256, S, E); }
      else { g8::EpiQ E{(bf16_t*)(ws + WS_QM), ssq_q, (const float2*)(ws + WS_ROPE)}; g8::gemm_phase<g8::EpiQ, g8::DenseSched, false>(lds, 256, NZ, 256, S, E); } }
#endif
#if !defined(X2) || (X2 & 2)
    { g8::DenseSched S; S.init(Z + ZKVL, NZ, ws + WS_WK, 256, M, 512, gridDim.x, blockIdx.x);
      if (MLA8) { g8::EpiK8 E{(unsigned char*)(ws + WS_KN), ssq_kv}; g8::gemm_phase<g8::EpiK8, g8::DenseSched, false>(lds, 256, NZ, 256, S, E); }
      else { g8::EpiK E{(bf16_t*)(ws + WS_KN), ssq_kv}; g8::gemm_phase<g8::EpiK, g8::DenseSched, false>(lds, 256, NZ, 256, S, E); } }
#endif
#if !defined(X2) || (X2 & 4)
    { g8::DenseSched S; S.init(ws + WS_WV, 256, Z + ZKVL, NZ, 512, M, gridDim.x, blockIdx.x);
      if (MLA8) { g8::EpiVT8 E{(unsigned char*)(ws + WS_VT), ssq_kv}; g8::gemm_phase<g8::EpiVT8, g8::DenseSched, false>(lds, 256, 256, NZ, S, E); }
      else { g8::EpiVT E{(bf16_t*)(ws + WS_VT), ssq_kv}; g8::gemm_phase<g8::EpiVT, g8::DenseSched, false>(lds, 256, 256, NZ, S, E); } }
#endif
    if (MLA8) {
        g8::DenseSched S; S.init(Z + ZKR, NZ, ws + WS_WA2T, 128, M, 256, gridDim.x, blockIdx.x);
        g8::EpiLOGA E{(float*)(ws + WS_LOGA), P.in[I_BA]}; g8::gemm_phase<g8::EpiLOGA, g8::DenseSched, false>(lds, 128, NZ, 128, S, E);
        kr8_rows(P);
    } else phase2_rows(P);
}
DEV void phase4_fast(const Params& P, LAS unsigned char* lds) {
    unsigned char* ws = P.ws;
    g8::DenseSched S; S.init(ws + WS_Y, D, ws + WS_WOUT, D, M, D, gridDim.x, blockIdx.x);
    g8::EpiD E{(bf16_t*)(ws + WS_D16), (size_t)D};
    g8::gemm_phase<g8::EpiD, g8::DenseSched, false>(lds, D, D, D, S, E);
}
DEV void phase6_fast(const Params& P, LAS unsigned char* lds) { const int tid_ = tid_fresh();
    unsigned char* ws = P.ws; const int lane = tid_ & 63;
    int c_l, total; const int st_l = slot_start_lane((const int*)(ws + WS_CTL) + CW_CNT, lane, c_l, total);
    if (tid_ < 64) { *(volatile LAS int*)(SLOTTAB_OFF + 4u * (unsigned)lane) = st_l; *(volatile LAS int*)(SLOTTAB_OFF + 256u + 4u * (unsigned)lane) = c_l; }
    __syncthreads();
    g8::MoeSched S{(const char*)(ws + WS_TN8), (const char*)(ws + WS_WGU), (size_t)1024 * 1024, (size_t)256 * 1024, 0, (const int*)(ws + WS_LIST), (total / 256) * 4, (int)gridDim.x, vcu_of(blockIdx.x, gridDim.x), D};
    g8::EpiGU8 E{(unsigned char*)(ws + WS_MH)};
    g8::gemm_phase<g8::EpiGU8, g8::MoeSched, true, true>(lds, D / 2, D / 2, D / 2, S, E);
}
DEV void phase7_fast(const Params& P, LAS unsigned char* lds) { const int tid_ = tid_fresh();
    unsigned char* ws = P.ws; const int lane = tid_ & 63;
    int c_l, total; const int st_l = slot_start_lane((const int*)(ws + WS_CTL) + CW_CNT, lane, c_l, total);
    if (tid_ < 64) { *(volatile LAS int*)(SLOTTAB_OFF + 4u * (unsigned)lane) = st_l; *(volatile LAS int*)(SLOTTAB_OFF + 256u + 4u * (unsigned)lane) = c_l; }
    __syncthreads();
    g8::MoeSched S{(const char*)(ws + WS_MH), (const char*)(ws + WS_WD), (size_t)1024 * 512, (size_t)256 * 512, (size_t)256 * 512, nullptr, (total / 256) * 4, (int)gridDim.x, vcu_of(blockIdx.x, gridDim.x), DE};
    g8::EpiD8 E{(unsigned char*)(ws + WS_MY), 16.f / (8.f * 32.f)};
    g8::gemm_phase<g8::EpiD8, g8::MoeSched, false, true>(lds, DE / 2, DE / 2, DE / 2, S, E);
}

#define XB_TMO      128
#define XB_XCNT(j)  (256  + 64 * (j))
#define XB_XSUB(j)  (1280 + 64 * (j))
#define XB_XGEN(j)  (2304 + 64 * (j))
#define XB_TOP      3328
#define XB_TOPGEN   3392
#define XCD_BAR_WORDS 3456
#define XB_SPIN_CAP (1u << 22)
DEV unsigned xb_ld(unsigned* p)              { return __hip_atomic_load(p, __ATOMIC_RELAXED, __HIP_MEMORY_SCOPE_AGENT); }
DEV unsigned xb_add(unsigned* p, unsigned v) { return __hip_atomic_fetch_add(p, v, __ATOMIC_RELAXED, __HIP_MEMORY_SCOPE_AGENT); }
DEV unsigned xb_xcc_id() { return (unsigned)__builtin_amdgcn_s_getreg((3 << 11) | 20) & 0xFu; }
#define XB_SPIN(cond, bar) do { unsigned _sp = 0; while (cond) { __builtin_amdgcn_s_sleep(1); \
    if ((++_sp & 255u) == 0u) { if (xb_ld(&(bar)[XB_TMO])) break; if (_sp > XB_SPIN_CAP) { atomicAdd(&(bar)[XB_TMO], 1u); break; } } } } while (0)
struct XcdBarrier { unsigned* bar; unsigned x; volatile LAS unsigned* st; };
DEV XcdBarrier xcd_barrier_post(unsigned* bar, volatile LAS unsigned* st) {
    XcdBarrier b; b.bar = bar; b.x = xb_xcc_id(); b.st = st;
    if (threadIdx.x == 0) (void)xb_add(&bar[XB_XCNT(b.x)], 1u);
    return b;
}
DEV void xcd_barrier_complete(unsigned* bar, unsigned x, unsigned& nloc, unsigned& nx) {
    const unsigned G = gridDim.x * gridDim.y * gridDim.z;
    unsigned sum, cnt, mine, sp = 0u;
    for (;;) {
        sum = 0u; cnt = 0u; mine = 0u;
#pragma unroll
        for (unsigned j = 0; j < 16; ++j) { const unsigned c = xb_ld(&bar[XB_XCNT(j)]); sum += c; cnt += (c > 0u) ? 1u : 0u; mine = (j == x) ? c : mine; }
        if (sum == G) break;
        __builtin_amdgcn_s_sleep(1);
        if ((++sp & 255u) == 0u) { if (xb_ld(&bar[XB_TMO])) break; if (sp > XB_SPIN_CAP) { atomicAdd(&bar[XB_TMO], 1u); break; } }
    }
    nloc = mine > 0u ? mine : 1u; nx = cnt > 0u ? cnt : 1u;
}
DEV void xcd_barrier(const XcdBarrier& b) {
    asm volatile("s_waitcnt vmcnt(0)" ::: "memory");
    __syncthreads();
    if (tid_fresh() == 0) {
        unsigned* bar = b.bar;
        __builtin_amdgcn_s_waitcnt(0);
        unsigned nloc = b.st[0], nx = b.st[1];
        if (nloc == 0u) { xcd_barrier_complete(bar, b.x, nloc, nx); b.st[0] = nloc; b.st[1] = nx; }
        const unsigned old = xb_add(&bar[XB_XSUB(b.x)], 1u);
        const unsigned gen = old / nloc;
        if (old + 1u == (gen + 1u) * nloc) {
            __builtin_amdgcn_fence(__ATOMIC_RELEASE, "agent");
            asm volatile("s_waitcnt vmcnt(0)" ::: "memory");
            const unsigned og = xb_add(&bar[XB_TOP], 1u);
            const unsigned tg = og / nx;
            if (og + 1u == (tg + 1u) * nx) xb_add(&bar[XB_TOPGEN], 1u);
            else XB_SPIN(xb_ld(&bar[XB_TOPGEN]) == tg, bar);
            __builtin_amdgcn_fence(__ATOMIC_ACQUIRE, "agent");
            xb_add(&bar[XB_XGEN(b.x)], 1u);
            asm volatile("s_waitcnt vmcnt(0)" ::: "memory");
        } else {
            XB_SPIN(xb_ld(&bar[XB_XGEN(b.x)]) == gen, bar);
            __builtin_amdgcn_fence(__ATOMIC_ACQUIRE, "agent");
            asm volatile("s_waitcnt vmcnt(0)" ::: "memory");
        }
    }
    __syncthreads();
}

__global__ void __launch_bounds__(NT) mega_kernel(Params P) {
    __shared__ __attribute__((aligned(16))) float scr[NWAVE * 4096 + 16 + 64 + 128];
    LAS unsigned char* lds = (LAS unsigned char*)scr;
    volatile LAS unsigned* MISC = (volatile LAS unsigned*)(lds + NWAVE * 4096 * 4);
    if (threadIdx.x < 16) MISC[threadIdx.x] = 0u;
    if ((threadIdx.x & 63) == 0) *(volatile LAS unsigned*)(TIDMAP_OFF + 4u * hw_wave_key()) = threadIdx.x >> 6;
    __syncthreads();
    XcdBarrier xbar = xcd_barrier_post((unsigned*)(P.ws + WS_CTL) + CW_BAR, MISC);
#define GSYNC() xcd_barrier(xbar)
#ifndef DUP
#define DUP 0
#endif
    phase0(P, scr); if (DUP & 1) phase0(P, scr);           GSYNC();
    if (FAST & 1) phase1_fast(P, lds); else phase1(P);
    GSYNC();
    if (FAST & 2) phase2_fast(P, lds); else { phase2a(P); GSYNC(); phase2b(P); }
    if (DUP & 2) phase2_fast(P, lds);
    GSYNC();
    phase3_fast(P, lds);
    if (DUP & 4) phase3_fast(P, lds);
    GSYNC();
    if (FAST & 4) phase4_fast(P, lds); else phase4(P);
    if (DUP & 16) phase4_fast(P, lds);
    GSYNC();
    if (FAST & 64) phase5_fast(P); else phase5(P, scr);
    GSYNC();
    if (FAST & 8) phase6_fast(P, lds); else phase6(P);
    if (DUP & 32) phase6_fast(P, lds);
    GSYNC();
    if (FAST & 16) phase7_fast(P, lds); else phase7(P);
    if (DUP & 64) phase7_fast(P, lds);
    GSYNC();
    phase8(P); if (DUP & 128) phase8(P);
}

extern "C" void kernel_launch(void* const* d_in, const int* in_sizes, int n_in, void* d_out, int out_size, void* d_ws, size_t ws_size, hipStream_t stream) {
    if (n_in != 21 || out_size != M * D || ws_size < WS_END) { fprintf(stderr, "kernel_launch: unexpected shapes (n_in %d out %d ws %zu)\n", n_in, out_size, ws_size); return; }
    static int grid_blocks = 0;
    if (!grid_blocks) {
        int dev = 0, cus = 0, per_cu = 0;
        (void)hipGetDevice(&dev);
        (void)hipDeviceGetAttribute(&cus, hipDeviceAttributeMultiprocessorCount, dev);
        (void)hipOccupancyMaxActiveBlocksPerMultiprocessor(&per_cu, mega_kernel, NT, 0);
        if (per_cu < 1) { fprintf(stderr, "kernel_launch: occupancy query says %d blocks per CU\n", per_cu); per_cu = 1; }
        grid_blocks = cus;
    }
    Params P{};
    for (int i = 0; i < 21; ++i) P.in[i] = (const float*)d_in[i];
    P.out = (float*)d_out; P.ws = (unsigned char*)d_ws;
    (void)hipMemsetAsync((char*)d_ws + WS_CTL, 0, 1 * MiB, stream);
    mega_kernel<<<dim3(grid_blocks), dim3(NT), 0, stream>>>(P);
}
```

```cpp
#include <hip/hip_runtime.h>
#include <hip/hip_cooperative_groups.h>
namespace cg = cooperative_groups;
#include <cstdio>
#include <cstdint>

#ifndef MLA8
#ifndef XCONV_P3
#define XCONV_P3 1
#endif
#ifndef XCONV_SEL
#define XCONV_SEL 1
#endif
#ifndef PINGPONG
#define PINGPONG 0
#endif
#ifndef SM2
#define SM2 0
#endif
#ifndef XCONV_DIV
#define XCONV_DIV 4
#endif
#define MLA8 1
#endif
#define DEV __device__ __forceinline__
typedef unsigned short bf16_t;
typedef short bf16x8 __attribute__((ext_vector_type(8)));
typedef float f32x16 __attribute__((ext_vector_type(16)));
typedef float f32x4 __attribute__((ext_vector_type(4)));
typedef unsigned u32x4 __attribute__((ext_vector_type(4)));
typedef unsigned u32x2 __attribute__((ext_vector_type(2)));

constexpr int NB = 16, SEQ = 4096, M = NB * SEQ, D = 1024, NMETA = 16;
constexpr int NZ = 2048;
constexpr int ZQ = 0, ZK = 256, ZV = 512, ZR = 1024, ZQL = 1536, ZKVL = 1792, ZKR = 1920, ZAL = 1984;
constexpr int NE = 64, DE = 512;
constexpr float EPS = 1e-6f;
constexpr int NT = 512, NWAVE = 8, GRID = 256;
constexpr int SLOT_CAP = 151552;

constexpr size_t MiB = 1ull << 20;
constexpr size_t WS_CTL = 0;
constexpr size_t WS_WIN = 1 * MiB;
constexpr size_t WS_WQ = 5 * MiB;
constexpr size_t WS_WK = 5 * MiB + 512 * 1024;
constexpr size_t WS_WV = 5 * MiB + 768 * 1024;
constexpr size_t WS_WOUT = 6 * MiB;
constexpr size_t WS_ROPE = 8 * MiB;
constexpr size_t WS_META = 10 * MiB;
constexpr size_t WS_RS = 11 * MiB;
constexpr size_t WS_WR = 11 * MiB + 512 * 1024;
constexpr size_t WS_WA2T = 11 * MiB + 768 * 1024;
constexpr size_t WS_TOK = 12 * MiB;
constexpr size_t WS_WGU = 16 * MiB;
constexpr size_t WS_WD = 144 * MiB;
constexpr size_t WS_R1 = 208 * MiB;
constexpr size_t WS_QM = WS_R1, WS_KN = WS_R1 + 96 * MiB, WS_VT = WS_R1 + 160 * MiB, WS_KR = WS_R1 + 224 * MiB;
constexpr size_t WS_H2 = WS_R1;
constexpr size_t WS_D16 = WS_R1, WS_H2B = WS_R1 + 128 * MiB;
constexpr size_t WS_R2 = 464 * MiB;
constexpr size_t WS_XN = WS_R2, WS_Y = WS_R2, WS_TN = WS_R2, WS_MY = WS_R2;
constexpr size_t WS_LOGA = 592 * MiB;
constexpr size_t WS_TN8 = 592 * MiB;
constexpr size_t WS_VTG = 656 * MiB;
constexpr size_t WS_MH = 760 * MiB;
constexpr size_t WS_LIST = 908 * MiB;
constexpr size_t WS_END = 924 * MiB;
constexpr size_t MT_Z = 0;
constexpr size_t MT_KN = 128 * 1024;
constexpr size_t MT_VT = 160 * 1024;
constexpr size_t MT_KR = 192 * 1024;
constexpr size_t MT_S1 = 256 * 1024;
constexpr size_t MT_KN8 = 640 * 1024, MT_VT8 = 672 * 1024, MT_KR8 = 704 * 1024;
constexpr int CW_CNT = 0;
constexpr int CW_MLAQ = 64;
constexpr int CW_BAR = 16384;
constexpr size_t CTL_MZ = 768 * 1024, CTL_RSM = 896 * 1024;
constexpr size_t CTL_SSQ_Q = 256 * 1024, CTL_SSQ_KV = 512 * 1024;

struct Params { const float* in[21]; float* out; unsigned char* ws; };
enum { I_X = 0, I_META, I_MIXN, I_WIN, I_WA2, I_BA, I_GOUTN, I_QN, I_WQB, I_KVN, I_WKVB, I_WOUT, I_FFN, I_RGW, I_RGB, I_REW, I_REB, I_WG, I_WU, I_WDN, I_FINAL };

DEV unsigned pk2(float lo, float hi) { unsigned r; asm("v_cvt_pk_bf16_f32 %0, %1, %2" : "=v"(r) : "v"(lo), "v"(hi)); return r; }
typedef float f32x2_t __attribute__((ext_vector_type(2))); typedef __bf16 bf16x2_t __attribute__((ext_vector_type(2)));
DEV unsigned pk2_mfma(float lo, float hi) { const f32x2_t v = {lo, hi}; const bf16x2_t b = __builtin_convertvector(v, bf16x2_t); return __builtin_bit_cast(unsigned, b); }
DEV unsigned f2bf(float f) { return pk2(f, 0.f) & 0xffffu; }
DEV float bf2f(unsigned h) { return __uint_as_float(h << 16); }
template <int CTRL> DEV float dpp_f(float v) { return __int_as_float(__builtin_amdgcn_mov_dpp(__float_as_int(v), CTRL, 0xf, 0xf, true)); }
template <int K> DEV float sx(float v) {
    if constexpr (K == 1) return dpp_f<0xB1>(v);
    else if constexpr (K == 2) return dpp_f<0x4E>(v);
    else return __int_as_float(__builtin_amdgcn_ds_swizzle(__float_as_int(v), 0x1f | (K << 10)));
}
DEV float half_sum(float v) { auto rr = __builtin_amdgcn_permlane32_swap(__float_as_uint(v), __float_as_uint(v), false, false); return __uint_as_float(rr[0]) + __uint_as_float(rr[1]); }
DEV float half_max(float v) { auto rr = __builtin_amdgcn_permlane32_swap(__float_as_uint(v), __float_as_uint(v), false, false); return fmaxf(__uint_as_float(rr[0]), __uint_as_float(rr[1])); }
DEV float wave_sum(float v) { v += sx<1>(v); v += sx<2>(v); v += sx<4>(v); v += sx<8>(v); v += sx<16>(v); return half_sum(v); }
DEV int rl_i(int v, int l) { return __builtin_amdgcn_readlane(v, l); }
DEV float rl_f(float v, int l) { return __int_as_float(__builtin_amdgcn_readlane(__float_as_int(v), l)); }
constexpr unsigned TIDMAP_OFF = 131072u + 64u;
constexpr unsigned SLOTTAB_OFF = TIDMAP_OFF + 256u;
DEV unsigned hw_wave_key() { return (unsigned)__builtin_amdgcn_s_getreg((5 << 11) | 4) & 63u; }
DEV int tid_fresh() { const unsigned w = *(volatile __attribute__((address_space(3))) unsigned*)(TIDMAP_OFF + 4u * hw_wave_key());
    unsigned l; asm volatile("v_mbcnt_lo_u32_b32 %0, -1, 0\n\tv_mbcnt_hi_u32_b32 %0, -1, %0" : "=v"(l));
    int t = (int)(w * 64u + l); asm volatile("" : "+v"(t)); return t; }
DEV int crow(int r, int hi) { return (r & 3) + 8 * (r >> 2) + 4 * hi; }
DEV int pi23(int i) { return (i & ~12) | ((i & 4) << 1) | ((i & 8) >> 1); }
DEV float logsigmoidf(float x) { return fminf(x, 0.f) - log1pf(__expf(-fabsf(x))); }
DEV float siluf(float x) { return x * __builtin_amdgcn_rcpf(1.f + __expf(-x)); }

DEV void wave_tile(const bf16_t* a0, const bf16_t* a1, const bf16_t* b0, const bf16_t* b1, int K, f32x16& c00, f32x16& c01, f32x16& c10, f32x16& c11) {
    for (int k = 0; k < K; k += 16) {
        const bf16x8 A0 = *(const bf16x8*)(a0 + k), A1 = *(const bf16x8*)(a1 + k), B0 = *(const bf16x8*)(b0 + k), B1 = *(const bf16x8*)(b1 + k);
        c00 = __builtin_amdgcn_mfma_f32_32x32x16_bf16(A0, B0, c00, 0, 0, 0);
        c01 = __builtin_amdgcn_mfma_f32_32x32x16_bf16(A0, B1, c01, 0, 0, 0);
        c10 = __builtin_amdgcn_mfma_f32_32x32x16_bf16(A1, B0, c10, 0, 0, 0);
        c11 = __builtin_amdgcn_mfma_f32_32x32x16_bf16(A1, B1, c11, 0, 0, 0);
    }
}
template <class AF, class BF, class EF>
DEV void gemm_simple(int Mt, int Nt, int K, AF arow, BF brow, EF epi, int gw, int ngw) { const int tid_ = tid_fresh();
    const int lane = tid_ & 63, r32 = lane & 31, hi = lane >> 5;
    for (int it = gw; it < Mt * Nt; it += ngw) {
        const int tm = it / Nt, tn = it % Nt;
        f32x16 c00 = {}, c01 = {}, c10 = {}, c11 = {};
        wave_tile(arow(tm * 64 + r32) + hi * 8, arow(tm * 64 + 32 + r32) + hi * 8, brow(tn * 64 + r32) + hi * 8, brow(tn * 64 + 32 + r32) + hi * 8, K, c00, c01, c10, c11);
#pragma unroll
        for (int r = 0; r < 16; ++r) {
            const int row = tm * 64 + crow(r, hi), col = tn * 64 + r32;
            epi(row, col, c00[r]); epi(row, col + 32, c01[r]); epi(row + 32, col, c10[r]); epi(row + 32, col + 32, c11[r]);
        }
    }
}


#define LAS __attribute__((address_space(3)))
namespace g8 {
constexpr int BM = 256, BK = 64, HALF = 128, HTB = HALF * BK * 2, STAGE_BYTES = 8 * HTB, NXCD = 8, WGM = 8;
DEV int lds_byte(int r, int c) { const int st = (r >> 4) * 2 + (c >> 5), rr = r & 15, cc = c & 31, ob = rr * 64 + cc * 2; return st * 1024 + (ob ^ (((ob >> 9) & 1) << 5)); }
DEV void stage_rc(int b, int& R, int& C) { const int st = b / 1024, sb = b % 1024, swz = sb ^ (((sb >> 9) & 1) << 5); R = (st >> 1) * 16 + swz / 64; C = (st & 1) * 32 + (swz % 64) / 2; }
DEV int perm32(int rho) { const int n = rho >> 4, i = rho & 15; return 8 * (i >> 2) + 4 * n + (i & 3); }
struct Unit { int pm, pn, e; };
typedef f32x4 Acc[2][2][4][2];
typedef int i32x8 __attribute__((ext_vector_type(8)));
typedef int i32x4 __attribute__((ext_vector_type(4)));
DEV f32x4 mfma_any(i32x8 a, i32x8 b, f32x4 c) { return __builtin_amdgcn_mfma_scale_f32_16x16x128_f8f6f4(a, b, c, 0, 0, 0, 0x7f7f7f7f, 0, 0x7f7f7f7f); }
DEV f32x4 mfma_any(bf16x8 a, bf16x8 b, f32x4 c) { return __builtin_amdgcn_mfma_f32_16x16x32_bf16(a, b, c, 0, 0, 0); }
template <bool F8> struct FragSel { typedef bf16x8 T; };
template <> struct FragSel<true> { typedef i32x8 T; };
template <class Epi, class Sched, bool GATHER, bool F8 = false>
DEV void gemm_phase(LAS unsigned char* lds, const int K, const int lda, const int ldb, const Sched& S, const Epi& E) { const int tid_ = tid_fresh();
    const int tid = tid_, wid = __builtin_amdgcn_readfirstlane(tid >> 6), lane = tid & 63, wr = wid >> 2, wc = wid & 3, fr = lane & 15, fq = lane >> 4;
    const int nt = K / BK;
    unsigned voffB, vC0;
    unsigned tkC0 = 0u, tkC1 = 0u, tkN0 = 0u, tkN1 = 0u, cbA = 0u;
    { int R, C; stage_rc(tid * 16, R, C); const int Rb = Epi::PERM ? ((R & ~31) + perm32(R & 31)) : R;
      voffB = (unsigned)(Rb * ldb + C) * 2u; vC0 = (unsigned)(R * lda + C) * 2u; cbA = (unsigned)C * 2u; }
    const unsigned pstepA = (unsigned)(64 * lda * 2), pstepB = (unsigned)(64 * ldb * 2);
    const unsigned kstep = (unsigned)(BK * 2), hstepB = (unsigned)(HALF * ldb * 2), hA = GATHER ? 0u : (unsigned)(HALF * lda * 2);
    const __amdgpu_buffer_rsrc_t rA = __builtin_amdgcn_make_buffer_rsrc((void*)S.A, 0, 0x7ffffff0, 0x00020000), rB = __builtin_amdgcn_make_buffer_rsrc((void*)S.B, 0, 0x7ffffff0, 0x00020000);
    const unsigned ldsw = (unsigned)wid * 1024u;
    int aoff = lds_byte(wr * 64 + fr, F8 ? fq * 16 : fq * 8), boff = lds_byte(wc * 32 + fr, F8 ? fq * 16 : fq * 8) + 4 * HTB;
    asm volatile("" : "+v"(aoff), "+v"(boff));
#define G8_SA(b, h) (((b) * 2 + (h)) * HTB)
#define G8_SB(b, h) ((4 + (b) * 2 + (h)) * HTB)
#define G8_SBR(b, h) (((b) * 2 + (h)) * HTB)
#define G8_STAGE1(bufoff, rs, soff, voff, i) __builtin_amdgcn_raw_ptr_buffer_load_lds(rs, (LAS void*)(lds + (bufoff) + ldsw + (i) * 8192), 16, (int)(voff), (int)(soff), 0, 0)
#define G8_STAGE_B(bufoff, soff) do { G8_STAGE1(bufoff, rB, soff, voffB, 0); G8_STAGE1(bufoff, rB, (soff) + pstepB, voffB, 1); } while (0)
#define G8_LDA(dst, b, h) do { _Pragma("unroll") for (int m = 0; m < 4; ++m) _Pragma("unroll") for (int k = 0; k < NK; ++k) dst[m][k] = *(const LAS FragT*)(lds + aoff + (G8_SA(b, h) + m * 2048 + k * 1024)); } while (0)
#define G8_LDB(dst, b, h) do { _Pragma("unroll") for (int n = 0; n < 2; ++n) _Pragma("unroll") for (int k = 0; k < NK; ++k) dst[n][k] = *(const LAS FragT*)(lds + boff + (G8_SBR(b, h) + n * 2048 + k * 1024)); } while (0)
#define G8_MMA(ai, bj, At, Bt) do { __builtin_amdgcn_s_setprio(1); _Pragma("unroll") for (int m = 0; m < 4; ++m) _Pragma("unroll") for (int n = 0; n < 2; ++n) { \
        _Pragma("unroll") for (int k = 0; k < NK; ++k) acc[ai][bj][m][n] = mfma_any(Bt[n][k], At[m][k], acc[ai][bj][m][n]); } \
        __builtin_amdgcn_s_setprio(0); } while (0)
#define G8_WAIT_V(n) asm volatile("s_waitcnt vmcnt(" #n ")" ::: "memory")
#define G8_WAIT_L(n) asm volatile("s_waitcnt lgkmcnt(" #n ")" ::: "memory")
#define G8_BAR __builtin_amdgcn_s_barrier()
#define G8_SCHED __builtin_amdgcn_sched_barrier(0)
#define G8_AOFF(d0, d1, u) do { const int _t = tid_fresh(); int _R, _C; stage_rc(_t * 16, _R, _C); \
        d0 = (S.atok(u, _R) & 0xffffu) | (S.atok(u, _R + 64) << 16); d1 = (S.atok(u, HALF + _R) & 0xffffu) | (S.atok(u, HALF + _R + 64) << 16); } while (0)
#define G8_STAGE_A(bufoff, soff, tk) do { if constexpr (GATHER) { G8_STAGE1(bufoff, rA, soff, ((tk) & 0xffffu) * (unsigned)S.lda2 + cbA, 0); G8_STAGE1(bufoff, rA, soff, ((tk) >> 16) * (unsigned)S.lda2 + cbA, 1); } \
        else { G8_STAGE1(bufoff, rA, soff, vC0, 0); G8_STAGE1(bufoff, rA, (soff) + pstepA, vC0, 1); } } while (0)
    Unit cur, nxt; int ui = 0;
    if (!S.next(0, cur)) return;
    Acc acc;
#pragma unroll
    for (int a = 0; a < 2; ++a)
#pragma unroll
        for (int b = 0; b < 2; ++b)
#pragma unroll
            for (int m = 0; m < 4; ++m)
#pragma unroll
                for (int n = 0; n < 2; ++n) acc[a][b][m][n] = (f32x4){0.f, 0.f, 0.f, 0.f};
    typedef typename FragSel<F8>::T FragT; constexpr int NK = F8 ? 1 : 2;
    FragT At[4][NK], B0[2][NK], B1[2][NK];
    unsigned cA = S.aoff(cur), cB = S.boff(cur);
    if (GATHER) { G8_AOFF(tkC0, tkC1, cur); }
    G8_STAGE_B(G8_SB(0, 0), cB); G8_STAGE_B(G8_SB(0, 1), cB + hstepB); G8_STAGE_A(G8_SA(0, 0), cA, tkC0); G8_STAGE_A(G8_SA(0, 1), cA + hA, tkC1);
    if (wr == 1) G8_BAR;
    G8_WAIT_V(2); G8_BAR;
    G8_STAGE_B(G8_SB(1, 0), cB + kstep); G8_STAGE_A(G8_SA(1, 0), cA + kstep, tkC0); G8_STAGE_B(G8_SB(1, 1), cB + hstepB + kstep);
    G8_WAIT_V(6); G8_BAR;
    for (;;) {
        const bool has_next = S.next(ui + 1, nxt);
        const unsigned nA = has_next ? S.aoff(nxt) : cA, nB = has_next ? S.boff(nxt) : cB;
#pragma unroll 1
        for (int t = 0; t < nt; t += 2) {
            const bool last = (t == nt - 2);
            if (GATHER && t == (nt >= 4 ? nt - 4 : 0)) {
                if (has_next) { G8_AOFF(tkN0, tkN1, nxt); } else { tkN0 = tkC0; tkN1 = tkC1; } }
            const unsigned a1 = cA + (unsigned)(t + 1) * kstep;
            const unsigned a2 = last ? nA : cA + (unsigned)(t + 2) * kstep, b2 = last ? nB : cB + (unsigned)(t + 2) * kstep;
            const unsigned a3 = a2 + kstep, b3 = b2 + kstep;
            const unsigned s0 = (GATHER && last) ? tkN0 : tkC0, s1 = (GATHER && last) ? tkN1 : tkC1;
            G8_LDB(B0, 0, 0); G8_LDB(B1, 0, 1); G8_SCHED; G8_LDA(At, 0, 0); G8_STAGE_A(G8_SA(1, 1), a1 + hA, tkC1);
            G8_WAIT_V(8); G8_WAIT_L(0); G8_BAR; G8_MMA(0, 0, At, B0); G8_MMA(0, 1, At, B1); G8_BAR; G8_SCHED;
            G8_LDA(At, 0, 1); G8_STAGE_B(G8_SB(0, 0), b2); G8_STAGE_B(G8_SB(0, 1), b2 + hstepB); G8_STAGE_A(G8_SA(0, 0), a2, s0);
            G8_WAIT_V(8); G8_WAIT_L(0); G8_BAR; G8_MMA(1, 0, At, B0); G8_MMA(1, 1, At, B1); G8_BAR; G8_SCHED;
            G8_LDB(B0, 1, 0); G8_LDB(B1, 1, 1); G8_SCHED; G8_LDA(At, 1, 0); G8_STAGE_A(G8_SA(0, 1), a2 + hA, s1);
            G8_WAIT_V(8); G8_WAIT_L(0); G8_BAR; G8_MMA(0, 0, At, B0); G8_MMA(0, 1, At, B1); G8_BAR; G8_SCHED;
            G8_LDA(At, 1, 1); G8_STAGE_B(G8_SB(1, 0), b3); G8_STAGE_B(G8_SB(1, 1), b3 + hstepB); G8_STAGE_A(G8_SA(1, 0), a3, s0);
            G8_WAIT_V(8); G8_WAIT_L(0); G8_BAR; G8_MMA(1, 0, At, B0); G8_MMA(1, 1, At, B1); G8_BAR; G8_SCHED;
        }
        if (wr == 0) G8_BAR;
        { const int te_ = tid_fresh(); E(acc, cur, wr, wc, te_ & 15, (te_ >> 4) & 3); }
        if (!has_next) break;
#pragma unroll
        for (int a = 0; a < 2; ++a)
#pragma unroll
            for (int b = 0; b < 2; ++b)
#pragma unroll
                for (int m = 0; m < 4; ++m)
#pragma unroll
                    for (int n = 0; n < 2; ++n) acc[a][b][m][n] = (f32x4){0.f, 0.f, 0.f, 0.f};
        cur = nxt; cA = nA; cB = nB; ++ui;
        if (GATHER) { tkC0 = tkN0; tkC1 = tkN1; }
        if (wr == 1) G8_BAR;
    }
    G8_WAIT_V(0);
    G8_BAR;
}
struct DenseSched {
    const char* A; const char* B; size_t tstepA, tstepB; int nM, nN, nwg, G, c;
    DEV void init(const void* A_, int lda, const void* B_, int ldb, int Mr, int Nc, int G_, int c_) { A = (const char*)A_; B = (const char*)B_; tstepA = (size_t)BM * lda * 2; tstepB = (size_t)BM * ldb * 2;
        nM = Mr / BM; nN = Nc / BM; nwg = nM * nN; G = G_; c = c_; }
    DEV bool next(int i, Unit& u) const {
        const long L = (long)i * G + c; if (L >= nwg) return false;
        int wgid = (int)L; { const int q = nwg / NXCD, r = nwg % NXCD, xcd = wgid % NXCD, off = wgid / NXCD; wgid = (xcd < r ? xcd * (q + 1) : r * (q + 1) + (xcd - r) * q) + off; }
        const int nig = WGM * nN, gid = wgid / nig, fm = gid * WGM, gsz = (nM - fm) < WGM ? (nM - fm) : WGM;
        u.pm = fm + ((wgid % nig) % gsz); u.pn = (wgid % nig) / gsz; u.e = 0; return true;
    }
    DEV unsigned aoff(const Unit& u) const { return (unsigned)((size_t)u.pm * tstepA); }
    DEV unsigned boff(const Unit& u) const { return (unsigned)((size_t)u.pn * tstepB); }
    DEV unsigned atok(const Unit&, int) const { return 0u; }
    static constexpr int lda2 = 0;
};
DEV unsigned cvt_pk_bf16(float lo, float hi) { unsigned r; asm volatile("v_cvt_pk_bf16_f32 %0, %1, %2" : "=v"(r) : "v"(lo), "v"(hi)); return r; }
DEV u32x4 pack8(const f32x4 v0, const f32x4 v1) { u32x4 w; w.x = cvt_pk_bf16(v0[0], v0[1]); w.y = cvt_pk_bf16(v0[2], v0[3]); w.z = cvt_pk_bf16(v1[0], v1[1]); w.w = cvt_pk_bf16(v1[2], v1[3]); return w; }
}

template <class SF>
DEV void transpose_item(SF src, bf16_t* dst, int ldd, int k0, int n0, float* scr, int lane) {
#pragma unroll 8
    for (int i = 0; i < 32; ++i) { const int kk = 2 * i + (lane >> 5); scr[kk * 33 + (lane & 31)] = src(k0 + kk, n0 + (lane & 31)); }
    __builtin_amdgcn_s_waitcnt(0xc07f); asm volatile("" ::: "memory");
    const int c = lane & 7;
#pragma unroll
    for (int j = 0; j < 4; ++j) { const int n = (lane >> 3) + 8 * j; const float* s = scr + (8 * c) * 33 + n;
        u32x4 o; o.x = pk2(s[0], s[33]); o.y = pk2(s[66], s[99]); o.z = pk2(s[132], s[165]); o.w = pk2(s[198], s[231]);
        *(u32x4*)(dst + (size_t)(n0 + n) * ldd + k0 + 8 * c) = o; }
    __builtin_amdgcn_s_waitcnt(0xc07f); asm volatile("" ::: "memory");
}
DEV unsigned pk4_fp8(float a, float b, float c, float d) { int t = __builtin_amdgcn_cvt_pk_fp8_f32(a, b, 0, false); t = __builtin_amdgcn_cvt_pk_fp8_f32(c, d, t, true); return (unsigned)t; }
DEV unsigned char f2fp8(float f) { return (unsigned char)(__builtin_amdgcn_cvt_pk_fp8_f32(f, 0.f, 0, false) & 0xff); }
template <class RM>
DEV void transpose_tile_reg8(const float* src, int ldn, unsigned char* dst, int ldd, int k0, int n0, RM rowmap, int lane, float sc) {
    const int kq = lane >> 4, nq = lane & 15; f32x4 v[16];
#pragma unroll
    for (int i = 0; i < 16; ++i) v[i] = *(const f32x4*)(src + (size_t)(k0 + 16 * kq + i) * ldn + n0 + 4 * nq) * sc;
#pragma unroll
    for (int j = 0; j < 4; ++j) { u32x4 a; a.x = pk4_fp8(v[0][j], v[1][j], v[2][j], v[3][j]); a.y = pk4_fp8(v[4][j], v[5][j], v[6][j], v[7][j]); a.z = pk4_fp8(v[8][j], v[9][j], v[10][j], v[11][j]); a.w = pk4_fp8(v[12][j], v[13][j], v[14][j], v[15][j]);
        *(u32x4*)(dst + (size_t)rowmap(n0 + 4 * nq + j) * ldd + k0 + 16 * kq) = a; }
}
template <class RM>
DEV void transpose_tile_reg(const float* src, int ldn, bf16_t* dst, int ldd, int k0, int n0, RM rowmap, int lane) {
    const int kq = lane >> 4, nq = lane & 15; f32x4 v[16];
#pragma unroll
    for (int i = 0; i < 16; ++i) v[i] = *(const f32x4*)(src + (size_t)(k0 + 16 * kq + i) * ldn + n0 + 4 * nq);
#pragma unroll
    for (int j = 0; j < 4; ++j) { bf16_t* o = dst + (size_t)rowmap(n0 + 4 * nq + j) * ldd + k0 + 16 * kq;
        u32x4 a, b2; a.x = pk2(v[0][j], v[1][j]); a.y = pk2(v[2][j], v[3][j]); a.z = pk2(v[4][j], v[5][j]); a.w = pk2(v[6][j], v[7][j]);
        b2.x = pk2(v[8][j], v[9][j]); b2.y = pk2(v[10][j], v[11][j]); b2.z = pk2(v[12][j], v[13][j]); b2.w = pk2(v[14][j], v[15][j]);
        *(u32x4*)o = a; *(u32x4*)(o + 8) = b2; }
}
DEV int zcol_src(int n) {
    if (n < 1536) return n;
    if (n < 1792) return 1552 + (n - 1536);
    if (n < 1920) return 1808 + (n - 1792);
    if (n < 1984) { const int j = n - 1920; return 1936 + (j >> 1) + 32 * (j & 1); }
    if (n < 2000) return 1536 + (n - 1984);
    return -1;
}
DEV int wrow_to_zcol(int n) {
    if (n < 512) return n;
    if (n < 1024) return n + 512;
    if (n < 1280) return ZQL + (n - 1024);
    if (n < 1536) return ZKVL + (n - 1280);
    return ZV + (n - 1536);
}
DEV void expert_convert(const Params& P, int gw, int ngw, int lane) {
    unsigned char* ws = P.ws; const int kq = lane >> 4, nq = lane & 15;
    auto ld = [&](const float* W, int ldn, int k0, int n0, f32x4 (&v)[16]) {
#pragma unroll
        for (int i = 0; i < 16; ++i) v[i] = *(const f32x4*)(W + (size_t)(k0 + 16 * kq + i) * ldn + n0 + 4 * nq); };
    auto st = [&](unsigned char* dst, int ldd, int k0, int n0, bool gu, bool isu, const f32x4 (&v)[16]) {
#pragma unroll
        for (int j = 0; j < 4; ++j) { const int n = n0 + 4 * nq + j; const int row = gu ? (((n >> 2) << 3) + (n & 3) + (isu ? 4 : 0)) : n;
            u32x4 a; a.x = pk4_fp8(v[0][j] * 32.f, v[1][j] * 32.f, v[2][j] * 32.f, v[3][j] * 32.f); a.y = pk4_fp8(v[4][j] * 32.f, v[5][j] * 32.f, v[6][j] * 32.f, v[7][j] * 32.f);
            a.z = pk4_fp8(v[8][j] * 32.f, v[9][j] * 32.f, v[10][j] * 32.f, v[11][j] * 32.f); a.w = pk4_fp8(v[12][j] * 32.f, v[13][j] * 32.f, v[14][j] * 32.f, v[15][j] * 32.f);
            *(u32x4*)(dst + (size_t)row * ldd + k0 + 16 * kq) = a; } };
    for (int it = gw; it < NE * 256; it += 2 * ngw) { const int it2 = it + ngw; const bool two = it2 < NE * 256;
        const int e = it >> 8, q = it & 255, e2 = it2 >> 8, q2 = it2 & 255; const bool isu = q >= 128, isu2 = q2 >= 128;
        const int kb = (q & 127) >> 3, nb = q & 7, kb2 = (q2 & 127) >> 3, nb2 = q2 & 7;
        f32x4 va[16], vb[16];
        ld(P.in[isu ? I_WU : I_WG] + (size_t)e * 1024 * 512, 512, kb * 64, nb * 64, va);
        if (two) ld(P.in[isu2 ? I_WU : I_WG] + (size_t)e2 * 1024 * 512, 512, kb2 * 64, nb2 * 64, vb);
        st(ws + WS_WGU + (size_t)e * 1024 * 1024, 1024, kb * 64, nb * 64, true, isu, va);
        if (two) st(ws + WS_WGU + (size_t)e2 * 1024 * 1024, 1024, kb2 * 64, nb2 * 64, true, isu2, vb); }
    for (int it = gw; it < NE * 128; it += 2 * ngw) { const int it2 = it + ngw; const bool two = it2 < NE * 128;
        const int e = it >> 7, q = it & 127, e2 = it2 >> 7, q2 = it2 & 127; const int kb = q >> 4, nb = q & 15, kb2 = q2 >> 4, nb2 = q2 & 15;
        f32x4 va[16], vb[16];
        ld(P.in[I_WDN] + (size_t)e * 512 * 1024, 1024, kb * 64, nb * 64, va);
        if (two) ld(P.in[I_WDN] + (size_t)e2 * 512 * 1024, 1024, kb2 * 64, nb2 * 64, vb);
        st(ws + WS_WD + (size_t)e * 1024 * 512, 512, kb * 64, nb * 64, false, false, va);
        if (two) st(ws + WS_WD + (size_t)e2 * 1024 * 512, 512, kb2 * 64, nb2 * 64, false, false, vb); }
}
DEV void phase0(const Params& P, float* scr_all) { const int tid_ = tid_fresh();
    const int tid = tid_, lane = tid & 63, wave = tid >> 6;
    const int gw = blockIdx.x * NWAVE + wave, ngw = gridDim.x * NWAVE;
    float* scr = scr_all + wave * (64 * 33);
    unsigned char* ws = P.ws;
    constexpr int I_IN = 16 * 64, I_Q = 4 * 24, I_K = 4 * 16, I_V = 4 * 16, I_O = 16 * 32, I_GU = 16 * 32, I_DN = 8 * 32;
    constexpr int NITEMS = I_IN + I_Q + I_K + I_V + I_O;
    const float c2 = 0.07216878364870322f * 1.4426950408889634f;
    for (int it = gw; it < NITEMS; it += ngw) {
        int r = it;
        if (r < I_IN) { const float* W = P.in[I_WIN]; const int kb = r / 64, nb = r % 64;
            transpose_item([&](int k, int n) { const int s = zcol_src(wrow_to_zcol(n)); return s < 0 ? 0.f : W[(size_t)k * 2000 + s]; }, (bf16_t*)(ws + WS_WIN), 1024, kb * 64, nb * 32, scr, lane); continue; }
        r -= I_IN;
        if (r < I_Q) { const float* W = P.in[I_WQB]; const float* g = P.in[I_QN]; const int kb = r / 24, nb = r % 24;
            transpose_item([&](int k, int n) { int s; if (n < 512) s = (n >> 7) * 192 + (n & 127); else { const int q = n - 512, h = q >> 6, jj = q & 63; s = h * 192 + 128 + (jj >> 1) + 32 * (jj & 1); }
                return W[(size_t)k * 768 + s] * g[k] * c2; }, (bf16_t*)(ws + WS_WQ), 256, kb * 64, nb * 32, scr, lane); continue; }
        r -= I_Q;
        if (r < I_K + I_V) { const bool isv = r >= I_K; if (isv) r -= I_K; const float* W = P.in[I_WKVB]; const float* g = P.in[I_KVN]; const int kb = r / 16, nb = r % 16;
            transpose_item([&](int k, int n) { if (k >= 128) return 0.f; const int s = (n >> 7) * 256 + (isv ? 128 : 0) + (n & 127); return W[(size_t)k * 1024 + s] * g[k]; },
                           (bf16_t*)(ws + (isv ? WS_WV : WS_WK)), 256, kb * 64, nb * 32, scr, lane); continue; }
        r -= I_K + I_V;
        if (r < I_O) { const float* W = P.in[I_WOUT]; const int kb = r / 32, nb = r % 32;
            transpose_item([&](int k, int n) { return W[(size_t)k * 1024 + n]; }, (bf16_t*)(ws + WS_WOUT), 1024, kb * 64, nb * 32, scr, lane); continue; }
        r -= I_O;
        { }
    }
#if !XCONV_P3
    expert_convert(P, gw, ngw, lane);
#endif
    { const float* g = P.in[I_MIXN]; bf16_t* XN = (bf16_t*)(ws + WS_XN);
      f32x4 gv[4];
#pragma unroll
      for (int j = 0; j < 4; ++j) gv[j] = *(const f32x4*)(g + 256 * j + 4 * lane);
      for (int m0 = gw * 4; m0 < M; m0 += ngw * 4) {
        f32x4 v[4][4];
#pragma unroll
        for (int q = 0; q < 4; ++q)
#pragma unroll
            for (int j = 0; j < 4; ++j) v[q][j] = ((const f32x4*)(P.in[I_X] + (size_t)(m0 + q) * D) + lane)[64 * j];
#pragma unroll
        for (int q = 0; q < 4; ++q) { float s = 0.f;
#pragma unroll
            for (int j = 0; j < 4; ++j) s += (v[q][j].x * v[q][j].x + v[q][j].y * v[q][j].y) + (v[q][j].z * v[q][j].z + v[q][j].w * v[q][j].w);
            const float rs = rsqrtf(wave_sum(s) * (1.f / D) + EPS);
            unsigned long long* o8 = (unsigned long long*)(XN + (size_t)(m0 + q) * D) + lane;
#pragma unroll
            for (int j = 0; j < 4; ++j) o8[64 * j] = (unsigned long long)pk2(v[q][j].x * rs * gv[j].x, v[q][j].y * rs * gv[j].y) | ((unsigned long long)pk2(v[q][j].z * rs * gv[j].z, v[q][j].w * rs * gv[j].w) << 32); }
      } }
    const int gt = blockIdx.x * NT + tid, ngt = gridDim.x * NT;
    { float2* rt = (float2*)(ws + WS_ROPE);
      for (int i = gt; i < (SEQ + NMETA) * 32; i += ngt) { const int pos = i >> 5, f = i & 31;
        const double inv = pow(10000.0, -(double)(2 * f) / 64.0), ang = (double)pos * inv; rt[i] = make_float2((float)cos(ang), (float)sin(ang)); } }
    { bf16_t* wt = (bf16_t*)(ws + WS_WA2T); const float* wa2 = P.in[I_WA2];
      for (int i = gt; i < 256 * 128; i += ngt) { const int n = i >> 7, k = i & 127; wt[i] = (bf16_t)f2bf((k >= 64 && k < 80) ? wa2[(k - 64) * 256 + n] : 0.f); } }
    { bf16_t* wr = (bf16_t*)(ws + WS_WR); const float* wg = P.in[I_RGW]; const float* we = P.in[I_REW];
      for (int i = gt; i < 96 * D; i += ngt) { const int row = i >> 10, k = i & 1023, t = row >> 5, rho = row & 31, hi = (rho >> 2) & 1, r = (rho & 3) + 4 * (rho >> 3);
        float v = 0.f; if (t < 2) v = we[k * 64 + 8 * (4 * t + 2 * hi + (r >> 3)) + (r & 7)]; else if (hi == 0 && r < 8) v = wg[k * 8 + r];
        wr[i] = (bf16_t)f2bf(v * P.in[I_FFN][k]); } }
    { float* mz = (float*)(ws + WS_CTL + CTL_MZ); float* rsm = (float*)(ws + WS_CTL + CTL_RSM); const float* mt = P.in[I_META]; const float* g = P.in[I_MIXN]; const float* W = P.in[I_WIN];
      for (int it = gt; it < 32 * 1024; it += ngt) { const int ks = it >> 10, ci = it & 1023; const int n = ci < 768 ? ZK + ci : ZKVL + (ci - 768); const int s = (ci < 976) ? zcol_src(n) : -1;
        if (s >= 0) { float acc[NMETA];
#pragma unroll
            for (int r = 0; r < NMETA; ++r) acc[r] = 0.f;
#pragma unroll 4
            for (int k = ks * 32; k < ks * 32 + 32; ++k) { const float w = W[(size_t)k * 2000 + s] * g[k];
#pragma unroll
                for (int r = 0; r < NMETA; ++r) acc[r] += mt[r * D + k] * w; }
#pragma unroll
            for (int r = 0; r < NMETA; ++r) atomicAdd(mz + r * NZ + n, acc[r]); } }
      if (gw < NMETA) { float ss = 0.f;
#pragma unroll
        for (int j = 0; j < 16; ++j) { const float x = mt[gw * D + 64 * j + lane]; ss += x * x; }
        ss = wave_sum(ss); if (lane == 0) rsm[gw] = rsqrtf(ss * (1.f / D) + EPS); } }
}

DEV void meta_phase(const Params& P) { const int tid_ = tid_fresh();
    unsigned char* ws = P.ws; const int gt = blockIdx.x * NT + tid_, ngt = gridDim.x * NT;
    const float* mzr = (const float*)(ws + WS_CTL + CTL_MZ); const float* rsm = (const float*)(ws + WS_CTL + CTL_RSM);
    bf16_t* KNm = (bf16_t*)(ws + WS_META + MT_KN); bf16_t* VTm = (bf16_t*)(ws + WS_META + MT_VT); bf16_t* KRm = (bf16_t*)(ws + WS_META + MT_KR); float* S1 = (float*)(ws + WS_META + MT_S1);
    const float* Wkv = P.in[I_WKVB]; const float* gk = P.in[I_KVN];
    for (int i = gt; i < NMETA * 1024; i += ngt) { const int row = i >> 10, col = i & 1023; const float* z = mzr + row * NZ + ZKVL; const float rm = rsm[row];
        float ss = 0.f, acc = 0.f;
#pragma unroll 16
        for (int k = 0; k < 128; ++k) { const float zk = z[k] * rm; ss += zk * zk; acc += zk * gk[k] * Wkv[(size_t)k * 1024 + col]; }
        acc *= rsqrtf(ss * (1.f / 128.f) + EPS);
        const int h = col >> 8, w = col & 255;
        unsigned char* KN8m = ws + WS_META + MT_KN8; unsigned char* VT8m = ws + WS_META + MT_VT8;
        if (w < 128) { KNm[row * 512 + h * 128 + w] = (bf16_t)f2bf(acc); KNm[(row + 16) * 512 + h * 128 + w] = 0; KN8m[row * 512 + h * 128 + w] = f2fp8(acc); KN8m[(row + 16) * 512 + h * 128 + w] = 0; }
        else { VTm[(h * 128 + w - 128) * 32 + row] = (bf16_t)f2bf(acc); VTm[(h * 128 + w - 128) * 32 + 16 + row] = 0; VT8m[(h * 128 + w - 128) * 32 + row] = f2fp8(acc); VT8m[(h * 128 + w - 128) * 32 + 16 + row] = 0; } }
    const float2* rt = (const float2*)(ws + WS_ROPE);
    for (int i = gt; i < NMETA * 32; i += ngt) { const int row = i >> 5, f = i & 31; const float x1 = mzr[row * NZ + ZKR + 2 * f] * rsm[row], x2 = mzr[row * NZ + ZKR + 2 * f + 1] * rsm[row]; const float2 cs = rt[row * 32 + f];
        KRm[row * 64 + 2 * f] = (bf16_t)f2bf(x1 * cs.x - x2 * cs.y); KRm[row * 64 + 2 * f + 1] = (bf16_t)f2bf(x2 * cs.x + x1 * cs.y); KRm[(row + 16) * 64 + 2 * f] = 0; KRm[(row + 16) * 64 + 2 * f + 1] = 0;
        unsigned char* KR8m = ws + WS_META + MT_KR8; KR8m[row * 64 + 2 * f] = f2fp8(x1 * cs.x - x2 * cs.y); KR8m[row * 64 + 2 * f + 1] = f2fp8(x2 * cs.x + x1 * cs.y); KR8m[(row + 16) * 64 + 2 * f] = 0; KR8m[(row + 16) * 64 + 2 * f + 1] = 0; }
    const float* wa2 = P.in[I_WA2]; const float* ba = P.in[I_BA];
    for (int i = gt; i < 4 * 64 * 128; i += ngt) { const int h = i >> 13, d = (i >> 7) & 63, e = i & 127; float S = 0.f;
        for (int s = 0; s < NMETA; ++s) { const float* z = mzr + s * NZ; const float rm = rsm[s]; float x = 0.f;
            for (int r = 0; r < 16; ++r) x += z[ZAL + r] * wa2[r * 256 + h * 64 + d];
            x = x * rm + ba[h * 64 + d];
            const float a = __expf((fminf(x, 0.f) - __logf(1.f + __expf(-fabsf(x)))) * (1.f / 16.f)); S = a * S + (z[ZK + h * 64 + d] * rm) * (z[ZV + h * 128 + e] * rm); }
        S1[i] = S; }
}
DEV void phase1(const Params& P) { const int tid_ = tid_fresh();
    unsigned char* ws = P.ws; const int gw = blockIdx.x * NWAVE + (tid_ >> 6), ngw = gridDim.x * NWAVE;
    const bf16_t* XN = (const bf16_t*)(ws + WS_XN); const bf16_t* W = (const bf16_t*)(ws + WS_WIN); bf16_t* Z = (bf16_t*)P.out;
    gemm_simple(M / 64, NZ / 64, D, [&](int r) { return XN + (size_t)r * D; }, [&](int c) { return W + (size_t)c * D; },
                [&](int row, int col, float v) { Z[(size_t)row * NZ + col] = (bf16_t)f2bf(v); }, gw, ngw);
    meta_phase(P);
}
DEV void phase2a(const Params& P) { const int tid_ = tid_fresh();
    unsigned char* ws = P.ws; const int lane = tid_ & 63; const int gw = blockIdx.x * NWAVE + (tid_ >> 6), ngw = gridDim.x * NWAVE;
    const bf16_t* Z = (const bf16_t*)P.out; float* rsq = (float*)(ws + WS_RS); float* rskv = rsq + M; bf16_t* KR = (bf16_t*)(ws + WS_KR); float* LOGA = (float*)(ws + WS_LOGA);
    const float2* rt = (const float2*)(ws + WS_ROPE); const float* wa2 = P.in[I_WA2]; const float* ba = P.in[I_BA];
    float w[4][16], bb[4];
#pragma unroll
    for (int j = 0; j < 4; ++j) { bb[j] = ba[64 * j + lane];
#pragma unroll
        for (int r = 0; r < 16; ++r) w[j][r] = wa2[r * 256 + 64 * j + lane]; }
    for (int m = gw; m < M; m += ngw) { const bf16_t* z = Z + (size_t)m * NZ;
        float s = 0.f;
#pragma unroll
        for (int j = 0; j < 4; ++j) { const float v = bf2f(z[ZQL + 64 * j + lane]); s += v * v; }
        s = wave_sum(s); float s2 = 0.f;
#pragma unroll
        for (int j = 0; j < 2; ++j) { const float v = bf2f(z[ZKVL + 64 * j + lane]); s2 += v * v; }
        s2 = wave_sum(s2);
        if (lane == 0) { rsq[m] = rsqrtf(s * (1.f / 256.f) + EPS); rskv[m] = rsqrtf(s2 * (1.f / 128.f) + EPS); }
        { const float v = bf2f(z[ZKR + lane]), o = sx<1>(v); const float2 cs = rt[(NMETA + (m & (SEQ - 1))) * 32 + (lane >> 1)];
          KR[(size_t)m * 64 + lane] = (bf16_t)f2bf((lane & 1) ? (v * cs.x + o * cs.y) : (v * cs.x - o * cs.y)); }
        float al[16];
#pragma unroll
        for (int r = 0; r < 16; ++r) al[r] = bf2f(z[ZAL + r]);
#pragma unroll
        for (int j = 0; j < 4; ++j) { float x = bb[j];
#pragma unroll
            for (int r = 0; r < 16; ++r) x += al[r] * w[j][r];
            LOGA[(size_t)m * 256 + 64 * j + lane] = logsigmoidf(x) * (1.f / 16.f); }
    }
}
DEV void phase2b(const Params& P) { const int tid_ = tid_fresh();
    unsigned char* ws = P.ws; const int gw = blockIdx.x * NWAVE + (tid_ >> 6), ngw = gridDim.x * NWAVE;
    const bf16_t* Z = (const bf16_t*)P.out; const float* rsq = (const float*)(ws + WS_RS); const float* rskv = rsq + M;
    const float2* rt = (const float2*)(ws + WS_ROPE);
    { bf16_t* QM = (bf16_t*)(ws + WS_QM); const bf16_t* W = (const bf16_t*)(ws + WS_WQ);
      gemm_simple(M / 64, 768 / 64, 256, [&](int r) { return Z + (size_t)r * NZ + ZQL; }, [&](int c) { return W + (size_t)c * 256; },
                  [&](int row, int col, float v) { v *= rsq[row]; const float o = sx<1>(v);
                      if (col >= 512) { const float2 cs = rt[(NMETA + (row & (SEQ - 1))) * 32 + ((col & 63) >> 1)]; v = (col & 1) ? (v * cs.x + o * cs.y) : (v * cs.x - o * cs.y); }
                      QM[(size_t)row * 768 + col] = (bf16_t)f2bf(v); }, gw, ngw); }
    { bf16_t* KN = (bf16_t*)(ws + WS_KN); const bf16_t* W = (const bf16_t*)(ws + WS_WK);
      gemm_simple(M / 64, 512 / 64, 256, [&](int r) { return Z + (size_t)r * NZ + ZKVL; }, [&](int c) { return W + (size_t)c * 256; },
                  [&](int row, int col, float v) { KN[(size_t)row * 512 + col] = (bf16_t)f2bf(v * rskv[row]); }, gw, ngw); }
    { bf16_t* VT = (bf16_t*)(ws + WS_VT); const bf16_t* W = (const bf16_t*)(ws + WS_WV);
      gemm_simple(512 / 64, M / 64, 256, [&](int r) { return W + (size_t)r * 256; }, [&](int c) { return Z + (size_t)c * NZ + ZKVL; },
                  [&](int row, int col, float v) { VT[(size_t)row * M + col] = (bf16_t)f2bf(v * rskv[col]); }, gw, ngw); }
}
DEV void gla_simple(const Params& P) { const int tid_ = tid_fresh();
    unsigned char* ws = P.ws; const int tid = tid_;
    const bf16_t* Z = (const bf16_t*)P.out; const float* LOGA = (const float*)(ws + WS_LOGA); const float* S1 = (const float*)(ws + WS_META + MT_S1); bf16_t* Y = (bf16_t*)(ws + WS_Y);
    for (int u = blockIdx.x; u < NB * 4; u += gridDim.x) { const int b = u >> 2, h = u & 3, e = tid >> 2, dq = tid & 3;
        float S[16];
#pragma unroll
        for (int j = 0; j < 16; ++j) S[j] = S1[(h * 64 + dq * 16 + j) * 128 + e];
        for (int t = 0; t < SEQ; ++t) { const size_t m = (size_t)b * SEQ + t; const bf16_t* z = Z + m * NZ;
            const u32x4 q0 = *(const u32x4*)(z + ZQ + h * 64 + dq * 16), q1 = *(const u32x4*)(z + ZQ + h * 64 + dq * 16 + 8);
            const u32x4 k0 = *(const u32x4*)(z + ZK + h * 64 + dq * 16), k1 = *(const u32x4*)(z + ZK + h * 64 + dq * 16 + 8);
            const f32x4* la = (const f32x4*)(LOGA + m * 256 + h * 64 + dq * 16);
            const float v = bf2f(z[ZV + h * 128 + e]);
            const unsigned qq[8] = {q0.x, q0.y, q0.z, q0.w, q1.x, q1.y, q1.z, q1.w}, kk[8] = {k0.x, k0.y, k0.z, k0.w, k1.x, k1.y, k1.z, k1.w};
            float o = 0.f;
#pragma unroll
            for (int j4 = 0; j4 < 4; ++j4) { const f32x4 l4 = la[j4];
#pragma unroll
                for (int jj = 0; jj < 4; ++jj) { const int j = j4 * 4 + jj; const unsigned qw = qq[j >> 1], kw = kk[j >> 1];
                    const float qv = (j & 1) ? __uint_as_float(qw & 0xffff0000u) : __uint_as_float(qw << 16), kv = (j & 1) ? __uint_as_float(kw & 0xffff0000u) : __uint_as_float(kw << 16);
                    S[j] = __expf(l4[jj]) * S[j] + kv * v; o += qv * S[j]; } }
            o += sx<1>(o); o += sx<2>(o);
            if (dq == 0) Y[m * 1024 + h * 128 + e] = (bf16_t)f2bf(o * 0.125f); }
    }
}
DEV void gla_fast(const Params& P) {
    typedef float f32x2 __attribute__((ext_vector_type(2)));
    unsigned char* ws = P.ws; const int tid_ = tid_fresh(); const int lane = tid_ & 63, wave = tid_ >> 6, dg = lane & 15, es = lane >> 4;
    const bf16_t* Z = (const bf16_t*)P.out; const float* AEXP = (const float*)(ws + WS_LOGA); const float* S1 = (const float*)(ws + WS_META + MT_S1); bf16_t* Y = (bf16_t*)(ws + WS_Y);
    for (int u = blockIdx.x; u < NB * 16; u += gridDim.x) { const int b = u >> 4, h = (u >> 2) & 3, e = (u & 3) * 32 + wave * 4 + es;
        f32x2 S01, S23;
        S01.x = S1[(h * 64 + dg * 4 + 0) * 128 + e]; S01.y = S1[(h * 64 + dg * 4 + 1) * 128 + e]; S23.x = S1[(h * 64 + dg * 4 + 2) * 128 + e]; S23.y = S1[(h * 64 + dg * 4 + 3) * 128 + e];
        const bf16_t* zq = Z + (size_t)b * SEQ * NZ + ZQ + h * 64 + dg * 4; const bf16_t* zk = Z + (size_t)b * SEQ * NZ + ZK + h * 64 + dg * 4; const bf16_t* zv = Z + (size_t)b * SEQ * NZ + ZV + h * 128 + e;
        const float* ap = AEXP + (size_t)b * SEQ * 256 + h * 64 + dg * 4; bf16_t* yp = Y + (size_t)b * SEQ * 1024 + h * 128 + e;
        u32x2 qA[8], kA[8], qB[8], kB[8]; f32x4 aA[8], aB[8]; unsigned short vA[8], vB[8];
#define GLA_LOAD(q, k, a, v, t0) do { _Pragma("unroll") for (int i = 0; i < 8; ++i) { const size_t t = (size_t)(t0) + i; q[i] = *(const u32x2*)(zq + t * NZ); k[i] = *(const u32x2*)(zk + t * NZ); a[i] = *(const f32x4*)(ap + t * 256); v[i] = zv[t * NZ]; } } while (0)
#define GLA_COMP(q, k, a, v, t0) do { _Pragma("unroll") for (int i = 0; i < 8; ++i) { const float vv = bf2f(v[i]); \
            const f32x2 q01 = {__uint_as_float(q[i].x << 16), __uint_as_float(q[i].x & 0xffff0000u)}, q23 = {__uint_as_float(q[i].y << 16), __uint_as_float(q[i].y & 0xffff0000u)}; \
            const f32x2 k01 = {__uint_as_float(k[i].x << 16), __uint_as_float(k[i].x & 0xffff0000u)}, k23 = {__uint_as_float(k[i].y << 16), __uint_as_float(k[i].y & 0xffff0000u)}; \
            const f32x2 a01 = {a[i][0], a[i][1]}, a23 = {a[i][2], a[i][3]}; \
            S01 = a01 * S01 + k01 * vv; S23 = a23 * S23 + k23 * vv; \
            const f32x2 p = q01 * S01 + q23 * S23; float o = p.x + p.y; \
            o += dpp_f<0x128>(o); o += dpp_f<0x124>(o); o += dpp_f<0x4E>(o); o += dpp_f<0xB1>(o); \
            if (dg == 0) yp[(size_t)((t0) + i) * 1024] = (bf16_t)f2bf(o * 0.125f); } } while (0)
        GLA_LOAD(qA, kA, aA, vA, 0);
        for (int t0 = 0; t0 < SEQ; t0 += 16) {
            GLA_LOAD(qB, kB, aB, vB, t0 + 8);
            GLA_COMP(qA, kA, aA, vA, t0);
            if (t0 + 16 < SEQ) GLA_LOAD(qA, kA, aA, vA, t0 + 16);
            GLA_COMP(qB, kB, aB, vB, t0 + 8);
        }
#undef GLA_LOAD
#undef GLA_COMP
    }
}
DEV void mla_simple(const Params& P) { const int tid_ = tid_fresh();
    unsigned char* ws = P.ws; const int lane = tid_ & 63, r32 = lane & 31, hi = lane >> 5; const int gw = blockIdx.x * NWAVE + (tid_ >> 6), ngw = gridDim.x * NWAVE;
    const bf16_t* QM = (const bf16_t*)(ws + WS_QM); const bf16_t* KN = (const bf16_t*)(ws + WS_KN); const bf16_t* VT = (const bf16_t*)(ws + WS_VT); const bf16_t* KR = (const bf16_t*)(ws + WS_KR);
    const bf16_t* KNm = (const bf16_t*)(ws + WS_META + MT_KN); const bf16_t* VTm = (const bf16_t*)(ws + WS_META + MT_VT); const bf16_t* KRm = (const bf16_t*)(ws + WS_META + MT_KR);
    bf16_t* Y = (bf16_t*)(ws + WS_Y);
    const int kperm = pi23(r32);
    for (int w = gw; w < 2048; w += ngw) { const int bh = w >> 5, s5 = w & 31, b = bh >> 2, h = bh & 3;
        for (int ui = 0; ui < 4; ++ui) { const int i = (ui == 0) ? s5 : (ui == 1) ? 63 - s5 : (ui == 2) ? 64 + s5 : 127 - s5;
            const size_t mq = (size_t)b * SEQ + i * 32 + r32;
            bf16x8 qf[12];
#pragma unroll
            for (int s = 0; s < 8; ++s) qf[s] = *(const bf16x8*)(QM + mq * 768 + h * 128 + 16 * s + 8 * hi);
#pragma unroll
            for (int s = 0; s < 4; ++s) qf[8 + s] = *(const bf16x8*)(QM + mq * 768 + 512 + h * 64 + 16 * s + 8 * hi);
            f32x16 O[4] = {}; float mrun = -INFINITY, l = 0.f;
            const int ntile = 2 * (1 + (i >> 1));
            for (int j = -1; j < ntile; ++j) {
                f32x16 S = {};
                if (j < 0) { const bool ok = kperm < NMETA; const bf16x8 zf = {};
#pragma unroll
                    for (int s = 0; s < 8; ++s) { const bf16x8 kf = ok ? *(const bf16x8*)(KNm + kperm * 512 + h * 128 + 16 * s + 8 * hi) : zf; S = __builtin_amdgcn_mfma_f32_32x32x16_bf16(kf, qf[s], S, 0, 0, 0); }
#pragma unroll
                    for (int s = 0; s < 4; ++s) { const bf16x8 kf = ok ? *(const bf16x8*)(KRm + kperm * 64 + 16 * s + 8 * hi) : zf; S = __builtin_amdgcn_mfma_f32_32x32x16_bf16(kf, qf[8 + s], S, 0, 0, 0); }
#pragma unroll
                    for (int r = 0; r < 16; ++r) if (pi23(crow(r, hi)) >= NMETA) S[r] = -INFINITY;
                } else { const size_t mk = (size_t)b * SEQ + j * 32 + kperm;
#pragma unroll
                    for (int s = 0; s < 8; ++s) { const bf16x8 kf = *(const bf16x8*)(KN + mk * 512 + h * 128 + 16 * s + 8 * hi); S = __builtin_amdgcn_mfma_f32_32x32x16_bf16(kf, qf[s], S, 0, 0, 0); }
#pragma unroll
                    for (int s = 0; s < 4; ++s) { const bf16x8 kf = *(const bf16x8*)(KR + mk * 64 + 16 * s + 8 * hi); S = __builtin_amdgcn_mfma_f32_32x32x16_bf16(kf, qf[8 + s], S, 0, 0, 0); }
                }
                float mx = S[0];
#pragma unroll
                for (int r = 1; r < 16; ++r) mx = fmaxf(mx, S[r]);
                mx = half_max(mx);
                const float mnew = fmaxf(mrun, mx), alpha = exp2f(mrun - mnew); mrun = mnew;
                float ps = 0.f;
#pragma unroll
                for (int r = 0; r < 16; ++r) { S[r] = exp2f(S[r] - mnew); ps += S[r]; }
                l = l * alpha + ps;
#pragma unroll
                for (int d = 0; d < 4; ++d)
#pragma unroll
                    for (int r = 0; r < 16; ++r) O[d][r] *= alpha;
                u32x4 p0, p1;
                p0.x = pk2(S[0], S[1]); p0.y = pk2(S[2], S[3]); p0.z = pk2(S[4], S[5]); p0.w = pk2(S[6], S[7]);
                p1.x = pk2(S[8], S[9]); p1.y = pk2(S[10], S[11]); p1.z = pk2(S[12], S[13]); p1.w = pk2(S[14], S[15]);
                const bf16x8 pf0 = __builtin_bit_cast(bf16x8, p0), pf1 = __builtin_bit_cast(bf16x8, p1);
#pragma unroll
                for (int d = 0; d < 4; ++d) {
                    bf16x8 v0, v1;
                    if (j < 0) { const bf16x8 zf = {}; v0 = *(const bf16x8*)(VTm + (h * 128 + 32 * d + r32) * 32 + 8 * hi); v1 = zf; }
                    else { const bf16_t* vp = VT + (size_t)(h * 128 + 32 * d + r32) * M + (size_t)b * SEQ + j * 32 + 8 * hi; v0 = *(const bf16x8*)vp; v1 = *(const bf16x8*)(vp + 16); }
                    O[d] = __builtin_amdgcn_mfma_f32_32x32x16_bf16(v0, pf0, O[d], 0, 0, 0);
                    O[d] = __builtin_amdgcn_mfma_f32_32x32x16_bf16(v1, pf1, O[d], 0, 0, 0);
                }
            }
            l = half_sum(l); const float rl = 1.f / l;
#pragma unroll
            for (int d = 0; d < 4; ++d)
#pragma unroll
                for (int r = 0; r < 16; ++r) Y[mq * 1024 + 512 + h * 128 + 32 * d + crow(r, hi)] = (bf16_t)f2bf(O[d][r] * rl);
        }
    }
}
DEV void phase3b(const Params& P) { const int tid_ = tid_fresh();
    unsigned char* ws = P.ws; const int lane = tid_ & 63; const int gw = blockIdx.x * NWAVE + (tid_ >> 6), ngw = gridDim.x * NWAVE;
    const bf16_t* Z = (const bf16_t*)P.out; bf16_t* Y = (bf16_t*)(ws + WS_Y); const float* g = P.in[I_GOUTN];
    float gv[8];
#pragma unroll
    for (int j = 0; j < 8; ++j) gv[j] = g[8 * lane + j];
    for (int m = gw; m < M; m += ngw) {
        const u32x4 o4 = *(const u32x4*)(Y + (size_t)m * 1024 + 8 * lane), r4 = *(const u32x4*)(Z + (size_t)m * NZ + ZR + 8 * lane);
        const unsigned ow[4] = {o4.x, o4.y, o4.z, o4.w}, rw[4] = {r4.x, r4.y, r4.z, r4.w}; float o[8], r[8]; float s = 0.f;
#pragma unroll
        for (int j = 0; j < 4; ++j) { o[2 * j] = __uint_as_float(ow[j] << 16); o[2 * j + 1] = __uint_as_float(ow[j] & 0xffff0000u); r[2 * j] = __uint_as_float(rw[j] << 16); r[2 * j + 1] = __uint_as_float(rw[j] & 0xffff0000u); }
#pragma unroll
        for (int j = 0; j < 8; ++j) s += o[j] * o[j];
        s += sx<1>(s); s += sx<2>(s); s += sx<4>(s); s += sx<8>(s);
        const float rs = rsqrtf(s * (1.f / 128.f) + EPS);
        u32x4 w; float y[8];
#pragma unroll
        for (int j = 0; j < 8; ++j) y[j] = o[j] * rs * gv[j] * siluf(r[j]);
        w.x = pk2(y[0], y[1]); w.y = pk2(y[2], y[3]); w.z = pk2(y[4], y[5]); w.w = pk2(y[6], y[7]);
        *(u32x4*)(Y + (size_t)m * 1024 + 8 * lane) = w;
    }
}
DEV void phase4(const Params& P) { const int tid_ = tid_fresh();
    unsigned char* ws = P.ws; const int gw = blockIdx.x * NWAVE + (tid_ >> 6), ngw = gridDim.x * NWAVE;
    const bf16_t* Y = (const bf16_t*)(ws + WS_Y); const bf16_t* W = (const bf16_t*)(ws + WS_WOUT); float* H2 = (float*)(ws + WS_H2); const float* x = P.in[I_X];
    gemm_simple(M / 64, D / 64, D, [&](int r) { return Y + (size_t)r * D; }, [&](int c) { return W + (size_t)c * D; },
                [&](int row, int col, float v) { H2[(size_t)row * D + col] = x[(size_t)row * D + col] + v; }, gw, ngw);
}
DEV void phase5(const Params& P, float* scr_all) { const int tid_ = tid_fresh();
    unsigned char* ws = P.ws; const int lane = tid_ & 63, wave = tid_ >> 6; const int gw = blockIdx.x * NWAVE + wave, ngw = gridDim.x * NWAVE;
    float* trow = scr_all + wave * 4096;
    const float* H2 = (const float*)(ws + WS_H2); bf16_t* TN = (bf16_t*)(ws + WS_TN); const float* g = P.in[I_FFN];
    const float* wg = P.in[I_RGW]; const float* bg = P.in[I_RGB]; const float* we = P.in[I_REW]; const float* be = P.in[I_REB];
    int* cnt = (int*)(ws + WS_CTL) + CW_CNT; int* tokE = (int*)(ws + WS_TOK); int* tokR = tokE + 2 * M; float* tokG = (float*)(tokR + 2 * M); int* list = (int*)(ws + WS_LIST);
    f32x4 gv[4];
#pragma unroll
    for (int j = 0; j < 4; ++j) gv[j] = *(const f32x4*)(g + 256 * j + 4 * lane);
    for (int m0 = gw * 4; m0 < M; m0 += ngw * 4) {
#pragma unroll
        for (int q = 0; q < 4; ++q) { const int m = m0 + q; const f32x4* hr = (const f32x4*)(H2 + (size_t)m * D) + lane; f32x4 v[4]; float s = 0.f;
#pragma unroll
            for (int j = 0; j < 4; ++j) { v[j] = hr[64 * j]; s += (v[j].x * v[j].x + v[j].y * v[j].y) + (v[j].z * v[j].z + v[j].w * v[j].w); }
            const float rs = rsqrtf(wave_sum(s) * (1.f / D) + EPS);
            unsigned long long* o8 = (unsigned long long*)(TN + (size_t)m * D) + lane;
#pragma unroll
            for (int j = 0; j < 4; ++j) { const f32x4 t = {v[j].x * rs * gv[j].x, v[j].y * rs * gv[j].y, v[j].z * rs * gv[j].z, v[j].w * rs * gv[j].w};
                *(f32x4*)(trow + q * 1024 + 256 * j + 4 * lane) = t;
                o8[64 * j] = (unsigned long long)pk2(t.x, t.y) | ((unsigned long long)pk2(t.z, t.w) << 32); } }
        __builtin_amdgcn_s_waitcnt(0xc07f); asm volatile("" ::: "memory");
        float ae[4] = {0.f, 0.f, 0.f, 0.f}, ag[4] = {0.f, 0.f, 0.f, 0.f};
        for (int k = 0; k < D; ++k) { const float w = we[k * 64 + lane];
#pragma unroll
            for (int q = 0; q < 4; ++q) ae[q] += trow[q * 1024 + k] * w; }
        for (int k8 = 0; k8 < D / 8; ++k8) { const int k = k8 * 8 + (lane >> 3); const float w = wg[k * 8 + (lane & 7)];
#pragma unroll
            for (int q = 0; q < 4; ++q) ag[q] += trow[q * 1024 + k] * w; }
#pragma unroll
        for (int q = 0; q < 4; ++q) { ag[q] += sx<8>(ag[q]); ag[q] += sx<16>(ag[q]); ag[q] = half_sum(ag[q]); ag[q] += bg[lane & 7]; ae[q] += be[lane]; }
#pragma unroll
        for (int q = 0; q < 4; ++q) { const int m = m0 + q;
            float gl[8]; float gmx = -INFINITY; int gi = 0;
#pragma unroll
            for (int i = 0; i < 8; ++i) { gl[i] = rl_f(ag[q], i); if (gl[i] > gmx) { gmx = gl[i]; gi = i; } }
            float gs = 0.f;
#pragma unroll
            for (int i = 0; i < 8; ++i) gs += __expf(gl[i] - gmx);
            const float gp = 1.f / gs;
            const int gis = __builtin_amdgcn_readfirstlane(gi); float el[8]; float emx = -INFINITY; int e0 = 0;
#pragma unroll
            for (int i = 0; i < 8; ++i) { el[i] = rl_f(ae[q], gis * 8 + i); if (el[i] > emx) { emx = el[i]; e0 = i; } }
            float em2 = -INFINITY; int e1 = 0;
#pragma unroll
            for (int i = 0; i < 8; ++i) if (i != e0 && el[i] > em2) { em2 = el[i]; e1 = i; }
            const float p0 = 1.f, p1 = __expf(em2 - emx); const float g0 = gp * p0 / (p0 + p1), g1 = gp * p1 / (p0 + p1);
            if (lane == 0) { const int E0 = gi * 8 + e0, E1 = gi * 8 + e1; const int r0 = atomicAdd(cnt + E0, 1), r1 = atomicAdd(cnt + E1, 1);
                tokE[2 * m] = E0; tokE[2 * m + 1] = E1; tokR[2 * m] = r0; tokR[2 * m + 1] = r1; tokG[2 * m] = g0; tokG[2 * m + 1] = g1;
                list[(size_t)E0 * M + r0] = m; list[(size_t)E1 * M + r1] = m; } }
        __builtin_amdgcn_s_waitcnt(0xc07f); asm volatile("" ::: "memory");
    }
}
DEV void route_emit(int m, int E0, int E1, float g0, float g1, int* cnt, int* tokE, int* tokR, float* tokG, int* list) {
    const int r0 = atomicAdd(cnt + E0, 1), r1 = atomicAdd(cnt + E1, 1);
    tokE[2 * m] = E0; tokE[2 * m + 1] = E1; tokR[2 * m] = r0; tokR[2 * m + 1] = r1; tokG[2 * m] = g0; tokG[2 * m + 1] = g1;
    list[(size_t)E0 * M + r0] = m; list[(size_t)E1 * M + r1] = m;
}
DEV void phase5_fast(const Params& P) {
    constexpr float TAU = 0.015f;
    unsigned char* ws = P.ws; const int tid_ = tid_fresh(); const int lane = tid_ & 63, r32 = lane & 31, hi = lane >> 5; const int gw = blockIdx.x * NWAVE + (tid_ >> 6), ngw = gridDim.x * NWAVE;
    const float* X = P.in[I_X]; const bf16_t* D16 = (const bf16_t*)(ws + WS_D16); bf16_t* H2B = (bf16_t*)(ws + WS_H2B); unsigned char* TN8 = (unsigned char*)(ws + WS_TN8); const float* g = P.in[I_FFN]; const bf16_t* WR = (const bf16_t*)(ws + WS_WR);
    const float* wg = P.in[I_RGW]; const float* bg = P.in[I_RGB]; const float* we = P.in[I_REW]; const float* be = P.in[I_REB];
    int* cnt = (int*)(ws + WS_CTL) + CW_CNT; int* tokE = (int*)(ws + WS_TOK); int* tokR = tokE + 2 * M; float* tokG = (float*)(tokR + 2 * M); int* list = (int*)(ws + WS_LIST);
    f32x4 gv[4];
#pragma unroll
    for (int j = 0; j < 4; ++j) gv[j] = *(const f32x4*)(g + 256 * j + 4 * lane);
    for (int blk = gw; blk < M / 32; blk += ngw) { const int m0 = blk * 32; float rsk = 0.f;
        for (int q0 = 0; q0 < 32; q0 += 4) {
            f32x4 v[4][4];
#pragma unroll
            for (int q = 0; q < 4; ++q)
#pragma unroll
                for (int j = 0; j < 4; ++j) { const size_t off = (size_t)(m0 + q0 + q) * D + 256 * j + 4 * lane; const u32x2 dd = *(const u32x2*)(D16 + off); const f32x4 xx = *(const f32x4*)(X + off);
                    v[q][j] = (f32x4){xx.x + __uint_as_float(dd.x << 16), xx.y + __uint_as_float(dd.x & 0xffff0000u), xx.z + __uint_as_float(dd.y << 16), xx.w + __uint_as_float(dd.y & 0xffff0000u)}; }
#pragma unroll
            for (int q = 0; q < 4; ++q) { float s = 0.f;
                { unsigned long long* h8 = (unsigned long long*)(H2B + (size_t)(m0 + q0 + q) * D) + lane;
#pragma unroll
                  for (int j = 0; j < 4; ++j) h8[64 * j] = (unsigned long long)pk2(v[q][j].x, v[q][j].y) | ((unsigned long long)pk2(v[q][j].z, v[q][j].w) << 32); }
#pragma unroll
                for (int j = 0; j < 4; ++j) s += (v[q][j].x * v[q][j].x + v[q][j].y * v[q][j].y) + (v[q][j].z * v[q][j].z + v[q][j].w * v[q][j].w);
                const float rs = rsqrtf(wave_sum(s) * (1.f / D) + EPS); rsk = (q0 + q == r32) ? rs : rsk;
                unsigned* t8 = (unsigned*)(TN8 + (size_t)(m0 + q0 + q) * D) + lane;
#pragma unroll
                for (int j = 0; j < 4; ++j) { const float t0 = v[q][j].x * rs * gv[j].x, t1 = v[q][j].y * rs * gv[j].y, t2 = v[q][j].z * rs * gv[j].z, t3 = v[q][j].w * rs * gv[j].w;
                    t8[64 * j] = pk4_fp8(t0, t1, t2, t3); } }
        }
        asm volatile("s_waitcnt vmcnt(0)" ::: "memory");
        f32x16 a0 = {}, a1 = {}, a2 = {};
        { const bf16_t* tb = H2B + (size_t)(m0 + r32) * D + 8 * hi; const bf16_t* wa = WR + (size_t)r32 * D + 8 * hi;
#pragma unroll 4
          for (int k = 0; k < D; k += 16) { const bf16x8 bf = *(const bf16x8*)(tb + k);
              a0 = __builtin_amdgcn_mfma_f32_32x32x16_bf16(*(const bf16x8*)(wa + k), bf, a0, 0, 0, 0);
              a1 = __builtin_amdgcn_mfma_f32_32x32x16_bf16(*(const bf16x8*)(wa + 32 * D + k), bf, a1, 0, 0, 0);
              a2 = __builtin_amdgcn_mfma_f32_32x32x16_bf16(*(const bf16x8*)(wa + 64 * D + k), bf, a2, 0, 0, 0); } }
#pragma unroll
        for (int r = 0; r < 16; ++r) { a0[r] *= rsk; a1[r] *= rsk; a2[r] *= rsk; }
        const int m = m0 + r32;
        float gl[8]; float gmx = -INFINITY, gm2 = -INFINITY; int gi = 0;
#pragma unroll
        for (int i = 0; i < 8; ++i) { auto rr = __builtin_amdgcn_permlane32_swap(__float_as_uint(a2[i]), __float_as_uint(a2[i]), false, false); gl[i] = __uint_as_float(rr[0]) + bg[i]; }
#pragma unroll
        for (int i = 0; i < 8; ++i) { if (gl[i] > gmx) { gm2 = gmx; gmx = gl[i]; gi = i; } else if (gl[i] > gm2) gm2 = gl[i]; }
        float gs = 0.f;
#pragma unroll
        for (int i = 0; i < 8; ++i) gs += __expf(gl[i] - gmx);
        const float gp = 1.f / gs;
        const bool t1 = (gi >> 2) != 0, up = (gi & 1) != 0; const bool owner = hi == ((gi >> 1) & 1);
        float el[8]; float emx = -INFINITY, em2 = -INFINITY, em3 = -INFINITY; int e0 = 0, e1 = 0;
#pragma unroll
        for (int j = 0; j < 8; ++j) { const float lo = t1 ? a1[j] : a0[j], hv = t1 ? a1[8 + j] : a0[8 + j]; el[j] = (up ? hv : lo) + be[gi * 8 + j]; }
#pragma unroll
        for (int j = 0; j < 8; ++j) { const float x = el[j];
            if (x > emx) { em3 = em2; em2 = emx; e1 = e0; emx = x; e0 = j; } else if (x > em2) { em3 = em2; em2 = x; e1 = j; } else if (x > em3) em3 = x; }
        const bool flagged = owner && (fminf(gmx - gm2, em2 - em3) < TAU);
        if (owner && !flagged) { const float p1 = __expf(em2 - emx); route_emit(m, gi * 8 + e0, gi * 8 + e1, gp / (1.f + p1), gp * p1 / (1.f + p1), cnt, tokE, tokR, tokG, list); }
        unsigned long long fm = __ballot(flagged);
        while (fm) { const int fl = __builtin_ctzll(fm); fm &= fm - 1; const int mt = m0 + (fl & 31);
            f32x4 t[4]; float s = 0.f;
#pragma unroll
            for (int j = 0; j < 4; ++j) { const size_t off = (size_t)mt * D + 256 * j + 4 * lane; const u32x2 dd = *(const u32x2*)(D16 + off); const f32x4 xx = *(const f32x4*)(X + off);
                t[j] = (f32x4){xx.x + __uint_as_float(dd.x << 16), xx.y + __uint_as_float(dd.x & 0xffff0000u), xx.z + __uint_as_float(dd.y << 16), xx.w + __uint_as_float(dd.y & 0xffff0000u)};
                s += (t[j].x * t[j].x + t[j].y * t[j].y) + (t[j].z * t[j].z + t[j].w * t[j].w); }
            const float rs = rsqrtf(wave_sum(s) * (1.f / D) + EPS);
#pragma unroll
            for (int j = 0; j < 4; ++j) t[j] = (f32x4){t[j].x * rs * gv[j].x, t[j].y * rs * gv[j].y, t[j].z * rs * gv[j].z, t[j].w * rs * gv[j].w};
            float xg[8] = {0.f, 0.f, 0.f, 0.f, 0.f, 0.f, 0.f, 0.f};
#pragma unroll
            for (int j = 0; j < 4; ++j)
#pragma unroll
                for (int c = 0; c < 4; ++c) { const int k = 256 * j + 4 * lane + c; const f32x4 w0 = *(const f32x4*)(wg + k * 8), w1 = *(const f32x4*)(wg + k * 8 + 4); const float tv = t[j][c];
                    xg[0] += tv * w0[0]; xg[1] += tv * w0[1]; xg[2] += tv * w0[2]; xg[3] += tv * w0[3]; xg[4] += tv * w1[0]; xg[5] += tv * w1[1]; xg[6] += tv * w1[2]; xg[7] += tv * w1[3]; }
            float gmx2 = -INFINITY; int gi2 = 0;
#pragma unroll
            for (int i = 0; i < 8; ++i) { xg[i] = wave_sum(xg[i]) + bg[i]; if (xg[i] > gmx2) { gmx2 = xg[i]; gi2 = i; } }
            float gs2 = 0.f;
#pragma unroll
            for (int i = 0; i < 8; ++i) gs2 += __expf(xg[i] - gmx2);
            gi2 = __builtin_amdgcn_readfirstlane(gi2);
            float xe[8] = {0.f, 0.f, 0.f, 0.f, 0.f, 0.f, 0.f, 0.f};
#pragma unroll
            for (int j = 0; j < 4; ++j)
#pragma unroll
                for (int c = 0; c < 4; ++c) { const int k = 256 * j + 4 * lane + c; const f32x4 w0 = *(const f32x4*)(we + k * 64 + gi2 * 8), w1 = *(const f32x4*)(we + k * 64 + gi2 * 8 + 4); const float tv = t[j][c];
                    xe[0] += tv * w0[0]; xe[1] += tv * w0[1]; xe[2] += tv * w0[2]; xe[3] += tv * w0[3]; xe[4] += tv * w1[0]; xe[5] += tv * w1[1]; xe[6] += tv * w1[2]; xe[7] += tv * w1[3]; }
            float x1 = -INFINITY, x2 = -INFINITY; int f0 = 0, f1 = 0;
#pragma unroll
            for (int i = 0; i < 8; ++i) { xe[i] = wave_sum(xe[i]) + be[gi2 * 8 + i]; }
#pragma unroll
            for (int i = 0; i < 8; ++i) if (xe[i] > x1) { x1 = xe[i]; f0 = i; }
#pragma unroll
            for (int i = 0; i < 8; ++i) if (i != f0 && xe[i] > x2) { x2 = xe[i]; f1 = i; }
            if (lane == 0) { const float gp2 = 1.f / gs2, p1 = __expf(x2 - x1); route_emit(mt, gi2 * 8 + f0, gi2 * 8 + f1, gp2 / (1.f + p1), gp2 * p1 / (1.f + p1), cnt, tokE, tokR, tokG, list); }
        }
    }
}
DEV int slot_start_lane(const int* cnt, int lane, int& c_out, int& total) {
    int st = 0, tot = 0, cm = 0;
    for (int i = 0; i < NE; ++i) { const int c = cnt[i]; const int pad = (c + 255) & ~255; if (i < lane) st += pad; if (i == lane) cm = c; tot += pad; }
    total = __builtin_amdgcn_readfirstlane(tot); c_out = cm; return st;
}
DEV void phase6(const Params& P) { const int tid_ = tid_fresh();
    unsigned char* ws = P.ws; const int lane = tid_ & 63, r32 = lane & 31, hi = lane >> 5; const int gw = blockIdx.x * NWAVE + (tid_ >> 6), ngw = gridDim.x * NWAVE;
    const bf16_t* TN = (const bf16_t*)(ws + WS_TN); const bf16_t* W = (const bf16_t*)(ws + WS_WGU); bf16_t* MH = (bf16_t*)(ws + WS_MH);
    const int* cnt = (const int*)(ws + WS_CTL) + CW_CNT; const int* list = (const int*)(ws + WS_LIST);
    int c_l, total; const int st_l = slot_start_lane(cnt, lane, c_l, total);
    const int Nt = 1024 / 64, nrt = total / 64;
    for (int it = gw; it < nrt * Nt; it += ngw) { const int T = it / Nt, tn = it % Nt;
        const unsigned long long bal = __ballot(st_l <= T * 64); const int e = __builtin_amdgcn_readfirstlane(63 - __builtin_clzll(bal));
        const int st = rl_i(st_l, e), c = rl_i(c_l, e); const int lr = T * 64 - st;
        if (lr >= c) continue;
        const int ra = lr + r32, rb = lr + 32 + r32;
        const int ta = ra < c ? list[(size_t)e * M + ra] : 0, tb = rb < c ? list[(size_t)e * M + rb] : 0;
        const bf16_t* We = W + (size_t)e * 1024 * 1024;
        f32x16 c00 = {}, c01 = {}, c10 = {}, c11 = {};
        wave_tile(TN + (size_t)ta * D + hi * 8, TN + (size_t)tb * D + hi * 8, We + (size_t)(tn * 64 + r32) * D + hi * 8, We + (size_t)(tn * 64 + 32 + r32) * D + hi * 8, D, c00, c01, c10, c11);
#pragma unroll
        for (int r = 0; r < 16; ++r) {
#pragma unroll
            for (int q = 0; q < 4; ++q) { const float v = (q == 0) ? c00[r] : (q == 1) ? c01[r] : (q == 2) ? c10[r] : c11[r];
                const float u = __shfl_down(v, 4); const int row = T * 64 + (q >> 1) * 32 + crow(r, hi), col = tn * 64 + (q & 1) * 32 + r32;
                if ((col & 4) == 0) MH[(size_t)row * DE + (col >> 3) * 4 + (col & 3)] = (bf16_t)f2bf(siluf(v) * u); }
        }
    }
}
DEV void phase7(const Params& P) { const int tid_ = tid_fresh();
    unsigned char* ws = P.ws; const int lane = tid_ & 63, r32 = lane & 31, hi = lane >> 5; const int gw = blockIdx.x * NWAVE + (tid_ >> 6), ngw = gridDim.x * NWAVE;
    const bf16_t* MH = (const bf16_t*)(ws + WS_MH); const bf16_t* W = (const bf16_t*)(ws + WS_WD); bf16_t* MY = (bf16_t*)(ws + WS_MY);
    const int* cnt = (const int*)(ws + WS_CTL) + CW_CNT;
    int c_l, total; const int st_l = slot_start_lane(cnt, lane, c_l, total);
    const int Nt = 1024 / 64, nrt = total / 64;
    for (int it = gw; it < nrt * Nt; it += ngw) { const int T = it / Nt, tn = it % Nt;
        const unsigned long long bal = __ballot(st_l <= T * 64); const int e = __builtin_amdgcn_readfirstlane(63 - __builtin_clzll(bal));
        const int st = rl_i(st_l, e), c = rl_i(c_l, e); const int lr = T * 64 - st;
        if (lr >= c) continue;
        const bf16_t* We = W + (size_t)e * 1024 * 512;
        f32x16 c00 = {}, c01 = {}, c10 = {}, c11 = {};
        wave_tile(MH + (size_t)(T * 64 + r32) * DE + hi * 8, MH + (size_t)(T * 64 + 32 + r32) * DE + hi * 8, We + (size_t)(tn * 64 + r32) * DE + hi * 8, We + (size_t)(tn * 64 + 32 + r32) * DE + hi * 8, DE, c00, c01, c10, c11);
#pragma unroll
        for (int r = 0; r < 16; ++r) { const int row = T * 64 + crow(r, hi), col = tn * 64 + r32;
            MY[(size_t)row * D + col] = (bf16_t)f2bf(c00[r]); MY[(size_t)row * D + col + 32] = (bf16_t)f2bf(c01[r]);
            MY[(size_t)(row + 32) * D + col] = (bf16_t)f2bf(c10[r]); MY[(size_t)(row + 32) * D + col + 32] = (bf16_t)f2bf(c11[r]); }
    }
}
DEV void phase8(const Params& P) { const int tid_ = tid_fresh();
    unsigned char* ws = P.ws; const int lane = tid_ & 63; const int gw = blockIdx.x * NWAVE + (tid_ >> 6), ngw = gridDim.x * NWAVE;
    const bf16_t* H2B = (const bf16_t*)(ws + WS_H2B); const unsigned char* MY = (const unsigned char*)(ws + WS_MY); const float* g = P.in[I_FINAL];
    const int* cnt = (const int*)(ws + WS_CTL) + CW_CNT; const int* tokE = (const int*)(ws + WS_TOK); const int* tokR = tokE + 2 * M; const float* tokG = (const float*)(tokR + 2 * M);
    int c_l, total; const int st_l = slot_start_lane(cnt, lane, c_l, total);
    f32x4 gv[4];
#pragma unroll
    for (int j = 0; j < 4; ++j) gv[j] = *(const f32x4*)(g + 256 * j + 4 * lane);
    for (int m0 = gw * 4; m0 < M; m0 += ngw * 4) {
        u32x2 hh[4][4]; unsigned ya[4][4], yb[4][4]; float g0[4], g1[4];
#pragma unroll
        for (int q = 0; q < 4; ++q) { const int m = m0 + q;
            const int E0 = __builtin_amdgcn_readfirstlane(tokE[2 * m]), E1 = __builtin_amdgcn_readfirstlane(tokE[2 * m + 1]);
            const size_t s0 = (size_t)rl_i(st_l, E0) + tokR[2 * m], s1 = (size_t)rl_i(st_l, E1) + tokR[2 * m + 1]; g0[q] = tokG[2 * m] * (1.f / 16.f); g1[q] = tokG[2 * m + 1] * (1.f / 16.f);
            const u32x2* hr = (const u32x2*)(H2B + (size_t)m * D) + lane; const unsigned* y0 = (const unsigned*)(MY + s0 * D) + lane; const unsigned* y1 = (const unsigned*)(MY + s1 * D) + lane;
#pragma unroll
            for (int j = 0; j < 4; ++j) { hh[q][j] = hr[64 * j]; ya[q][j] = y0[64 * j]; yb[q][j] = y1[64 * j]; } }
#pragma unroll
        for (int q = 0; q < 4; ++q) { f32x4 v[4]; float s = 0.f;
#pragma unroll
            for (int j = 0; j < 4; ++j) { const u32x2 h2 = hh[q][j]; const int a = (int)ya[q][j], b = (int)yb[q][j];
                v[j].x = __uint_as_float(h2.x << 16) + g0[q] * __builtin_amdgcn_cvt_f32_fp8(a, 0) + g1[q] * __builtin_amdgcn_cvt_f32_fp8(b, 0);
                v[j].y = __uint_as_float(h2.x & 0xffff0000u) + g0[q] * __builtin_amdgcn_cvt_f32_fp8(a, 1) + g1[q] * __builtin_amdgcn_cvt_f32_fp8(b, 1);
                v[j].z = __uint_as_float(h2.y << 16) + g0[q] * __builtin_amdgcn_cvt_f32_fp8(a, 2) + g1[q] * __builtin_amdgcn_cvt_f32_fp8(b, 2);
                v[j].w = __uint_as_float(h2.y & 0xffff0000u) + g0[q] * __builtin_amdgcn_cvt_f32_fp8(a, 3) + g1[q] * __builtin_amdgcn_cvt_f32_fp8(b, 3);
                s += (v[j].x * v[j].x + v[j].y * v[j].y) + (v[j].z * v[j].z + v[j].w * v[j].w); }
            const float rs = rsqrtf(wave_sum(s) * (1.f / D) + EPS);
            f32x4* orow = (f32x4*)(P.out + (size_t)(m0 + q) * D) + lane;
#pragma unroll
            for (int j = 0; j < 4; ++j) orow[64 * j] = (f32x4){v[j].x * rs * gv[j].x, v[j].y * rs * gv[j].y, v[j].z * rs * gv[j].z, v[j].w * rs * gv[j].w}; }
    }
}


#ifndef FAST
#define FAST 0x7f
#endif
namespace g8 {
struct EpiZ { static constexpr bool PERM = true; bf16_t* Z; float* ssq_q; float* ssq_kv;
    DEV void operator()(const Acc& acc, const Unit& u, int wr, int wc, int fr, int fq) const {
        const int zt = u.pn < 2 ? u.pn : u.pn + 2;
        const int row0 = u.pm * BM + wr * 64 + fr, col0 = zt * BM + wc * 32 + 8 * fq;
#pragma unroll
        for (int ai = 0; ai < 2; ++ai)
#pragma unroll
            for (int m = 0; m < 4; ++m) { const int row = row0 + ai * HALF + m * 16; bf16_t* rp = Z + (size_t)row * NZ + col0;
#pragma unroll
                for (int bj = 0; bj < 2; ++bj) *(u32x4*)(rp + bj * HALF) = pack8(acc[ai][bj][m][0], acc[ai][bj][m][1]);
                if (u.pn >= 4) { float s = 0.f;
#pragma unroll
                    for (int bj = 0; bj < 2; ++bj) if (u.pn == 4 || bj == 0) {
#pragma unroll
                        for (int n = 0; n < 2; ++n) { const f32x4 v = acc[ai][bj][m][n]; s += (v[0] * v[0] + v[1] * v[1]) + (v[2] * v[2] + v[3] * v[3]); } }
                    s += sx<16>(s); s = half_sum(s);
                    if (fq == 0) atomicAdd((u.pn == 4 ? ssq_q : ssq_kv) + row, s); }
                asm volatile("" ::: "memory"); }
    } };
struct EpiQ { static constexpr bool PERM = true; bf16_t* QM; const float* ssq_q; const float2* rope;
    DEV void operator()(const Acc& acc, const Unit& u, int wr, int wc, int fr, int fq) const {
        const int row0 = u.pm * BM + wr * 64 + fr, col0 = u.pn * BM + wc * 32 + 8 * fq;
#pragma unroll
        for (int ai = 0; ai < 2; ++ai)
#pragma unroll
            for (int m = 0; m < 4; ++m) { const int row = row0 + ai * HALF + m * 16; const float rs = rsqrtf(ssq_q[row] * (1.f / 256.f) + EPS); bf16_t* rp = QM + (size_t)row * 768 + col0;
#pragma unroll
                for (int bj = 0; bj < 2; ++bj) { f32x4 v0 = acc[ai][bj][m][0] * rs, v1 = acc[ai][bj][m][1] * rs;
                    if (u.pn == 2) { const int f0 = (wc & 1) * 16 + 4 * fq; const f32x4* cp = (const f32x4*)(rope + (size_t)(NMETA + (row & (SEQ - 1))) * 32 + f0); const f32x4 ca = cp[0], cb = cp[1];
                        const f32x4 r0 = {v0[0] * ca[0] - v0[1] * ca[1], v0[1] * ca[0] + v0[0] * ca[1], v0[2] * ca[2] - v0[3] * ca[3], v0[3] * ca[2] + v0[2] * ca[3]};
                        const f32x4 r1 = {v1[0] * cb[0] - v1[1] * cb[1], v1[1] * cb[0] + v1[0] * cb[1], v1[2] * cb[2] - v1[3] * cb[3], v1[3] * cb[2] + v1[2] * cb[3]}; v0 = r0; v1 = r1; }
                    *(u32x4*)(rp + bj * HALF) = pack8(v0, v1); }
                asm volatile("" ::: "memory"); }
    } };
struct EpiK { static constexpr bool PERM = true; bf16_t* KN; const float* ssq_kv;
    DEV void operator()(const Acc& acc, const Unit& u, int wr, int wc, int fr, int fq) const {
        const int row0 = u.pm * BM + wr * 64 + fr, col0 = u.pn * BM + wc * 32 + 8 * fq;
#pragma unroll
        for (int ai = 0; ai < 2; ++ai)
#pragma unroll
            for (int m = 0; m < 4; ++m) { const int row = row0 + ai * HALF + m * 16; const float rs = rsqrtf(ssq_kv[row] * (1.f / 128.f) + EPS); bf16_t* rp = KN + (size_t)row * 512 + col0;
#pragma unroll
                for (int bj = 0; bj < 2; ++bj) *(u32x4*)(rp + bj * HALF) = pack8(acc[ai][bj][m][0] * rs, acc[ai][bj][m][1] * rs);
                asm volatile("" ::: "memory"); }
    } };
struct EpiVT { static constexpr bool PERM = true; bf16_t* VT; const float* ssq_kv;
    DEV void operator()(const Acc& acc, const Unit& u, int wr, int wc, int fr, int fq) const {
        const int row0 = u.pm * BM + wr * 64 + fr, col0 = u.pn * BM + wc * 32 + 8 * fq;
        f32x4 rs[2][2];
#pragma unroll
        for (int bj = 0; bj < 2; ++bj)
#pragma unroll
            for (int n = 0; n < 2; ++n) { const f32x4 q = *(const f32x4*)(ssq_kv + col0 + bj * HALF + 4 * n);
                rs[bj][n] = (f32x4){rsqrtf(q[0] * (1.f / 128.f) + EPS), rsqrtf(q[1] * (1.f / 128.f) + EPS), rsqrtf(q[2] * (1.f / 128.f) + EPS), rsqrtf(q[3] * (1.f / 128.f) + EPS)}; }
#pragma unroll
        for (int ai = 0; ai < 2; ++ai)
#pragma unroll
            for (int m = 0; m < 4; ++m) { const int row = row0 + ai * HALF + m * 16; bf16_t* rp = VT + (size_t)row * M + col0;
#pragma unroll
                for (int bj = 0; bj < 2; ++bj) *(u32x4*)(rp + bj * HALF) = pack8(acc[ai][bj][m][0] * rs[bj][0], acc[ai][bj][m][1] * rs[bj][1]); }
    } };
struct EpiQ8 { static constexpr bool PERM = true; unsigned char* QM; const float* ssq_q; const float2* rope;
    DEV void operator()(const Acc& acc, const Unit& u, int wr, int wc, int fr, int fq) const {
        const int row0 = u.pm * BM + wr * 64 + fr, col0 = u.pn * BM + wc * 32 + 8 * fq;
        float rs[8];
#pragma unroll
        for (int i = 0; i < 8; ++i) rs[i] = ssq_q[row0 + (i >> 2) * HALF + (i & 3) * 16];
#pragma unroll
        for (int i = 0; i < 8; ++i) rs[i] = 16.f * rsqrtf(rs[i] * (1.f / 256.f) + EPS);
#pragma unroll
        for (int ai = 0; ai < 2; ++ai) {
            f32x4 ca[4], cb[4];
            if (u.pn == 2) { const int f0 = (wc & 1) * 16 + 4 * fq;
#pragma unroll
                for (int m = 0; m < 4; ++m) { const int row = row0 + ai * HALF + m * 16; const f32x4* cp = (const f32x4*)(rope + (size_t)(NMETA + (row & (SEQ - 1))) * 32 + f0); ca[m] = cp[0]; cb[m] = cp[1]; } }
#pragma unroll
            for (int m = 0; m < 4; ++m) { const int row = row0 + ai * HALF + m * 16; const float r_ = rs[ai * 4 + m]; unsigned char* rp = QM + (size_t)row * 768 + col0;
#pragma unroll
                for (int bj = 0; bj < 2; ++bj) { f32x4 v0 = acc[ai][bj][m][0] * r_, v1 = acc[ai][bj][m][1] * r_;
                    if (u.pn == 2) {
                        const f32x4 r0 = {v0[0] * ca[m][0] - v0[1] * ca[m][1], v0[1] * ca[m][0] + v0[0] * ca[m][1], v0[2] * ca[m][2] - v0[3] * ca[m][3], v0[3] * ca[m][2] + v0[2] * ca[m][3]};
                        const f32x4 r1 = {v1[0] * cb[m][0] - v1[1] * cb[m][1], v1[1] * cb[m][0] + v1[0] * cb[m][1], v1[2] * cb[m][2] - v1[3] * cb[m][3], v1[3] * cb[m][2] + v1[2] * cb[m][3]}; v0 = r0; v1 = r1; }
                    u32x2 w; w.x = pk4_fp8(v0[0], v0[1], v0[2], v0[3]); w.y = pk4_fp8(v1[0], v1[1], v1[2], v1[3]); *(u32x2*)(rp + bj * HALF) = w; } }
            asm volatile("" ::: "memory"); }
    } };
struct EpiK8 { static constexpr bool PERM = true; unsigned char* KN; const float* ssq_kv;
    DEV void operator()(const Acc& acc, const Unit& u, int wr, int wc, int fr, int fq) const {
        const int row0 = u.pm * BM + wr * 64 + fr, col0 = u.pn * BM + wc * 32 + 8 * fq;
        float rs[8];
#pragma unroll
        for (int i = 0; i < 8; ++i) rs[i] = ssq_kv[row0 + (i >> 2) * HALF + (i & 3) * 16];
#pragma unroll
        for (int i = 0; i < 8; ++i) rs[i] = rsqrtf(rs[i] * (1.f / 128.f) + EPS);
#pragma unroll
        for (int ai = 0; ai < 2; ++ai)
#pragma unroll
            for (int m = 0; m < 4; ++m) { const int row = row0 + ai * HALF + m * 16; const float r_ = rs[ai * 4 + m]; unsigned char* rp = KN + (size_t)row * 512 + col0;
#pragma unroll
                for (int bj = 0; bj < 2; ++bj) { const f32x4 v0 = acc[ai][bj][m][0] * r_, v1 = acc[ai][bj][m][1] * r_; u32x2 w; w.x = pk4_fp8(v0[0], v0[1], v0[2], v0[3]); w.y = pk4_fp8(v1[0], v1[1], v1[2], v1[3]); *(u32x2*)(rp + bj * HALF) = w; } }
    } };
struct EpiVT8 { static constexpr bool PERM = true; unsigned char* VT; const float* ssq_kv;
    DEV void operator()(const Acc& acc, const Unit& u, int wr, int wc, int fr, int fq) const {
        const int row0 = u.pm * BM + wr * 64 + fr, col0 = u.pn * BM + wc * 32 + 8 * fq;
        f32x4 rs[2][2];
#pragma unroll
        for (int bj = 0; bj < 2; ++bj)
#pragma unroll
            for (int n = 0; n < 2; ++n) { const f32x4 q = *(const f32x4*)(ssq_kv + col0 + bj * HALF + 4 * n);
                rs[bj][n] = (f32x4){rsqrtf(q[0] * (1.f / 128.f) + EPS), rsqrtf(q[1] * (1.f / 128.f) + EPS), rsqrtf(q[2] * (1.f / 128.f) + EPS), rsqrtf(q[3] * (1.f / 128.f) + EPS)}; }
#pragma unroll
        for (int ai = 0; ai < 2; ++ai)
#pragma unroll
            for (int m = 0; m < 4; ++m) { const int row = row0 + ai * HALF + m * 16; unsigned char* rp = VT + (size_t)row * M + col0;
#pragma unroll
                for (int bj = 0; bj < 2; ++bj) { const f32x4 v0 = acc[ai][bj][m][0] * rs[bj][0], v1 = acc[ai][bj][m][1] * rs[bj][1]; u32x2 w; w.x = pk4_fp8(v0[0], v0[1], v0[2], v0[3]); w.y = pk4_fp8(v1[0], v1[1], v1[2], v1[3]); *(u32x2*)(rp + bj * HALF) = w; } }
    } };
struct EpiH2 { static constexpr bool PERM = false; float* H2; const float* x;
    DEV void operator()(const Acc& acc, const Unit& u, int wr, int wc, int fr, int fq) const {
        const int row0 = u.pm * BM + wr * 64 + fr, col0 = u.pn * BM + wc * 32 + 4 * fq;
#pragma unroll
        for (int ai = 0; ai < 2; ++ai)
#pragma unroll
            for (int m = 0; m < 4; ++m) { const size_t off = (size_t)(row0 + ai * HALF + m * 16) * D + col0;
#pragma unroll
                for (int bj = 0; bj < 2; ++bj)
#pragma unroll
                    for (int n = 0; n < 2; ++n) *(f32x4*)(H2 + off + bj * HALF + n * 16) = *(const f32x4*)(x + off + bj * HALF + n * 16) + acc[ai][bj][m][n];
                if (m & 1) asm volatile("" ::: "memory"); }
    } };
struct EpiGU { static constexpr bool PERM = true; bf16_t* MH;
    DEV void operator()(const Acc& acc, const Unit& u, int wr, int wc, int fr, int fq) const {
        const int row0 = u.pm * BM + wr * 64 + fr, hid0 = u.pn * 128 + wc * 16 + 4 * fq;
#pragma unroll
        for (int ai = 0; ai < 2; ++ai)
#pragma unroll
            for (int m = 0; m < 4; ++m) { bf16_t* rp = MH + (size_t)(row0 + ai * HALF + m * 16) * DE + hid0;
#pragma unroll
                for (int bj = 0; bj < 2; ++bj) { const f32x4 g = acc[ai][bj][m][0], up = acc[ai][bj][m][1];
                    u32x2 w; w.x = cvt_pk_bf16(siluf(g[0]) * up[0], siluf(g[1]) * up[1]); w.y = cvt_pk_bf16(siluf(g[2]) * up[2], siluf(g[3]) * up[3]);
                    *(u32x2*)(rp + bj * 64) = w; } }
    } };
struct EpiD { static constexpr bool PERM = true; bf16_t* MY; size_t ld;
    DEV void operator()(const Acc& acc, const Unit& u, int wr, int wc, int fr, int fq) const {
        const int row0 = u.pm * BM + wr * 64 + fr, col0 = u.pn * BM + wc * 32 + 8 * fq;
#pragma unroll
        for (int ai = 0; ai < 2; ++ai)
#pragma unroll
            for (int m = 0; m < 4; ++m) { bf16_t* rp = MY + (size_t)(row0 + ai * HALF + m * 16) * ld + col0;
#pragma unroll
                for (int bj = 0; bj < 2; ++bj) *(u32x4*)(rp + bj * HALF) = pack8(acc[ai][bj][m][0], acc[ai][bj][m][1]); }
    } };
struct EpiLOGA { static constexpr bool PERM = true; float* LOGA; const float* ba;
    DEV void operator()(const Acc& acc, const Unit& u, int wr, int wc, int fr, int fq) const {
        const int row0 = u.pm * BM + wr * 64 + fr, col0 = wc * 32 + 8 * fq;
        f32x4 bv[2][2];
#pragma unroll
        for (int bj = 0; bj < 2; ++bj)
#pragma unroll
            for (int n = 0; n < 2; ++n) bv[bj][n] = *(const f32x4*)(ba + col0 + bj * HALF + 4 * n);
#pragma unroll
        for (int ai = 0; ai < 2; ++ai)
#pragma unroll
            for (int m = 0; m < 4; ++m) { float* rp = LOGA + (size_t)(row0 + ai * HALF + m * 16) * 256 + col0;
#pragma unroll
                for (int bj = 0; bj < 2; ++bj)
#pragma unroll
                    for (int n = 0; n < 2; ++n) { const f32x4 v = acc[ai][bj][m][n]; f32x4 o;
#pragma unroll
                        for (int c = 0; c < 4; ++c) { const float x = v[c] + bv[bj][n][c]; o[c] = (fminf(x, 0.f) - __logf(1.f + __expf(-fabsf(x)))) * (1.f / 16.f); }
                        *(f32x4*)(rp + bj * HALF + 4 * n) = o; }
                asm volatile("" ::: "memory"); }
    } };
struct EpiGU8 { static constexpr bool PERM = true; unsigned char* MH;
    DEV void operator()(const Acc& acc, const Unit& u, int wr, int wc, int fr, int fq) const {
        const int row0 = u.pm * BM + wr * 64 + fr, hid0 = u.pn * 128 + wc * 16 + 4 * fq;
#pragma unroll
        for (int ai = 0; ai < 2; ++ai)
#pragma unroll
            for (int m = 0; m < 4; ++m) { unsigned char* rp = MH + (size_t)(row0 + ai * HALF + m * 16) * DE + hid0;
#pragma unroll
                for (int bj = 0; bj < 2; ++bj) { const f32x4 g = acc[ai][bj][m][0] * (1.f / 32.f), up = acc[ai][bj][m][1] * (8.f / 32.f);
                    *(unsigned*)(rp + bj * 64) = pk4_fp8(siluf(g[0]) * up[0], siluf(g[1]) * up[1], siluf(g[2]) * up[2], siluf(g[3]) * up[3]); }
                asm volatile("" ::: "memory"); }
    } };
struct EpiD8 { static constexpr bool PERM = true; unsigned char* MY; float osc;
    DEV void operator()(const Acc& acc, const Unit& u, int wr, int wc, int fr, int fq) const {
        const int row0 = u.pm * BM + wr * 64 + fr, col0 = u.pn * BM + wc * 32 + 8 * fq;
#pragma unroll
        for (int ai = 0; ai < 2; ++ai)
#pragma unroll
            for (int m = 0; m < 4; ++m) { unsigned char* rp = MY + (size_t)(row0 + ai * HALF + m * 16) * D + col0;
#pragma unroll
                for (int bj = 0; bj < 2; ++bj) { const f32x4 a = acc[ai][bj][m][0] * osc, b = acc[ai][bj][m][1] * osc; u32x2 w;
                    int t = __builtin_amdgcn_cvt_pk_fp8_f32(a[0], a[1], 0, false); t = __builtin_amdgcn_cvt_pk_fp8_f32(a[2], a[3], t, true); w.x = (unsigned)t;
                    t = __builtin_amdgcn_cvt_pk_fp8_f32(b[0], b[1], 0, false); t = __builtin_amdgcn_cvt_pk_fp8_f32(b[2], b[3], t, true); w.y = (unsigned)t;
                    *(u32x2*)(rp + bj * HALF) = w; }
                asm volatile("" ::: "memory"); }
    } };
struct MoeSched {
    const char* A; const char* B; size_t estepB, tstepB, tstepA; const int* list; int nunits, G, c, lda2;
    DEV static int st_of(int e) { return *(volatile LAS int*)(SLOTTAB_OFF + 4u * (unsigned)e); }
    DEV static int cn_of(int e) { return *(volatile LAS int*)(SLOTTAB_OFF + 256u + 4u * (unsigned)e); }
    DEV bool next(int i, Unit& u) const {
        const int L = i * G + c; if (L >= nunits) return false;
        u.pm = L >> 2; u.pn = L & 3; unsigned l_; asm volatile("v_mbcnt_lo_u32_b32 %0, -1, 0\n\tv_mbcnt_hi_u32_b32 %0, -1, %0" : "=v"(l_));
        const unsigned long long bal = __ballot(st_of((int)l_) <= u.pm * BM); u.e = __builtin_amdgcn_readfirstlane(63 - __builtin_clzll(bal)); return true;
    }
    DEV unsigned aoff(const Unit& u) const { return (unsigned)((size_t)u.pm * tstepA); }
    DEV unsigned boff(const Unit& u) const { return (unsigned)((size_t)u.e * estepB + (size_t)u.pn * tstepB); }
    DEV unsigned atok(const Unit& u, int r) const { const int st = st_of(u.e), cn = cn_of(u.e); const int lr = u.pm * BM - st + r;
        return (unsigned)(lr < cn ? list[u.e * M + lr] : 0); }
};
}
DEV int vcu_of(int bx, int G) { return (G % 8 == 0) ? (bx % 8) * (G / 8) + bx / 8 : bx; }
namespace mla {
constexpr int KSLOT = 24576, OFF_KR = 16384, VRING = 3 * KSLOT, VSLOT = 16384;
constexpr float THR = 8.f;
DEV void blds(__amdgpu_buffer_rsrc_t r, unsigned voff, unsigned soff, LAS unsigned char* l) { __builtin_amdgcn_raw_ptr_buffer_load_lds(r, (LAS void*)l, 16, (int)voff, (int)soff, 0, 0); }
DEV void unit(const Params& P, LAS unsigned char* lds, int b, int h, int qb, int tid) {
    asm volatile("" : "+v"(tid));
    unsigned char* ws = P.ws; const int lane = tid & 63, r32 = lane & 31, hi = lane >> 5; const int wave = __builtin_amdgcn_readfirstlane(tid >> 6);
    const bf16_t* QM = (const bf16_t*)(ws + WS_QM); const char* KN = (const char*)(ws + WS_KN); const char* VT = (const char*)(ws + WS_VT); const char* KR = (const char*)(ws + WS_KR);
    const bf16_t* KNm = (const bf16_t*)(ws + WS_META + MT_KN); const bf16_t* VTm = (const bf16_t*)(ws + WS_META + MT_VT); const bf16_t* KRm = (const bf16_t*)(ws + WS_META + MT_KR);
    bf16_t* Y = (bf16_t*)(ws + WS_Y);
    const int NTL = 4 * qb + 4, nact = 4 * qb + (wave >> 1) + 1;
    unsigned okn[2], ovt[2], okr;
#pragma unroll
    for (int i = 0; i < 2; ++i) { const int p = 2 * wave + i;
        { const int row = 4 * p + (lane >> 4), c = (lane & 15) ^ (row & 15); okn[i] = (unsigned)(((size_t)(b * SEQ + row) * 512 + h * 128 + c * 8) * 2); }
        { const int row = 8 * p + (lane >> 3), c = (lane & 7) ^ ((row >> 1) & 7); ovt[i] = (unsigned)(((size_t)(h * 128 + row) * M + (size_t)b * SEQ + c * 8) * 2); } }
    { const int row = 8 * wave + (lane >> 3), c = (lane & 7) ^ ((row >> 1) & 7); okr = (unsigned)(((size_t)(b * SEQ + row) * 64 + c * 8) * 2); }
    const unsigned wl = (unsigned)wave * 2048u;
    const __amdgpu_buffer_rsrc_t rKN = __builtin_amdgcn_make_buffer_rsrc((void*)KN, 0, 64 << 20, 0x00020000), rKR = __builtin_amdgcn_make_buffer_rsrc((void*)KR, 0, 8 << 20, 0x00020000),
                                 rVT = __builtin_amdgcn_make_buffer_rsrc((void*)VT, 0, 64 << 20, 0x00020000);
#define MLA_ISSUE_K(j, slot) do { LAS unsigned char* sb_ = lds + (slot) * KSLOT; const unsigned jk_ = (unsigned)(j) * (64u * 512u * 2u), jr_ = (unsigned)(j) * (64u * 64u * 2u); \
        blds(rKN, okn[0], jk_, sb_ + wl); blds(rKN, okn[1], jk_, sb_ + wl + 1024); blds(rKR, okr, jr_, sb_ + OFF_KR + (wl >> 1)); } while (0)
#define MLA_ISSUE_V(j, slot) do { LAS unsigned char* sb_ = lds + VRING + (slot) * VSLOT; const unsigned jv_ = (unsigned)(j) * 128u; \
        blds(rVT, ovt[0], jv_, sb_ + wl); blds(rVT, ovt[1], jv_, sb_ + wl + 1024); } while (0)
    asm volatile("s_waitcnt vmcnt(0)" ::: "memory"); __builtin_amdgcn_s_barrier();
    MLA_ISSUE_K(0, 0); MLA_ISSUE_V(0, 0); MLA_ISSUE_K(1, 1);
    const size_t mq = (size_t)b * SEQ + qb * 256 + wave * 32 + r32;
    bf16x8 qf[12];
#pragma unroll
    for (int s = 0; s < 8; ++s) qf[s] = *(const bf16x8*)(QM + mq * 768 + h * 128 + 16 * s + 8 * hi);
#pragma unroll
    for (int s = 0; s < 4; ++s) qf[8 + s] = *(const bf16x8*)(QM + mq * 768 + 512 + h * 64 + 16 * s + 8 * hi);
    f32x16 O[4] = {}; float mrun = -INFINITY, l = 0.f;
    const int kperm = pi23(r32);
    const int xk = (kperm & 15) ^ hi, xr = ((kperm >> 1) & 7) ^ hi, xv = ((r32 >> 1) & 7) ^ hi;
    const int kn_b = kperm * 256, kr_b = OFF_KR + kperm * 128, vt_b = r32 * 128;
#define MLA_SOFTMAX(S0, S1) do { \
        float mx = fmaxf(S0[0], S1[0]); \
        _Pragma("unroll") for (int r = 1; r < 16; ++r) mx = fmaxf(mx, fmaxf(S0[r], S1[r])); \
        mx = half_max(mx); \
        if (__any(mx > mrun + THR)) { const float mnew = fmaxf(mrun, mx), alpha = __builtin_amdgcn_exp2f(mrun - mnew); mrun = mnew; l *= alpha; \
            _Pragma("unroll") for (int d = 0; d < 4; ++d) _Pragma("unroll") for (int r = 0; r < 16; ++r) O[d][r] *= alpha; } \
        float ps = 0.f; \
        _Pragma("unroll") for (int r = 0; r < 16; ++r) { S0[r] = __builtin_amdgcn_exp2f(S0[r] - mrun); S1[r] = __builtin_amdgcn_exp2f(S1[r] - mrun); ps += S0[r] + S1[r]; } \
        l += ps; \
        { u32x4 w; w.x = g8::cvt_pk_bf16(S0[0], S0[1]); w.y = g8::cvt_pk_bf16(S0[2], S0[3]); w.z = g8::cvt_pk_bf16(S0[4], S0[5]); w.w = g8::cvt_pk_bf16(S0[6], S0[7]); pf[0] = __builtin_bit_cast(bf16x8, w); \
          w.x = g8::cvt_pk_bf16(S0[8], S0[9]); w.y = g8::cvt_pk_bf16(S0[10], S0[11]); w.z = g8::cvt_pk_bf16(S0[12], S0[13]); w.w = g8::cvt_pk_bf16(S0[14], S0[15]); pf[1] = __builtin_bit_cast(bf16x8, w); \
          w.x = g8::cvt_pk_bf16(S1[0], S1[1]); w.y = g8::cvt_pk_bf16(S1[2], S1[3]); w.z = g8::cvt_pk_bf16(S1[4], S1[5]); w.w = g8::cvt_pk_bf16(S1[6], S1[7]); pf[2] = __builtin_bit_cast(bf16x8, w); \
          w.x = g8::cvt_pk_bf16(S1[8], S1[9]); w.y = g8::cvt_pk_bf16(S1[10], S1[11]); w.z = g8::cvt_pk_bf16(S1[12], S1[13]); w.w = g8::cvt_pk_bf16(S1[14], S1[15]); pf[3] = __builtin_bit_cast(bf16x8, w); } \
    } while (0)
#define MLA_PV(VLOAD) do { \
        _Pragma("unroll") for (int d = 0; d < 4; ++d) { _Pragma("unroll") for (int sp = 0; sp < 4; ++sp) { const bf16x8 vf = VLOAD(d, sp); O[d] = __builtin_amdgcn_mfma_f32_32x32x16_bf16(vf, pf[sp], O[d], 0, 0, 0); } } \
        __builtin_amdgcn_sched_group_barrier(0x100, 8, 1); \
        _Pragma("unroll") for (int i_ = 0; i_ < 4; ++i_) { __builtin_amdgcn_sched_group_barrier(0x8, 2, 1); __builtin_amdgcn_sched_group_barrier(0x100, 2, 1); } \
        __builtin_amdgcn_sched_group_barrier(0x8, 8, 1); \
    } while (0)
    bf16x8 pf[4];
    { f32x16 S0 = {}, S1; const bf16x8 zf = {};
#pragma unroll
      for (int s = 0; s < 8; ++s) { const bf16x8 kf = *(const bf16x8*)(KNm + kperm * 512 + h * 128 + 16 * s + 8 * hi); S0 = __builtin_amdgcn_mfma_f32_32x32x16_bf16(kf, qf[s], S0, 0, 0, 0); }
#pragma unroll
      for (int s = 0; s < 4; ++s) { const bf16x8 kf = *(const bf16x8*)(KRm + kperm * 64 + 16 * s + 8 * hi); S0 = __builtin_amdgcn_mfma_f32_32x32x16_bf16(kf, qf[8 + s], S0, 0, 0, 0); }
#pragma unroll
      for (int r = 0; r < 16; ++r) { if (pi23(crow(r, hi)) >= NMETA) S0[r] = -INFINITY; S1[r] = -INFINITY; }
#define MLA_VMETA(d, sp) ((sp) == 0 ? *(const bf16x8*)(VTm + (h * 128 + 32 * (d) + r32) * 32 + 8 * hi) : zf)
      MLA_SOFTMAX(S0, S1); MLA_PV(MLA_VMETA);
    }
#define MLA_QK(S0, S1, kslot) do { LAS const unsigned char* sb = lds + (kslot) * KSLOT; int xk_ = xk, xr_ = xr; asm volatile("" : "+v"(xk_), "+v"(xr_));   \
        _Pragma("unroll") for (int r = 0; r < 16; ++r) { S0[r] = 0.f; S1[r] = 0.f; } \
        _Pragma("unroll") for (int s = 0; s < 8; ++s) { const int co = ((2 * s) ^ xk_) << 4; const bf16x8 k0 = *(LAS const bf16x8*)(sb + kn_b + co), k1 = *(LAS const bf16x8*)(sb + kn_b + 32 * 256 + co); \
            S0 = __builtin_amdgcn_mfma_f32_32x32x16_bf16(k0, qf[s], S0, 0, 0, 0); S1 = __builtin_amdgcn_mfma_f32_32x32x16_bf16(k1, qf[s], S1, 0, 0, 0); } \
        _Pragma("unroll") for (int s = 0; s < 4; ++s) { const int co = ((2 * s) ^ xr_) << 4; const bf16x8 k0 = *(LAS const bf16x8*)(sb + kr_b + co), k1 = *(LAS const bf16x8*)(sb + kr_b + 32 * 128 + co); \
            S0 = __builtin_amdgcn_mfma_f32_32x32x16_bf16(k0, qf[8 + s], S0, 0, 0, 0); S1 = __builtin_amdgcn_mfma_f32_32x32x16_bf16(k1, qf[8 + s], S1, 0, 0, 0); } \
        __builtin_amdgcn_sched_group_barrier(0x100, 8, 0); \
        _Pragma("unroll") for (int i_ = 0; i_ < 8; ++i_) { __builtin_amdgcn_sched_group_barrier(0x8, 2, 0); __builtin_amdgcn_sched_group_barrier(0x100, 2, 0); } \
        __builtin_amdgcn_sched_group_barrier(0x8, 8, 0); } while (0)
#define MLA_VLDS(d, sp) (*(LAS const bf16x8*)(vb + vt_b + (d) * (32 * 128) + (((2 * (sp)) ^ xv_) << 4)))
    { const bool late = wave >= 4; int ks = 0;
      for (int j = 0; j < NTL; ++j) {
        if (j + 1 < NTL) asm volatile("s_waitcnt vmcnt(3)" ::: "memory"); else asm volatile("s_waitcnt vmcnt(0)" ::: "memory");
        __builtin_amdgcn_s_barrier(); asm volatile("" ::: "memory");
        if (j + 1 < NTL) MLA_ISSUE_V(j + 1, ks == 2 ? 0 : ks + 1);
        if (j + 2 < NTL) MLA_ISSUE_K(j + 2, ks == 0 ? 2 : ks - 1);
        if (late && j >= 1 && j - 1 < nact) { LAS const unsigned char* vb = lds + VRING + (ks == 0 ? 2 : ks - 1) * VSLOT; int xv_ = xv; asm volatile("" : "+v"(xv_)); MLA_PV(MLA_VLDS); }
        if (j < nact) { f32x16 S0, S1; MLA_QK(S0, S1, ks); MLA_SOFTMAX(S0, S1);
            if (!late) { LAS const unsigned char* vb = lds + VRING + ks * VSLOT; int xv_ = xv; asm volatile("" : "+v"(xv_)); MLA_PV(MLA_VLDS); } }
        ks = ks == 2 ? 0 : ks + 1;
      }
      if (late && NTL - 1 < nact) { LAS const unsigned char* vb = lds + VRING + (ks == 0 ? 2 : ks - 1) * VSLOT; int xv_ = xv; asm volatile("" : "+v"(xv_)); MLA_PV(MLA_VLDS); } }
    l = half_sum(l); const float rl = 1.f / l;
    { int te = tid; asm volatile("" : "+v"(te));
      bf16_t* yr = Y + ((size_t)b * SEQ + qb * 256 + wave * 32 + (te & 31)) * 1024 + 512 + h * 128 + 4 * ((te >> 5) & 1);
#pragma unroll
      for (int d = 0; d < 4; ++d)
#pragma unroll
        for (int g = 0; g < 4; ++g) { u32x2 w; w.x = g8::cvt_pk_bf16(O[d][4 * g] * rl, O[d][4 * g + 1] * rl); w.y = g8::cvt_pk_bf16(O[d][4 * g + 2] * rl, O[d][4 * g + 3] * rl);
            *(u32x2*)(yr + 32 * d + 8 * g) = w; } }
#undef MLA_ISSUE_K
#undef MLA_ISSUE_V
#undef MLA_QK
#undef MLA_SOFTMAX
#undef MLA_PV
#undef MLA_VMETA
#undef MLA_VLDS
}
}
namespace mla8 {
typedef int i32x8 __attribute__((ext_vector_type(8)));
typedef int i32x4 __attribute__((ext_vector_type(4)));
constexpr int KSLOT = 12288, OFF_KR = 8192, VRING = 3 * KSLOT, VSLOT = 8192;
constexpr float THR = 8.f, INVQS = 1.f / 16.f;
DEV int pip(int i) { return (i & 3) | (((i >> 3) & 3) << 2) | (((i >> 2) & 1) << 4); }
DEV f32x16 mfma8(i32x8 a, i32x8 b, f32x16 c) { return __builtin_amdgcn_mfma_scale_f32_32x32x64_f8f6f4(a, b, c, 0, 0, 0, 0x7f7f7f7f, 0, 0x7f7f7f7f); }
DEV i32x8 cat(i32x4 a, i32x4 b) { return (i32x8){a[0], a[1], a[2], a[3], b[0], b[1], b[2], b[3]}; }
DEV void unit(const Params& P, LAS unsigned char* lds, int b, int h, int qb, int tid) {
    asm volatile("" : "+v"(tid));
    unsigned char* ws = P.ws; const int lane = tid & 63, r32 = lane & 31, hi = lane >> 5; const int wave = __builtin_amdgcn_readfirstlane(tid >> 6);
    const unsigned char* QM = ws + WS_QM; const unsigned char* KN = ws + WS_KN; const unsigned char* VT = ws + WS_VT; const unsigned char* KR = ws + WS_KR;
    const unsigned char* KNm = ws + WS_META + MT_KN8; const unsigned char* VTm = ws + WS_META + MT_VT8; const unsigned char* KRm = ws + WS_META + MT_KR8;
    bf16_t* Y = (bf16_t*)(ws + WS_Y);
    const int NTL = 4 * qb + 4, nact = 4 * qb + (wave >> 1) + 1;
    unsigned okn, okr, ovt;
    { const int row = 8 * wave + (lane >> 3), c = (lane & 7) ^ ((row >> 1) & 7); okn = (unsigned)((size_t)(b * SEQ + row) * 512 + h * 128 + c * 16); }
    { const int row = 16 * (wave & 3) + (lane >> 2), c = (lane & 3) ^ ((row >> 2) & 3); okr = (unsigned)((size_t)(b * SEQ + row) * 64 + c * 16); }
    { const int row = 16 * wave + (lane >> 2), c = (lane & 3) ^ ((row >> 2) & 3); ovt = (unsigned)((size_t)(h * 128 + row) * M + (size_t)b * SEQ + c * 16); }
    const unsigned wl = (unsigned)wave * 1024u, wl3 = (unsigned)(wave & 3) * 1024u;
    const __amdgpu_buffer_rsrc_t rKN = __builtin_amdgcn_make_buffer_rsrc((void*)KN, 0, 32 << 20, 0x00020000), rKR = __builtin_amdgcn_make_buffer_rsrc((void*)KR, 0, 4 << 20, 0x00020000),
                                 rVT = __builtin_amdgcn_make_buffer_rsrc((void*)VT, 0, 32 << 20, 0x00020000);
#define M8_ISSUE_K(j, slot) do { LAS unsigned char* sb_ = lds + (slot) * KSLOT; mla::blds(rKN, okn, (unsigned)(j) * (64u * 512u), sb_ + wl); mla::blds(rKR, okr, (unsigned)(j) * (64u * 64u), sb_ + OFF_KR + wl3); } while (0)
#define M8_ISSUE_V(j, slot) do { mla::blds(rVT, ovt, (unsigned)(j) * 64u, lds + VRING + (slot) * VSLOT + wl); } while (0)
    asm volatile("s_waitcnt vmcnt(0)" ::: "memory"); __builtin_amdgcn_s_barrier();
    M8_ISSUE_K(0, 0); M8_ISSUE_V(0, 0); M8_ISSUE_K(1, 1);
    i32x8 qf[3];
    { const unsigned char* qp = QM + ((size_t)b * SEQ + qb * 256 + wave * 32 + r32) * 768;
      qf[0] = *(const i32x8*)(qp + h * 128 + 32 * hi); qf[1] = *(const i32x8*)(qp + h * 128 + 64 + 32 * hi); qf[2] = *(const i32x8*)(qp + 512 + h * 64 + 32 * hi); }
    f32x16 O[4] = {}; float mrun = -INFINITY, l = 0.f;
    const int kperm = pip(r32);
    const int xk = (kperm >> 1) & 7, xr = (kperm >> 2) & 3, xv = (r32 >> 2) & 3;
    const int kn_b = kperm * 128, kr_b = OFF_KR + kperm * 64, vt_b = r32 * 64;
    i32x8 pb;
#define M8_SOFTMAX(S0, S1) do { \
        float mx = fmaxf(S0[0], S1[0]); \
        _Pragma("unroll") for (int r = 1; r < 16; ++r) mx = fmaxf(mx, fmaxf(S0[r], S1[r])); \
        mx = half_max(mx) * INVQS; \
        if (__any(mx > mrun + THR)) { const float mnew = fmaxf(mrun, mx), alpha = __builtin_amdgcn_exp2f(mrun - mnew); mrun = mnew; l *= alpha; \
            _Pragma("unroll") for (int d = 0; d < 4; ++d) _Pragma("unroll") for (int r = 0; r < 16; ++r) O[d][r] *= alpha; } \
        float ps = 0.f; \
        _Pragma("unroll") for (int r = 0; r < 16; ++r) { S0[r] = __builtin_amdgcn_exp2f(S0[r] * INVQS - mrun); S1[r] = __builtin_amdgcn_exp2f(S1[r] * INVQS - mrun); ps += S0[r] + S1[r]; } \
        l += ps; \
        pb[0] = (int)pk4_fp8(S0[0], S0[1], S0[2], S0[3]); pb[1] = (int)pk4_fp8(S0[4], S0[5], S0[6], S0[7]); pb[2] = (int)pk4_fp8(S0[8], S0[9], S0[10], S0[11]); pb[3] = (int)pk4_fp8(S0[12], S0[13], S0[14], S0[15]); \
        pb[4] = (int)pk4_fp8(S1[0], S1[1], S1[2], S1[3]); pb[5] = (int)pk4_fp8(S1[4], S1[5], S1[6], S1[7]); pb[6] = (int)pk4_fp8(S1[8], S1[9], S1[10], S1[11]); pb[7] = (int)pk4_fp8(S1[12], S1[13], S1[14], S1[15]); \
    } while (0)
#define M8_SOFTMAX2(S0, S1) do { \
        _Pragma("unroll") for (int r = 0; r < 16; ++r) { S0[r] = __builtin_fmaf(S0[r], INVQS, -mrun); S1[r] = __builtin_fmaf(S1[r], INVQS, -mrun); } \
        float mxa = fmaxf(fmaxf(S0[0], S0[1]), S0[2]), mxb = fmaxf(fmaxf(S1[0], S1[1]), S1[2]); \
        _Pragma("unroll") for (int r = 3; r < 15; r += 2) { mxa = fmaxf(fmaxf(mxa, S0[r]), S0[r + 1]); mxb = fmaxf(fmaxf(mxb, S1[r]), S1[r + 1]); } \
        float mx = half_max(fmaxf(fmaxf(mxa, S0[15]), fmaxf(mxb, S1[15]))); \
        if (__any(mx > THR)) { const float d = fmaxf(mx, 0.f), alpha = __builtin_amdgcn_exp2f(-d); mrun += d; l *= alpha; \
            _Pragma("unroll") for (int r = 0; r < 16; ++r) { S0[r] -= d; S1[r] -= d; } \
            _Pragma("unroll") for (int d_ = 0; d_ < 4; ++d_) _Pragma("unroll") for (int r = 0; r < 16; ++r) O[d_][r] *= alpha; } \
        float ps = 0.f; \
        _Pragma("unroll") for (int r = 0; r < 16; ++r) { S0[r] = __builtin_amdgcn_exp2f(S0[r]); S1[r] = __builtin_amdgcn_exp2f(S1[r]); ps += S0[r] + S1[r]; } \
        l += ps; \
        pb[0] = (int)pk4_fp8(S0[0], S0[1], S0[2], S0[3]); pb[1] = (int)pk4_fp8(S0[4], S0[5], S0[6], S0[7]); pb[2] = (int)pk4_fp8(S0[8], S0[9], S0[10], S0[11]); pb[3] = (int)pk4_fp8(S0[12], S0[13], S0[14], S0[15]); \
        pb[4] = (int)pk4_fp8(S1[0], S1[1], S1[2], S1[3]); pb[5] = (int)pk4_fp8(S1[4], S1[5], S1[6], S1[7]); pb[6] = (int)pk4_fp8(S1[8], S1[9], S1[10], S1[11]); pb[7] = (int)pk4_fp8(S1[12], S1[13], S1[14], S1[15]); \
    } while (0)
    { f32x16 S0 = {}, S1;
      S0 = mfma8(*(const i32x8*)(KNm + kperm * 512 + h * 128 + 32 * hi), qf[0], S0);
      S0 = mfma8(*(const i32x8*)(KNm + kperm * 512 + h * 128 + 64 + 32 * hi), qf[1], S0);
      S0 = mfma8(*(const i32x8*)(KRm + kperm * 64 + 32 * hi), qf[2], S0);
#pragma unroll
      for (int r = 0; r < 16; ++r) { if (hi) S0[r] = -INFINITY; S1[r] = -INFINITY; }
      M8_SOFTMAX(S0, S1);
      const i32x4 z4 = {0, 0, 0, 0};
#pragma unroll
      for (int d = 0; d < 4; ++d) { const i32x8 vf = cat(*(const i32x4*)(VTm + (h * 128 + 32 * d + r32) * 32 + 16 * hi), z4); O[d] = mfma8(vf, pb, O[d]); } }
#define M8_QK(S0, S1, kslot) do { LAS const unsigned char* sb = lds + (kslot) * KSLOT; int xk_ = xk, xr_ = xr; asm volatile("" : "+v"(xk_), "+v"(xr_)); \
        _Pragma("unroll") for (int r = 0; r < 16; ++r) { S0[r] = 0.f; S1[r] = 0.f; } \
        _Pragma("unroll") for (int s = 0; s < 2; ++s) { const int co = ((4 * s + 2 * hi) ^ xk_) << 4; \
            const i32x8 k0 = cat(*(LAS const i32x4*)(sb + kn_b + co), *(LAS const i32x4*)(sb + kn_b + (co ^ 16))), k1 = cat(*(LAS const i32x4*)(sb + kn_b + 32 * 128 + co), *(LAS const i32x4*)(sb + kn_b + 32 * 128 + (co ^ 16))); \
            S0 = mfma8(k0, qf[s], S0); S1 = mfma8(k1, qf[s], S1); } \
        { const int co = ((2 * hi) ^ xr_) << 4; \
            const i32x8 k0 = cat(*(LAS const i32x4*)(sb + kr_b + co), *(LAS const i32x4*)(sb + kr_b + (co ^ 16))), k1 = cat(*(LAS const i32x4*)(sb + kr_b + 32 * 64 + co), *(LAS const i32x4*)(sb + kr_b + 32 * 64 + (co ^ 16))); \
            S0 = mfma8(k0, qf[2], S0); S1 = mfma8(k1, qf[2], S1); } } while (0)
#define M8_PV(vslot) do { LAS const unsigned char* vb = lds + VRING + (vslot) * VSLOT; int xv_ = xv; asm volatile("" : "+v"(xv_)); const int c0 = (hi ^ xv_) << 4, c1 = ((2 + hi) ^ xv_) << 4; \
        _Pragma("unroll") for (int d = 0; d < 4; ++d) { const i32x8 vf = cat(*(LAS const i32x4*)(vb + vt_b + d * (32 * 64) + c0), *(LAS const i32x4*)(vb + vt_b + d * (32 * 64) + c1)); O[d] = mfma8(vf, pb, O[d]); } } while (0)
#if PINGPONG
#define M8_HALF_A(jj, ks_) do { if ((jj) + 1 < NTL) asm volatile("s_waitcnt vmcnt(3)" ::: "memory"); else asm volatile("s_waitcnt vmcnt(0)" ::: "memory"); \
        __builtin_amdgcn_s_barrier(); asm volatile("" ::: "memory"); \
        if ((jj) + 1 < NTL) M8_ISSUE_V((jj) + 1, (ks_) == 2 ? 0 : (ks_) + 1); \
        if ((jj) + 2 < NTL) M8_ISSUE_K((jj) + 2, (ks_) == 0 ? 2 : (ks_) - 1); } while (0)
#define M8_HALF_B() do { asm volatile("" ::: "memory"); __builtin_amdgcn_s_barrier(); asm volatile("" ::: "memory"); } while (0)
    if (wave < 4) { int ks = 0;
      for (int j = 0; j <= NTL; ++j) { const int kp = ks == 0 ? 2 : ks - 1;
        M8_HALF_A(j, ks);
        f32x16 S0, S1;
        if (j < nact) M8_QK(S0, S1, ks);
        if (j >= 1 && j - 1 < nact) M8_PV(kp);
        M8_HALF_B();
        if (j < nact) M8_SOFTMAX(S0, S1);
        ks = ks == 2 ? 0 : ks + 1; } }
    else { int ks = 0;
      M8_HALF_A(0, 0);
      for (int j = 0; j <= NTL; ++j) { const int kp = ks == 0 ? 2 : ks - 1;
        M8_HALF_B();
        if (j >= 1 && j - 1 < nact) M8_PV(kp);
        f32x16 S0, S1;
        if (j < nact) M8_QK(S0, S1, ks);
        if (j == NTL) break;
        ks = ks == 2 ? 0 : ks + 1;
        M8_HALF_A(j + 1, ks);
        if (j < nact) M8_SOFTMAX(S0, S1); } }
#undef M8_HALF_A
#undef M8_HALF_B
#else
    { const bool late = wave >= 4; int ks = 0;
      for (int j = 0; j < NTL; ++j) {
        if (j + 1 < NTL) asm volatile("s_waitcnt vmcnt(2)" ::: "memory"); else asm volatile("s_waitcnt vmcnt(0)" ::: "memory");
        __builtin_amdgcn_s_barrier(); asm volatile("" ::: "memory");
        if (j + 1 < NTL) M8_ISSUE_V(j + 1, ks == 2 ? 0 : ks + 1);
        if (j + 2 < NTL) M8_ISSUE_K(j + 2, ks == 0 ? 2 : ks - 1);
        if (late && j >= 1 && j - 1 < nact) M8_PV(ks == 0 ? 2 : ks - 1);
        if (j < nact) { f32x16 S0, S1; M8_QK(S0, S1, ks); if (SM2) M8_SOFTMAX2(S0, S1); else M8_SOFTMAX(S0, S1); if (!late) M8_PV(ks); }
        ks = ks == 2 ? 0 : ks + 1;
      }
      if (late && NTL - 1 < nact) M8_PV(ks == 0 ? 2 : ks - 1); }
#endif
    l = half_sum(l); const float rl = 1.f / l;
    { int te = tid; asm volatile("" : "+v"(te));
      bf16_t* yr = Y + ((size_t)b * SEQ + qb * 256 + wave * 32 + (te & 31)) * 1024 + 512 + h * 128 + 4 * ((te >> 5) & 1);
#pragma unroll
      for (int d = 0; d < 4; ++d)
#pragma unroll
        for (int g = 0; g < 4; ++g) { u32x2 w; w.x = g8::cvt_pk_bf16(O[d][4 * g] * rl, O[d][4 * g + 1] * rl); w.y = g8::cvt_pk_bf16(O[d][4 * g + 2] * rl, O[d][4 * g + 3] * rl);
            *(u32x2*)(yr + 32 * d + 8 * g) = w; } }
#undef M8_ISSUE_K
#undef M8_ISSUE_V
#undef M8_SOFTMAX
#undef M8_SOFTMAX2
#undef M8_QK
#undef M8_PV
}
}
DEV void mla_fast(const Params& P, LAS unsigned char* lds) {
    const int tid = tid_fresh(); const int G = gridDim.x;
    for (int v = vcu_of(blockIdx.x, G); v < 256; v += G) { const int bh = v >> 2, s = v & 3;
        for (int ui = 0; ui < 4; ++ui) { const int qb = (ui == 0) ? s : (ui == 1) ? 7 - s : (ui == 2) ? 8 + s : 15 - s; mla::unit(P, lds, bh >> 2, bh & 3, qb, tid); } }
    asm volatile("s_waitcnt vmcnt(0)" ::: "memory"); __builtin_amdgcn_s_barrier();
}
namespace gla {
constexpr int L_QE = 0, L_KD = 9216, L_KDT = 18432, L_VT = 27648, L_ST = 46080  , STB = 18432, L_D = 82944, L_RED = 83200, L_G = 84224;
DEV int sw128(int row, int chunk) { return row * 144 + chunk * 16; }
template <int CTRL, int RM> DEV float dppz(float v) { return __int_as_float(__builtin_amdgcn_update_dpp(0, __float_as_int(v), CTRL, RM, 0xf, false)); }
DEV float wave_scan(float x) {
    x += __int_as_float(__builtin_amdgcn_update_dpp(0, __float_as_int(x), 0x111, 0xf, 0xf, true));
    x += __int_as_float(__builtin_amdgcn_update_dpp(0, __float_as_int(x), 0x112, 0xf, 0xf, true));
    x += __int_as_float(__builtin_amdgcn_update_dpp(0, __float_as_int(x), 0x114, 0xf, 0xf, true));
    x += __int_as_float(__builtin_amdgcn_update_dpp(0, __float_as_int(x), 0x118, 0xf, 0xf, true));
    x += dppz<0x142, 0xa>(x);
    x += dppz<0x143, 0xc>(x);
    return x;
}
DEV void item(const Params& P, LAS unsigned char* lds, int b, int h, int tid) {
    unsigned char* ws = P.ws; const int lane = tid & 63, r32 = lane & 31, hi = lane >> 5; const int wave = __builtin_amdgcn_readfirstlane(tid >> 6), ie = wave >> 1, ih = wave & 1;
    const bf16_t* Z = (const bf16_t*)P.out; const float* LOGA = (const float*)(ws + WS_LOGA); const bf16_t* VTG = (const bf16_t*)(ws + WS_VTG); bf16_t* Y = (bf16_t*)(ws + WS_Y);
    const float* S1 = (const float*)(ws + WS_META + MT_S1); const float* gain = P.in[I_GOUTN];
    __syncthreads();
    f32x16 accS;
#pragma unroll
    for (int r = 0; r < 16; ++r) { const int e = 32 * ie + crow(r, hi), d = 32 * ih + r32; accS[r] = S1[(h * 64 + d) * 128 + e];
        *(LAS bf16_t*)(lds + L_ST + sw128(e, d >> 3) + (d & 7) * 2) = (bf16_t)f2bf(accS[r]); }
    const size_t m0 = (size_t)b * SEQ;
    const char* Zb = (const char*)Z + m0 * NZ * 2; const char* Lb = (const char*)LOGA + m0 * 256 * 4; const char* Vb = (const char*)VTG + ((size_t)h * 128 * M + m0) * 2;
    const unsigned oq = (unsigned)(lane * NZ + ZQ + h * 64 + 8 * wave) * 2u, ok = (unsigned)(lane * NZ + ZK + h * 64 + 8 * wave) * 2u, ola = (unsigned)(lane * 256 + h * 64 + 8 * wave) * 4u;
    const unsigned ovt = (unsigned)(((size_t)(tid >> 2) * M + 16 * (tid & 3)) * 2), org = (unsigned)((32 * ih + r32) * NZ + ZR + h * 128 + 32 * ie + 4 * hi) * 2u;
#define GLA_LD(q_, k_, a0_, a1_, v0_, v1_, n_) do { const char* zc_ = Zb + (size_t)(n_) * 64 * NZ * 2; const char* lc_ = Lb + (size_t)(n_) * 64 * 256 * 4; const char* vc_ = Vb + (size_t)(n_) * 64 * 2; \
        q_ = *(const u32x4*)(zc_ + oq); k_ = *(const u32x4*)(zc_ + ok); a0_ = *(const f32x4*)(lc_ + ola); a1_ = *(const f32x4*)(lc_ + ola + 16); v0_ = *(const u32x4*)(vc_ + ovt); v1_ = *(const u32x4*)(vc_ + ovt + 16); } while (0)
#define GLA_LDRG(r_, n_) do { const char* zc_ = Zb + (size_t)(n_) * 64 * NZ * 2; _Pragma("unroll") for (int g = 0; g < 4; ++g) r_[g] = *(const u32x2*)(zc_ + org + 16 * g); } while (0)
    u32x4 qv, kv, vt0, vt1, qv2, kv2, vt02, vt12; f32x4 la0, la1, la02, la12; u32x2 rg[4], rgn[4];
    GLA_LD(qv, kv, la0, la1, vt0, vt1, 0); GLA_LD(qv2, kv2, la02, la12, vt02, vt12, 1); GLA_LDRG(rg, 0);
    if (tid < 128) *(LAS float*)(lds + L_G + 4 * tid) = gain[h * 128 + tid];
    const int kperm = pi23(r32);
    int par = 0;
    for (int n = 0; n < 64; n += 2) {
        { float bq[8] = {la0[0], la0[1], la0[2], la0[3], la1[0], la1[1], la1[2], la1[3]}; const unsigned qw[4] = {qv.x, qv.y, qv.z, qv.w}, kw[4] = {kv.x, kv.y, kv.z, kv.w};
          u32x4 qo, ko; unsigned qo_[4], ko_[4];
#pragma unroll
          for (int i = 0; i < 8; ++i) bq[i] = wave_scan(bq[i]);
          float e1[8], kd[8], qe[8];
#pragma unroll
          for (int i = 0; i < 8; ++i) { e1[i] = __expf(bq[i]); const float e2 = __builtin_amdgcn_rcpf(e1[i]);
              const float qf_ = (i & 1) ? __uint_as_float(qw[i >> 1] & 0xffff0000u) : __uint_as_float(qw[i >> 1] << 16), kf_ = (i & 1) ? __uint_as_float(kw[i >> 1] & 0xffff0000u) : __uint_as_float(kw[i >> 1] << 16);
              qe[i] = qf_ * e1[i] * 0.125f; kd[i] = kf_ * e2; }
#pragma unroll
          for (int i = 0; i < 4; ++i) { qo_[i] = pk2(qe[2 * i], qe[2 * i + 1]); ko_[i] = pk2(kd[2 * i], kd[2 * i + 1]); }
          qo.x = qo_[0]; qo.y = qo_[1]; qo.z = qo_[2]; qo.w = qo_[3]; ko.x = ko_[0]; ko.y = ko_[1]; ko.z = ko_[2]; ko.w = ko_[3];
          *(LAS u32x4*)(lds + L_QE + sw128(lane, wave)) = qo; *(LAS u32x4*)(lds + L_KD + sw128(lane, wave)) = ko;
#pragma unroll
          for (int i = 0; i < 8; ++i) { const int d = 8 * wave + i; *(LAS bf16_t*)(lds + L_KDT + sw128(d, lane >> 3) + (lane & 7) * 2) = (bf16_t)f2bf(kd[i]);
              const float dl = rl_f(e1[i], 63); if (lane == 0) *(LAS float*)(lds + L_D + 4 * d) = dl; }
          { const int e = tid >> 2, c0 = 2 * (tid & 3); *(LAS u32x4*)(lds + L_VT + sw128(e, c0)) = vt0; *(LAS u32x4*)(lds + L_VT + sw128(e, c0 + 1)) = vt1; } }
        __syncthreads();
        if (n + 2 < 64) GLA_LD(qv, kv, la0, la1, vt0, vt1, n + 2);
        if (n + 1 < 64) GLA_LDRG(rgn, n + 1);
        const size_t mtok = m0 + (size_t)n * 64 + 32 * ih + r32;
        bf16x8 qf[4], vf[4];
#pragma unroll
        for (int ks = 0; ks < 4; ++ks) { qf[ks] = *(LAS const bf16x8*)(lds + L_QE + sw128(32 * ih + r32, 2 * ks + hi)); vf[ks] = *(LAS const bf16x8*)(lds + L_VT + sw128(32 * ie + r32, 2 * ks + hi)); }
        f32x16 o = {};
#pragma unroll
        for (int ts = 0; ts < 2; ++ts) if (ts <= ih) {
            f32x16 at = {};
#pragma unroll
            for (int ks = 0; ks < 4; ++ks) { const bf16x8 kf = *(LAS const bf16x8*)(lds + L_KD + sw128(32 * ts + kperm, 2 * ks + hi)); at = __builtin_amdgcn_mfma_f32_32x32x16_bf16(kf, qf[ks], at, 0, 0, 0); }
            if (ts == ih) {
#pragma unroll
                for (int r = 0; r < 16; ++r) if (pi23(crow(r, hi)) > r32) at[r] = 0.f; }
            u32x4 w0, w1; w0.x = pk2_mfma(at[0], at[1]); w0.y = pk2_mfma(at[2], at[3]); w0.z = pk2_mfma(at[4], at[5]); w0.w = pk2_mfma(at[6], at[7]);
            w1.x = pk2_mfma(at[8], at[9]); w1.y = pk2_mfma(at[10], at[11]); w1.z = pk2_mfma(at[12], at[13]); w1.w = pk2_mfma(at[14], at[15]);
            o = __builtin_amdgcn_mfma_f32_32x32x16_bf16(vf[2 * ts], __builtin_bit_cast(bf16x8, w0), o, 0, 0, 0);
            o = __builtin_amdgcn_mfma_f32_32x32x16_bf16(vf[2 * ts + 1], __builtin_bit_cast(bf16x8, w1), o, 0, 0, 0);
        }
#pragma unroll
        for (int ks = 0; ks < 4; ++ks) { const bf16x8 sf = *(LAS const bf16x8*)(lds + L_ST + par * STB + sw128(32 * ie + r32, 2 * ks + hi)); o = __builtin_amdgcn_mfma_f32_32x32x16_bf16(sf, qf[ks], o, 0, 0, 0); }
#pragma unroll
        for (int ks = 0; ks < 4; ++ks) { const bf16x8 tf = *(LAS const bf16x8*)(lds + L_KDT + sw128(32 * ih + r32, 2 * ks + hi)); accS = __builtin_amdgcn_mfma_f32_32x32x16_bf16(vf[ks], tf, accS, 0, 0, 0); }
        { const float dl = *(LAS const float*)(lds + L_D + 4 * (32 * ih + r32));
#pragma unroll
          for (int r = 0; r < 16; ++r) { accS[r] *= dl; const int e = 32 * ie + crow(r, hi), d = 32 * ih + r32;
              *(LAS bf16_t*)(lds + L_ST + (par ^ 1) * STB + sw128(e, d >> 3) + (d & 7) * 2) = (bf16_t)f2bf(accS[r]); } }
        { float ss = 0.f;
#pragma unroll
          for (int r = 0; r < 16; ++r) ss += o[r] * o[r];
          ss = half_sum(ss); if (hi == 0) *(LAS float*)(lds + L_RED + (wave * 32 + r32) * 4) = ss; }
        __syncthreads();
        { float tot = 0.f;
#pragma unroll
          for (int q = 0; q < 4; ++q) tot += *(LAS const float*)(lds + L_RED + ((2 * q + ih) * 32 + r32) * 4);
          const float rs = rsqrtf(tot * (1.f / 128.f) + EPS);
#pragma unroll
          for (int g = 0; g < 4; ++g) { const float r0 = __uint_as_float(rg[g].x << 16), r1 = __uint_as_float(rg[g].x & 0xffff0000u), r2 = __uint_as_float(rg[g].y << 16), r3 = __uint_as_float(rg[g].y & 0xffff0000u);
              const f32x4 gn = *(LAS const f32x4*)(lds + L_G + 4 * (32 * ie + 8 * g + 4 * hi));
              u32x2 w; w.x = g8::cvt_pk_bf16(o[4 * g] * rs * gn[0] * siluf(r0), o[4 * g + 1] * rs * gn[1] * siluf(r1));
              w.y = g8::cvt_pk_bf16(o[4 * g + 2] * rs * gn[2] * siluf(r2), o[4 * g + 3] * rs * gn[3] * siluf(r3));
              *(u32x2*)(Y + mtok * 1024 + h * 128 + 32 * ie + 8 * g + 4 * hi) = w; } }

        par ^= 1;
        { const int n1 = n + 1;
        { float bq[8] = {la02[0], la02[1], la02[2], la02[3], la12[0], la12[1], la12[2], la12[3]}; const unsigned qw[4] = {qv2.x, qv2.y, qv2.z, qv2.w}, kw[4] = {kv2.x, kv2.y, kv2.z, kv2.w};
          u32x4 qo, ko; unsigned qo_[4], ko_[4];
#pragma unroll
          for (int i = 0; i < 8; ++i) bq[i] = wave_scan(bq[i]);
          float e1[8], kd[8], qe[8];
#pragma unroll
          for (int i = 0; i < 8; ++i) { e1[i] = __expf(bq[i]); const float e2 = __builtin_amdgcn_rcpf(e1[i]);
              const float qf_ = (i & 1) ? __uint_as_float(qw[i >> 1] & 0xffff0000u) : __uint_as_float(qw[i >> 1] << 16), kf_ = (i & 1) ? __uint_as_float(kw[i >> 1] & 0xffff0000u) : __uint_as_float(kw[i >> 1] << 16);
              qe[i] = qf_ * e1[i] * 0.125f; kd[i] = kf_ * e2; }
#pragma unroll
          for (int i = 0; i < 4; ++i) { qo_[i] = pk2(qe[2 * i], qe[2 * i + 1]); ko_[i] = pk2(kd[2 * i], kd[2 * i + 1]); }
          qo.x = qo_[0]; qo.y = qo_[1]; qo.z = qo_[2]; qo.w = qo_[3]; ko.x = ko_[0]; ko.y = ko_[1]; ko.z = ko_[2]; ko.w = ko_[3];
          *(LAS u32x4*)(lds + L_QE + sw128(lane, wave)) = qo; *(LAS u32x4*)(lds + L_KD + sw128(lane, wave)) = ko;
#pragma unroll
          for (int i = 0; i < 8; ++i) { const int d = 8 * wave + i; *(LAS bf16_t*)(lds + L_KDT + sw128(d, lane >> 3) + (lane & 7) * 2) = (bf16_t)f2bf(kd[i]);
              const float dl = rl_f(e1[i], 63); if (lane == 0) *(LAS float*)(lds + L_D + 4 * d) = dl; }
          { const int e = tid >> 2, c0 = 2 * (tid & 3); *(LAS u32x4*)(lds + L_VT + sw128(e, c0)) = vt02; *(LAS u32x4*)(lds + L_VT + sw128(e, c0 + 1)) = vt12; } }
        __syncthreads();
        if (n1 + 2 < 64) GLA_LD(qv2, kv2, la02, la12, vt02, vt12, n1 + 2);
        if (n1 + 1 < 64) GLA_LDRG(rg, n1 + 1);
        const size_t mtok = m0 + (size_t)n1 * 64 + 32 * ih + r32;
        bf16x8 qf[4], vf[4];
#pragma unroll
        for (int ks = 0; ks < 4; ++ks) { qf[ks] = *(LAS const bf16x8*)(lds + L_QE + sw128(32 * ih + r32, 2 * ks + hi)); vf[ks] = *(LAS const bf16x8*)(lds + L_VT + sw128(32 * ie + r32, 2 * ks + hi)); }
        f32x16 o = {};
#pragma unroll
        for (int ts = 0; ts < 2; ++ts) if (ts <= ih) {
            f32x16 at = {};
#pragma unroll
            for (int ks = 0; ks < 4; ++ks) { const bf16x8 kf = *(LAS const bf16x8*)(lds + L_KD + sw128(32 * ts + kperm, 2 * ks + hi)); at = __builtin_amdgcn_mfma_f32_32x32x16_bf16(kf, qf[ks], at, 0, 0, 0); }
            if (ts == ih) {
#pragma unroll
                for (int r = 0; r < 16; ++r) if (pi23(crow(r, hi)) > r32) at[r] = 0.f; }
            u32x4 w0, w1; w0.x = pk2_mfma(at[0], at[1]); w0.y = pk2_mfma(at[2], at[3]); w0.z = pk2_mfma(at[4], at[5]); w0.w = pk2_mfma(at[6], at[7]);
            w1.x = pk2_mfma(at[8], at[9]); w1.y = pk2_mfma(at[10], at[11]); w1.z = pk2_mfma(at[12], at[13]); w1.w = pk2_mfma(at[14], at[15]);
            o = __builtin_amdgcn_mfma_f32_32x32x16_bf16(vf[2 * ts], __builtin_bit_cast(bf16x8, w0), o, 0, 0, 0);
            o = __builtin_amdgcn_mfma_f32_32x32x16_bf16(vf[2 * ts + 1], __builtin_bit_cast(bf16x8, w1), o, 0, 0, 0);
        }
#pragma unroll
        for (int ks = 0; ks < 4; ++ks) { const bf16x8 sf = *(LAS const bf16x8*)(lds + L_ST + par * STB + sw128(32 * ie + r32, 2 * ks + hi)); o = __builtin_amdgcn_mfma_f32_32x32x16_bf16(sf, qf[ks], o, 0, 0, 0); }
#pragma unroll
        for (int ks = 0; ks < 4; ++ks) { const bf16x8 tf = *(LAS const bf16x8*)(lds + L_KDT + sw128(32 * ih + r32, 2 * ks + hi)); accS = __builtin_amdgcn_mfma_f32_32x32x16_bf16(vf[ks], tf, accS, 0, 0, 0); }
        { const float dl = *(LAS const float*)(lds + L_D + 4 * (32 * ih + r32));
#pragma unroll
          for (int r = 0; r < 16; ++r) { accS[r] *= dl; const int e = 32 * ie + crow(r, hi), d = 32 * ih + r32;
              *(LAS bf16_t*)(lds + L_ST + (par ^ 1) * STB + sw128(e, d >> 3) + (d & 7) * 2) = (bf16_t)f2bf(accS[r]); } }
        { float ss = 0.f;
#pragma unroll
          for (int r = 0; r < 16; ++r) ss += o[r] * o[r];
          ss = half_sum(ss); if (hi == 0) *(LAS float*)(lds + L_RED + (wave * 32 + r32) * 4) = ss; }
        __syncthreads();
        { float tot = 0.f;
#pragma unroll
          for (int q = 0; q < 4; ++q) tot += *(LAS const float*)(lds + L_RED + ((2 * q + ih) * 32 + r32) * 4);
          const float rs = rsqrtf(tot * (1.f / 128.f) + EPS);
#pragma unroll
          for (int g = 0; g < 4; ++g) { const float r0 = __uint_as_float(rgn[g].x << 16), r1 = __uint_as_float(rgn[g].x & 0xffff0000u), r2 = __uint_as_float(rgn[g].y << 16), r3 = __uint_as_float(rgn[g].y & 0xffff0000u);
              const f32x4 gn = *(LAS const f32x4*)(lds + L_G + 4 * (32 * ie + 8 * g + 4 * hi));
              u32x2 w; w.x = g8::cvt_pk_bf16(o[4 * g] * rs * gn[0] * siluf(r0), o[4 * g + 1] * rs * gn[1] * siluf(r1));
              w.y = g8::cvt_pk_bf16(o[4 * g + 2] * rs * gn[2] * siluf(r2), o[4 * g + 3] * rs * gn[3] * siluf(r3));
              *(u32x2*)(Y + mtok * 1024 + h * 128 + 32 * ie + 8 * g + 4 * hi) = w; } }

        par ^= 1; }
    }
}
}
DEV void phase3_fast(const Params& P, LAS unsigned char* lds) {
    const int tid = tid_fresh(); const int G = gridDim.x; const int vcu = vcu_of(blockIdx.x, G);
    int* qhead = (int*)(P.ws + WS_CTL) + CW_MLAQ;
    for (int it = vcu; it < 256; it += G) if ((it & 3) == 0) gla::item(P, lds, it >> 4, (it >> 2) & 3, tid);
#if XCONV_P3
    for (int it = vcu; it < 256; it += G) if ((it & (XCONV_DIV - 1)) == XCONV_SEL) expert_convert(P, (it / XCONV_DIV) * NWAVE + (tid >> 6), (256 / XCONV_DIV) * NWAVE, tid & 63);
#endif
    for (;;) {
        __syncthreads();
        if (tid == 0) *(LAS int*)(lds + 131072 + 16) = atomicAdd(qhead, 1);
        __syncthreads();
        const int idx = __builtin_amdgcn_readfirstlane(*(LAS const int*)(lds + 131072 + 16));
        if (idx >= 1024) break;
        const int qb = 15 - (idx >> 6), bh = idx & 63;
        if (MLA8) mla8::unit(P, lds, bh >> 2, bh & 3, qb, tid); else mla::unit(P, lds, bh >> 2, bh & 3, qb, tid);
    }
    asm volatile("s_waitcnt vmcnt(0)" ::: "memory"); __builtin_amdgcn_s_barrier();
}
DEV void phase1_fast(const Params& P, LAS unsigned char* lds) {
    unsigned char* ws = P.ws;
    { g8::DenseSched S; S.init(ws + WS_XN, D, ws + WS_WIN, D, M, 1536, gridDim.x, blockIdx.x);
      g8::EpiZ E{(bf16_t*)P.out, (float*)(ws + WS_CTL + CTL_SSQ_Q), (float*)(ws + WS_CTL + CTL_SSQ_KV)};
      g8::gemm_phase<g8::EpiZ, g8::DenseSched, false>(lds, D, D, D, S, E); }
    { g8::DenseSched S; S.init(ws + WS_WIN + (size_t)1536 * D * 2, D, ws + WS_XN, D, 512, M, gridDim.x, blockIdx.x);
      g8::EpiD E{(bf16_t*)(ws + WS_VTG), (size_t)M};
      g8::gemm_phase<g8::EpiD, g8::DenseSched, false>(lds, D, D, D, S, E); }
    meta_phase(P);
}
DEV void phase2_rows(const Params& P) { const int tid_ = tid_fresh();
    unsigned char* ws = P.ws; const int lane = tid_ & 63; const int gw = blockIdx.x * NWAVE + (tid_ >> 6), ngw = gridDim.x * NWAVE;
    const bf16_t* Z = (const bf16_t*)P.out; bf16_t* KR = (bf16_t*)(ws + WS_KR); float* LOGA = (float*)(ws + WS_LOGA);
    const float2* rt = (const float2*)(ws + WS_ROPE); const float* wa2 = P.in[I_WA2]; const float* ba = P.in[I_BA];
    float w[4][16], bb[4];
#pragma unroll
    for (int j = 0; j < 4; ++j) { bb[j] = ba[64 * j + lane];
#pragma unroll
        for (int r = 0; r < 16; ++r) w[j][r] = wa2[r * 256 + 64 * j + lane]; }
    for (int m = gw; m < M; m += ngw) { const bf16_t* z = Z + (size_t)m * NZ;
        { const float v = bf2f(z[ZKR + lane]), o = sx<1>(v); const float2 cs = rt[(NMETA + (m & (SEQ - 1))) * 32 + (lane >> 1)];
          const float kr_ = (lane & 1) ? (v * cs.x + o * cs.y) : (v * cs.x - o * cs.y);
          if (MLA8) { const int b8 = __builtin_amdgcn_cvt_pk_fp8_f32(kr_, 0.f, 0, false) & 0xff;
              const int w8 = __builtin_amdgcn_mov_dpp(b8, 0x00, 0xf, 0xf, true) | (__builtin_amdgcn_mov_dpp(b8, 0x55, 0xf, 0xf, true) << 8) | (__builtin_amdgcn_mov_dpp(b8, 0xAA, 0xf, 0xf, true) << 16) | (__builtin_amdgcn_mov_dpp(b8, 0xFF, 0xf, 0xf, true) << 24);
              if ((lane & 3) == 0) *(int*)((unsigned char*)KR + (size_t)m * 64 + lane) = w8; }
          else KR[(size_t)m * 64 + lane] = (bf16_t)f2bf(kr_); }
        float al[16];
#pragma unroll
        for (int r = 0; r < 16; ++r) al[r] = bf2f(z[ZAL + r]);
#pragma unroll
        for (int j = 0; j < 4; ++j) { float x = bb[j];
#pragma unroll
            for (int r = 0; r < 16; ++r) x += al[r] * w[j][r];
            LOGA[(size_t)m * 256 + 64 * j + lane] = logsigmoidf(x) * (1.f / 16.f); }
    }
}
DEV void kr8_rows(const Params& P) { const int tid_ = tid_fresh();
    unsigned char* ws = P.ws; const int lane = tid_ & 63; const int gw = blockIdx.x * NWAVE + (tid_ >> 6), ngw = gridDim.x * NWAVE;
    const bf16_t* Z = (const bf16_t*)P.out; unsigned char* KR = ws + WS_KR; const float2* rt = (const float2*)(ws + WS_ROPE);
    for (int blk = gw; blk < M / 32; blk += ngw) {
        u32x4 zz[4]; f32x4 c0[4], c1[4];
#pragma unroll
        for (int q = 0; q < 4; ++q) { const int m = blk * 32 + q * 8 + (lane >> 3), c8 = lane & 7;
            zz[q] = *(const u32x4*)(Z + (size_t)m * NZ + ZKR + 8 * c8);
            const f32x4* cp = (const f32x4*)(rt + (NMETA + (m & (SEQ - 1))) * 32 + 4 * c8); c0[q] = cp[0]; c1[q] = cp[1]; }
#pragma unroll
        for (int q = 0; q < 4; ++q) { const int m = blk * 32 + q * 8 + (lane >> 3), c8 = lane & 7;
            const unsigned zw[4] = {zz[q].x, zz[q].y, zz[q].z, zz[q].w}; const float cs[8] = {c0[q][0], c0[q][1], c0[q][2], c0[q][3], c1[q][0], c1[q][1], c1[q][2], c1[q][3]};
            float o[8];
#pragma unroll
            for (int i = 0; i < 4; ++i) { const float a = __uint_as_float(zw[i] << 16), b = __uint_as_float(zw[i] & 0xffff0000u), c = cs[2 * i], s = cs[2 * i + 1];
                o[2 * i] = a * c - b * s; o[2 * i + 1] = b * c + a * s; }
            u32x2 w; w.x = pk4_fp8(o[0], o[1], o[2], o[3]); w.y = pk4_fp8(o[4], o[5], o[6], o[7]);
            *(u32x2*)(KR + (size_t)m * 64 + 8 * c8) = w; }
    }
}
DEV void phase2_fast(const Params& P, LAS unsigned char* lds) {
    unsigned char* ws = P.ws; const bf16_t* Z = (const bf16_t*)P.out; const float* ssq_q = (const float*)(ws + WS_CTL + CTL_SSQ_Q); const float* ssq_kv = (const float*)(ws + WS_CTL + CTL_SSQ_KV);
#if !defined(X2) || (X2 & 1)
    { g8::DenseSched S; S.init(Z + ZQL, NZ, ws + WS_WQ, 256, M, 768, gridDim.x, blockIdx.x);
      if (MLA8) { g8::EpiQ8 E{(unsigned char*)(ws + WS_QM), ssq_q, (const float2*)(ws + WS_ROPE)}; g8::gemm_phase<g8::EpiQ8, g8::DenseSched, false>(lds, 256, NZ, 256, S, E); }
      else { g8::EpiQ E{(bf16_t*)(ws + WS_QM), ssq_q, (const float2*)(ws + WS_ROPE)}; g8::gemm_phase<g8::EpiQ, g8::DenseSched, false>(lds, 256, NZ, 256, S, E); } }
#endif
#if !defined(X2) || (X2 & 2)
    { g8::DenseSched S; S.init(Z + ZKVL, NZ, ws + WS_WK, 256, M, 512, gridDim.x, blockIdx.x);
      if (MLA8) { g8::EpiK8 E{(unsigned char*)(ws + WS_KN), ssq_kv}; g8::gemm_phase<g8::EpiK8, g8::DenseSched, false>(lds, 256, NZ, 256, S, E); }
      else { g8::EpiK E{(bf16_t*)(ws + WS_KN), ssq_kv}; g8::gemm_phase<g8::EpiK, g8::DenseSched, false>(lds, 256, NZ, 256, S, E); } }
#endif
#if !defined(X2) || (X2 & 4)
    { g8::DenseSched S; S.init(ws + WS_WV, 256, Z + ZKVL, NZ, 512, M, gridDim.x, blockIdx.x);
      if (MLA8) { g8::EpiVT8 E{(unsigned char*)(ws + WS_VT), ssq_kv}; g8::gemm_phase<g8::EpiVT8, g8::DenseSched, false>(lds, 256, 256, NZ, S, E); }
      else { g8::EpiVT E{(bf16_t*)(ws + WS_VT), ssq_kv}; g8::gemm_phase<g8::EpiVT, g8::DenseSched, false>(lds, 256, 256, NZ, S, E); } }
#endif
    if (MLA8) {
        g8::DenseSched S; S.init(Z + ZKR, NZ, ws + WS_WA2T, 128, M, 256, gridDim.x, blockIdx.x);
        g8::EpiLOGA E{(float*)(ws + WS_LOGA), P.in[I_BA]}; g8::gemm_phase<g8::EpiLOGA, g8::DenseSched, false>(lds, 128, NZ, 128, S, E);
        kr8_rows(P);
    } else phase2_rows(P);
}
DEV void phase4_fast(const Params& P, LAS unsigned char* lds) {
    unsigned char* ws = P.ws;
    g8::DenseSched S; S.init(ws + WS_Y, D, ws + WS_WOUT, D, M, D, gridDim.x, blockIdx.x);
    g8::EpiD E{(bf16_t*)(ws + WS_D16), (size_t)D};
    g8::gemm_phase<g8::EpiD, g8::DenseSched, false>(lds, D, D, D, S, E);
}
DEV void phase6_fast(const Params& P, LAS unsigned char* lds) { const int tid_ = tid_fresh();
    unsigned char* ws = P.ws; const int lane = tid_ & 63;
    int c_l, total; const int st_l = slot_start_lane((const int*)(ws + WS_CTL) + CW_CNT, lane, c_l, total);
    if (tid_ < 64) { *(volatile LAS int*)(SLOTTAB_OFF + 4u * (unsigned)lane) = st_l; *(volatile LAS int*)(SLOTTAB_OFF + 256u + 4u * (unsigned)lane) = c_l; }
    __syncthreads();
    g8::MoeSched S{(const char*)(ws + WS_TN8), (const char*)(ws + WS_WGU), (size_t)1024 * 1024, (size_t)256 * 1024, 0, (const int*)(ws + WS_LIST), (total / 256) * 4, (int)gridDim.x, vcu_of(blockIdx.x, gridDim.x), D};
    g8::EpiGU8 E{(unsigned char*)(ws + WS_MH)};
    g8::gemm_phase<g8::EpiGU8, g8::MoeSched, true, true>(lds, D / 2, D / 2, D / 2, S, E);
}
DEV void phase7_fast(const Params& P, LAS unsigned char* lds) { const int tid_ = tid_fresh();
    unsigned char* ws = P.ws; const int lane = tid_ & 63;
    int c_l, total; const int st_l = slot_start_lane((const int*)(ws + WS_CTL) + CW_CNT, lane, c_l, total);
    if (tid_ < 64) { *(volatile LAS int*)(SLOTTAB_OFF + 4u * (unsigned)lane) = st_l; *(volatile LAS int*)(SLOTTAB_OFF + 256u + 4u * (unsigned)lane) = c_l; }
    __syncthreads();
    g8::MoeSched S{(const char*)(ws + WS_MH), (const char*)(ws + WS_WD), (size_t)1024 * 512, (size_t)256 * 512, (size_t)256 * 512, nullptr, (total / 256) * 4, (int)gridDim.x, vcu_of(blockIdx.x, gridDim.x), DE};
    g8::EpiD8 E{(unsigned char*)(ws + WS_MY), 16.f / (8.f * 32.f)};
    g8::gemm_phase<g8::EpiD8, g8::MoeSched, false, true>(lds, DE / 2, DE / 2, DE / 2, S, E);
}

#define XB_TMO      128
#define XB_XCNT(j)  (256  + 64 * (j))
#define XB_XSUB(j)  (1280 + 64 * (j))
#define XB_XGEN(j)  (2304 + 64 * (j))
#define XB_TOP      3328
#define XB_TOPGEN   3392
#define XCD_BAR_WORDS 3456
#define XB_SPIN_CAP (1u << 22)
DEV unsigned xb_ld(unsigned* p)              { return __hip_atomic_load(p, __ATOMIC_RELAXED, __HIP_MEMORY_SCOPE_AGENT); }
DEV unsigned xb_add(unsigned* p, unsigned v) { return __hip_atomic_fetch_add(p, v, __ATOMIC_RELAXED, __HIP_MEMORY_SCOPE_AGENT); }
DEV unsigned xb_xcc_id() { return (unsigned)__builtin_amdgcn_s_getreg((3 << 11) | 20) & 0xFu; }
#define XB_SPIN(cond, bar) do { unsigned _sp = 0; while (cond) { __builtin_amdgcn_s_sleep(1); \
    if ((++_sp & 255u) == 0u) { if (xb_ld(&(bar)[XB_TMO])) break; if (_sp > XB_SPIN_CAP) { atomicAdd(&(bar)[XB_TMO], 1u); break; } } } } while (0)
struct XcdBarrier { unsigned* bar; unsigned x; volatile LAS unsigned* st; };
DEV XcdBarrier xcd_barrier_post(unsigned* bar, volatile LAS unsigned* st) {
    XcdBarrier b; b.bar = bar; b.x = xb_xcc_id(); b.st = st;
    if (threadIdx.x == 0) (void)xb_add(&bar[XB_XCNT(b.x)], 1u);
    return b;
}
DEV void xcd_barrier_complete(unsigned* bar, unsigned x, unsigned& nloc, unsigned& nx) {
    const unsigned G = gridDim.x * gridDim.y * gridDim.z;
    unsigned sum, cnt, mine, sp = 0u;
    for (;;) {
        sum = 0u; cnt = 0u; mine = 0u;
#pragma unroll
        for (unsigned j = 0; j < 16; ++j) { const unsigned c = xb_ld(&bar[XB_XCNT(j)]); sum += c; cnt += (c > 0u) ? 1u : 0u; mine = (j == x) ? c : mine; }
        if (sum == G) break;
        __builtin_amdgcn_s_sleep(1);
        if ((++sp & 255u) == 0u) { if (xb_ld(&bar[XB_TMO])) break; if (sp > XB_SPIN_CAP) { atomicAdd(&bar[XB_TMO], 1u); break; } }
    }
    nloc = mine > 0u ? mine : 1u; nx = cnt > 0u ? cnt : 1u;
}
DEV void xcd_barrier(const XcdBarrier& b) {
    asm volatile("s_waitcnt vmcnt(0)" ::: "memory");
    __syncthreads();
    if (tid_fresh() == 0) {
        unsigned* bar = b.bar;
        __builtin_amdgcn_s_waitcnt(0);
        unsigned nloc = b.st[0], nx = b.st[1];
        if (nloc == 0u) { xcd_barrier_complete(bar, b.x, nloc, nx); b.st[0] = nloc; b.st[1] = nx; }
        const unsigned old = xb_add(&bar[XB_XSUB(b.x)], 1u);
        const unsigned gen = old / nloc;
        if (old + 1u == (gen + 1u) * nloc) {
            __builtin_amdgcn_fence(__ATOMIC_RELEASE, "agent");
            asm volatile("s_waitcnt vmcnt(0)" ::: "memory");
            const unsigned og = xb_add(&bar[XB_TOP], 1u);
            const unsigned tg = og / nx;
            if (og + 1u == (tg + 1u) * nx) xb_add(&bar[XB_TOPGEN], 1u);
            else XB_SPIN(xb_ld(&bar[XB_TOPGEN]) == tg, bar);
            __builtin_amdgcn_fence(__ATOMIC_ACQUIRE, "agent");
            xb_add(&bar[XB_XGEN(b.x)], 1u);
            asm volatile("s_waitcnt vmcnt(0)" ::: "memory");
        } else {
            XB_SPIN(xb_ld(&bar[XB_XGEN(b.x)]) == gen, bar);
            __builtin_amdgcn_fence(__ATOMIC_ACQUIRE, "agent");
            asm volatile("s_waitcnt vmcnt(0)" ::: "memory");
        }
    }
    __syncthreads();
}

__global__ void __launch_bounds__(NT) mega_kernel(Params P) {
    __shared__ __attribute__((aligned(16))) float scr[NWAVE * 4096 + 16 + 64 + 128];
    LAS unsigned char* lds = (LAS unsigned char*)scr;
    volatile LAS unsigned* MISC = (volatile LAS unsigned*)(lds + NWAVE * 4096 * 4);
    if (threadIdx.x < 16) MISC[threadIdx.x] = 0u;
    if ((threadIdx.x & 63) == 0) *(volatile LAS unsigned*)(TIDMAP_OFF + 4u * hw_wave_key()) = threadIdx.x >> 6;
    __syncthreads();
    XcdBarrier xbar = xcd_barrier_post((unsigned*)(P.ws + WS_CTL) + CW_BAR, MISC);
#define GSYNC() xcd_barrier(xbar)
#ifndef DUP
#define DUP 0
#endif
    phase0(P, scr); if (DUP & 1) phase0(P, scr);           GSYNC();
    if (FAST & 1) phase1_fast(P, lds); else phase1(P);
    GSYNC();
    if (FAST & 2) phase2_fast(P, lds); else { phase2a(P); GSYNC(); phase2b(P); }
    if (DUP & 2) phase2_fast(P, lds);
    GSYNC();
    phase3_fast(P, lds);
    if (DUP & 4) phase3_fast(P, lds);
    GSYNC();
    if (FAST & 4) phase4_fast(P, lds); else phase4(P);
    if (DUP & 16) phase4_fast(P, lds);
    GSYNC();
    if (FAST & 64) phase5_fast(P); else phase5(P, scr);
    GSYNC();
    if (FAST & 8) phase6_fast(P, lds); else phase6(P);
    if (DUP & 32) phase6_fast(P, lds);
    GSYNC();
    if (FAST & 16) phase7_fast(P, lds); else phase7(P);
    if (DUP & 64) phase7_fast(P, lds);
    GSYNC();
    phase8(P); if (DUP & 128) phase8(P);
}

extern "C" void kernel_launch(void* const* d_in, const int* in_sizes, int n_in, void* d_out, int out_size, void* d_ws, size_t ws_size, hipStream_t stream) {
    if (n_in != 21 || out_size != M * D || ws_size < WS_END) { fprintf(stderr, "kernel_launch: unexpected shapes (n_in %d out %d ws %zu)\n", n_in, out_size, ws_size); return; }
    static int grid_blocks = 0;
    if (!grid_blocks) {
        int dev = 0, cus = 0, per_cu = 0;
        (void)hipGetDevice(&dev);
        (void)hipDeviceGetAttribute(&cus, hipDeviceAttributeMultiprocessorCount, dev);
        (void)hipOccupancyMaxActiveBlocksPerMultiprocessor(&per_cu, mega_kernel, NT, 0);
        if (per_cu < 1) { fprintf(stderr, "kernel_launch: occupancy query says %d blocks per CU\n", per_cu); per_cu = 1; }
        grid_blocks = cus;
    }
    Params P{};
    for (int i = 0; i < 21; ++i) P.in[i] = (const float*)d_in[i];
    P.out = (float*)d_out; P.ws = (unsigned char*)d_ws;
    (void)hipMemsetAsync((char*)d_ws + WS_CTL, 0, 1 * MiB, stream);
    mega_kernel<<<dim3(grid_blocks), dim3(NT), 0, stream>>>(P);
}
```

```cpp
#include <hip/hip_runtime.h>
#include <hip/hip_cooperative_groups.h>
namespace cg = cooperative_groups;
#include <cstdio>
#include <cstdint>

#ifndef MLA8
#ifndef XCONV_P3
#define XCONV_P3 1
#endif
#ifndef XCONV_SEL
#define XCONV_SEL 1
#endif
#ifndef PINGPONG
#define PINGPONG 0
#endif
#ifndef SM2
#define SM2 0
#endif
#ifndef XCONV_DIV
#define XCONV_DIV 4
#endif
#define MLA8 1
#endif
#define DEV __device__ __forceinline__
typedef unsigned short bf16_t;
typedef short bf16x8 __attribute__((ext_vector_type(8)));
typedef float f32x16 __attribute__((ext_vector_type(16)));
typedef float f32x4 __attribute__((ext_vector_type(4)));
typedef unsigned u32x4 __attribute__((ext_vector_type(4)));
typedef unsigned u32x2 __attribute__((ext_vector_type(2)));

constexpr int NB = 16, SEQ = 4096, M = NB * SEQ, D = 1024, NMETA = 16;
constexpr int NZ = 2048;
constexpr int ZQ = 0, ZK = 256, ZV = 512, ZR = 1024, ZQL = 1536, ZKVL = 1792, ZKR = 1920, ZAL = 1984;
constexpr int NE = 64, DE = 512;
constexpr float EPS = 1e-6f;
constexpr int NT = 512, NWAVE = 8, GRID = 256;
constexpr int SLOT_CAP = 151552;

constexpr size_t MiB = 1ull << 20;
constexpr size_t WS_CTL = 0;
constexpr size_t WS_WIN = 1 * MiB;
constexpr size_t WS_WQ = 5 * MiB;
constexpr size_t WS_WK = 5 * MiB + 512 * 1024;
constexpr size_t WS_WV = 5 * MiB + 768 * 1024;
constexpr size_t WS_WOUT = 6 * MiB;
constexpr size_t WS_ROPE = 8 * MiB;
constexpr size_t WS_META = 10 * MiB;
constexpr size_t WS_RS = 11 * MiB;
constexpr size_t WS_WR = 11 * MiB + 512 * 1024;
constexpr size_t WS_WA2T = 11 * MiB + 768 * 1024;
constexpr size_t WS_TOK = 12 * MiB;
constexpr size_t WS_WGU = 16 * MiB;
constexpr size_t WS_WD = 144 * MiB;
constexpr size_t WS_R1 = 208 * MiB;
constexpr size_t WS_QM = WS_R1, WS_KN = WS_R1 + 96 * MiB, WS_VT = WS_R1 + 160 * MiB, WS_KR = WS_R1 + 224 * MiB;
constexpr size_t WS_H2 = WS_R1;
constexpr size_t WS_D16 = WS_R1, WS_H2B = WS_R1 + 128 * MiB;
constexpr size_t WS_R2 = 464 * MiB;
constexpr size_t WS_XN = WS_R2, WS_Y = WS_R2, WS_TN = WS_R2, WS_MY = WS_R2;
constexpr size_t WS_LOGA = 592 * MiB;
constexpr size_t WS_TN8 = 592 * MiB;
constexpr size_t WS_VTG = 656 * MiB;
constexpr size_t WS_MH = 760 * MiB;
constexpr size_t WS_LIST = 908 * MiB;
constexpr size_t WS_END = 924 * MiB;
constexpr size_t MT_Z = 0;
constexpr size_t MT_KN = 128 * 1024;
constexpr size_t MT_VT = 160 * 1024;
constexpr size_t MT_KR = 192 * 1024;
constexpr size_t MT_S1 = 256 * 1024;
constexpr size_t MT_KN8 = 640 * 1024, MT_VT8 = 672 * 1024, MT_KR8 = 704 * 1024;
constexpr int CW_CNT = 0;
constexpr int CW_MLAQ = 64;
constexpr int CW_BAR = 16384;
constexpr size_t CTL_MZ = 768 * 1024, CTL_RSM = 896 * 1024;
constexpr size_t CTL_SSQ_Q = 256 * 1024, CTL_SSQ_KV = 512 * 1024;

struct Params { const float* in[21]; float* out; unsigned char* ws; };
enum { I_X = 0, I_META, I_MIXN, I_WIN, I_WA2, I_BA, I_GOUTN, I_QN, I_WQB, I_KVN, I_WKVB, I_WOUT, I_FFN, I_RGW, I_RGB, I_REW, I_REB, I_WG, I_WU, I_WDN, I_FINAL };

DEV unsigned pk2(float lo, float hi) { unsigned r; asm("v_cvt_pk_bf16_f32 %0, %1, %2" : "=v"(r) : "v"(lo), "v"(hi)); return r; }
typedef float f32x2_t __attribute__((ext_vector_type(2))); typedef __bf16 bf16x2_t __attribute__((ext_vector_type(2)));
DEV unsigned pk2_mfma(float lo, float hi) { const f32x2_t v = {lo, hi}; const bf16x2_t b = __builtin_convertvector(v, bf16x2_t); return __builtin_bit_cast(unsigned, b); }
DEV unsigned f2bf(float f) { return pk2(f, 0.f) & 0xffffu; }
DEV float bf2f(unsigned h) { return __uint_as_float(h << 16); }
template <int CTRL> DEV float dpp_f(float v) { return __int_as_float(__builtin_amdgcn_mov_dpp(__float_as_int(v), CTRL, 0xf, 0xf, true)); }
template <int K> DEV float sx(float v) {
    if constexpr (K == 1) return dpp_f<0xB1>(v);
    else if constexpr (K == 2) return dpp_f<0x4E>(v);
    else return __int_as_float(__builtin_amdgcn_ds_swizzle(__float_as_int(v), 0x1f | (K << 10)));
}
DEV float half_sum(float v) { auto rr = __builtin_amdgcn_permlane32_swap(__float_as_uint(v), __float_as_uint(v), false, false); return __uint_as_float(rr[0]) + __uint_as_float(rr[1]); }
DEV float half_max(float v) { auto rr = __builtin_amdgcn_permlane32_swap(__float_as_uint(v), __float_as_uint(v), false, false); return fmaxf(__uint_as_float(rr[0]), __uint_as_float(rr[1])); }
DEV float wave_sum(float v) { v += sx<1>(v); v += sx<2>(v); v += sx<4>(v); v += sx<8>(v); v += sx<16>(v); return half_sum(v); }
DEV int rl_i(int v, int l) { return __builtin_amdgcn_readlane(v, l); }
DEV float rl_f(float v, int l) { return __int_as_float(__builtin_amdgcn_readlane(__float_as_int(v), l)); }
constexpr unsigned TIDMAP_OFF = 131072u + 64u;
constexpr unsigned SLOTTAB_OFF = TIDMAP_OFF + 256u;
DEV unsigned hw_wave_key() { return (unsigned)__builtin_amdgcn_s_getreg((5 << 11) | 4) & 63u; }
DEV int tid_fresh() { const unsigned w = *(volatile __attribute__((address_space(3))) unsigned*)(TIDMAP_OFF + 4u * hw_wave_key());
    unsigned l; asm volatile("v_mbcnt_lo_u32_b32 %0, -1, 0\n\tv_mbcnt_hi_u32_b32 %0, -1, %0" : "=v"(l));
    int t = (int)(w * 64u + l); asm volatile("" : "+v"(t)); return t; }
DEV int crow(int r, int hi) { return (r & 3) + 8 * (r >> 2) + 4 * hi; }
DEV int pi23(int i) { return (i & ~12) | ((i & 4) << 1) | ((i & 8) >> 1); }
DEV float logsigmoidf(float x) { return fminf(x, 0.f) - log1pf(__expf(-fabsf(x))); }
DEV float siluf(float x) { return x * __builtin_amdgcn_rcpf(1.f + __expf(-x)); }

DEV void wave_tile(const bf16_t* a0, const bf16_t* a1, const bf16_t* b0, const bf16_t* b1, int K, f32x16& c00, f32x16& c01, f32x16& c10, f32x16& c11) {
    for (int k = 0; k < K; k += 16) {
        const bf16x8 A0 = *(const bf16x8*)(a0 + k), A1 = *(const bf16x8*)(a1 + k), B0 = *(const bf16x8*)(b0 + k), B1 = *(const bf16x8*)(b1 + k);
        c00 = __builtin_amdgcn_mfma_f32_32x32x16_bf16(A0, B0, c00, 0, 0, 0);
        c01 = __builtin_amdgcn_mfma_f32_32x32x16_bf16(A0, B1, c01, 0, 0, 0);
        c10 = __builtin_amdgcn_mfma_f32_32x32x16_bf16(A1, B0, c10, 0, 0, 0);
        c11 = __builtin_amdgcn_mfma_f32_32x32x16_bf16(A1, B1, c11, 0, 0, 0);
    }
}
template <class AF, class BF, class EF>
DEV void gemm_simple(int Mt, int Nt, int K, AF arow, BF brow, EF epi, int gw, int ngw) { const int tid_ = tid_fresh();
    const int lane = tid_ & 63, r32 = lane & 31, hi = lane >> 5;
    for (int it = gw; it < Mt * Nt; it += ngw) {
        const int tm = it / Nt, tn = it % Nt;
        f32x16 c00 = {}, c01 = {}, c10 = {}, c11 = {};
        wave_tile(arow(tm * 64 + r32) + hi * 8, arow(tm * 64 + 32 + r32) + hi * 8, brow(tn * 64 + r32) + hi * 8, brow(tn * 64 + 32 + r32) + hi * 8, K, c00, c01, c10, c11);
#pragma unroll
        for (int r = 0; r < 16; ++r) {
            const int row = tm * 64 + crow(r, hi), col = tn * 64 + r32;
            epi(row, col, c00[r]); epi(row, col + 32, c01[r]); epi(row + 32, col, c10[r]); epi(row + 32, col + 32, c11[r]);
        }
    }
}


#define LAS __attribute__((address_space(3)))
namespace g8 {
constexpr int BM = 256, BK = 64, HALF = 128, HTB = HALF * BK * 2, STAGE_BYTES = 8 * HTB, NXCD = 8, WGM = 8;
DEV int lds_byte(int r, int c) { const int st = (r >> 4) * 2 + (c >> 5), rr = r & 15, cc = c & 31, ob = rr * 64 + cc * 2; return st * 1024 + (ob ^ (((ob >> 9) & 1) << 5)); }
DEV void stage_rc(int b, int& R, int& C) { const int st = b / 1024, sb = b % 1024, swz = sb ^ (((sb >> 9) & 1) << 5); R = (st >> 1) * 16 + swz / 64; C = (st & 1) * 32 + (swz % 64) / 2; }
DEV int perm32(int rho) { const int n = rho >> 4, i = rho & 15; return 8 * (i >> 2) + 4 * n + (i & 3); }
struct Unit { int pm, pn, e; };
typedef f32x4 Acc[2][2][4][2];
typedef int i32x8 __attribute__((ext_vector_type(8)));
typedef int i32x4 __attribute__((ext_vector_type(4)));
DEV f32x4 mfma_any(i32x8 a, i32x8 b, f32x4 c) { return __builtin_amdgcn_mfma_scale_f32_16x16x128_f8f6f4(a, b, c, 0, 0, 0, 0x7f7f7f7f, 0, 0x7f7f7f7f); }
DEV f32x4 mfma_any(bf16x8 a, bf16x8 b, f32x4 c) { return __builtin_amdgcn_mfma_f32_16x16x32_bf16(a, b, c, 0, 0, 0); }
template <bool F8> struct FragSel { typedef bf16x8 T; };
template <> struct FragSel<true> { typedef i32x8 T; };
template <class Epi, class Sched, bool GATHER, bool F8 = false>
DEV void gemm_phase(LAS unsigned char* lds, const int K, const int lda, const int ldb, const Sched& S, const Epi& E) { const int tid_ = tid_fresh();
    const int tid = tid_, wid = __builtin_amdgcn_readfirstlane(tid >> 6), lane = tid & 63, wr = wid >> 2, wc = wid & 3, fr = lane & 15, fq = lane >> 4;
    const int nt = K / BK;
    unsigned voffB, vC0;
    unsigned tkC0 = 0u, tkC1 = 0u, tkN0 = 0u, tkN1 = 0u, cbA = 0u;
    { int R, C; stage_rc(tid * 16, R, C); const int Rb = Epi::PERM ? ((R & ~31) + perm32(R & 31)) : R;
      voffB = (unsigned)(Rb * ldb + C) * 2u; vC0 = (unsigned)(R * lda + C) * 2u; cbA = (unsigned)C * 2u; }
    const unsigned pstepA = (unsigned)(64 * lda * 2), pstepB = (unsigned)(64 * ldb * 2);
    const unsigned kstep = (unsigned)(BK * 2), hstepB = (unsigned)(HALF * ldb * 2), hA = GATHER ? 0u : (unsigned)(HALF * lda * 2);
    const __amdgpu_buffer_rsrc_t rA = __builtin_amdgcn_make_buffer_rsrc((void*)S.A, 0, 0x7ffffff0, 0x00020000), rB = __builtin_amdgcn_make_buffer_rsrc((void*)S.B, 0, 0x7ffffff0, 0x00020000);
    const unsigned ldsw = (unsigned)wid * 1024u;
    int aoff = lds_byte(wr * 64 + fr, F8 ? fq * 16 : fq * 8), boff = lds_byte(wc * 32 + fr, F8 ? fq * 16 : fq * 8) + 4 * HTB;
    asm volatile("" : "+v"(aoff), "+v"(boff));
#define G8_SA(b, h) (((b) * 2 + (h)) * HTB)
#define G8_SB(b, h) ((4 + (b) * 2 + (h)) * HTB)
#define G8_SBR(b, h) (((b) * 2 + (h)) * HTB)
#define G8_STAGE1(bufoff, rs, soff, voff, i) __builtin_amdgcn_raw_ptr_buffer_load_lds(rs, (LAS void*)(lds + (bufoff) + ldsw + (i) * 8192), 16, (int)(voff), (int)(soff), 0, 0)
#define G8_STAGE_B(bufoff, soff) do { G8_STAGE1(bufoff, rB, soff, voffB, 0); G8_STAGE1(bufoff, rB, (soff) + pstepB, voffB, 1); } while (0)
#define G8_LDA(dst, b, h) do { _Pragma("unroll") for (int m = 0; m < 4; ++m) _Pragma("unroll") for (int k = 0; k < NK; ++k) dst[m][k] = *(const LAS FragT*)(lds + aoff + (G8_SA(b, h) + m * 2048 + k * 1024)); } while (0)
#define G8_LDB(dst, b, h) do { _Pragma("unroll") for (int n = 0; n < 2; ++n) _Pragma("unroll") for (int k = 0; k < NK; ++k) dst[n][k] = *(const LAS FragT*)(lds + boff + (G8_SBR(b, h) + n * 2048 + k * 1024)); } while (0)
#define G8_MMA(ai, bj, At, Bt) do { __builtin_amdgcn_s_setprio(1); _Pragma("unroll") for (int m = 0; m < 4; ++m) _Pragma("unroll") for (int n = 0; n < 2; ++n) { \
        _Pragma("unroll") for (int k = 0; k < NK; ++k) acc[ai][bj][m][n] = mfma_any(Bt[n][k], At[m][k], acc[ai][bj][m][n]); } \
        __builtin_amdgcn_s_setprio(0); } while (0)
#define G8_WAIT_V(n) asm volatile("s_waitcnt vmcnt(" #n ")" ::: "memory")
#define G8_WAIT_L(n) asm volatile("s_waitcnt lgkmcnt(" #n ")" ::: "memory")
#define G8_BAR __builtin_amdgcn_s_barrier()
#define G8_SCHED __builtin_amdgcn_sched_barrier(0)
#define G8_AOFF(d0, d1, u) do { const int _t = tid_fresh(); int _R, _C; stage_rc(_t * 16, _R, _C); \
        d0 = (S.atok(u, _R) & 0xffffu) | (S.atok(u, _R + 64) << 16); d1 = (S.atok(u, HALF + _R) & 0xffffu) | (S.atok(u, HALF + _R + 64) << 16); } while (0)
#define G8_STAGE_A(bufoff, soff, tk) do { if constexpr (GATHER) { G8_STAGE1(bufoff, rA, soff, ((tk) & 0xffffu) * (unsigned)S.lda2 + cbA, 0); G8_STAGE1(bufoff, rA, soff, ((tk) >> 16) * (unsigned)S.lda2 + cbA, 1); } \
        else { G8_STAGE1(bufoff, rA, soff, vC0, 0); G8_STAGE1(bufoff, rA, (soff) + pstepA, vC0, 1); } } while (0)
    Unit cur, nxt; int ui = 0;
    if (!S.next(0, cur)) return;
    Acc acc;
#pragma unroll
    for (int a = 0; a < 2; ++a)
#pragma unroll
        for (int b = 0; b < 2; ++b)
#pragma unroll
            for (int m = 0; m < 4; ++m)
#pragma unroll
                for (int n = 0; n < 2; ++n) acc[a][b][m][n] = (f32x4){0.f, 0.f, 0.f, 0.f};
    typedef typename FragSel<F8>::T FragT; constexpr int NK = F8 ? 1 : 2;
    FragT At[4][NK], B0[2][NK], B1[2][NK];
    unsigned cA = S.aoff(cur), cB = S.boff(cur);
    if (GATHER) { G8_AOFF(tkC0, tkC1, cur); }
    G8_STAGE_B(G8_SB(0, 0), cB); G8_STAGE_B(G8_SB(0, 1), cB + hstepB); G8_STAGE_A(G8_SA(0, 0), cA, tkC0); G8_STAGE_A(G8_SA(0, 1), cA + hA, tkC1);
    if (wr == 1) G8_BAR;
    G8_WAIT_V(2); G8_BAR;
    G8_STAGE_B(G8_SB(1, 0), cB + kstep); G8_STAGE_A(G8_SA(1, 0), cA + kstep, tkC0); G8_STAGE_B(G8_SB(1, 1), cB + hstepB + kstep);
    G8_WAIT_V(6); G8_BAR;
    for (;;) {
        const bool has_next = S.next(ui + 1, nxt);
        const unsigned nA = has_next ? S.aoff(nxt) : cA, nB = has_next ? S.boff(nxt) : cB;
#pragma unroll 1
        for (int t = 0; t < nt; t += 2) {
            const bool last = (t == nt - 2);
            if (GATHER && t == (nt >= 4 ? nt - 4 : 0)) {
                if (has_next) { G8_AOFF(tkN0, tkN1, nxt); } else { tkN0 = tkC0; tkN1 = tkC1; } }
            const unsigned a1 = cA + (unsigned)(t + 1) * kstep;
            const unsigned a2 = last ? nA : cA + (unsigned)(t + 2) * kstep, b2 = last ? nB : cB + (unsigned)(t + 2) * kstep;
            const unsigned a3 = a2 + kstep, b3 = b2 + kstep;
            const unsigned s0 = (GATHER && last) ? tkN0 : tkC0, s1 = (GATHER && last) ? tkN1 : tkC1;
            G8_LDB(B0, 0, 0); G8_LDB(B1, 0, 1); G8_SCHED; G8_LDA(At, 0, 0); G8_STAGE_A(G8_SA(1, 1), a1 + hA, tkC1);
            G8_WAIT_V(8); G8_WAIT_L(0); G8_BAR; G8_MMA(0, 0, At, B0); G8_MMA(0, 1, At, B1); G8_BAR; G8_SCHED;
            G8_LDA(At, 0, 1); G8_STAGE_B(G8_SB(0, 0), b2); G8_STAGE_B(G8_SB(0, 1), b2 + hstepB); G8_STAGE_A(G8_SA(0, 0), a2, s0);
            G8_WAIT_V(8); G8_WAIT_L(0); G8_BAR; G8_MMA(1, 0, At, B0); G8_MMA(1, 1, At, B1); G8_BAR; G8_SCHED;
            G8_LDB(B0, 1, 0); G8_LDB(B1, 1, 1); G8_SCHED; G8_LDA(At, 1, 0); G8_STAGE_A(G8_SA(0, 1), a2 + hA, s1);
            G8_WAIT_V(8); G8_WAIT_L(0); G8_BAR; G8_MMA(0, 0, At, B0); G8_MMA(0, 1, At, B1); G8_BAR; G8_SCHED;
            G8_LDA(At, 1, 1); G8_STAGE_B(G8_SB(1, 0), b3); G8_STAGE_B(G8_SB(1, 1), b3 + hstepB); G8_STAGE_A(G8_SA(1, 0), a3, s0);
            G8_WAIT_V(8); G8_WAIT_L(0); G8_BAR; G8_MMA(1, 0, At, B0); G8_MMA(1, 1, At, B1); G8_BAR; G8_SCHED;
        }
        if (wr == 0) G8_BAR;
        { const int te_ = tid_fresh(); E(acc, cur, wr, wc, te_ & 15, (te_ >> 4) & 3); }
        if (!has_next) break;
#pragma unroll
        for (int a = 0; a < 2; ++a)
#pragma unroll
            for (int b = 0; b < 2; ++b)
#pragma unroll
                for (int m = 0; m < 4; ++m)
#pragma unroll
                    for (int n = 0; n < 2; ++n) acc[a][b][m][n] = (f32x4){0.f, 0.f, 0.f, 0.f};
        cur = nxt; cA = nA; cB = nB; ++ui;
        if (GATHER) { tkC0 = tkN0; tkC1 = tkN1; }
        if (wr == 1) G8_BAR;
    }
    G8_WAIT_V(0);
    G8_BAR;
}
struct DenseSched {
    const char* A; const char* B; size_t tstepA, tstepB; int nM, nN, nwg, G, c;
    DEV void init(const void* A_, int lda, const void* B_, int ldb, int Mr, int Nc, int G_, int c_) { A = (const char*)A_; B = (const char*)B_; tstepA = (size_t)BM * lda * 2; tstepB = (size_t)BM * ldb * 2;
        nM = Mr / BM; nN = Nc / BM; nwg = nM * nN; G = G_; c = c_; }
    DEV bool next(int i, Unit& u) const {
        const long L = (long)i * G + c; if (L >= nwg) return false;
        int wgid = (int)L; { const int q = nwg / NXCD, r = nwg % NXCD, xcd = wgid % NXCD, off = wgid / NXCD; wgid = (xcd < r ? xcd * (q + 1) : r * (q + 1) + (xcd - r) * q) + off; }
        const int nig = WGM * nN, gid = wgid / nig, fm = gid * WGM, gsz = (nM - fm) < WGM ? (nM - fm) : WGM;
        u.pm = fm + ((wgid % nig) % gsz); u.pn = (wgid % nig) / gsz; u.e = 0; return true;
    }
    DEV unsigned aoff(const Unit& u) const { return (unsigned)((size_t)u.pm * tstepA); }
    DEV unsigned boff(const Unit& u) const { return (unsigned)((size_t)u.pn * tstepB); }
    DEV unsigned atok(const Unit&, int) const { return 0u; }
    static constexpr int lda2 = 0;
};
DEV unsigned cvt_pk_bf16(float lo, float hi) { unsigned r; asm volatile("v_cvt_pk_bf16_f32 %0, %1, %2" : "=v"(r) : "v"(lo), "v"(hi)); return r; }
DEV u32x4 pack8(const f32x4 v0, const f32x4 v1) { u32x4 w; w.x = cvt_pk_bf16(v0[0], v0[1]); w.y = cvt_pk_bf16(v0[2], v0[3]); w.z = cvt_pk_bf16(v1[0], v1[1]); w.w = cvt_pk_bf16(v1[2], v1[3]); return w; }
}

template <class SF>
DEV void transpose_item(SF src, bf16_t* dst, int ldd, int k0, int n0, float* scr, int lane) {
#pragma unroll 8
    for (int i = 0; i < 32; ++i) { const int kk = 2 * i + (lane >> 5); scr[kk * 33 + (lane & 31)] = src(k0 + kk, n0 + (lane & 31)); }
    __builtin_amdgcn_s_waitcnt(0xc07f); asm volatile("" ::: "memory");
    const int c = lane & 7;
#pragma unroll
    for (int j = 0; j < 4; ++j) { const int n = (lane >> 3) + 8 * j; const float* s = scr + (8 * c) * 33 + n;
        u32x4 o; o.x = pk2(s[0], s[33]); o.y = pk2(s[66], s[99]); o.z = pk2(s[132], s[165]); o.w = pk2(s[198], s[231]);
        *(u32x4*)(dst + (size_t)(n0 + n) * ldd + k0 + 8 * c) = o; }
    __builtin_amdgcn_s_waitcnt(0xc07f); asm volatile("" ::: "memory");
}
DEV unsigned pk4_fp8(float a, float b, float c, float d) { int t = __builtin_amdgcn_cvt_pk_fp8_f32(a, b, 0, false); t = __builtin_amdgcn_cvt_pk_fp8_f32(c, d, t, true); return (unsigned)t; }
DEV unsigned char f2fp8(float f) { return (unsigned char)(__builtin_amdgcn_cvt_pk_fp8_f32(f, 0.f, 0, false) & 0xff); }
template <class RM>
DEV void transpose_tile_reg8(const float* src, int ldn, unsigned char* dst, int ldd, int k0, int n0, RM rowmap, int lane, float sc) {
    const int kq = lane >> 4, nq = lane & 15; f32x4 v[16];
#pragma unroll
    for (int i = 0; i < 16; ++i) v[i] = *(const f32x4*)(src + (size_t)(k0 + 16 * kq + i) * ldn + n0 + 4 * nq) * sc;
#pragma unroll
    for (int j = 0; j < 4; ++j) { u32x4 a; a.x = pk4_fp8(v[0][j], v[1][j], v[2][j], v[3][j]); a.y = pk4_fp8(v[4][j], v[5][j], v[6][j], v[7][j]); a.z = pk4_fp8(v[8][j], v[9][j], v[10][j], v[11][j]); a.w = pk4_fp8(v[12][j], v[13][j], v[14][j], v[15][j]);
        *(u32x4*)(dst + (size_t)rowmap(n0 + 4 * nq + j) * ldd + k0 + 16 * kq) = a; }
}
template <class RM>
DEV void transpose_tile_reg(const float* src, int ldn, bf16_t* dst, int ldd, int k0, int n0, RM rowmap, int lane) {
    const int kq = lane >> 4, nq = lane & 15; f32x4 v[16];
#pragma unroll
    for (int i = 0; i < 16; ++i) v[i] = *(const f32x4*)(src + (size_t)(k0 + 16 * kq + i) * ldn + n0 + 4 * nq);
#pragma unroll
    for (int j = 0; j < 4; ++j) { bf16_t* o = dst + (size_t)rowmap(n0 + 4 * nq + j) * ldd + k0 + 16 * kq;
        u32x4 a, b2; a.x = pk2(v[0][j], v[1][j]); a.y = pk2(v[2][j], v[3][j]); a.z = pk2(v[4][j], v[5][j]); a.w = pk2(v[6][j], v[7][j]);
        b2.x = pk2(v[8][j], v[9][j]); b2.y = pk2(v[10][j], v[11][j]); b2.z = pk2(v[12][j], v[13][j]); b2.w = pk2(v[14][j], v[15][j]);
        *(u32x4*)o = a; *(u32x4*)(o + 8) = b2; }
}
DEV int zcol_src(int n) {
    if (n < 1536) return n;
    if (n < 1792) return 1552 + (n - 1536);
    if (n < 1920) return 1808 + (n - 1792);
    if (n < 1984) { const int j = n - 1920; return 1936 + (j >> 1) + 32 * (j & 1); }
    if (n < 2000) return 1536 + (n - 1984);
    return -1;
}
DEV int wrow_to_zcol(int n) {
    if (n < 512) return n;
    if (n < 1024) return n + 512;
    if (n < 1280) return ZQL + (n - 1024);
    if (n < 1536) return ZKVL + (n - 1280);
    return ZV + (n - 1536);
}
DEV void expert_convert(const Params& P, int gw, int ngw, int lane) {
    unsigned char* ws = P.ws; const int kq = lane >> 4, nq = lane & 15;
    auto ld = [&](const float* W, int ldn, int k0, int n0, f32x4 (&v)[16]) {
#pragma unroll
        for (int i = 0; i < 16; ++i) v[i] = *(const f32x4*)(W + (size_t)(k0 + 16 * kq + i) * ldn + n0 + 4 * nq); };
    auto st = [&](unsigned char* dst, int ldd, int k0, int n0, bool gu, bool isu, const f32x4 (&v)[16]) {
#pragma unroll
        for (int j = 0; j < 4; ++j) { const int n = n0 + 4 * nq + j; const int row = gu ? (((n >> 2) << 3) + (n & 3) + (isu ? 4 : 0)) : n;
            u32x4 a; a.x = pk4_fp8(v[0][j] * 32.f, v[1][j] * 32.f, v[2][j] * 32.f, v[3][j] * 32.f); a.y = pk4_fp8(v[4][j] * 32.f, v[5][j] * 32.f, v[6][j] * 32.f, v[7][j] * 32.f);
            a.z = pk4_fp8(v[8][j] * 32.f, v[9][j] * 32.f, v[10][j] * 32.f, v[11][j] * 32.f); a.w = pk4_fp8(v[12][j] * 32.f, v[13][j] * 32.f, v[14][j] * 32.f, v[15][j] * 32.f);
            *(u32x4*)(dst + (size_t)row * ldd + k0 + 16 * kq) = a; } };
    for (int it = gw; it < NE * 256; it += 2 * ngw) { const int it2 = it + ngw; const bool two = it2 < NE * 256;
        const int e = it >> 8, q = it & 255, e2 = it2 >> 8, q2 = it2 & 255; const bool isu = q >= 128, isu2 = q2 >= 128;
        const int kb = (q & 127) >> 3, nb = q & 7, kb2 = (q2 & 127) >> 3, nb2 = q2 & 7;
        f32x4 va[16], vb[16];
        ld(P.in[isu ? I_WU : I_WG] + (size_t)e * 1024 * 512, 512, kb * 64, nb * 64, va);
        if (two) ld(P.in[isu2 ? I_WU : I_WG] + (size_t)e2 * 1024 * 512, 512, kb2 * 64, nb2 * 64, vb);
        st(ws + WS_WGU + (size_t)e * 1024 * 1024, 1024, kb * 64, nb * 64, true, isu, va);
        if (two) st(ws + WS_WGU + (size_t)e2 * 1024 * 1024, 1024, kb2 * 64, nb2 * 64, true, isu2, vb); }
    for (int it = gw; it < NE * 128; it += 2 * ngw) { const int it2 = it + ngw; const bool two = it2 < NE * 128;
        const int e = it >> 7, q = it & 127, e2 = it2 >> 7, q2 = it2 & 127; const int kb = q >> 4, nb = q & 15, kb2 = q2 >> 4, nb2 = q2 & 15;
        f32x4 va[16], vb[16];
        ld(P.in[I_WDN] + (size_t)e * 512 * 1024, 1024, kb * 64, nb * 64, va);
        if (two) ld(P.in[I_WDN] + (size_t)e2 * 512 * 1024, 1024, kb2 * 64, nb2 * 64, vb);
        st(ws + WS_WD + (size_t)e * 1024 * 512, 512, kb * 64, nb * 64, false, false, va);
        if (two) st(ws + WS_WD + (size_t)e2 * 1024 * 512, 512, kb2 * 64, nb2 * 64, false, false, vb); }
}
DEV void phase0(const Params& P, float* scr_all) { const int tid_ = tid_fresh();
    const int tid = tid_, lane = tid & 63, wave = tid >> 6;
    const int gw = blockIdx.x * NWAVE + wave, ngw = gridDim.x * NWAVE;
    float* scr = scr_all + wave * (64 * 33);
    unsigned char* ws = P.ws;
    constexpr int I_IN = 16 * 64, I_Q = 4 * 24, I_K = 4 * 16, I_V = 4 * 16, I_O = 16 * 32, I_GU = 16 * 32, I_DN = 8 * 32;
    constexpr int NITEMS = I_IN + I_Q + I_K + I_V + I_O;
    const float c2 = 0.07216878364870322f * 1.4426950408889634f;
    for (int it = gw; it < NITEMS; it += ngw) {
        int r = it;
        if (r < I_IN) { const float* W = P.in[I_WIN]; const int kb = r / 64, nb = r % 64;
            transpose_item([&](int k, int n) { const int s = zcol_src(wrow_to_zcol(n)); return s < 0 ? 0.f : W[(size_t)k * 2000 + s]; }, (bf16_t*)(ws + WS_WIN), 1024, kb * 64, nb * 32, scr, lane); continue; }
        r -= I_IN;
        if (r < I_Q) { const float* W = P.in[I_WQB]; const float* g = P.in[I_QN]; const int kb = r / 24, nb = r % 24;
            transpose_item([&](int k, int n) { int s; if (n < 512) s = (n >> 7) * 192 + (n & 127); else { const int q = n - 512, h = q >> 6, jj = q & 63; s = h * 192 + 128 + (jj >> 1) + 32 * (jj & 1); }
                return W[(size_t)k * 768 + s] * g[k] * c2; }, (bf16_t*)(ws + WS_WQ), 256, kb * 64, nb * 32, scr, lane); continue; }
        r -= I_Q;
        if (r < I_K + I_V) { const bool isv = r >= I_K; if (isv) r -= I_K; const float* W = P.in[I_WKVB]; const float* g = P.in[I_KVN]; const int kb = r / 16, nb = r % 16;
            transpose_item([&](int k, int n) { if (k >= 128) return 0.f; const int s = (n >> 7) * 256 + (isv ? 128 : 0) + (n & 127); return W[(size_t)k * 1024 + s] * g[k]; },
                           (bf16_t*)(ws + (isv ? WS_WV : WS_WK)), 256, kb * 64, nb * 32, scr, lane); continue; }
        r -= I_K + I_V;
        if (r < I_O) { const float* W = P.in[I_WOUT]; const int kb = r / 32, nb = r % 32;
            transpose_item([&](int k, int n) { return W[(size_t)k * 1024 + n]; }, (bf16_t*)(ws + WS_WOUT), 1024, kb * 64, nb * 32, scr, lane); continue; }
        r -= I_O;
        { }
    }
#if !XCONV_P3
    expert_convert(P, gw, ngw, lane);
#endif
    { const float* g = P.in[I_MIXN]; bf16_t* XN = (bf16_t*)(ws + WS_XN);
      f32x4 gv[4];
#pragma unroll
      for (int j = 0; j < 4; ++j) gv[j] = *(const f32x4*)(g + 256 * j + 4 * lane);
      for (int m0 = gw * 4; m0 < M; m0 += ngw * 4) {
        f32x4 v[4][4];
#pragma unroll
        for (int q = 0; q < 4; ++q)
#pragma unroll
            for (int j = 0; j < 4; ++j) v[q][j] = ((const f32x4*)(P.in[I_X] + (size_t)(m0 + q) * D) + lane)[64 * j];
#pragma unroll
        for (int q = 0; q < 4; ++q) { float s = 0.f;
#pragma unroll
            for (int j = 0; j < 4; ++j) s += (v[q][j].x * v[q][j].x + v[q][j].y * v[q][j].y) + (v[q][j].z * v[q][j].z + v[q][j].w * v[q][j].w);
            const float rs = rsqrtf(wave_sum(s) * (1.f / D) + EPS);
            unsigned long long* o8 = (unsigned long long*)(XN + (size_t)(m0 + q) * D) + lane;
#pragma unroll
            for (int j = 0; j < 4; ++j) o8[64 * j] = (unsigned long long)pk2(v[q][j].x * rs * gv[j].x, v[q][j].y * rs * gv[j].y) | ((unsigned long long)pk2(v[q][j].z * rs * gv[j].z, v[q][j].w * rs * gv[j].w) << 32); }
      } }
    const int gt = blockIdx.x * NT + tid, ngt = gridDim.x * NT;
    { float2* rt = (float2*)(ws + WS_ROPE);
      for (int i = gt; i < (SEQ + NMETA) * 32; i += ngt) { const int pos = i >> 5, f = i & 31;
        const double inv = pow(10000.0, -(double)(2 * f) / 64.0), ang = (double)pos * inv; rt[i] = make_float2((float)cos(ang), (float)sin(ang)); } }
    { bf16_t* wt = (bf16_t*)(ws + WS_WA2T); const float* wa2 = P.in[I_WA2];
      for (int i = gt; i < 256 * 128; i += ngt) { const int n = i >> 7, k = i & 127; wt[i] = (bf16_t)f2bf((k >= 64 && k < 80) ? wa2[(k - 64) * 256 + n] : 0.f); } }
    { bf16_t* wr = (bf16_t*)(ws + WS_WR); const float* wg = P.in[I_RGW]; const float* we = P.in[I_REW];
      for (int i = gt; i < 96 * D; i += ngt) { const int row = i >> 10, k = i & 1023, t = row >> 5, rho = row & 31, hi = (rho >> 2) & 1, r = (rho & 3) + 4 * (rho >> 3);
        float v = 0.f; if (t < 2) v = we[k * 64 + 8 * (4 * t + 2 * hi + (r >> 3)) + (r & 7)]; else if (hi == 0 && r < 8) v = wg[k * 8 + r];
        wr[i] = (bf16_t)f2bf(v * P.in[I_FFN][k]); } }
    { float* mz = (float*)(ws + WS_CTL + CTL_MZ); float* rsm = (float*)(ws + WS_CTL + CTL_RSM); const float* mt = P.in[I_META]; const float* g = P.in[I_MIXN]; const float* W = P.in[I_WIN];
      for (int it = gt; it < 32 * 1024; it += ngt) { const int ks = it >> 10, ci = it & 1023; const int n = ci < 768 ? ZK + ci : ZKVL + (ci - 768); const int s = (ci < 976) ? zcol_src(n) : -1;
        if (s >= 0) { float acc[NMETA];
#pragma unroll
            for (int r = 0; r < NMETA; ++r) acc[r] = 0.f;
#pragma unroll 4
            for (int k = ks * 32; k < ks * 32 + 32; ++k) { const float w = W[(size_t)k * 2000 + s] * g[k];
#pragma unroll
                for (int r = 0; r < NMETA; ++r) acc[r] += mt[r * D + k] * w; }
#pragma unroll
            for (int r = 0; r < NMETA; ++r) atomicAdd(mz + r * NZ + n, acc[r]); } }
      if (gw < NMETA) { float ss = 0.f;
#pragma unroll
        for (int j = 0; j < 16; ++j) { const float x = mt[gw * D + 64 * j + lane]; ss += x * x; }
        ss = wave_sum(ss); if (lane == 0) rsm[gw] = rsqrtf(ss * (1.f / D) + EPS); } }
}

DEV void meta_phase(const Params& P) { const int tid_ = tid_fresh();
    unsigned char* ws = P.ws; const int gt = blockIdx.x * NT + tid_, ngt = gridDim.x * NT;
    const float* mzr = (const float*)(ws + WS_CTL + CTL_MZ); const float* rsm = (const float*)(ws + WS_CTL + CTL_RSM);
    bf16_t* KNm = (bf16_t*)(ws + WS_META + MT_KN); bf16_t* VTm = (bf16_t*)(ws + WS_META + MT_VT); bf16_t* KRm = (bf16_t*)(ws + WS_META + MT_KR); float* S1 = (float*)(ws + WS_META + MT_S1);
    const float* Wkv = P.in[I_WKVB]; const float* gk = P.in[I_KVN];
    for (int i = gt; i < NMETA * 1024; i += ngt) { const int row = i >> 10, col = i & 1023; const float* z = mzr + row * NZ + ZKVL; const float rm = rsm[row];
        float ss = 0.f, acc = 0.f;
#pragma unroll 16
        for (int k = 0; k < 128; ++k) { const float zk = z[k] * rm; ss += zk * zk; acc += zk * gk[k] * Wkv[(size_t)k * 1024 + col]; }
        acc *= rsqrtf(ss * (1.f / 128.f) + EPS);
        const int h = col >> 8, w = col & 255;
        unsigned char* KN8m = ws + WS_META + MT_KN8; unsigned char* VT8m = ws + WS_META + MT_VT8;
        if (w < 128) { KNm[row * 512 + h * 128 + w] = (bf16_t)f2bf(acc); KNm[(row + 16) * 512 + h * 128 + w] = 0; KN8m[row * 512 + h * 128 + w] = f2fp8(acc); KN8m[(row + 16) * 512 + h * 128 + w] = 0; }
        else { VTm[(h * 128 + w - 128) * 32 + row] = (bf16_t)f2bf(acc); VTm[(h * 128 + w - 128) * 32 + 16 + row] = 0; VT8m[(h * 128 + w - 128) * 32 + row] = f2fp8(acc); VT8m[(h * 128 + w - 128) * 32 + 16 + row] = 0; } }
    const float2* rt = (const float2*)(ws + WS_ROPE);
    for (int i = gt; i < NMETA * 32; i += ngt) { const int row = i >> 5, f = i & 31; const float x1 = mzr[row * NZ + ZKR + 2 * f] * rsm[row], x2 = mzr[row * NZ + ZKR + 2 * f + 1] * rsm[row]; const float2 cs = rt[row * 32 + f];
        KRm[row * 64 + 2 * f] = (bf16_t)f2bf(x1 * cs.x - x2 * cs.y); KRm[row * 64 + 2 * f + 1] = (bf16_t)f2bf(x2 * cs.x + x1 * cs.y); KRm[(row + 16) * 64 + 2 * f] = 0; KRm[(row + 16) * 64 + 2 * f + 1] = 0;
        unsigned char* KR8m = ws + WS_META + MT_KR8; KR8m[row * 64 + 2 * f] = f2fp8(x1 * cs.x - x2 * cs.y); KR8m[row * 64 + 2 * f + 1] = f2fp8(x2 * cs.x + x1 * cs.y); KR8m[(row + 16) * 64 + 2 * f] = 0; KR8m[(row + 16) * 64 + 2 * f + 1] = 0; }
    const float* wa2 = P.in[I_WA2]; const float* ba = P.in[I_BA];
    for (int i = gt; i < 4 * 64 * 128; i += ngt) { const int h = i >> 13, d = (i >> 7) & 63, e = i & 127; float S = 0.f;
        for (int s = 0; s < NMETA; ++s) { const float* z = mzr + s * NZ; const float rm = rsm[s]; float x = 0.f;
            for (int r = 0; r < 16; ++r) x += z[ZAL + r] * wa2[r * 256 + h * 64 + d];
            x = x * rm + ba[h * 64 + d];
            const float a = __expf((fminf(x, 0.f) - __logf(1.f + __expf(-fabsf(x)))) * (1.f / 16.f)); S = a * S + (z[ZK + h * 64 + d] * rm) * (z[ZV + h * 128 + e] * rm); }
        S1[i] = S; }
}
DEV void phase1(const Params& P) { const int tid_ = tid_fresh();
    unsigned char* ws = P.ws; const int gw = blockIdx.x * NWAVE + (tid_ >> 6), ngw = gridDim.x * NWAVE;
    const bf16_t* XN = (const bf16_t*)(ws + WS_XN); const bf16_t* W = (const bf16_t*)(ws + WS_WIN); bf16_t* Z = (bf16_t*)P.out;
    gemm_simple(M / 64, NZ / 64, D, [&](int r) { return XN + (size_t)r * D; }, [&](int c) { return W + (size_t)c * D; },
                [&](int row, int col, float v) { Z[(size_t)row * NZ + col] = (bf16_t)f2bf(v); }, gw, ngw);
    meta_phase(P);
}
DEV void phase2a(const Params& P) { const int tid_ = tid_fresh();
    unsigned char* ws = P.ws; const int lane = tid_ & 63; const int gw = blockIdx.x * NWAVE + (tid_ >> 6), ngw = gridDim.x * NWAVE;
    const bf16_t* Z = (const bf16_t*)P.out; float* rsq = (float*)(ws + WS_RS); float* rskv = rsq + M; bf16_t* KR = (bf16_t*)(ws + WS_KR); float* LOGA = (float*)(ws + WS_LOGA);
    const float2* rt = (const float2*)(ws + WS_ROPE); const float* wa2 = P.in[I_WA2]; const float* ba = P.in[I_BA];
    float w[4][16], bb[4];
#pragma unroll
    for (int j = 0; j < 4; ++j) { bb[j] = ba[64 * j + lane];
#pragma unroll
        for (int r = 0; r < 16; ++r) w[j][r] = wa2[r * 256 + 64 * j + lane]; }
    for (int m = gw; m < M; m += ngw) { const bf16_t* z = Z + (size_t)m * NZ;
        float s = 0.f;
#pragma unroll
        for (int j = 0; j < 4; ++j) { const float v = bf2f(z[ZQL + 64 * j + lane]); s += v * v; }
        s = wave_sum(s); float s2 = 0.f;
#pragma unroll
        for (int j = 0; j < 2; ++j) { const float v = bf2f(z[ZKVL + 64 * j + lane]); s2 += v * v; }
        s2 = wave_sum(s2);
        if (lane == 0) { rsq[m] = rsqrtf(s * (1.f / 256.f) + EPS); rskv[m] = rsqrtf(s2 * (1.f / 128.f) + EPS); }
        { const float v = bf2f(z[ZKR + lane]), o = sx<1>(v); const float2 cs = rt[(NMETA + (m & (SEQ - 1))) * 32 + (lane >> 1)];
          KR[(size_t)m * 64 + lane] = (bf16_t)f2bf((lane & 1) ? (v * cs.x + o * cs.y) : (v * cs.x - o * cs.y)); }
        float al[16];
#pragma unroll
        for (int r = 0; r < 16; ++r) al[r] = bf2f(z[ZAL + r]);
#pragma unroll
        for (int j = 0; j < 4; ++j) { float x = bb[j];
#pragma unroll
            for (int r = 0; r < 16; ++r) x += al[r] * w[j][r];
            LOGA[(size_t)m * 256 + 64 * j + lane] = logsigmoidf(x) * (1.f / 16.f); }
    }
}
DEV void phase2b(const Params& P) { const int tid_ = tid_fresh();
    unsigned char* ws = P.ws; const int gw = blockIdx.x * NWAVE + (tid_ >> 6), ngw = gridDim.x * NWAVE;
    const bf16_t* Z = (const bf16_t*)P.out; const float* rsq = (const float*)(ws + WS_RS); const float* rskv = rsq + M;
    const float2* rt = (const float2*)(ws + WS_ROPE);
    { bf16_t* QM = (bf16_t*)(ws + WS_QM); const bf16_t* W = (const bf16_t*)(ws + WS_WQ);
      gemm_simple(M / 64, 768 / 64, 256, [&](int r) { return Z + (size_t)r * NZ + ZQL; }, [&](int c) { return W + (size_t)c * 256; },
                  [&](int row, int col, float v) { v *= rsq[row]; const float o = sx<1>(v);
                      if (col >= 512) { const float2 cs = rt[(NMETA + (row & (SEQ - 1))) * 32 + ((col & 63) >> 1)]; v = (col & 1) ? (v * cs.x + o * cs.y) : (v * cs.x - o * cs.y); }
                      QM[(size_t)row * 768 + col] = (bf16_t)f2bf(v); }, gw, ngw); }
    { bf16_t* KN = (bf16_t*)(ws + WS_KN); const bf16_t* W = (const bf16_t*)(ws + WS_WK);
      gemm_simple(M / 64, 512 / 64, 256, [&](int r) { return Z + (size_t)r * NZ + ZKVL; }, [&](int c) { return W + (size_t)c * 256; },
                  [&](int row, int col, float v) { KN[(size_t)row * 512 + col] = (bf16_t)f2bf(v * rskv[row]); }, gw, ngw); }
    { bf16_t* VT = (bf16_t*)(ws + WS_VT); const bf16_t* W = (const bf16_t*)(ws + WS_WV);
      gemm_simple(512 / 64, M / 64, 256, [&](int r) { return W + (size_t)r * 256; }, [&](int c) { return Z + (size_t)c * NZ + ZKVL; },
                  [&](int row, int col, float v) { VT[(size_t)row * M + col] = (bf16_t)f2bf(v * rskv[col]); }, gw, ngw); }
}
DEV void gla_simple(const Params& P) { const int tid_ = tid_fresh();
    unsigned char* ws = P.ws; const int tid = tid_;
    const bf16_t* Z = (const bf16_t*)P.out; const float* LOGA = (const float*)(ws + WS_LOGA); const float* S1 = (const float*)(ws + WS_META + MT_S1); bf16_t* Y = (bf16_t*)(ws + WS_Y);
    for (int u = blockIdx.x; u < NB * 4; u += gridDim.x) { const int b = u >> 2, h = u & 3, e = tid >> 2, dq = tid & 3;
        float S[16];
#pragma unroll
        for (int j = 0; j < 16; ++j) S[j] = S1[(h * 64 + dq * 16 + j) * 128 + e];
        for (int t = 0; t < SEQ; ++t) { const size_t m = (size_t)b * SEQ + t; const bf16_t* z = Z + m * NZ;
            const u32x4 q0 = *(const u32x4*)(z + ZQ + h * 64 + dq * 16), q1 = *(const u32x4*)(z + ZQ + h * 64 + dq * 16 + 8);
            const u32x4 k0 = *(const u32x4*)(z + ZK + h * 64 + dq * 16), k1 = *(const u32x4*)(z + ZK + h * 64 + dq * 16 + 8);
            const f32x4* la = (const f32x4*)(LOGA + m * 256 + h * 64 + dq * 16);
            const float v = bf2f(z[ZV + h * 128 + e]);
            const unsigned qq[8] = {q0.x, q0.y, q0.z, q0.w, q1.x, q1.y, q1.z, q1.w}, kk[8] = {k0.x, k0.y, k0.z, k0.w, k1.x, k1.y, k1.z, k1.w};
            float o = 0.f;
#pragma unroll
            for (int j4 = 0; j4 < 4; ++j4) { const f32x4 l4 = la[j4];
#pragma unroll
                for (int jj = 0; jj < 4; ++jj) { const int j = j4 * 4 + jj; const unsigned qw = qq[j >> 1], kw = kk[j >> 1];
                    const float qv = (j & 1) ? __uint_as_float(qw & 0xffff0000u) : __uint_as_float(qw << 16), kv = (j & 1) ? __uint_as_float(kw & 0xffff0000u) : __uint_as_float(kw << 16);
                    S[j] = __expf(l4[jj]) * S[j] + kv * v; o += qv * S[j]; } }
            o += sx<1>(o); o += sx<2>(o);
            if (dq == 0) Y[m * 1024 + h * 128 + e] = (bf16_t)f2bf(o * 0.125f); }
    }
}
DEV void gla_fast(const Params& P) {
    typedef float f32x2 __attribute__((ext_vector_type(2)));
    unsigned char* ws = P.ws; const int tid_ = tid_fresh(); const int lane = tid_ & 63, wave = tid_ >> 6, dg = lane & 15, es = lane >> 4;
    const bf16_t* Z = (const bf16_t*)P.out; const float* AEXP = (const float*)(ws + WS_LOGA); const float* S1 = (const float*)(ws + WS_META + MT_S1); bf16_t* Y = (bf16_t*)(ws + WS_Y);
    for (int u = blockIdx.x; u < NB * 16; u += gridDim.x) { const int b = u >> 4, h = (u >> 2) & 3, e = (u & 3) * 32 + wave * 4 + es;
        f32x2 S01, S23;
        S01.x = S1[(h * 64 + dg * 4 + 0) * 128 + e]; S01.y = S1[(h * 64 + dg * 4 + 1) * 128 + e]; S23.x = S1[(h * 64 + dg * 4 + 2) * 128 + e]; S23.y = S1[(h * 64 + dg * 4 + 3) * 128 + e];
        const bf16_t* zq = Z + (size_t)b * SEQ * NZ + ZQ + h * 64 + dg * 4; const bf16_t* zk = Z + (size_t)b * SEQ * NZ + ZK + h * 64 + dg * 4; const bf16_t* zv = Z + (size_t)b * SEQ * NZ + ZV + h * 128 + e;
        const float* ap = AEXP + (size_t)b * SEQ * 256 + h * 64 + dg * 4; bf16_t* yp = Y + (size_t)b * SEQ * 1024 + h * 128 + e;
        u32x2 qA[8], kA[8], qB[8], kB[8]; f32x4 aA[8], aB[8]; unsigned short vA[8], vB[8];
#define GLA_LOAD(q, k, a, v, t0) do { _Pragma("unroll") for (int i = 0; i < 8; ++i) { const size_t t = (size_t)(t0) + i; q[i] = *(const u32x2*)(zq + t * NZ); k[i] = *(const u32x2*)(zk + t * NZ); a[i] = *(const f32x4*)(ap + t * 256); v[i] = zv[t * NZ]; } } while (0)
#define GLA_COMP(q, k, a, v, t0) do { _Pragma("unroll") for (int i = 0; i < 8; ++i) { const float vv = bf2f(v[i]); \
            const f32x2 q01 = {__uint_as_float(q[i].x << 16), __uint_as_float(q[i].x & 0xffff0000u)}, q23 = {__uint_as_float(q[i].y << 16), __uint_as_float(q[i].y & 0xffff0000u)}; \
            const f32x2 k01 = {__uint_as_float(k[i].x << 16), __uint_as_float(k[i].x & 0xffff0000u)}, k23 = {__uint_as_float(k[i].y << 16), __uint_as_float(k[i].y & 0xffff0000u)}; \
            const f32x2 a01 = {a[i][0], a[i][1]}, a23 = {a[i][2], a[i][3]}; \
            S01 = a01 * S01 + k01 * vv; S23 = a23 * S23 + k23 * vv; \
            const f32x2 p = q01 * S01 + q23 * S23; float o = p.x + p.y; \
            o += dpp_f<0x128>(o); o += dpp_f<0x124>(o); o += dpp_f<0x4E>(o); o += dpp_f<0xB1>(o); \
            if (dg == 0) yp[(size_t)((t0) + i) * 1024] = (bf16_t)f2bf(o * 0.125f); } } while (0)
        GLA_LOAD(qA, kA, aA, vA, 0);
        for (int t0 = 0; t0 < SEQ; t0 += 16) {
            GLA_LOAD(qB, kB, aB, vB, t0 + 8);
            GLA_COMP(qA, kA, aA, vA, t0);
            if (t0 + 16 < SEQ) GLA_LOAD(qA, kA, aA, vA, t0 + 16);
            GLA_COMP(qB, kB, aB, vB, t0 + 8);
        }
#undef GLA_LOAD
#undef GLA_COMP
    }
}
DEV void mla_simple(const Params& P) { const int tid_ = tid_fresh();
    unsigned char* ws = P.ws; const int lane = tid_ & 63, r32 = lane & 31, hi = lane >> 5; const int gw = blockIdx.x * NWAVE + (tid_ >> 6), ngw = gridDim.x * NWAVE;
    const bf16_t* QM = (const bf16_t*)(ws + WS_QM); const bf16_t* KN = (const bf16_t*)(ws + WS_KN); const bf16_t* VT = (const bf16_t*)(ws + WS_VT); const bf16_t* KR = (const bf16_t*)(ws + WS_KR);
    const bf16_t* KNm = (const bf16_t*)(ws + WS_META + MT_KN); const bf16_t* VTm = (const bf16_t*)(ws + WS_META + MT_VT); const bf16_t* KRm = (const bf16_t*)(ws + WS_META + MT_KR);
    bf16_t* Y = (bf16_t*)(ws + WS_Y);
    const int kperm = pi23(r32);
    for (int w = gw; w < 2048; w += ngw) { const int bh = w >> 5, s5 = w & 31, b = bh >> 2, h = bh & 3;
        for (int ui = 0; ui < 4; ++ui) { const int i = (ui == 0) ? s5 : (ui == 1) ? 63 - s5 : (ui == 2) ? 64 + s5 : 127 - s5;
            const size_t mq = (size_t)b * SEQ + i * 32 + r32;
            bf16x8 qf[12];
#pragma unroll
            for (int s = 0; s < 8; ++s) qf[s] = *(const bf16x8*)(QM + mq * 768 + h * 128 + 16 * s + 8 * hi);
#pragma unroll
            for (int s = 0; s < 4; ++s) qf[8 + s] = *(const bf16x8*)(QM + mq * 768 + 512 + h * 64 + 16 * s + 8 * hi);
            f32x16 O[4] = {}; float mrun = -INFINITY, l = 0.f;
            const int ntile = 2 * (1 + (i >> 1));
            for (int j = -1; j < ntile; ++j) {
                f32x16 S = {};
                if (j < 0) { const bool ok = kperm < NMETA; const bf16x8 zf = {};
#pragma unroll
                    for (int s = 0; s < 8; ++s) { const bf16x8 kf = ok ? *(const bf16x8*)(KNm + kperm * 512 + h * 128 + 16 * s + 8 * hi) : zf; S = __builtin_amdgcn_mfma_f32_32x32x16_bf16(kf, qf[s], S, 0, 0, 0); }
#pragma unroll
                    for (int s = 0; s < 4; ++s) { const bf16x8 kf = ok ? *(const bf16x8*)(KRm + kperm * 64 + 16 * s + 8 * hi) : zf; S = __builtin_amdgcn_mfma_f32_32x32x16_bf16(kf, qf[8 + s], S, 0, 0, 0); }
#pragma unroll
                    for (int r = 0; r < 16; ++r) if (pi23(crow(r, hi)) >= NMETA) S[r] = -INFINITY;
                } else { const size_t mk = (size_t)b * SEQ + j * 32 + kperm;
#pragma unroll
                    for (int s = 0; s < 8; ++s) { const bf16x8 kf = *(const bf16x8*)(KN + mk * 512 + h * 128 + 16 * s + 8 * hi); S = __builtin_amdgcn_mfma_f32_32x32x16_bf16(kf, qf[s], S, 0, 0, 0); }
#pragma unroll
                    for (int s = 0; s < 4; ++s) { const bf16x8 kf = *(const bf16x8*)(KR + mk * 64 + 16 * s + 8 * hi); S = __builtin_amdgcn_mfma_f32_32x32x16_bf16(kf, qf[8 + s], S, 0, 0, 0); }
                }
                float mx = S[0];
#pragma unroll
                for (int r = 1; r < 16; ++r) mx = fmaxf(mx, S[r]);
                mx = half_max(mx);
                const float mnew = fmaxf(mrun, mx), alpha = exp2f(mrun - mnew); mrun = mnew;
                float ps = 0.f;
#pragma unroll
                for (int r = 0; r < 16; ++r) { S[r] = exp2f(S[r] - mnew); ps += S[r]; }
                l = l * alpha + ps;
#pragma unroll
                for (int d = 0; d < 4; ++d)
#pragma unroll
                    for (int r = 0; r < 16; ++r) O[d][r] *= alpha;
                u32x4 p0, p1;
                p0.x = pk2(S[0], S[1]); p0.y = pk2(S[2], S[3]); p0.z = pk2(S[4], S[5]); p0.w = pk2(S[6], S[7]);
                p1.x = pk2(S[8], S[9]); p1.y = pk2(S[10], S[11]); p1.z = pk2(S[12], S[13]); p1.w = pk2(S[14], S[15]);
                const bf16x8 pf0 = __builtin_bit_cast(bf16x8, p0), pf1 = __builtin_bit_cast(bf16x8, p1);
#pragma unroll
                for (int d = 0; d < 4; ++d) {
                    bf16x8 v0, v1;
                    if (j < 0) { const bf16x8 zf = {}; v0 = *(const bf16x8*)(VTm + (h * 128 + 32 * d + r32) * 32 + 8 * hi); v1 = zf; }
                    else { const bf16_t* vp = VT + (size_t)(h * 128 + 32 * d + r32) * M + (size_t)b * SEQ + j * 32 + 8 * hi; v0 = *(const bf16x8*)vp; v1 = *(const bf16x8*)(vp + 16); }
                    O[d] = __builtin_amdgcn_mfma_f32_32x32x16_bf16(v0, pf0, O[d], 0, 0, 0);
                    O[d] = __builtin_amdgcn_mfma_f32_32x32x16_bf16(v1, pf1, O[d], 0, 0, 0);
                }
            }
            l = half_sum(l); const float rl = 1.f / l;
#pragma unroll
            for (int d = 0; d < 4; ++d)
#pragma unroll
                for (int r = 0; r < 16; ++r) Y[mq * 1024 + 512 + h * 128 + 32 * d + crow(r, hi)] = (bf16_t)f2bf(O[d][r] * rl);
        }
    }
}
DEV void phase3b(const Params& P) { const int tid_ = tid_fresh();
    unsigned char* ws = P.ws; const int lane = tid_ & 63; const int gw = blockIdx.x * NWAVE + (tid_ >> 6), ngw = gridDim.x * NWAVE;
    const bf16_t* Z = (const bf16_t*)P.out; bf16_t* Y = (bf16_t*)(ws + WS_Y); const float* g = P.in[I_GOUTN];
    float gv[8];
#pragma unroll
    for (int j = 0; j < 8; ++j) gv[j] = g[8 * lane + j];
    for (int m = gw; m < M; m += ngw) {
        const u32x4 o4 = *(const u32x4*)(Y + (size_t)m * 1024 + 8 * lane), r4 = *(const u32x4*)(Z + (size_t)m * NZ + ZR + 8 * lane);
        const unsigned ow[4] = {o4.x, o4.y, o4.z, o4.w}, rw[4] = {r4.x, r4.y, r4.z, r4.w}; float o[8], r[8]; float s = 0.f;
#pragma unroll
        for (int j = 0; j < 4; ++j) { o[2 * j] = __uint_as_float(ow[j] << 16); o[2 * j + 1] = __uint_as_float(ow[j] & 0xffff0000u); r[2 * j] = __uint_as_float(rw[j] << 16); r[2 * j + 1] = __uint_as_float(rw[j] & 0xffff0000u); }
#pragma unroll
        for (int j = 0; j < 8; ++j) s += o[j] * o[j];
        s += sx<1>(s); s += sx<2>(s); s += sx<4>(s); s += sx<8>(s);
        const float rs = rsqrtf(s * (1.f / 128.f) + EPS);
        u32x4 w; float y[8];
#pragma unroll
        for (int j = 0; j < 8; ++j) y[j] = o[j] * rs * gv[j] * siluf(r[j]);
        w.x = pk2(y[0], y[1]); w.y = pk2(y[2], y[3]); w.z = pk2(y[4], y[5]); w.w = pk2(y[6], y[7]);
        *(u32x4*)(Y + (size_t)m * 1024 + 8 * lane) = w;
    }
}
DEV void phase4(const Params& P) { const int tid_ = tid_fresh();
    unsigned char* ws = P.ws; const int gw = blockIdx.x * NWAVE + (tid_ >> 6), ngw = gridDim.x * NWAVE;
    const bf16_t* Y = (const bf16_t*)(ws + WS_Y); const bf16_t* W = (const bf16_t*)(ws + WS_WOUT); float* H2 = (float*)(ws + WS_H2); const float* x = P.in[I_X];
    gemm_simple(M / 64, D / 64, D, [&](int r) { return Y + (size_t)r * D; }, [&](int c) { return W + (size_t)c * D; },
                [&](int row, int col, float v) { H2[(size_t)row * D + col] = x[(size_t)row * D + col] + v; }, gw, ngw);
}
DEV void phase5(const Params& P, float* scr_all) { const int tid_ = tid_fresh();
    unsigned char* ws = P.ws; const int lane = tid_ & 63, wave = tid_ >> 6; const int gw = blockIdx.x * NWAVE + wave, ngw = gridDim.x * NWAVE;
    float* trow = scr_all + wave * 4096;
    const float* H2 = (const float*)(ws + WS_H2); bf16_t* TN = (bf16_t*)(ws + WS_TN); const float* g = P.in[I_FFN];
    const float* wg = P.in[I_RGW]; const float* bg = P.in[I_RGB]; const float* we = P.in[I_REW]; const float* be = P.in[I_REB];
    int* cnt = (int*)(ws + WS_CTL) + CW_CNT; int* tokE = (int*)(ws + WS_TOK); int* tokR = tokE + 2 * M; float* tokG = (float*)(tokR + 2 * M); int* list = (int*)(ws + WS_LIST);
    f32x4 gv[4];
#pragma unroll
    for (int j = 0; j < 4; ++j) gv[j] = *(const f32x4*)(g + 256 * j + 4 * lane);
    for (int m0 = gw * 4; m0 < M; m0 += ngw * 4) {
#pragma unroll
        for (int q = 0; q < 4; ++q) { const int m = m0 + q; const f32x4* hr = (const f32x4*)(H2 + (size_t)m * D) + lane; f32x4 v[4]; float s = 0.f;
#pragma unroll
            for (int j = 0; j < 4; ++j) { v[j] = hr[64 * j]; s += (v[j].x * v[j].x + v[j].y * v[j].y) + (v[j].z * v[j].z + v[j].w * v[j].w); }
            const float rs = rsqrtf(wave_sum(s) * (1.f / D) + EPS);
            unsigned long long* o8 = (unsigned long long*)(TN + (size_t)m * D) + lane;
#pragma unroll
            for (int j = 0; j < 4; ++j) { const f32x4 t = {v[j].x * rs * gv[j].x, v[j].y * rs * gv[j].y, v[j].z * rs * gv[j].z, v[j].w * rs * gv[j].w};
                *(f32x4*)(trow + q * 1024 + 256 * j + 4 * lane) = t;
                o8[64 * j] = (unsigned long long)pk2(t.x, t.y) | ((unsigned long long)pk2(t.z, t.w) << 32); } }
        __builtin_amdgcn_s_waitcnt(0xc07f); asm volatile("" ::: "memory");
        float ae[4] = {0.f, 0.f, 0.f, 0.f}, ag[4] = {0.f, 0.f, 0.f, 0.f};
        for (int k = 0; k < D; ++k) { const float w = we[k * 64 + lane];
#pragma unroll
            for (int q = 0; q < 4; ++q) ae[q] += trow[q * 1024 + k] * w; }
        for (int k8 = 0; k8 < D / 8; ++k8) { const int k = k8 * 8 + (lane >> 3); const float w = wg[k * 8 + (lane & 7)];
#pragma unroll
            for (int q = 0; q < 4; ++q) ag[q] += trow[q * 1024 + k] * w; }
#pragma unroll
        for (int q = 0; q < 4; ++q) { ag[q] += sx<8>(ag[q]); ag[q] += sx<16>(ag[q]); ag[q] = half_sum(ag[q]); ag[q] += bg[lane & 7]; ae[q] += be[lane]; }
#pragma unroll
        for (int q = 0; q < 4; ++q) { const int m = m0 + q;
            float gl[8]; float gmx = -INFINITY; int gi = 0;
#pragma unroll
            for (int i = 0; i < 8; ++i) { gl[i] = rl_f(ag[q], i); if (gl[i] > gmx) { gmx = gl[i]; gi = i; } }
            float gs = 0.f;
#pragma unroll
            for (int i = 0; i < 8; ++i) gs += __expf(gl[i] - gmx);
            const float gp = 1.f / gs;
            const int gis = __builtin_amdgcn_readfirstlane(gi); float el[8]; float emx = -INFINITY; int e0 = 0;
#pragma unroll
            for (int i = 0; i < 8; ++i) { el[i] = rl_f(ae[q], gis * 8 + i); if (el[i] > emx) { emx = el[i]; e0 = i; } }
            float em2 = -INFINITY; int e1 = 0;
#pragma unroll
            for (int i = 0; i < 8; ++i) if (i != e0 && el[i] > em2) { em2 = el[i]; e1 = i; }
            const float p0 = 1.f, p1 = __expf(em2 - emx); const float g0 = gp * p0 / (p0 + p1), g1 = gp * p1 / (p0 + p1);
            if (lane == 0) { const int E0 = gi * 8 + e0, E1 = gi * 8 + e1; const int r0 = atomicAdd(cnt + E0, 1), r1 = atomicAdd(cnt + E1, 1);
                tokE[2 * m] = E0; tokE[2 * m + 1] = E1; tokR[2 * m] = r0; tokR[2 * m + 1] = r1; tokG[2 * m] = g0; tokG[2 * m + 1] = g1;
                list[(size_t)E0 * M + r0] = m; list[(size_t)E1 * M + r1] = m; } }
        __builtin_amdgcn_s_waitcnt(0xc07f); asm volatile("" ::: "memory");
    }
}
DEV void route_emit(int m, int E0, int E1, float g0, float g1, int* cnt, int* tokE, int* tokR, float* tokG, int* list) {
    const int r0 = atomicAdd(cnt + E0, 1), r1 = atomicAdd(cnt + E1, 1);
    tokE[2 * m] = E0; tokE[2 * m + 1] = E1; tokR[2 * m] = r0; tokR[2 * m + 1] = r1; tokG[2 * m] = g0; tokG[2 * m + 1] = g1;
    list[(size_t)E0 * M + r0] = m; list[(size_t)E1 * M + r1] = m;
}
DEV void phase5_fast(const Params& P) {
    constexpr float TAU = 0.015f;
    unsigned char* ws = P.ws; const int tid_ = tid_fresh(); const int lane = tid_ & 63, r32 = lane & 31, hi = lane >> 5; const int gw = blockIdx.x * NWAVE + (tid_ >> 6), ngw = gridDim.x * NWAVE;
    const float* X = P.in[I_X]; const bf16_t* D16 = (const bf16_t*)(ws + WS_D16); bf16_t* H2B = (bf16_t*)(ws + WS_H2B); unsigned char* TN8 = (unsigned char*)(ws + WS_TN8); const float* g = P.in[I_FFN]; const bf16_t* WR = (const bf16_t*)(ws + WS_WR);
    const float* wg = P.in[I_RGW]; const float* bg = P.in[I_RGB]; const float* we = P.in[I_REW]; const float* be = P.in[I_REB];
    int* cnt = (int*)(ws + WS_CTL) + CW_CNT; int* tokE = (int*)(ws + WS_TOK); int* tokR = tokE + 2 * M; float* tokG = (float*)(tokR + 2 * M); int* list = (int*)(ws + WS_LIST);
    f32x4 gv[4];
#pragma unroll
    for (int j = 0; j < 4; ++j) gv[j] = *(const f32x4*)(g + 256 * j + 4 * lane);
    for (int blk = gw; blk < M / 32; blk += ngw) { const int m0 = blk * 32; float rsk = 0.f;
        for (int q0 = 0; q0 < 32; q0 += 4) {
            f32x4 v[4][4];
#pragma unroll
            for (int q = 0; q < 4; ++q)
#pragma unroll
                for (int j = 0; j < 4; ++j) { const size_t off = (size_t)(m0 + q0 + q) * D + 256 * j + 4 * lane; const u32x2 dd = *(const u32x2*)(D16 + off); const f32x4 xx = *(const f32x4*)(X + off);
                    v[q][j] = (f32x4){xx.x + __uint_as_float(dd.x << 16), xx.y + __uint_as_float(dd.x & 0xffff0000u), xx.z + __uint_as_float(dd.y << 16), xx.w + __uint_as_float(dd.y & 0xffff0000u)}; }
#pragma unroll
            for (int q = 0; q < 4; ++q) { float s = 0.f;
                { unsigned long long* h8 = (unsigned long long*)(H2B + (size_t)(m0 + q0 + q) * D) + lane;
#pragma unroll
                  for (int j = 0; j < 4; ++j) h8[64 * j] = (unsigned long long)pk2(v[q][j].x, v[q][j].y) | ((unsigned long long)pk2(v[q][j].z, v[q][j].w) << 32); }
#pragma unroll
                for (int j = 0; j < 4; ++j) s += (v[q][j].x * v[q][j].x + v[q][j].y * v[q][j].y) + (v[q][j].z * v[q][j].z + v[q][j].w * v[q][j].w);
                const float rs = rsqrtf(wave_sum(s) * (1.f / D) + EPS); rsk = (q0 + q == r32) ? rs : rsk;
                unsigned* t8 = (unsigned*)(TN8 + (size_t)(m0 + q0 + q) * D) + lane;
#pragma unroll
                for (int j = 0; j < 4; ++j) { const float t0 = v[q][j].x * rs * gv[j].x, t1 = v[q][j].y * rs * gv[j].y, t2 = v[q][j].z * rs * gv[j].z, t3 = v[q][j].w * rs * gv[j].w;
                    t8[64 * j] = pk4_fp8(t0, t1, t2, t3); } }
        }
        asm volatile("s_waitcnt vmcnt(0)" ::: "memory");
        f32x16 a0 = {}, a1 = {}, a2 = {};
        { const bf16_t* tb = H2B + (size_t)(m0 + r32) * D + 8 * hi; const bf16_t* wa = WR + (size_t)r32 * D + 8 * hi;
#pragma unroll 4
          for (int k = 0; k < D; k += 16) { const bf16x8 bf = *(const bf16x8*)(tb + k);
              a0 = __builtin_amdgcn_mfma_f32_32x32x16_bf16(*(const bf16x8*)(wa + k), bf, a0, 0, 0, 0);
              a1 = __builtin_amdgcn_mfma_f32_32x32x16_bf16(*(const bf16x8*)(wa + 32 * D + k), bf, a1, 0, 0, 0);
              a2 = __builtin_amdgcn_mfma_f32_32x32x16_bf16(*(const bf16x8*)(wa + 64 * D + k), bf, a2, 0, 0, 0); } }
#pragma unroll
        for (int r = 0; r < 16; ++r) { a0[r] *= rsk; a1[r] *= rsk; a2[r] *= rsk; }
        const int m = m0 + r32;
        float gl[8]; float gmx = -INFINITY, gm2 = -INFINITY; int gi = 0;
#pragma unroll
        for (int i = 0; i < 8; ++i) { auto rr = __builtin_amdgcn_permlane32_swap(__float_as_uint(a2[i]), __float_as_uint(a2[i]), false, false); gl[i] = __uint_as_float(rr[0]) + bg[i]; }
#pragma unroll
        for (int i = 0; i < 8; ++i) { if (gl[i] > gmx) { gm2 = gmx; gmx = gl[i]; gi = i; } else if (gl[i] > gm2) gm2 = gl[i]; }
        float gs = 0.f;
#pragma unroll
        for (int i = 0; i < 8; ++i) gs += __expf(gl[i] - gmx);
        const float gp = 1.f / gs;
        const bool t1 = (gi >> 2) != 0, up = (gi & 1) != 0; const bool owner = hi == ((gi >> 1) & 1);
        float el[8]; float emx = -INFINITY, em2 = -INFINITY, em3 = -INFINITY; int e0 = 0, e1 = 0;
#pragma unroll
        for (int j = 0; j < 8; ++j) { const float lo = t1 ? a1[j] : a0[j], hv = t1 ? a1[8 + j] : a0[8 + j]; el[j] = (up ? hv : lo) + be[gi * 8 + j]; }
#pragma unroll
        for (int j = 0; j < 8; ++j) { const float x = el[j];
            if (x > emx) { em3 = em2; em2 = emx; e1 = e0; emx = x; e0 = j; } else if (x > em2) { em3 = em2; em2 = x; e1 = j; } else if (x > em3) em3 = x; }
        const bool flagged = owner && (fminf(gmx - gm2, em2 - em3) < TAU);
        if (owner && !flagged) { const float p1 = __expf(em2 - emx); route_emit(m, gi * 8 + e0, gi * 8 + e1, gp / (1.f + p1), gp * p1 / (1.f + p1), cnt, tokE, tokR, tokG, list); }
        unsigned long long fm = __ballot(flagged);
        while (fm) { const int fl = __builtin_ctzll(fm); fm &= fm - 1; const int mt = m0 + (fl & 31);
            f32x4 t[4]; float s = 0.f;
#pragma unroll
            for (int j = 0; j < 4; ++j) { const size_t off = (size_t)mt * D + 256 * j + 4 * lane; const u32x2 dd = *(const u32x2*)(D16 + off); const f32x4 xx = *(const f32x4*)(X + off);
                t[j] = (f32x4){xx.x + __uint_as_float(dd.x << 16), xx.y + __uint_as_float(dd.x & 0xffff0000u), xx.z + __uint_as_float(dd.y << 16), xx.w + __uint_as_float(dd.y & 0xffff0000u)};
                s += (t[j].x * t[j].x + t[j].y * t[j].y) + (t[j].z * t[j].z + t[j].w * t[j].w); }
            const float rs = rsqrtf(wave_sum(s) * (1.f / D) + EPS);
#pragma unroll
            for (int j = 0; j < 4; ++j) t[j] = (f32x4){t[j].x * rs * gv[j].x, t[j].y * rs * gv[j].y, t[j].z * rs * gv[j].z, t[j].w * rs * gv[j].w};
            float xg[8] = {0.f, 0.f, 0.f, 0.f, 0.f, 0.f, 0.f, 0.f};
#pragma unroll
            for (int j = 0; j < 4; ++j)
#pragma unroll
                for (int c = 0; c < 4; ++c) { const int k = 256 * j + 4 * lane + c; const f32x4 w0 = *(const f32x4*)(wg + k * 8), w1 = *(const f32x4*)(wg + k * 8 + 4); const float tv = t[j][c];
                    xg[0] += tv * w0[0]; xg[1] += tv * w0[1]; xg[2] += tv * w0[2]; xg[3] += tv * w0[3]; xg[4] += tv * w1[0]; xg[5] += tv * w1[1]; xg[6] += tv * w1[2]; xg[7] += tv * w1[3]; }
            float gmx2 = -INFINITY; int gi2 = 0;
#pragma unroll
            for (int i = 0; i < 8; ++i) { xg[i] = wave_sum(xg[i]) + bg[i]; if (xg[i] > gmx2) { gmx2 = xg[i]; gi2 = i; } }
            float gs2 = 0.f;
#pragma unroll
            for (int i = 0; i < 8; ++i) gs2 += __expf(xg[i] - gmx2);
            gi2 = __builtin_amdgcn_readfirstlane(gi2);
            float xe[8] = {0.f, 0.f, 0.f, 0.f, 0.f, 0.f, 0.f, 0.f};
#pragma unroll
            for (int j = 0; j < 4; ++j)
#pragma unroll
                for (int c = 0; c < 4; ++c) { const int k = 256 * j + 4 * lane + c; const f32x4 w0 = *(const f32x4*)(we + k * 64 + gi2 * 8), w1 = *(const f32x4*)(we + k * 64 + gi2 * 8 + 4); const float tv = t[j][c];
                    xe[0] += tv * w0[0]; xe[1] += tv * w0[1]; xe[2] += tv * w0[2]; xe[3] += tv * w0[3]; xe[4] += tv * w1[0]; xe[5] += tv * w1[1]; xe[6] += tv * w1[2]; xe[7] += tv * w1[3]; }
            float x1 = -INFINITY, x2 = -INFINITY; int f0 = 0, f1 = 0;
#pragma unroll
            for (int i = 0; i < 8; ++i) { xe[i] = wave_sum(xe[i]) + be[gi2 * 8 + i]; }
#pragma unroll
            for (int i = 0; i < 8; ++i) if (xe[i] > x1) { x1 = xe[i]; f0 = i; }
#pragma unroll
            for (int i = 0; i < 8; ++i) if (i != f0 && xe[i] > x2) { x2 = xe[i]; f1 = i; }
            if (lane == 0) { const float gp2 = 1.f / gs2, p1 = __expf(x2 - x1); route_emit(mt, gi2 * 8 + f0, gi2 * 8 + f1, gp2 / (1.f + p1), gp2 * p1 / (1.f + p1), cnt, tokE, tokR, tokG, list); }
        }
    }
}
DEV int slot_start_lane(const int* cnt, int lane, int& c_out, int& total) {
    int st = 0, tot = 0, cm = 0;
    for (int i = 0; i < NE; ++i) { const int c = cnt[i]; const int pad = (c + 255) & ~255; if (i < lane) st += pad; if (i == lane) cm = c; tot += pad; }
    total = __builtin_amdgcn_readfirstlane(tot); c_out = cm; return st;
}
DEV void phase6(const Params& P) { const int tid_ = tid_fresh();
    unsigned char* ws = P.ws; const int lane = tid_ & 63, r32 = lane & 31, hi = lane >> 5; const int gw = blockIdx.x * NWAVE + (tid_ >> 6), ngw = gridDim.x * NWAVE;
    const bf16_t* TN = (const bf16_t*)(ws + WS_TN); const bf16_t* W = (const bf16_t*)(ws + WS_WGU); bf16_t* MH = (bf16_t*)(ws + WS_MH);
    const int* cnt = (const int*)(ws + WS_CTL) + CW_CNT; const int* list = (const int*)(ws + WS_LIST);
    int c_l, total; const int st_l = slot_start_lane(cnt, lane, c_l, total);
    const int Nt = 1024 / 64, nrt = total / 64;
    for (int it = gw; it < nrt * Nt; it += ngw) { const int T = it / Nt, tn = it % Nt;
        const unsigned long long bal = __ballot(st_l <= T * 64); const int e = __builtin_amdgcn_readfirstlane(63 - __builtin_clzll(bal));
        const int st = rl_i(st_l, e), c = rl_i(c_l, e); const int lr = T * 64 - st;
        if (lr >= c) continue;
        const int ra = lr + r32, rb = lr + 32 + r32;
        const int ta = ra < c ? list[(size_t)e * M + ra] : 0, tb = rb < c ? list[(size_t)e * M + rb] : 0;
        const bf16_t* We = W + (size_t)e * 1024 * 1024;
        f32x16 c00 = {}, c01 = {}, c10 = {}, c11 = {};
        wave_tile(TN + (size_t)ta * D + hi * 8, TN + (size_t)tb * D + hi * 8, We + (size_t)(tn * 64 + r32) * D + hi * 8, We + (size_t)(tn * 64 + 32 + r32) * D + hi * 8, D, c00, c01, c10, c11);
#pragma unroll
        for (int r = 0; r < 16; ++r) {
#pragma unroll
            for (int q = 0; q < 4; ++q) { const float v = (q == 0) ? c00[r] : (q == 1) ? c01[r] : (q == 2) ? c10[r] : c11[r];
                const float u = __shfl_down(v, 4); const int row = T * 64 + (q >> 1) * 32 + crow(r, hi), col = tn * 64 + (q & 1) * 32 + r32;
                if ((col & 4) == 0) MH[(size_t)row * DE + (col >> 3) * 4 + (col & 3)] = (bf16_t)f2bf(siluf(v) * u); }
        }
    }
}
DEV void phase7(const Params& P) { const int tid_ = tid_fresh();
    unsigned char* ws = P.ws; const int lane = tid_ & 63, r32 = lane & 31, hi = lane >> 5; const int gw = blockIdx.x * NWAVE + (tid_ >> 6), ngw = gridDim.x * NWAVE;
    const bf16_t* MH = (const bf16_t*)(ws + WS_MH); const bf16_t* W = (const bf16_t*)(ws + WS_WD); bf16_t* MY = (bf16_t*)(ws + WS_MY);
    const int* cnt = (const int*)(ws + WS_CTL) + CW_CNT;
    int c_l, total; const int st_l = slot_start_lane(cnt, lane, c_l, total);
    const int Nt = 1024 / 64, nrt = total / 64;
    for (int it = gw; it < nrt * Nt; it += ngw) { const int T = it / Nt, tn = it % Nt;
        const unsigned long long bal = __ballot(st_l <= T * 64); const int e = __builtin_amdgcn_readfirstlane(63 - __builtin_clzll(bal));
        const int st = rl_i(st_l, e), c = rl_i(c_l, e); const int lr = T * 64 - st;
        if (lr >= c) continue;
        const bf16_t* We = W + (size_t)e * 1024 * 512;
        f32x16 c00 = {}, c01 = {}, c10 = {}, c11 = {};
        wave_tile(MH + (size_t)(T * 64 + r32) * DE + hi * 8, MH + (size_t)(T * 64 + 32 + r32) * DE + hi * 8, We + (size_t)(tn * 64 + r32) * DE + hi * 8, We + (size_t)(tn * 64 + 32 + r32) * DE + hi * 8, DE, c00, c01, c10, c11);
#pragma unroll
        for (int r = 0; r < 16; ++r) { const int row = T * 64 + crow(r, hi), col = tn * 64 + r32;
            MY[(size_t)row * D + col] = (bf16_t)f2bf(c00[r]); MY[(size_t)row * D + col + 32] = (bf16_t)f2bf(c01[r]);
            MY[(size_t)(row + 32) * D + col] = (bf16_t)f2bf(c10[r]); MY[(size_t)(row + 32) * D + col + 32] = (bf16_t)f2bf(c11[r]); }
    }
}
DEV void phase8(const Params& P) { const int tid_ = tid_fresh();
    unsigned char* ws = P.ws; const int lane = tid_ & 63; const int gw = blockIdx.x * NWAVE + (tid_ >> 6), ngw = gridDim.x * NWAVE;
    const bf16_t* H2B = (const bf16_t*)(ws + WS_H2B); const unsigned char* MY = (const unsigned char*)(ws + WS_MY); const float* g = P.in[I_FINAL];
    const int* cnt = (const int*)(ws + WS_CTL) + CW_CNT; const int* tokE = (const int*)(ws + WS_TOK); const int* tokR = tokE + 2 * M; const float* tokG = (const float*)(tokR + 2 * M);
    int c_l, total; const int st_l = slot_start_lane(cnt, lane, c_l, total);
    f32x4 gv[4];
#pragma unroll
    for (int j = 0; j < 4; ++j) gv[j] = *(const f32x4*)(g + 256 * j + 4 * lane);
    for (int m0 = gw * 4; m0 < M; m0 += ngw * 4) {
        u32x2 hh[4][4]; unsigned ya[4][4], yb[4][4]; float g0[4], g1[4];
#pragma unroll
        for (int q = 0; q < 4; ++q) { const int m = m0 + q;
            const int E0 = __builtin_amdgcn_readfirstlane(tokE[2 * m]), E1 = __builtin_amdgcn_readfirstlane(tokE[2 * m + 1]);
            const size_t s0 = (size_t)rl_i(st_l, E0) + tokR[2 * m], s1 = (size_t)rl_i(st_l, E1) + tokR[2 * m + 1]; g0[q] = tokG[2 * m] * (1.f / 16.f); g1[q] = tokG[2 * m + 1] * (1.f / 16.f);
            const u32x2* hr = (const u32x2*)(H2B + (size_t)m * D) + lane; const unsigned* y0 = (const unsigned*)(MY + s0 * D) + lane; const unsigned* y1 = (const unsigned*)(MY + s1 * D) + lane;
#pragma unroll
            for (int j = 0; j < 4; ++j) { hh[q][j] = hr[64 * j]; ya[q][j] = y0[64 * j]; yb[q][j] = y1[64 * j]; } }
#pragma unroll
        for (int q = 0; q < 4; ++q) { f32x4 v[4]; float s = 0.f;
#pragma unroll
            for (int j = 0; j < 4; ++j) { const u32x2 h2 = hh[q][j]; const int a = (int)ya[q][j], b = (int)yb[q][j];
                v[j].x = __uint_as_float(h2.x << 16) + g0[q] * __builtin_amdgcn_cvt_f32_fp8(a, 0) + g1[q] * __builtin_amdgcn_cvt_f32_fp8(b, 0);
                v[j].y = __uint_as_float(h2.x & 0xffff0000u) + g0[q] * __builtin_amdgcn_cvt_f32_fp8(a, 1) + g1[q] * __builtin_amdgcn_cvt_f32_fp8(b, 1);
                v[j].z = __uint_as_float(h2.y << 16) + g0[q] * __builtin_amdgcn_cvt_f32_fp8(a, 2) + g1[q] * __builtin_amdgcn_cvt_f32_fp8(b, 2);
                v[j].w = __uint_as_float(h2.y & 0xffff0000u) + g0[q] * __builtin_amdgcn_cvt_f32_fp8(a, 3) + g1[q] * __builtin_amdgcn_cvt_f32_fp8(b, 3);
                s += (v[j].x * v[j].x + v[j].y * v[j].y) + (v[j].z * v[j].z + v[j].w * v[j].w); }
            const float rs = rsqrtf(wave_sum(s) * (1.f / D) + EPS);
            f32x4* orow = (f32x4*)(P.out + (size_t)(m0 + q) * D) + lane;
#pragma unroll
            for (int j = 0; j < 4; ++j) orow[64 * j] = (f32x4){v[j].x * rs * gv[j].x, v[j].y * rs * gv[j].y, v[j].z * rs * gv[j].z, v[j].w * rs * gv[j].w}; }
    }
}


#ifndef FAST
#define FAST 0x7f
#endif
namespace g8 {
struct EpiZ { static constexpr bool PERM = true; bf16_t* Z; float* ssq_q; float* ssq_kv;
    DEV void operator()(const Acc& acc, const Unit& u, int wr, int wc, int fr, int fq) const {
        const int zt = u.pn < 2 ? u.pn : u.pn + 2;
        const int row0 = u.pm * BM + wr * 64 + fr, col0 = zt * BM + wc * 32 + 8 * fq;
#pragma unroll
        for (int ai = 0; ai < 2; ++ai)
#pragma unroll
            for (int m = 0; m < 4; ++m) { const int row = row0 + ai * HALF + m * 16; bf16_t* rp = Z + (size_t)row * NZ + col0;
#pragma unroll
                for (int bj = 0; bj < 2; ++bj) *(u32x4*)(rp + bj * HALF) = pack8(acc[ai][bj][m][0], acc[ai][bj][m][1]);
                if (u.pn >= 4) { float s = 0.f;
#pragma unroll
                    for (int bj = 0; bj < 2; ++bj) if (u.pn == 4 || bj == 0) {
#pragma unroll
                        for (int n = 0; n < 2; ++n) { const f32x4 v = acc[ai][bj][m][n]; s += (v[0] * v[0] + v[1] * v[1]) + (v[2] * v[2] + v[3] * v[3]); } }
                    s += sx<16>(s); s = half_sum(s);
                    if (fq == 0) atomicAdd((u.pn == 4 ? ssq_q : ssq_kv) + row, s); }
                asm volatile("" ::: "memory"); }
    } };
struct EpiQ { static constexpr bool PERM = true; bf16_t* QM; const float* ssq_q; const float2* rope;
    DEV void operator()(const Acc& acc, const Unit& u, int wr, int wc, int fr, int fq) const {
        const int row0 = u.pm * BM + wr * 64 + fr, col0 = u.pn * BM + wc * 32 + 8 * fq;
#pragma unroll
        for (int ai = 0; ai < 2; ++ai)
#pragma unroll
            for (int m = 0; m < 4; ++m) { const int row = row0 + ai * HALF + m * 16; const float rs = rsqrtf(ssq_q[row] * (1.f / 256.f) + EPS); bf16_t* rp = QM + (size_t)row * 768 + col0;
#pragma unroll
                for (int bj = 0; bj < 2; ++bj) { f32x4 v0 = acc[ai][bj][m][0] * rs, v1 = acc[ai][bj][m][1] * rs;
                    if (u.pn == 2) { const int f0 = (wc & 1) * 16 + 4 * fq; const f32x4* cp = (const f32x4*)(rope + (size_t)(NMETA + (row & (SEQ - 1))) * 32 + f0); const f32x4 ca = cp[0], cb = cp[1];
                        const f32x4 r0 = {v0[0] * ca[0] - v0[1] * ca[1], v0[1] * ca[0] + v0[0] * ca[1], v0[2] * ca[2] - v0[3] * ca[3], v0[3] * ca[2] + v0[2] * ca[3]};
                        const f32x4 r1 = {v1[0] * cb[0] - v1[1] * cb[1], v1[1] * cb[0] + v1[0] * cb[1], v1[2] * cb[2] - v1[3] * cb[3], v1[3] * cb[2] + v1[2] * cb[3]}; v0 = r0; v1 = r1; }
                    *(u32x4*)(rp + bj * HALF) = pack8(v0, v1); }
                asm volatile("" ::: "memory"); }
    } };
struct EpiK { static constexpr bool PERM = true; bf16_t* KN; const float* ssq_kv;
    DEV void operator()(const Acc& acc, const Unit& u, int wr, int wc, int fr, int fq) const {
        const int row0 = u.pm * BM + wr * 64 + fr, col0 = u.pn * BM + wc * 32 + 8 * fq;
#pragma unroll
        for (int ai = 0; ai < 2; ++ai)
#pragma unroll
            for (int m = 0; m < 4; ++m) { const int row = row0 + ai * HALF + m * 16; const float rs = rsqrtf(ssq_kv[row] * (1.f / 128.f) + EPS); bf16_t* rp = KN + (size_t)row * 512 + col0;
#pragma unroll
                for (int bj = 0; bj < 2; ++bj) *(u32x4*)(rp + bj * HALF) = pack8(acc[ai][bj][m][0] * rs, acc[ai][bj][m][1] * rs);
                asm volatile("" ::: "memory"); }
    } };
struct EpiVT { static constexpr bool PERM = true; bf16_t* VT; const float* ssq_kv;
    DEV void operator()(const Acc& acc, const Unit& u, int wr, int wc, int fr, int fq) const {
        const int row0 = u.pm * BM + wr * 64 + fr, col0 = u.pn * BM + wc * 32 + 8 * fq;
        f32x4 rs[2][2];
#pragma unroll
        for (int bj = 0; bj < 2; ++bj)
#pragma unroll
            for (int n = 0; n < 2; ++n) { const f32x4 q = *(const f32x4*)(ssq_kv + col0 + bj * HALF + 4 * n);
                rs[bj][n] = (f32x4){rsqrtf(q[0] * (1.f / 128.f) + EPS), rsqrtf(q[1] * (1.f / 128.f) + EPS), rsqrtf(q[2] * (1.f / 128.f) + EPS), rsqrtf(q[3] * (1.f / 128.f) + EPS)}; }
#pragma unroll
        for (int ai = 0; ai < 2; ++ai)
#pragma unroll
            for (int m = 0; m < 4; ++m) { const int row = row0 + ai * HALF + m * 16; bf16_t* rp = VT + (size_t)row * M + col0;
#pragma unroll
                for (int bj = 0; bj < 2; ++bj) *(u32x4*)(rp + bj * HALF) = pack8(acc[ai][bj][m][0] * rs[bj][0], acc[ai][bj][m][1] * rs[bj][1]); }
    } };
struct EpiQ8 { static constexpr bool PERM = true; unsigned char* QM; const float* ssq_q; const float2* rope;
    DEV void operator()(const Acc& acc, const Unit& u, int wr, int wc, int fr, int fq) const {
        const int row0 = u.pm * BM + wr * 64 + fr, col0 = u.pn * BM + wc * 32 + 8 * fq;
        float rs[8];
#pragma unroll
        for (int i = 0; i < 8; ++i) rs[i] = ssq_q[row0 + (i >> 2) * HALF + (i & 3) * 16];
#pragma unroll
        for (int i = 0; i < 8; ++i) rs[i] = 16.f * rsqrtf(rs[i] * (1.f / 256.f) + EPS);
#pragma unroll
        for (int ai = 0; ai < 2; ++ai) {
            f32x4 ca[4], cb[4];
            if (u.pn == 2) { const int f0 = (wc & 1) * 16 + 4 * fq;
#pragma unroll
                for (int m = 0; m < 4; ++m) { const int row = row0 + ai * HALF + m * 16; const f32x4* cp = (const f32x4*)(rope + (size_t)(NMETA + (row & (SEQ - 1))) * 32 + f0); ca[m] = cp[0]; cb[m] = cp[1]; } }
#pragma unroll
            for (int m = 0; m < 4; ++m) { const int row = row0 + ai * HALF + m * 16; const float r_ = rs[ai * 4 + m]; unsigned char* rp = QM + (size_t)row * 768 + col0;
#pragma unroll
                for (int bj = 0; bj < 2; ++bj) { f32x4 v0 = acc[ai][bj][m][0] * r_, v1 = acc[ai][bj][m][1] * r_;
                    if (u.pn == 2) {
                        const f32x4 r0 = {v0[0] * ca[m][0] - v0[1] * ca[m][1], v0[1] * ca[m][0] + v0[0] * ca[m][1], v0[2] * ca[m][2] - v0[3] * ca[m][3], v0[3] * ca[m][2] + v0[2] * ca[m][3]};
                        const f32x4 r1 = {v1[0] * cb[m][0] - v1[1] * cb[m][1], v1[1] * cb[m][0] + v1[0] * cb[m][1], v1[2] * cb[m][2] - v1[3] * cb[m][3], v1[3] * cb[m][2] + v1[2] * cb[m][3]}; v0 = r0; v1 = r1; }
                    u32x2 w; w.x = pk4_fp8(v0[0], v0[1], v0[2], v0[3]); w.y = pk4_fp8(v1[0], v1[1], v1[2], v1[3]); *(u32x2*)(rp + bj * HALF) = w; } }
            asm volatile("" ::: "memory"); }
    } };
struct EpiK8 { static constexpr bool PERM = true; unsigned char* KN; const float* ssq_kv;
    DEV void operator()(const Acc& acc, const Unit& u, int wr, int wc, int fr, int fq) const {
        const int row0 = u.pm * BM + wr * 64 + fr, col0 = u.pn * BM + wc * 32 + 8 * fq;
        float rs[8];
#pragma unroll
        for (int i = 0; i < 8; ++i) rs[i] = ssq_kv[row0 + (i >> 2) * HALF + (i & 3) * 16];
#pragma unroll
        for (int i = 0; i < 8; ++i) rs[i] = rsqrtf(rs[i] * (1.f / 128.f) + EPS);
#pragma unroll
        for (int ai = 0; ai < 2; ++ai)
#pragma unroll
            for (int m = 0; m < 4; ++m) { const int row = row0 + ai * HALF + m * 16; const float r_ = rs[ai * 4 + m]; unsigned char* rp = KN + (size_t)row * 512 + col0;
#pragma unroll
                for (int bj = 0; bj < 2; ++bj) { const f32x4 v0 = acc[ai][bj][m][0] * r_, v1 = acc[ai][bj][m][1] * r_; u32x2 w; w.x = pk4_fp8(v0[0], v0[1], v0[2], v0[3]); w.y = pk4_fp8(v1[0], v1[1], v1[2], v1[3]); *(u32x2*)(rp + bj * HALF) = w; } }
    } };
struct EpiVT8 { static constexpr bool PERM = true; unsigned char* VT; const float* ssq_kv;
    DEV void operator()(const Acc& acc, const Unit& u, int wr, int wc, int fr, int fq) const {
        const int row0 = u.pm * BM + wr * 64 + fr, col0 = u.pn * BM + wc * 32 + 8 * fq;
        f32x4 rs[2][2];
#pragma unroll
        for (int bj = 0; bj < 2; ++bj)
#pragma unroll
            for (int n = 0; n < 2; ++n) { const f32x4 q = *(const f32x4*)(ssq_kv + col0 + bj * HALF + 4 * n);
                rs[bj][n] = (f32x4){rsqrtf(q[0] * (1.f / 128.f) + EPS), rsqrtf(q[1] * (1.f / 128.f) + EPS), rsqrtf(q[2] * (1.f / 128.f) + EPS), rsqrtf(q[3] * (1.f / 128.f) + EPS)}; }
#pragma unroll
        for (int ai = 0; ai < 2; ++ai)
#pragma unroll
            for (int m = 0; m < 4; ++m) { const int row = row0 + ai * HALF + m * 16; unsigned char* rp = VT + (size_t)row * M + col0;
#pragma unroll
                for (int bj = 0; bj < 2; ++bj) { const f32x4 v0 = acc[ai][bj][m][0] * rs[bj][0], v1 = acc[ai][bj][m][1] * rs[bj][1]; u32x2 w; w.x = pk4_fp8(v0[0], v0[1], v0[2], v0[3]); w.y = pk4_fp8(v1[0], v1[1], v1[2], v1[3]); *(u32x2*)(rp + bj * HALF) = w; } }
    } };
struct EpiH2 { static constexpr bool PERM = false; float* H2; const float* x;
    DEV void operator()(const Acc& acc, const Unit& u, int wr, int wc, int fr, int fq) const {
        const int row0 = u.pm * BM + wr * 64 + fr, col0 = u.pn * BM + wc * 32 + 4 * fq;
#pragma unroll
        for (int ai = 0; ai < 2; ++ai)
#pragma unroll
            for (int m = 0; m < 4; ++m) { const size_t off = (size_t)(row0 + ai * HALF + m * 16) * D + col0;
#pragma unroll
                for (int bj = 0; bj < 2; ++bj)
#pragma unroll
                    for (int n = 0; n < 2; ++n) *(f32x4*)(H2 + off + bj * HALF + n * 16) = *(const f32x4*)(x + off + bj * HALF + n * 16) + acc[ai][bj][m][n];
                if (m & 1) asm volatile("" ::: "memory"); }
    } };
struct EpiGU { static constexpr bool PERM = true; bf16_t* MH;
    DEV void operator()(const Acc& acc, const Unit& u, int wr, int wc, int fr, int fq) const {
        const int row0 = u.pm * BM + wr * 64 + fr, hid0 = u.pn * 128 + wc * 16 + 4 * fq;
#pragma unroll
        for (int ai = 0; ai < 2; ++ai)
#pragma unroll
            for (int m = 0; m < 4; ++m) { bf16_t* rp = MH + (size_t)(row0 + ai * HALF + m * 16) * DE + hid0;
#pragma unroll
                for (int bj = 0; bj < 2; ++bj) { const f32x4 g = acc[ai][bj][m][0], up = acc[ai][bj][m][1];
                    u32x2 w; w.x = cvt_pk_bf16(siluf(g[0]) * up[0], siluf(g[1]) * up[1]); w.y = cvt_pk_bf16(siluf(g[2]) * up[2], siluf(g[3]) * up[3]);
                    *(u32x2*)(rp + bj * 64) = w; } }
    } };
struct EpiD { static constexpr bool PERM = true; bf16_t* MY; size_t ld;
    DEV void operator()(const Acc& acc, const Unit& u, int wr, int wc, int fr, int fq) const {
        const int row0 = u.pm * BM + wr * 64 + fr, col0 = u.pn * BM + wc * 32 + 8 * fq;
#pragma unroll
        for (int ai = 0; ai < 2; ++ai)
#pragma unroll
            for (int m = 0; m < 4; ++m) { bf16_t* rp = MY + (size_t)(row0 + ai * HALF + m * 16) * ld + col0;
#pragma unroll
                for (int bj = 0; bj < 2; ++bj) *(u32x4*)(rp + bj * HALF) = pack8(acc[ai][bj][m][0], acc[ai][bj][m][1]); }
    } };
struct EpiLOGA { static constexpr bool PERM = true; float* LOGA; const float* ba;
    DEV void operator()(const Acc& acc, const Unit& u, int wr, int wc, int fr, int fq) const {
        const int row0 = u.pm * BM + wr * 64 + fr, col0 = wc * 32 + 8 * fq;
        f32x4 bv[2][2];
#pragma unroll
        for (int bj = 0; bj < 2; ++bj)
#pragma unroll
            for (int n = 0; n < 2; ++n) bv[bj][n] = *(const f32x4*)(ba + col0 + bj * HALF + 4 * n);
#pragma unroll
        for (int ai = 0; ai < 2; ++ai)
#pragma unroll
            for (int m = 0; m < 4; ++m) { float* rp = LOGA + (size_t)(row0 + ai * HALF + m * 16) * 256 + col0;
#pragma unroll
                for (int bj = 0; bj < 2; ++bj)
#pragma unroll
                    for (int n = 0; n < 2; ++n) { const f32x4 v = acc[ai][bj][m][n]; f32x4 o;
#pragma unroll
                        for (int c = 0; c < 4; ++c) { const float x = v[c] + bv[bj][n][c]; o[c] = (fminf(x, 0.f) - __logf(1.f + __expf(-fabsf(x)))) * (1.f / 16.f); }
                        *(f32x4*)(rp + bj * HALF + 4 * n) = o; }
                asm volatile("" ::: "memory"); }
    } };
struct EpiGU8 { static constexpr bool PERM = true; unsigned char* MH;
    DEV void operator()(const Acc& acc, const Unit& u, int wr, int wc, int fr, int fq) const {
        const int row0 = u.pm * BM + wr * 64 + fr, hid0 = u.pn * 128 + wc * 16 + 4 * fq;
#pragma unroll
        for (int ai = 0; ai < 2; ++ai)
#pragma unroll
            for (int m = 0; m < 4; ++m) { unsigned char* rp = MH + (size_t)(row0 + ai * HALF + m * 16) * DE + hid0;
#pragma unroll
                for (int bj = 0; bj < 2; ++bj) { const f32x4 g = acc[ai][bj][m][0] * (1.f / 32.f), up = acc[ai][bj][m][1] * (8.f / 32.f);
                    *(unsigned*)(rp + bj * 64) = pk4_fp8(siluf(g[0]) * up[0], siluf(g[1]) * up[1], siluf(g[2]) * up[2], siluf(g[3]) * up[3]); }
                asm volatile("" ::: "memory"); }
    } };
struct EpiD8 { static constexpr bool PERM = true; unsigned char* MY; float osc;
    DEV void operator()(const Acc& acc, const Unit& u, int wr, int wc, int fr, int fq) const {
        const int row0 = u.pm * BM + wr * 64 + fr, col0 = u.pn * BM + wc * 32 + 8 * fq;
#pragma unroll
        for (int ai = 0; ai < 2; ++ai)
#pragma unroll
            for (int m = 0; m < 4; ++m) { unsigned char* rp = MY + (size_t)(row0 + ai * HALF + m * 16) * D + col0;
#pragma unroll
                for (int bj = 0; bj < 2; ++bj) { const f32x4 a = acc[ai][bj][m][0] * osc, b = acc[ai][bj][m][1] * osc; u32x2 w;
                    int t = __builtin_amdgcn_cvt_pk_fp8_f32(a[0], a[1], 0, false); t = __builtin_amdgcn_cvt_pk_fp8_f32(a[2], a[3], t, true); w.x = (unsigned)t;
                    t = __builtin_amdgcn_cvt_pk_fp8_f32(b[0], b[1], 0, false); t = __builtin_amdgcn_cvt_pk_fp8_f32(b[2], b[3], t, true); w.y = (unsigned)t;
                    *(u32x2*)(rp + bj * HALF) = w; }
                asm volatile("" ::: "memory"); }
    } };
struct MoeSched {
    const char* A; const char* B; size_t estepB, tstepB, tstepA; const int* list; int nunits, G, c, lda2;
    DEV static int st_of(int e) { return *(volatile LAS int*)(SLOTTAB_OFF + 4u * (unsigned)e); }
    DEV static int cn_of(int e) { return *(volatile LAS int*)(SLOTTAB_OFF + 256u + 4u * (unsigned)e); }
    DEV bool next(int i, Unit& u) const {
        const int L = i * G + c; if (L >= nunits) return false;
        u.pm = L >> 2; u.pn = L & 3; unsigned l_; asm volatile("v_mbcnt_lo_u32_b32 %0, -1, 0\n\tv_mbcnt_hi_u32_b32 %0, -1, %0" : "=v"(l_));
        const unsigned long long bal = __ballot(st_of((int)l_) <= u.pm * BM); u.e = __builtin_amdgcn_readfirstlane(63 - __builtin_clzll(bal)); return true;
    }
    DEV unsigned aoff(const Unit& u) const { return (unsigned)((size_t)u.pm * tstepA); }
    DEV unsigned boff(const Unit& u) const { return (unsigned)((size_t)u.e * estepB + (size_t)u.pn * tstepB); }
    DEV unsigned atok(const Unit& u, int r) const { const int st = st_of(u.e), cn = cn_of(u.e); const int lr = u.pm * BM - st + r;
        return (unsigned)(lr < cn ? list[u.e * M + lr] : 0); }
};
}
DEV int vcu_of(int bx, int G) { return (G % 8 == 0) ? (bx % 8) * (G / 8) + bx / 8 : bx; }
namespace mla {
constexpr int KSLOT = 24576, OFF_KR = 16384, VRING = 3 * KSLOT, VSLOT = 16384;
constexpr float THR = 8.f;
DEV void blds(__amdgpu_buffer_rsrc_t r, unsigned voff, unsigned soff, LAS unsigned char* l) { __builtin_amdgcn_raw_ptr_buffer_load_lds(r, (LAS void*)l, 16, (int)voff, (int)soff, 0, 0); }
DEV void unit(const Params& P, LAS unsigned char* lds, int b, int h, int qb, int tid) {
    asm volatile("" : "+v"(tid));
    unsigned char* ws = P.ws; const int lane = tid & 63, r32 = lane & 31, hi = lane >> 5; const int wave = __builtin_amdgcn_readfirstlane(tid >> 6);
    const bf16_t* QM = (const bf16_t*)(ws + WS_QM); const char* KN = (const char*)(ws + WS_KN); const char* VT = (const char*)(ws + WS_VT); const char* KR = (const char*)(ws + WS_KR);
    const bf16_t* KNm = (const bf16_t*)(ws + WS_META + MT_KN); const bf16_t* VTm = (const bf16_t*)(ws + WS_META + MT_VT); const bf16_t* KRm = (const bf16_t*)(ws + WS_META + MT_KR);
    bf16_t* Y = (bf16_t*)(ws + WS_Y);
    const int NTL = 4 * qb + 4, nact = 4 * qb + (wave >> 1) + 1;
    unsigned okn[2], ovt[2], okr;
#pragma unroll
    for (int i = 0; i < 2; ++i) { const int p = 2 * wave + i;
        { const int row = 4 * p + (lane >> 4), c = (lane & 15) ^ (row & 15); okn[i] = (unsigned)(((size_t)(b * SEQ + row) * 512 + h * 128 + c * 8) * 2); }
        { const int row = 8 * p + (lane >> 3), c = (lane & 7) ^ ((row >> 1) & 7); ovt[i] = (unsigned)(((size_t)(h * 128 + row) * M + (size_t)b * SEQ + c * 8) * 2); } }
    { const int row = 8 * wave + (lane >> 3), c = (lane & 7) ^ ((row >> 1) & 7); okr = (unsigned)(((size_t)(b * SEQ + row) * 64 + c * 8) * 2); }
    const unsigned wl = (unsigned)wave * 2048u;
    const __amdgpu_buffer_rsrc_t rKN = __builtin_amdgcn_make_buffer_rsrc((void*)KN, 0, 64 << 20, 0x00020000), rKR = __builtin_amdgcn_make_buffer_rsrc((void*)KR, 0, 8 << 20, 0x00020000),
                                 rVT = __builtin_amdgcn_make_buffer_rsrc((void*)VT, 0, 64 << 20, 0x00020000);
#define MLA_ISSUE_K(j, slot) do { LAS unsigned char* sb_ = lds + (slot) * KSLOT; const unsigned jk_ = (unsigned)(j) * (64u * 512u * 2u), jr_ = (unsigned)(j) * (64u * 64u * 2u); \
        blds(rKN, okn[0], jk_, sb_ + wl); blds(rKN, okn[1], jk_, sb_ + wl + 1024); blds(rKR, okr, jr_, sb_ + OFF_KR + (wl >> 1)); } while (0)
#define MLA_ISSUE_V(j, slot) do { LAS unsigned char* sb_ = lds + VRING + (slot) * VSLOT; const unsigned jv_ = (unsigned)(j) * 128u; \
        blds(rVT, ovt[0], jv_, sb_ + wl); blds(rVT, ovt[1], jv_, sb_ + wl + 1024); } while (0)
    asm volatile("s_waitcnt vmcnt(0)" ::: "memory"); __builtin_amdgcn_s_barrier();
    MLA_ISSUE_K(0, 0); MLA_ISSUE_V(0, 0); MLA_ISSUE_K(1, 1);
    const size_t mq = (size_t)b * SEQ + qb * 256 + wave * 32 + r32;
    bf16x8 qf[12];
#pragma unroll
    for (int s = 0; s < 8; ++s) qf[s] = *(const bf16x8*)(QM + mq * 768 + h * 128 + 16 * s + 8 * hi);
#pragma unroll
    for (int s = 0; s < 4; ++s) qf[8 + s] = *(const bf16x8*)(QM + mq * 768 + 512 + h * 64 + 16 * s + 8 * hi);
    f32x16 O[4] = {}; float mrun = -INFINITY, l = 0.f;
    const int kperm = pi23(r32);
    const int xk = (kperm & 15) ^ hi, xr = ((kperm >> 1) & 7) ^ hi, xv = ((r32 >> 1) & 7) ^ hi;
    const int kn_b = kperm * 256, kr_b = OFF_KR + kperm * 128, vt_b = r32 * 128;
#define MLA_SOFTMAX(S0, S1) do { \
        float mx = fmaxf(S0[0], S1[0]); \
        _Pragma("unroll") for (int r = 1; r < 16; ++r) mx = fmaxf(mx, fmaxf(S0[r], S1[r])); \
        mx = half_max(mx); \
        if (__any(mx > mrun + THR)) { const float mnew = fmaxf(mrun, mx), alpha = __builtin_amdgcn_exp2f(mrun - mnew); mrun = mnew; l *= alpha; \
            _Pragma("unroll") for (int d = 0; d < 4; ++d) _Pragma("unroll") for (int r = 0; r < 16; ++r) O[d][r] *= alpha; } \
        float ps = 0.f; \
        _Pragma("unroll") for (int r = 0; r < 16; ++r) { S0[r] = __builtin_amdgcn_exp2f(S0[r] - mrun); S1[r] = __builtin_amdgcn_exp2f(S1[r] - mrun); ps += S0[r] + S1[r]; } \
        l += ps; \
        { u32x4 w; w.x = g8::cvt_pk_bf16(S0[0], S0[1]); w.y = g8::cvt_pk_bf16(S0[2], S0[3]); w.z = g8::cvt_pk_bf16(S0[4], S0[5]); w.w = g8::cvt_pk_bf16(S0[6], S0[7]); pf[0] = __builtin_bit_cast(bf16x8, w); \
          w.x = g8::cvt_pk_bf16(S0[8], S0[9]); w.y = g8::cvt_pk_bf16(S0[10], S0[11]); w.z = g8::cvt_pk_bf16(S0[12], S0[13]); w.w = g8::cvt_pk_bf16(S0[14], S0[15]); pf[1] = __builtin_bit_cast(bf16x8, w); \
          w.x = g8::cvt_pk_bf16(S1[0], S1[1]); w.y = g8::cvt_pk_bf16(S1[2], S1[3]); w.z = g8::cvt_pk_bf16(S1[4], S1[5]); w.w = g8::cvt_pk_bf16(S1[6], S1[7]); pf[2] = __builtin_bit_cast(bf16x8, w); \
          w.x = g8::cvt_pk_bf16(S1[8], S1[9]); w.y = g8::cvt_pk_bf16(S1[10], S1[11]); w.z = g8::cvt_pk_bf16(S1[12], S1[13]); w.w = g8::cvt_pk_bf16(S1[14], S1[15]); pf[3] = __builtin_bit_cast(bf16x8, w); } \
    } while (0)
#define MLA_PV(VLOAD) do { \
        _Pragma("unroll") for (int d = 0; d < 4; ++d) { _Pragma("unroll") for (int sp = 0; sp < 4; ++sp) { const bf16x8 vf = VLOAD(d, sp); O[d] = __builtin_amdgcn_mfma_f32_32x32x16_bf16(vf, pf[sp], O[d], 0, 0, 0); } } \
        __builtin_amdgcn_sched_group_barrier(0x100, 8, 1); \
        _Pragma("unroll") for (int i_ = 0; i_ < 4; ++i_) { __builtin_amdgcn_sched_group_barrier(0x8, 2, 1); __builtin_amdgcn_sched_group_barrier(0x100, 2, 1); } \
        __builtin_amdgcn_sched_group_barrier(0x8, 8, 1); \
    } while (0)
    bf16x8 pf[4];
    { f32x16 S0 = {}, S1; const bf16x8 zf = {};
#pragma unroll
      for (int s = 0; s < 8; ++s) { const bf16x8 kf = *(const bf16x8*)(KNm + kperm * 512 + h * 128 + 16 * s + 8 * hi); S0 = __builtin_amdgcn_mfma_f32_32x32x16_bf16(kf, qf[s], S0, 0, 0, 0); }
#pragma unroll
      for (int s = 0; s < 4; ++s) { const bf16x8 kf = *(const bf16x8*)(KRm + kperm * 64 + 16 * s + 8 * hi); S0 = __builtin_amdgcn_mfma_f32_32x32x16_bf16(kf, qf[8 + s], S0, 0, 0, 0); }
#pragma unroll
      for (int r = 0; r < 16; ++r) { if (pi23(crow(r, hi)) >= NMETA) S0[r] = -INFINITY; S1[r] = -INFINITY; }
#define MLA_VMETA(d, sp) ((sp) == 0 ? *(const bf16x8*)(VTm + (h * 128 + 32 * (d) + r32) * 32 + 8 * hi) : zf)
      MLA_SOFTMAX(S0, S1); MLA_PV(MLA_VMETA);
    }
#define MLA_QK(S0, S1, kslot) do { LAS const unsigned char* sb = lds + (kslot) * KSLOT; int xk_ = xk, xr_ = xr; asm volatile("" : "+v"(xk_), "+v"(xr_));   \
        _Pragma("unroll") for (int r = 0; r < 16; ++r) { S0[r] = 0.f; S1[r] = 0.f; } \
        _Pragma("unroll") for (int s = 0; s < 8; ++s) { const int co = ((2 * s) ^ xk_) << 4; const bf16x8 k0 = *(LAS const bf16x8*)(sb + kn_b + co), k1 = *(LAS const bf16x8*)(sb + kn_b + 32 * 256 + co); \
            S0 = __builtin_amdgcn_mfma_f32_32x32x16_bf16(k0, qf[s], S0, 0, 0, 0); S1 = __builtin_amdgcn_mfma_f32_32x32x16_bf16(k1, qf[s], S1, 0, 0, 0); } \
        _Pragma("unroll") for (int s = 0; s < 4; ++s) { const int co = ((2 * s) ^ xr_) << 4; const bf16x8 k0 = *(LAS const bf16x8*)(sb + kr_b + co), k1 = *(LAS const bf16x8*)(sb + kr_b + 32 * 128 + co); \
            S0 = __builtin_amdgcn_mfma_f32_32x32x16_bf16(k0, qf[8 + s], S0, 0, 0, 0); S1 = __builtin_amdgcn_mfma_f32_32x32x16_bf16(k1, qf[8 + s], S1, 0, 0, 0); } \
        __builtin_amdgcn_sched_group_barrier(0x100, 8, 0); \
        _Pragma("unroll") for (int i_ = 0; i_ < 8; ++i_) { __builtin_amdgcn_sched_group_barrier(0x8, 2, 0); __builtin_amdgcn_sched_group_barrier(0x100, 2, 0); } \
        __builtin_amdgcn_sched_group_barrier(0x8, 8, 0); } while (0)
#define MLA_VLDS(d, sp) (*(LAS const bf16x8*)(vb + vt_b + (d) * (32 * 128) + (((2 * (sp)) ^ xv_) << 4)))
    { const bool late = wave >= 4; int ks = 0;
      for (int j = 0; j < NTL; ++j) {
        if (j + 1 < NTL) asm volatile("s_waitcnt vmcnt(3)" ::: "memory"); else asm volatile("s_waitcnt vmcnt(0)" ::: "memory");
        __builtin_amdgcn_s_barrier(); asm volatile("" ::: "memory");
        if (j + 1 < NTL) MLA_ISSUE_V(j + 1, ks == 2 ? 0 : ks + 1);
        if (j + 2 < NTL) MLA_ISSUE_K(j + 2, ks == 0 ? 2 : ks - 1);
        if (late && j >= 1 && j - 1 < nact) { LAS const unsigned char* vb = lds + VRING + (ks == 0 ? 2 : ks - 1) * VSLOT; int xv_ = xv; asm volatile("" : "+v"(xv_)); MLA_PV(MLA_VLDS); }
        if (j < nact) { f32x16 S0, S1; MLA_QK(S0, S1, ks); MLA_SOFTMAX(S0, S1);
            if (!late) { LAS const unsigned char* vb = lds + VRING + ks * VSLOT; int xv_ = xv; asm volatile("" : "+v"(xv_)); MLA_PV(MLA_VLDS); } }
        ks = ks == 2 ? 0 : ks + 1;
      }
      if (late && NTL - 1 < nact) { LAS const unsigned char* vb = lds + VRING + (ks == 0 ? 2 : ks - 1) * VSLOT; int xv_ = xv; asm volatile("" : "+v"(xv_)); MLA_PV(MLA_VLDS); } }
    l = half_sum(l); const float rl = 1.f / l;
    { int te = tid; asm volatile("" : "+v"(te));
      bf16_t* yr = Y + ((size_t)b * SEQ + qb * 256 + wave * 32 + (te & 31)) * 1024 + 512 + h * 128 + 4 * ((te >> 5) & 1);
#pragma unroll
      for (int d = 0; d < 4; ++d)
#pragma unroll
        for (int g = 0; g < 4; ++g) { u32x2 w; w.x = g8::cvt_pk_bf16(O[d][4 * g] * rl, O[d][4 * g + 1] * rl); w.y = g8::cvt_pk_bf16(O[d][4 * g + 2] * rl, O[d][4 * g + 3] * rl);
            *(u32x2*)(yr + 32 * d + 8 * g) = w; } }
#undef MLA_ISSUE_K
#undef MLA_ISSUE_V
#undef MLA_QK
#undef MLA_SOFTMAX
#undef MLA_PV
#undef MLA_VMETA
#undef MLA_VLDS
}
}
namespace mla8 {
typedef int i32x8 __attribute__((ext_vector_type(8)));
typedef int i32x4 __attribute__((ext_vector_type(4)));
constexpr int KSLOT = 12288, OFF_KR = 8192, VRING = 3 * KSLOT, VSLOT = 8192;
constexpr float THR = 8.f, INVQS = 1.f / 16.f;
DEV int pip(int i) { return (i & 3) | (((i >> 3) & 3) << 2) | (((i >> 2) & 1) << 4); }
DEV f32x16 mfma8(i32x8 a, i32x8 b, f32x16 c) { return __builtin_amdgcn_mfma_scale_f32_32x32x64_f8f6f4(a, b, c, 0, 0, 0, 0x7f7f7f7f, 0, 0x7f7f7f7f); }
DEV i32x8 cat(i32x4 a, i32x4 b) { return (i32x8){a[0], a[1], a[2], a[3], b[0], b[1], b[2], b[3]}; }
DEV void unit(const Params& P, LAS unsigned char* lds, int b, int h, int qb, int tid) {
    asm volatile("" : "+v"(tid));
    unsigned char* ws = P.ws; const int lane = tid & 63, r32 = lane & 31, hi = lane >> 5; const int wave = __builtin_amdgcn_readfirstlane(tid >> 6);
    const unsigned char* QM = ws + WS_QM; const unsigned char* KN = ws + WS_KN; const unsigned char* VT = ws + WS_VT; const unsigned char* KR = ws + WS_KR;
    const unsigned char* KNm = ws + WS_META + MT_KN8; const unsigned char* VTm = ws + WS_META + MT_VT8; const unsigned char* KRm = ws + WS_META + MT_KR8;
    bf16_t* Y = (bf16_t*)(ws + WS_Y);
    const int NTL = 4 * qb + 4, nact = 4 * qb + (wave >> 1) + 1;
    unsigned okn, okr, ovt;
    { const int row = 8 * wave + (lane >> 3), c = (lane & 7) ^ ((row >> 1) & 7); okn = (unsigned)((size_t)(b * SEQ + row) * 512 + h * 128 + c * 16); }
    { const int row = 16 * (wave & 3) + (lane >> 2), c = (lane & 3) ^ ((row >> 2) & 3); okr = (unsigned)((size_t)(b * SEQ + row) * 64 + c * 16); }
    { const int row = 16 * wave + (lane >> 2), c = (lane & 3) ^ ((row >> 2) & 3); ovt = (unsigned)((size_t)(h * 128 + row) * M + (size_t)b * SEQ + c * 16); }
    const unsigned wl = (unsigned)wave * 1024u, wl3 = (unsigned)(wave & 3) * 1024u;
    const __amdgpu_buffer_rsrc_t rKN = __builtin_amdgcn_make_buffer_rsrc((void*)KN, 0, 32 << 20, 0x00020000), rKR = __builtin_amdgcn_make_buffer_rsrc((void*)KR, 0, 4 << 20, 0x00020000),
                                 rVT = __builtin_amdgcn_make_buffer_rsrc((void*)VT, 0, 32 << 20, 0x00020000);
#define M8_ISSUE_K(j, slot) do { LAS unsigned char* sb_ = lds + (slot) * KSLOT; mla::blds(rKN, okn, (unsigned)(j) * (64u * 512u), sb_ + wl); mla::blds(rKR, okr, (unsigned)(j) * (64u * 64u), sb_ + OFF_KR + wl3); } while (0)
#define M8_ISSUE_V(j, slot) do { mla::blds(rVT, ovt, (unsigned)(j) * 64u, lds + VRING + (slot) * VSLOT + wl); } while (0)
    asm volatile("s_waitcnt vmcnt(0)" ::: "memory"); __builtin_amdgcn_s_barrier();
    M8_ISSUE_K(0, 0); M8_ISSUE_V(0, 0); M8_ISSUE_K(1, 1);
    i32x8 qf[3];
    { const unsigned char* qp = QM + ((size_t)b * SEQ + qb * 256 + wave * 32 + r32) * 768;
      qf[0] = *(const i32x8*)(qp + h * 128 + 32 * hi); qf[1] = *(const i32x8*)(qp + h * 128 + 64 + 32 * hi); qf[2] = *(const i32x8*)(qp + 512 + h * 64 + 32 * hi); }
    f32x16 O[4] = {}; float mrun = -INFINITY, l = 0.f;
    const int kperm = pip(r32);
    const int xk = (kperm >> 1) & 7, xr = (kperm >> 2) & 3, xv = (r32 >> 2) & 3;
    const int kn_b = kperm * 128, kr_b = OFF_KR + kperm * 64, vt_b = r32 * 64;
    i32x8 pb;
#define M8_SOFTMAX(S0, S1) do { \
        float mx = __builtin_amdgcn_fmed3f(S0[0], S1[0], INFINITY);             \
        _Pragma("unroll") for (int r = 1; r < 16; ++r) { mx = __builtin_amdgcn_fmed3f(mx, S0[r], INFINITY); mx = __builtin_amdgcn_fmed3f(mx, S1[r], INFINITY); } \
        mx = half_max(mx) * INVQS; \
        if (__any(mx > mrun + THR)) { const float mnew = fmaxf(mrun, mx), alpha = __builtin_amdgcn_exp2f(mrun - mnew); mrun = mnew; l *= alpha; \
            _Pragma("unroll") for (int d = 0; d < 4; ++d) _Pragma("unroll") for (int r = 0; r < 16; ++r) O[d][r] *= alpha; } \
        float ps = 0.f; \
        _Pragma("unroll") for (int r = 0; r < 16; ++r) { S0[r] = __builtin_amdgcn_exp2f(S0[r] * INVQS - mrun); S1[r] = __builtin_amdgcn_exp2f(S1[r] * INVQS - mrun); ps += S0[r] + S1[r]; } \
        l += ps; \
        pb[0] = (int)pk4_fp8(S0[0], S0[1], S0[2], S0[3]); pb[1] = (int)pk4_fp8(S0[4], S0[5], S0[6], S0[7]); pb[2] = (int)pk4_fp8(S0[8], S0[9], S0[10], S0[11]); pb[3] = (int)pk4_fp8(S0[12], S0[13], S0[14], S0[15]); \
        pb[4] = (int)pk4_fp8(S1[0], S1[1], S1[2], S1[3]); pb[5] = (int)pk4_fp8(S1[4], S1[5], S1[6], S1[7]); pb[6] = (int)pk4_fp8(S1[8], S1[9], S1[10], S1[11]); pb[7] = (int)pk4_fp8(S1[12], S1[13], S1[14], S1[15]); \
    } while (0)
#define M8_SOFTMAX2(S0, S1) do { \
        _Pragma("unroll") for (int r = 0; r < 16; ++r) { S0[r] = __builtin_fmaf(S0[r], INVQS, -mrun); S1[r] = __builtin_fmaf(S1[r], INVQS, -mrun); } \
        float mxa = fmaxf(fmaxf(S0[0], S0[1]), S0[2]), mxb = fmaxf(fmaxf(S1[0], S1[1]), S1[2]); \
        _Pragma("unroll") for (int r = 3; r < 15; r += 2) { mxa = fmaxf(fmaxf(mxa, S0[r]), S0[r + 1]); mxb = fmaxf(fmaxf(mxb, S1[r]), S1[r + 1]); } \
        float mx = half_max(fmaxf(fmaxf(mxa, S0[15]), fmaxf(mxb, S1[15]))); \
        if (__any(mx > THR)) { const float d = fmaxf(mx, 0.f), alpha = __builtin_amdgcn_exp2f(-d); mrun += d; l *= alpha; \
            _Pragma("unroll") for (int r = 0; r < 16; ++r) { S0[r] -= d; S1[r] -= d; } \
            _Pragma("unroll") for (int d_ = 0; d_ < 4; ++d_) _Pragma("unroll") for (int r = 0; r < 16; ++r) O[d_][r] *= alpha; } \
        float ps = 0.f; \
        _Pragma("unroll") for (int r = 0; r < 16; ++r) { S0[r] = __builtin_amdgcn_exp2f(S0[r]); S1[r] = __builtin_amdgcn_exp2f(S1[r]); ps += S0[r] + S1[r]; } \
        l += ps; \
        pb[0] = (int)pk4_fp8(S0[0], S0[1], S0[2], S0[3]); pb[1] = (int)pk4_fp8(S0[4], S0[5], S0[6], S0[7]); pb[2] = (int)pk4_fp8(S0[8], S0[9], S0[10], S0[11]); pb[3] = (int)pk4_fp8(S0[12], S0[13], S0[14], S0[15]); \
        pb[4] = (int)pk4_fp8(S1[0], S1[1], S1[2], S1[3]); pb[5] = (int)pk4_fp8(S1[4], S1[5], S1[6], S1[7]); pb[6] = (int)pk4_fp8(S1[8], S1[9], S1[10], S1[11]); pb[7] = (int)pk4_fp8(S1[12], S1[13], S1[14], S1[15]); \
    } while (0)
    { f32x16 S0 = {}, S1;
      S0 = mfma8(*(const i32x8*)(KNm + kperm * 512 + h * 128 + 32 * hi), qf[0], S0);
      S0 = mfma8(*(const i32x8*)(KNm + kperm * 512 + h * 128 + 64 + 32 * hi), qf[1], S0);
      S0 = mfma8(*(const i32x8*)(KRm + kperm * 64 + 32 * hi), qf[2], S0);
#pragma unroll
      for (int r = 0; r < 16; ++r) { if (hi) S0[r] = -INFINITY; S1[r] = -INFINITY; }
      M8_SOFTMAX(S0, S1);
      const i32x4 z4 = {0, 0, 0, 0};
#pragma unroll
      for (int d = 0; d < 4; ++d) { const i32x8 vf = cat(*(const i32x4*)(VTm + (h * 128 + 32 * d + r32) * 32 + 16 * hi), z4); O[d] = mfma8(vf, pb, O[d]); } }
#define M8_QK(S0, S1, kslot) do { LAS const unsigned char* sb = lds + (kslot) * KSLOT; int xk_ = xk, xr_ = xr; asm volatile("" : "+v"(xk_), "+v"(xr_)); \
        _Pragma("unroll") for (int r = 0; r < 16; ++r) { S0[r] = 0.f; S1[r] = 0.f; } \
        _Pragma("unroll") for (int s = 0; s < 2; ++s) { const int co = ((4 * s + 2 * hi) ^ xk_) << 4; \
            const i32x8 k0 = cat(*(LAS const i32x4*)(sb + kn_b + co), *(LAS const i32x4*)(sb + kn_b + (co ^ 16))), k1 = cat(*(LAS const i32x4*)(sb + kn_b + 32 * 128 + co), *(LAS const i32x4*)(sb + kn_b + 32 * 128 + (co ^ 16))); \
            S0 = mfma8(k0, qf[s], S0); S1 = mfma8(k1, qf[s], S1); } \
        { const int co = ((2 * hi) ^ xr_) << 4; \
            const i32x8 k0 = cat(*(LAS const i32x4*)(sb + kr_b + co), *(LAS const i32x4*)(sb + kr_b + (co ^ 16))), k1 = cat(*(LAS const i32x4*)(sb + kr_b + 32 * 64 + co), *(LAS const i32x4*)(sb + kr_b + 32 * 64 + (co ^ 16))); \
            S0 = mfma8(k0, qf[2], S0); S1 = mfma8(k1, qf[2], S1); } } while (0)
#define M8_PV(vslot) do { LAS const unsigned char* vb = lds + VRING + (vslot) * VSLOT; int xv_ = xv; asm volatile("" : "+v"(xv_)); const int c0 = (hi ^ xv_) << 4, c1 = ((2 + hi) ^ xv_) << 4; \
        _Pragma("unroll") for (int d = 0; d < 4; ++d) { const i32x8 vf = cat(*(LAS const i32x4*)(vb + vt_b + d * (32 * 64) + c0), *(LAS const i32x4*)(vb + vt_b + d * (32 * 64) + c1)); O[d] = mfma8(vf, pb, O[d]); } } while (0)
#if PINGPONG
#define M8_HALF_A(jj, ks_) do { if ((jj) + 1 < NTL) asm volatile("s_waitcnt vmcnt(3)" ::: "memory"); else asm volatile("s_waitcnt vmcnt(0)" ::: "memory"); \
        __builtin_amdgcn_s_barrier(); asm volatile("" ::: "memory"); \
        if ((jj) + 1 < NTL) M8_ISSUE_V((jj) + 1, (ks_) == 2 ? 0 : (ks_) + 1); \
        if ((jj) + 2 < NTL) M8_ISSUE_K((jj) + 2, (ks_) == 0 ? 2 : (ks_) - 1); } while (0)
#define M8_HALF_B() do { asm volatile("" ::: "memory"); __builtin_amdgcn_s_barrier(); asm volatile("" ::: "memory"); } while (0)
    if (wave < 4) { int ks = 0;
      for (int j = 0; j <= NTL; ++j) { const int kp = ks == 0 ? 2 : ks - 1;
        M8_HALF_A(j, ks);
        f32x16 S0, S1;
        if (j < nact) M8_QK(S0, S1, ks);
        if (j >= 1 && j - 1 < nact) M8_PV(kp);
        M8_HALF_B();
        if (j < nact) M8_SOFTMAX(S0, S1);
        ks = ks == 2 ? 0 : ks + 1; } }
    else { int ks = 0;
      M8_HALF_A(0, 0);
      for (int j = 0; j <= NTL; ++j) { const int kp = ks == 0 ? 2 : ks - 1;
        M8_HALF_B();
        if (j >= 1 && j - 1 < nact) M8_PV(kp);
        f32x16 S0, S1;
        if (j < nact) M8_QK(S0, S1, ks);
        if (j == NTL) break;
        ks = ks == 2 ? 0 : ks + 1;
        M8_HALF_A(j + 1, ks);
        if (j < nact) M8_SOFTMAX(S0, S1); } }
#undef M8_HALF_A
#undef M8_HALF_B
#else
    { const bool late = wave >= 4; int ks = 0;
      for (int j = 0; j < NTL; ++j) {
        if (j + 1 < NTL) asm volatile("s_waitcnt vmcnt(2)" ::: "memory"); else asm volatile("s_waitcnt vmcnt(0)" ::: "memory");
        __builtin_amdgcn_s_barrier(); asm volatile("" ::: "memory");
        if (j + 1 < NTL) M8_ISSUE_V(j + 1, ks == 2 ? 0 : ks + 1);
        if (j + 2 < NTL) M8_ISSUE_K(j + 2, ks == 0 ? 2 : ks - 1);
        if (late && j >= 1 && j - 1 < nact) M8_PV(ks == 0 ? 2 : ks - 1);
        if (j < nact) { f32x16 S0, S1; M8_QK(S0, S1, ks); if (SM2) M8_SOFTMAX2(S0, S1); else M8_SOFTMAX(S0, S1); if (!late) M8_PV(ks); }
        ks = ks == 2 ? 0 : ks + 1;
      }
      if (late && NTL - 1 < nact) M8_PV(ks == 0 ? 2 : ks - 1); }
#endif
    l = half_sum(l); const float rl = 1.f / l;
    { int te = tid; asm volatile("" : "+v"(te));
      bf16_t* yr = Y + ((size_t)b * SEQ + qb * 256 + wave * 32 + (te & 31)) * 1024 + 512 + h * 128 + 4 * ((te >> 5) & 1);
#pragma unroll
      for (int d = 0; d < 4; ++d)
#pragma unroll
        for (int g = 0; g < 4; ++g) { u32x2 w; w.x = g8::cvt_pk_bf16(O[d][4 * g] * rl, O[d][4 * g + 1] * rl); w.y = g8::cvt_pk_bf16(O[d][4 * g + 2] * rl, O[d][4 * g + 3] * rl);
            *(u32x2*)(yr + 32 * d + 8 * g) = w; } }
#undef M8_ISSUE_K
#undef M8_ISSUE_V
#undef M8_SOFTMAX
#undef M8_SOFTMAX2
#undef M8_QK
#undef M8_PV
}
}
DEV void mla_fast(const Params& P, LAS unsigned char* lds) {
    const int tid = tid_fresh(); const int G = gridDim.x;
    for (int v = vcu_of(blockIdx.x, G); v < 256; v += G) { const int bh = v >> 2, s = v & 3;
        for (int ui = 0; ui < 4; ++ui) { const int qb = (ui == 0) ? s : (ui == 1) ? 7 - s : (ui == 2) ? 8 + s : 15 - s; mla::unit(P, lds, bh >> 2, bh & 3, qb, tid); } }
    asm volatile("s_waitcnt vmcnt(0)" ::: "memory"); __builtin_amdgcn_s_barrier();
}
namespace gla {
constexpr int L_QE = 0, L_KD = 9216, L_KDT = 18432, L_VT = 27648, L_ST = 46080  , STB = 18432, L_D = 82944, L_RED = 83200, L_G = 84224;
DEV int sw128(int row, int chunk) { return row * 144 + chunk * 16; }
template <int CTRL, int RM> DEV float dppz(float v) { return __int_as_float(__builtin_amdgcn_update_dpp(0, __float_as_int(v), CTRL, RM, 0xf, false)); }
DEV float wave_scan(float x) {
    x += __int_as_float(__builtin_amdgcn_update_dpp(0, __float_as_int(x), 0x111, 0xf, 0xf, true));
    x += __int_as_float(__builtin_amdgcn_update_dpp(0, __float_as_int(x), 0x112, 0xf, 0xf, true));
    x += __int_as_float(__builtin_amdgcn_update_dpp(0, __float_as_int(x), 0x114, 0xf, 0xf, true));
    x += __int_as_float(__builtin_amdgcn_update_dpp(0, __float_as_int(x), 0x118, 0xf, 0xf, true));
    x += dppz<0x142, 0xa>(x);
    x += dppz<0x143, 0xc>(x);
    return x;
}
DEV void item(const Params& P, LAS unsigned char* lds, int b, int h, int tid) {
    unsigned char* ws = P.ws; const int lane = tid & 63, r32 = lane & 31, hi = lane >> 5; const int wave = __builtin_amdgcn_readfirstlane(tid >> 6), ie = wave >> 1, ih = wave & 1;
    const bf16_t* Z = (const bf16_t*)P.out; const float* LOGA = (const float*)(ws + WS_LOGA); const bf16_t* VTG = (const bf16_t*)(ws + WS_VTG); bf16_t* Y = (bf16_t*)(ws + WS_Y);
    const float* S1 = (const float*)(ws + WS_META + MT_S1); const float* gain = P.in[I_GOUTN];
    __syncthreads();
    f32x16 accS;
#pragma unroll
    for (int r = 0; r < 16; ++r) { const int e = 32 * ie + crow(r, hi), d = 32 * ih + r32; accS[r] = S1[(h * 64 + d) * 128 + e];
        *(LAS bf16_t*)(lds + L_ST + sw128(e, d >> 3) + (d & 7) * 2) = (bf16_t)f2bf(accS[r]); }
    const size_t m0 = (size_t)b * SEQ;
    const char* Zb = (const char*)Z + m0 * NZ * 2; const char* Lb = (const char*)LOGA + m0 * 256 * 4; const char* Vb = (const char*)VTG + ((size_t)h * 128 * M + m0) * 2;
    const unsigned oq = (unsigned)(lane * NZ + ZQ + h * 64 + 8 * wave) * 2u, ok = (unsigned)(lane * NZ + ZK + h * 64 + 8 * wave) * 2u, ola = (unsigned)(lane * 256 + h * 64 + 8 * wave) * 4u;
    const unsigned ovt = (unsigned)(((size_t)(tid >> 2) * M + 16 * (tid & 3)) * 2), org = (unsigned)((32 * ih + r32) * NZ + ZR + h * 128 + 32 * ie + 4 * hi) * 2u;
#define GLA_LD(q_, k_, a0_, a1_, v0_, v1_, n_) do { const char* zc_ = Zb + (size_t)(n_) * 64 * NZ * 2; const char* lc_ = Lb + (size_t)(n_) * 64 * 256 * 4; const char* vc_ = Vb + (size_t)(n_) * 64 * 2; \
        q_ = *(const u32x4*)(zc_ + oq); k_ = *(const u32x4*)(zc_ + ok); a0_ = *(const f32x4*)(lc_ + ola); a1_ = *(const f32x4*)(lc_ + ola + 16); v0_ = *(const u32x4*)(vc_ + ovt); v1_ = *(const u32x4*)(vc_ + ovt + 16); } while (0)
#define GLA_LDRG(r_, n_) do { const char* zc_ = Zb + (size_t)(n_) * 64 * NZ * 2; _Pragma("unroll") for (int g = 0; g < 4; ++g) r_[g] = *(const u32x2*)(zc_ + org + 16 * g); } while (0)
    u32x4 qv, kv, vt0, vt1, qv2, kv2, vt02, vt12; f32x4 la0, la1, la02, la12; u32x2 rg[4], rgn[4];
    GLA_LD(qv, kv, la0, la1, vt0, vt1, 0); GLA_LD(qv2, kv2, la02, la12, vt02, vt12, 1); GLA_LDRG(rg, 0);
    if (tid < 128) *(LAS float*)(lds + L_G + 4 * tid) = gain[h * 128 + tid];
    const int kperm = pi23(r32);
    int par = 0;
    for (int n = 0; n < 64; n += 2) {
        { float bq[8] = {la0[0], la0[1], la0[2], la0[3], la1[0], la1[1], la1[2], la1[3]}; const unsigned qw[4] = {qv.x, qv.y, qv.z, qv.w}, kw[4] = {kv.x, kv.y, kv.z, kv.w};
          u32x4 qo, ko; unsigned qo_[4], ko_[4];
#pragma unroll
          for (int i = 0; i < 8; ++i) bq[i] = wave_scan(bq[i]);
          float e1[8], kd[8], qe[8];
#pragma unroll
          for (int i = 0; i < 8; ++i) { e1[i] = __expf(bq[i]); const float e2 = __builtin_amdgcn_rcpf(e1[i]);
              const float qf_ = (i & 1) ? __uint_as_float(qw[i >> 1] & 0xffff0000u) : __uint_as_float(qw[i >> 1] << 16), kf_ = (i & 1) ? __uint_as_float(kw[i >> 1] & 0xffff0000u) : __uint_as_float(kw[i >> 1] << 16);
              qe[i] = qf_ * e1[i] * 0.125f; kd[i] = kf_ * e2; }
#pragma unroll
          for (int i = 0; i < 4; ++i) { qo_[i] = pk2(qe[2 * i], qe[2 * i + 1]); ko_[i] = pk2(kd[2 * i], kd[2 * i + 1]); }
          qo.x = qo_[0]; qo.y = qo_[1]; qo.z = qo_[2]; qo.w = qo_[3]; ko.x = ko_[0]; ko.y = ko_[1]; ko.z = ko_[2]; ko.w = ko_[3];
          *(LAS u32x4*)(lds + L_QE + sw128(lane, wave)) = qo; *(LAS u32x4*)(lds + L_KD + sw128(lane, wave)) = ko;
#pragma unroll
          for (int i = 0; i < 8; ++i) { const int d = 8 * wave + i; *(LAS bf16_t*)(lds + L_KDT + sw128(d, lane >> 3) + (lane & 7) * 2) = (bf16_t)f2bf(kd[i]);
              const float dl = rl_f(e1[i], 63); if (lane == 0) *(LAS float*)(lds + L_D + 4 * d) = dl; }
          { const int e = tid >> 2, c0 = 2 * (tid & 3); *(LAS u32x4*)(lds + L_VT + sw128(e, c0)) = vt0; *(LAS u32x4*)(lds + L_VT + sw128(e, c0 + 1)) = vt1; } }
        __syncthreads();
        if (n + 2 < 64) GLA_LD(qv, kv, la0, la1, vt0, vt1, n + 2);
        if (n + 1 < 64) GLA_LDRG(rgn, n + 1);
        const size_t mtok = m0 + (size_t)n * 64 + 32 * ih + r32;
        bf16x8 qf[4], vf[4];
#pragma unroll
        for (int ks = 0; ks < 4; ++ks) { qf[ks] = *(LAS const bf16x8*)(lds + L_QE + sw128(32 * ih + r32, 2 * ks + hi)); vf[ks] = *(LAS const bf16x8*)(lds + L_VT + sw128(32 * ie + r32, 2 * ks + hi)); }
        f32x16 o = {};
#pragma unroll
        for (int ts = 0; ts < 2; ++ts) if (ts <= ih) {
            f32x16 at = {};
#pragma unroll
            for (int ks = 0; ks < 4; ++ks) { const bf16x8 kf = *(LAS const bf16x8*)(lds + L_KD + sw128(32 * ts + kperm, 2 * ks + hi)); at = __builtin_amdgcn_mfma_f32_32x32x16_bf16(kf, qf[ks], at, 0, 0, 0); }
            if (ts == ih) {
#pragma unroll
                for (int r = 0; r < 16; ++r) if (pi23(crow(r, hi)) > r32) at[r] = 0.f; }
            u32x4 w0, w1; w0.x = pk2_mfma(at[0], at[1]); w0.y = pk2_mfma(at[2], at[3]); w0.z = pk2_mfma(at[4], at[5]); w0.w = pk2_mfma(at[6], at[7]);
            w1.x = pk2_mfma(at[8], at[9]); w1.y = pk2_mfma(at[10], at[11]); w1.z = pk2_mfma(at[12], at[13]); w1.w = pk2_mfma(at[14], at[15]);
            o = __builtin_amdgcn_mfma_f32_32x32x16_bf16(vf[2 * ts], __builtin_bit_cast(bf16x8, w0), o, 0, 0, 0);
            o = __builtin_amdgcn_mfma_f32_32x32x16_bf16(vf[2 * ts + 1], __builtin_bit_cast(bf16x8, w1), o, 0, 0, 0);
        }
#pragma unroll
        for (int ks = 0; ks < 4; ++ks) { const bf16x8 sf = *(LAS const bf16x8*)(lds + L_ST + par * STB + sw128(32 * ie + r32, 2 * ks + hi)); o = __builtin_amdgcn_mfma_f32_32x32x16_bf16(sf, qf[ks], o, 0, 0, 0); }
#pragma unroll
        for (int ks = 0; ks < 4; ++ks) { const bf16x8 tf = *(LAS const bf16x8*)(lds + L_KDT + sw128(32 * ih + r32, 2 * ks + hi)); accS = __builtin_amdgcn_mfma_f32_32x32x16_bf16(vf[ks], tf, accS, 0, 0, 0); }
        { const float dl = *(LAS const float*)(lds + L_D + 4 * (32 * ih + r32));
#pragma unroll
          for (int r = 0; r < 16; ++r) { accS[r] *= dl; const int e = 32 * ie + crow(r, hi), d = 32 * ih + r32;
              *(LAS bf16_t*)(lds + L_ST + (par ^ 1) * STB + sw128(e, d >> 3) + (d & 7) * 2) = (bf16_t)f2bf(accS[r]); } }
        { float ss = 0.f;
#pragma unroll
          for (int r = 0; r < 16; ++r) ss += o[r] * o[r];
          ss = half_sum(ss); if (hi == 0) *(LAS float*)(lds + L_RED + (wave * 32 + r32) * 4) = ss; }
        __syncthreads();
        { float tot = 0.f;
#pragma unroll
          for (int q = 0; q < 4; ++q) tot += *(LAS const float*)(lds + L_RED + ((2 * q + ih) * 32 + r32) * 4);
          const float rs = rsqrtf(tot * (1.f / 128.f) + EPS);
#pragma unroll
          for (int g = 0; g < 4; ++g) { const float r0 = __uint_as_float(rg[g].x << 16), r1 = __uint_as_float(rg[g].x & 0xffff0000u), r2 = __uint_as_float(rg[g].y << 16), r3 = __uint_as_float(rg[g].y & 0xffff0000u);
              const f32x4 gn = *(LAS const f32x4*)(lds + L_G + 4 * (32 * ie + 8 * g + 4 * hi));
              u32x2 w; w.x = g8::cvt_pk_bf16(o[4 * g] * rs * gn[0] * siluf(r0), o[4 * g + 1] * rs * gn[1] * siluf(r1));
              w.y = g8::cvt_pk_bf16(o[4 * g + 2] * rs * gn[2] * siluf(r2), o[4 * g + 3] * rs * gn[3] * siluf(r3));
              *(u32x2*)(Y + mtok * 1024 + h * 128 + 32 * ie + 8 * g + 4 * hi) = w; } }

        par ^= 1;
        { const int n1 = n + 1;
        { float bq[8] = {la02[0], la02[1], la02[2], la02[3], la12[0], la12[1], la12[2], la12[3]}; const unsigned qw[4] = {qv2.x, qv2.y, qv2.z, qv2.w}, kw[4] = {kv2.x, kv2.y, kv2.z, kv2.w};
          u32x4 qo, ko; unsigned qo_[4], ko_[4];
#pragma unroll
          for (int i = 0; i < 8; ++i) bq[i] = wave_scan(bq[i]);
          float e1[8], kd[8], qe[8];
#pragma unroll
          for (int i = 0; i < 8; ++i) { e1[i] = __expf(bq[i]); const float e2 = __builtin_amdgcn_rcpf(e1[i]);
              const float qf_ = (i & 1) ? __uint_as_float(qw[i >> 1] & 0xffff0000u) : __uint_as_float(qw[i >> 1] << 16), kf_ = (i & 1) ? __uint_as_float(kw[i >> 1] & 0xffff0000u) : __uint_as_float(kw[i >> 1] << 16);
              qe[i] = qf_ * e1[i] * 0.125f; kd[i] = kf_ * e2; }
#pragma unroll
          for (int i = 0; i < 4; ++i) { qo_[i] = pk2(qe[2 * i], qe[2 * i + 1]); ko_[i] = pk2(kd[2 * i], kd[2 * i + 1]); }
          qo.x = qo_[0]; qo.y = qo_[1]; qo.z = qo_[2]; qo.w = qo_[3]; ko.x = ko_[0]; ko.y = ko_[1]; ko.z = ko_[2]; ko.w = ko_[3];
          *(LAS u32x4*)(lds + L_QE + sw128(lane, wave)) = qo; *(LAS u32x4*)(lds + L_KD + sw128(lane, wave)) = ko;
#pragma unroll
          for (int i = 0; i < 8; ++i) { const int d = 8 * wave + i; *(LAS bf16_t*)(lds + L_KDT + sw128(d, lane >> 3) + (lane & 7) * 2) = (bf16_t)f2bf(kd[i]);
              const float dl = rl_f(e1[i], 63); if (lane == 0) *(LAS float*)(lds + L_D + 4 * d) = dl; }
          { const int e = tid >> 2, c0 = 2 * (tid & 3); *(LAS u32x4*)(lds + L_VT + sw128(e, c0)) = vt02; *(LAS u32x4*)(lds + L_VT + sw128(e, c0 + 1)) = vt12; } }
        __syncthreads();
        if (n1 + 2 < 64) GLA_LD(qv2, kv2, la02, la12, vt02, vt12, n1 + 2);
        if (n1 + 1 < 64) GLA_LDRG(rg, n1 + 1);
        const size_t mtok = m0 + (size_t)n1 * 64 + 32 * ih + r32;
        bf16x8 qf[4], vf[4];
#pragma unroll
        for (int ks = 0; ks < 4; ++ks) { qf[ks] = *(LAS const bf16x8*)(lds + L_QE + sw128(32 * ih + r32, 2 * ks + hi)); vf[ks] = *(LAS const bf16x8*)(lds + L_VT + sw128(32 * ie + r32, 2 * ks + hi)); }
        f32x16 o = {};
#pragma unroll
        for (int ts = 0; ts < 2; ++ts) if (ts <= ih) {
            f32x16 at = {};
#pragma unroll
            for (int ks = 0; ks < 4; ++ks) { const bf16x8 kf = *(LAS const bf16x8*)(lds + L_KD + sw128(32 * ts + kperm, 2 * ks + hi)); at = __builtin_amdgcn_mfma_f32_32x32x16_bf16(kf, qf[ks], at, 0, 0, 0); }
            if (ts == ih) {
#pragma unroll
                for (int r = 0; r < 16; ++r) if (pi23(crow(r, hi)) > r32) at[r] = 0.f; }
            u32x4 w0, w1; w0.x = pk2_mfma(at[0], at[1]); w0.y = pk2_mfma(at[2], at[3]); w0.z = pk2_mfma(at[4], at[5]); w0.w = pk2_mfma(at[6], at[7]);
            w1.x = pk2_mfma(at[8], at[9]); w1.y = pk2_mfma(at[10], at[11]); w1.z = pk2_mfma(at[12], at[13]); w1.w = pk2_mfma(at[14], at[15]);
            o = __builtin_amdgcn_mfma_f32_32x32x16_bf16(vf[2 * ts], __builtin_bit_cast(bf16x8, w0), o, 0, 0, 0);
            o = __builtin_amdgcn_mfma_f32_32x32x16_bf16(vf[2 * ts + 1], __builtin_bit_cast(bf16x8, w1), o, 0, 0, 0);
        }
#pragma unroll
        for (int ks = 0; ks < 4; ++ks) { const bf16x8 sf = *(LAS const bf16x8*)(lds + L_ST + par * STB + sw128(32 * ie + r32, 2 * ks + hi)); o = __builtin_amdgcn_mfma_f32_32x32x16_bf16(sf, qf[ks], o, 0, 0, 0); }
#pragma unroll
        for (int ks = 0; ks < 4; ++ks) { const bf16x8 tf = *(LAS const bf16x8*)(lds + L_KDT + sw128(32 * ih + r32, 2 * ks + hi)); accS = __builtin_amdgcn_mfma_f32_32x32x16_bf16(vf[ks], tf, accS, 0, 0, 0); }
        { const float dl = *(LAS const float*)(lds + L_D + 4 * (32 * ih + r32));
#pragma unroll
          for (int r = 0; r < 16; ++r) { accS[r] *= dl; const int e = 32 * ie + crow(r, hi), d = 32 * ih + r32;
              *(LAS bf16_t*)(lds + L_ST + (par ^ 1) * STB + sw128(e, d >> 3) + (d & 7) * 2) = (bf16_t)f2bf(accS[r]); } }
        { float ss = 0.f;
#pragma unroll
          for (int r = 0; r < 16; ++r) ss += o[r] * o[r];
          ss = half_sum(ss); if (hi == 0) *(LAS float*)(lds + L_RED + (wave * 32 + r32) * 4) = ss; }
        __syncthreads();
        { float tot = 0.f;
#pragma unroll
          for (int q = 0; q < 4; ++q) tot += *(LAS const float*)(lds + L_RED + ((2 * q + ih) * 32 + r32) * 4);
          const float rs = rsqrtf(tot * (1.f / 128.f) + EPS);
#pragma unroll
          for (int g = 0; g < 4; ++g) { const float r0 = __uint_as_float(rgn[g].x << 16), r1 = __uint_as_float(rgn[g].x & 0xffff0000u), r2 = __uint_as_float(rgn[g].y << 16), r3 = __uint_as_float(rgn[g].y & 0xffff0000u);
              const f32x4 gn = *(LAS const f32x4*)(lds + L_G + 4 * (32 * ie + 8 * g + 4 * hi));
              u32x2 w; w.x = g8::cvt_pk_bf16(o[4 * g] * rs * gn[0] * siluf(r0), o[4 * g + 1] * rs * gn[1] * siluf(r1));
              w.y = g8::cvt_pk_bf16(o[4 * g + 2] * rs * gn[2] * siluf(r2), o[4 * g + 3] * rs * gn[3] * siluf(r3));
              *(u32x2*)(Y + mtok * 1024 + h * 128 + 32 * ie + 8 * g + 4 * hi) = w; } }

        par ^= 1; }
    }
}
}
DEV void phase3_fast(const Params& P, LAS unsigned char* lds) {
    const int tid = tid_fresh(); const int G = gridDim.x; const int vcu = vcu_of(blockIdx.x, G);
    int* qhead = (int*)(P.ws + WS_CTL) + CW_MLAQ;
    for (int it = vcu; it < 256; it += G) if ((it & 3) == 0) gla::item(P, lds, it >> 4, (it >> 2) & 3, tid);
#if XCONV_P3
    for (int it = vcu; it < 256; it += G) if ((it & (XCONV_DIV - 1)) == XCONV_SEL) expert_convert(P, (it / XCONV_DIV) * NWAVE + (tid >> 6), (256 / XCONV_DIV) * NWAVE, tid & 63);
#endif
    for (;;) {
        __syncthreads();
        if (tid == 0) *(LAS int*)(lds + 131072 + 16) = atomicAdd(qhead, 1);
        __syncthreads();
        const int idx = __builtin_amdgcn_readfirstlane(*(LAS const int*)(lds + 131072 + 16));
        if (idx >= 1024) break;
        const int qb = 15 - (idx >> 6), bh = idx & 63;
        if (MLA8) mla8::unit(P, lds, bh >> 2, bh & 3, qb, tid); else mla::unit(P, lds, bh >> 2, bh & 3, qb, tid);
    }
    asm volatile("s_waitcnt vmcnt(0)" ::: "memory"); __builtin_amdgcn_s_barrier();
}
DEV void phase1_fast(const Params& P, LAS unsigned char* lds) {
    unsigned char* ws = P.ws;
    { g8::DenseSched S; S.init(ws + WS_XN, D, ws + WS_WIN, D, M, 1536, gridDim.x, blockIdx.x);
      g8::EpiZ E{(bf16_t*)P.out, (float*)(ws + WS_CTL + CTL_SSQ_Q), (float*)(ws + WS_CTL + CTL_SSQ_KV)};
      g8::gemm_phase<g8::EpiZ, g8::DenseSched, false>(lds, D, D, D, S, E); }
    { g8::DenseSched S; S.init(ws + WS_WIN + (size_t)1536 * D * 2, D, ws + WS_XN, D, 512, M, gridDim.x, blockIdx.x);
      g8::EpiD E{(bf16_t*)(ws + WS_VTG), (size_t)M};
      g8::gemm_phase<g8::EpiD, g8::DenseSched, false>(lds, D, D, D, S, E); }
    meta_phase(P);
}
DEV void phase2_rows(const Params& P) { const int tid_ = tid_fresh();
    unsigned char* ws = P.ws; const int lane = tid_ & 63; const int gw = blockIdx.x * NWAVE + (tid_ >> 6), ngw = gridDim.x * NWAVE;
    const bf16_t* Z = (const bf16_t*)P.out; bf16_t* KR = (bf16_t*)(ws + WS_KR); float* LOGA = (float*)(ws + WS_LOGA);
    const float2* rt = (const float2*)(ws + WS_ROPE); const float* wa2 = P.in[I_WA2]; const float* ba = P.in[I_BA];
    float w[4][16], bb[4];
#pragma unroll
    for (int j = 0; j < 4; ++j) { bb[j] = ba[64 * j + lane];
#pragma unroll
        for (int r = 0; r < 16; ++r) w[j][r] = wa2[r * 256 + 64 * j + lane]; }
    for (int m = gw; m < M; m += ngw) { const bf16_t* z = Z + (size_t)m * NZ;
        { const float v = bf2f(z[ZKR + lane]), o = sx<1>(v); const float2 cs = rt[(NMETA + (m & (SEQ - 1))) * 32 + (lane >> 1)];
          const float kr_ = (lane & 1) ? (v * cs.x + o * cs.y) : (v * cs.x - o * cs.y);
          if (MLA8) { const int b8 = __builtin_amdgcn_cvt_pk_fp8_f32(kr_, 0.f, 0, false) & 0xff;
              const int w8 = __builtin_amdgcn_mov_dpp(b8, 0x00, 0xf, 0xf, true) | (__builtin_amdgcn_mov_dpp(b8, 0x55, 0xf, 0xf, true) << 8) | (__builtin_amdgcn_mov_dpp(b8, 0xAA, 0xf, 0xf, true) << 16) | (__builtin_amdgcn_mov_dpp(b8, 0xFF, 0xf, 0xf, true) << 24);
              if ((lane & 3) == 0) *(int*)((unsigned char*)KR + (size_t)m * 64 + lane) = w8; }
          else KR[(size_t)m * 64 + lane] = (bf16_t)f2bf(kr_); }
        float al[16];
#pragma unroll
        for (int r = 0; r < 16; ++r) al[r] = bf2f(z[ZAL + r]);
#pragma unroll
        for (int j = 0; j < 4; ++j) { float x = bb[j];
#pragma unroll
            for (int r = 0; r < 16; ++r) x += al[r] * w[j][r];
            LOGA[(size_t)m * 256 + 64 * j + lane] = logsigmoidf(x) * (1.f / 16.f); }
    }
}
DEV void kr8_rows(const Params& P) { const int tid_ = tid_fresh();
    unsigned char* ws = P.ws; const int lane = tid_ & 63; const int gw = blockIdx.x * NWAVE + (tid_ >> 6), ngw = gridDim.x * NWAVE;
    const bf16_t* Z = (const bf16_t*)P.out; unsigned char* KR = ws + WS_KR; const float2* rt = (const float2*)(ws + WS_ROPE);
    for (int blk = gw; blk < M / 32; blk += ngw) {
        u32x4 zz[4]; f32x4 c0[4], c1[4];
#pragma unroll
        for (int q = 0; q < 4; ++q) { const int m = blk * 32 + q * 8 + (lane >> 3), c8 = lane & 7;
            zz[q] = *(const u32x4*)(Z + (size_t)m * NZ + ZKR + 8 * c8);
            const f32x4* cp = (const f32x4*)(rt + (NMETA + (m & (SEQ - 1))) * 32 + 4 * c8); c0[q] = cp[0]; c1[q] = cp[1]; }
#pragma unroll
        for (int q = 0; q < 4; ++q) { const int m = blk * 32 + q * 8 + (lane >> 3), c8 = lane & 7;
            const unsigned zw[4] = {zz[q].x, zz[q].y, zz[q].z, zz[q].w}; const float cs[8] = {c0[q][0], c0[q][1], c0[q][2], c0[q][3], c1[q][0], c1[q][1], c1[q][2], c1[q][3]};
            float o[8];
#pragma unroll
            for (int i = 0; i < 4; ++i) { const float a = __uint_as_float(zw[i] << 16), b = __uint_as_float(zw[i] & 0xffff0000u), c = cs[2 * i], s = cs[2 * i + 1];
                o[2 * i] = a * c - b * s; o[2 * i + 1] = b * c + a * s; }
            u32x2 w; w.x = pk4_fp8(o[0], o[1], o[2], o[3]); w.y = pk4_fp8(o[4], o[5], o[6], o[7]);
            *(u32x2*)(KR + (size_t)m * 64 + 8 * c8) = w; }
    }
}
DEV void phase2_fast(const Params& P, LAS unsigned char* lds) {
    unsigned char* ws = P.ws; const bf16_t* Z = (const bf16_t*)P.out; const float* ssq_q = (const float*)(ws + WS_CTL + CTL_SSQ_Q); const float* ssq_kv = (const float*)(ws + WS_CTL + CTL_SSQ_KV);
#if !defined(X2) || (X2 & 1)
    { g8::DenseSched S; S.init(Z + ZQL, NZ, ws + WS_WQ, 256, M, 768, gridDim.x, blockIdx.x);
      if (MLA8) { g8::EpiQ8 E{(unsigned char*)(ws + WS_QM), ssq_q, (const float2*)(ws + WS_ROPE)}; g8::gemm_phase<g8::EpiQ8, g8::DenseSched, false>(lds, 256, NZ, 256, S, E); }
      else { g8::EpiQ E{(bf16_t*)(ws + WS_QM), ssq_q, (const float2*)(ws + WS_ROPE)}; g8::gemm_phase<g8::EpiQ, g8::DenseSched, false>(lds, 256, NZ, 256, S, E); } }
#endif
#if !defined(X2) || (X2 & 2)
    { g8::DenseSched S; S.init(Z + ZKVL, NZ, ws + WS_WK, 256, M, 512, gridDim.x, blockIdx.x);
      if (MLA8) { g8::EpiK8 E{(unsigned char*)(ws + WS_KN), ssq_kv}; g8::gemm_phase<g8::EpiK8, g8::DenseSched, false>(lds, 256, NZ, 256, S, E); }
      else { g8::EpiK E{(bf16_t*)(ws + WS_KN), ssq_kv}; g8::gemm_phase<g8::EpiK, g8::DenseSched, false>(lds, 256, NZ, 256, S, E); } }
#endif
#if !defined(X2) || (X2 & 4)
    { g8::DenseSched S; S.init(ws + WS_WV, 256, Z + ZKVL, NZ, 512, M, gridDim.x, blockIdx.x);
      if (MLA8) { g8::EpiVT8 E{(unsigned char*)(ws + WS_VT), ssq_kv}; g8::gemm_phase<g8::EpiVT8, g8::DenseSched, false>(lds, 256, 256, NZ, S, E); }
      else { g8::EpiVT E{(bf16_t*)(ws + WS_VT), ssq_kv}; g8::gemm_phase<g8::EpiVT, g8::DenseSched, false>(lds, 256, 256, NZ, S, E); } }
#endif
    if (MLA8) {
        g8::DenseSched S; S.init(Z + ZKR, NZ, ws + WS_WA2T, 128, M, 256, gridDim.x, blockIdx.x);
        g8::EpiLOGA E{(float*)(ws + WS_LOGA), P.in[I_BA]}; g8::gemm_phase<g8::EpiLOGA, g8::DenseSched, false>(lds, 128, NZ, 128, S, E);
        kr8_rows(P);
    } else phase2_rows(P);
}
DEV void phase4_fast(const Params& P, LAS unsigned char* lds) {
    unsigned char* ws = P.ws;
    g8::DenseSched S; S.init(ws + WS_Y, D, ws + WS_WOUT, D, M, D, gridDim.x, blockIdx.x);
    g8::EpiD E{(bf16_t*)(ws + WS_D16), (size_t)D};
    g8::gemm_phase<g8::EpiD, g8::DenseSched, false>(lds, D, D, D, S, E);
}
DEV void phase6_fast(const Params& P, LAS unsigned char* lds) { const int tid_ = tid_fresh();
    unsigned char* ws = P.ws; const int lane = tid_ & 63;
    int c_l, total; const int st_l = slot_start_lane((const int*)(ws + WS_CTL) + CW_CNT, lane, c_l, total);
    if (tid_ < 64) { *(volatile LAS int*)(SLOTTAB_OFF + 4u * (unsigned)lane) = st_l; *(volatile LAS int*)(SLOTTAB_OFF + 256u + 4u * (unsigned)lane) = c_l; }
    __syncthreads();
    g8::MoeSched S{(const char*)(ws + WS_TN8), (const char*)(ws + WS_WGU), (size_t)1024 * 1024, (size_t)256 * 1024, 0, (const int*)(ws + WS_LIST), (total / 256) * 4, (int)gridDim.x, vcu_of(blockIdx.x, gridDim.x), D};
    g8::EpiGU8 E{(unsigned char*)(ws + WS_MH)};
    g8::gemm_phase<g8::EpiGU8, g8::MoeSched, true, true>(lds, D / 2, D / 2, D / 2, S, E);
}
DEV void phase7_fast(const Params& P, LAS unsigned char* lds) { const int tid_ = tid_fresh();
    unsigned char* ws = P.ws; const int lane = tid_ & 63;
    int c_l, total; const int st_l = slot_start_lane((const int*)(ws + WS_CTL) + CW_CNT, lane, c_l, total);
    if (tid_ < 64) { *(volatile LAS int*)(SLOTTAB_OFF + 4u * (unsigned)lane) = st_l; *(volatile LAS int*)(SLOTTAB_OFF + 256u + 4u * (unsigned)lane) = c_l; }
    __syncthreads();
    g8::MoeSched S{(const char*)(ws + WS_MH), (const char*)(ws + WS_WD), (size_t)1024 * 512, (size_t)256 * 512, (size_t)256 * 512, nullptr, (total / 256) * 4, (int)gridDim.x, vcu_of(blockIdx.x, gridDim.x), DE};
    g8::EpiD8 E{(unsigned char*)(ws + WS_MY), 16.f / (8.f * 32.f)};
    g8::gemm_phase<g8::EpiD8, g8::MoeSched, false, true>(lds, DE / 2, DE / 2, DE / 2, S, E);
}

#define XB_TMO      128
#define XB_XCNT(j)  (256  + 64 * (j))
#define XB_XSUB(j)  (1280 + 64 * (j))
#define XB_XGEN(j)  (2304 + 64 * (j))
#define XB_TOP      3328
#define XB_TOPGEN   3392
#define XCD_BAR_WORDS 3456
#define XB_SPIN_CAP (1u << 22)
DEV unsigned xb_ld(unsigned* p)              { return __hip_atomic_load(p, __ATOMIC_RELAXED, __HIP_MEMORY_SCOPE_AGENT); }
DEV unsigned xb_add(unsigned* p, unsigned v) { return __hip_atomic_fetch_add(p, v, __ATOMIC_RELAXED, __HIP_MEMORY_SCOPE_AGENT); }
DEV unsigned xb_xcc_id() { return (unsigned)__builtin_amdgcn_s_getreg((3 << 11) | 20) & 0xFu; }
#define XB_SPIN(cond, bar) do { unsigned _sp = 0; while (cond) { __builtin_amdgcn_s_sleep(1); \
    if ((++_sp & 255u) == 0u) { if (xb_ld(&(bar)[XB_TMO])) break; if (_sp > XB_SPIN_CAP) { atomicAdd(&(bar)[XB_TMO], 1u); break; } } } } while (0)
struct XcdBarrier { unsigned* bar; unsigned x; volatile LAS unsigned* st; };
DEV XcdBarrier xcd_barrier_post(unsigned* bar, volatile LAS unsigned* st) {
    XcdBarrier b; b.bar = bar; b.x = xb_xcc_id(); b.st = st;
    if (threadIdx.x == 0) (void)xb_add(&bar[XB_XCNT(b.x)], 1u);
    return b;
}
DEV void xcd_barrier_complete(unsigned* bar, unsigned x, unsigned& nloc, unsigned& nx) {
    const unsigned G = gridDim.x * gridDim.y * gridDim.z;
    unsigned sum, cnt, mine, sp = 0u;
    for (;;) {
        sum = 0u; cnt = 0u; mine = 0u;
#pragma unroll
        for (unsigned j = 0; j < 16; ++j) { const unsigned c = xb_ld(&bar[XB_XCNT(j)]); sum += c; cnt += (c > 0u) ? 1u : 0u; mine = (j == x) ? c : mine; }
        if (sum == G) break;
        __builtin_amdgcn_s_sleep(1);
        if ((++sp & 255u) == 0u) { if (xb_ld(&bar[XB_TMO])) break; if (sp > XB_SPIN_CAP) { atomicAdd(&bar[XB_TMO], 1u); break; } }
    }
    nloc = mine > 0u ? mine : 1u; nx = cnt > 0u ? cnt : 1u;
}
DEV void xcd_barrier(const XcdBarrier& b) {
    asm volatile("s_waitcnt vmcnt(0)" ::: "memory");
    __syncthreads();
    if (tid_fresh() == 0) {
        unsigned* bar = b.bar;
        __builtin_amdgcn_s_waitcnt(0);
        unsigned nloc = b.st[0], nx = b.st[1];
        if (nloc == 0u) { xcd_barrier_complete(bar, b.x, nloc, nx); b.st[0] = nloc; b.st[1] = nx; }
        const unsigned old = xb_add(&bar[XB_XSUB(b.x)], 1u);
        const unsigned gen = old / nloc;
        if (old + 1u == (gen + 1u) * nloc) {
            __builtin_amdgcn_fence(__ATOMIC_RELEASE, "agent");
            asm volatile("s_waitcnt vmcnt(0)" ::: "memory");
            const unsigned og = xb_add(&bar[XB_TOP], 1u);
            const unsigned tg = og / nx;
            if (og + 1u == (tg + 1u) * nx) xb_add(&bar[XB_TOPGEN], 1u);
            else XB_SPIN(xb_ld(&bar[XB_TOPGEN]) == tg, bar);
            __builtin_amdgcn_fence(__ATOMIC_ACQUIRE, "agent");
            xb_add(&bar[XB_XGEN(b.x)], 1u);
            asm volatile("s_waitcnt vmcnt(0)" ::: "memory");
        } else {
            XB_SPIN(xb_ld(&bar[XB_XGEN(b.x)]) == gen, bar);
            __builtin_amdgcn_fence(__ATOMIC_ACQUIRE, "agent");
            asm volatile("s_waitcnt vmcnt(0)" ::: "memory");
        }
    }
    __syncthreads();
}

__global__ void __launch_bounds__(NT) mega_kernel(Params P) {
    __shared__ __attribute__((aligned(16))) float scr[NWAVE * 4096 + 16 + 64 + 128];
    LAS unsigned char* lds = (LAS unsigned char*)scr;
    volatile LAS unsigned* MISC = (volatile LAS unsigned*)(lds + NWAVE * 4096 * 4);
    if (threadIdx.x < 16) MISC[threadIdx.x] = 0u;
    if ((threadIdx.x & 63) == 0) *(volatile LAS unsigned*)(TIDMAP_OFF + 4u * hw_wave_key()) = threadIdx.x >> 6;
    __syncthreads();
    XcdBarrier xbar = xcd_barrier_post((unsigned*)(P.ws + WS_CTL) + CW_BAR, MISC);
#define GSYNC() xcd_barrier(xbar)
#ifndef DUP
#define DUP 0
#endif
    phase0(P, scr); if (DUP & 1) phase0(P, scr);           GSYNC();
    if (FAST & 1) phase1_fast(P, lds); else phase1(P);
    GSYNC();
    if (FAST & 2) phase2_fast(P, lds); else { phase2a(P); GSYNC(); phase2b(P); }
    if (DUP & 2) phase2_fast(P, lds);
    GSYNC();
    phase3_fast(P, lds);
    if (DUP & 4) phase3_fast(P, lds);
    GSYNC();
    if (FAST & 4) phase4_fast(P, lds); else phase4(P);
    if (DUP & 16) phase4_fast(P, lds);
    GSYNC();
    if (FAST & 64) phase5_fast(P); else phase5(P, scr);
    GSYNC();
    if (FAST & 8) phase6_fast(P, lds); else phase6(P);
    if (DUP & 32) phase6_fast(P, lds);
    GSYNC();
    if (FAST & 16) phase7_fast(P, lds); else phase7(P);
    if (DUP & 64) phase7_fast(P, lds);
    GSYNC();
    phase8(P); if (DUP & 128) phase8(P);
}

extern "C" void kernel_launch(void* const* d_in, const int* in_sizes, int n_in, void* d_out, int out_size, void* d_ws, size_t ws_size, hipStream_t stream) {
    if (n_in != 21 || out_size != M * D || ws_size < WS_END) { fprintf(stderr, "kernel_launch: unexpected shapes (n_in %d out %d ws %zu)\n", n_in, out_size, ws_size); return; }
    static int grid_blocks = 0;
    if (!grid_blocks) {
        int dev = 0, cus = 0, per_cu = 0;
        (void)hipGetDevice(&dev);
        (void)hipDeviceGetAttribute(&cus, hipDeviceAttributeMultiprocessorCount, dev);
        (void)hipOccupancyMaxActiveBlocksPerMultiprocessor(&per_cu, mega_kernel, NT, 0);
        if (per_cu < 1) { fprintf(stderr, "kernel_launch: occupancy query says %d blocks per CU\n", per_cu); per_cu = 1; }
        grid_blocks = cus;
    }
    Params P{};
    for (int i = 0; i < 21; ++i) P.in[i] = (const float*)d_in[i];
    P.out = (float*)d_out; P.ws = (unsigned char*)d_ws;
    (void)hipMemsetAsync((char*)d_ws + WS_CTL, 0, 1 * MiB, stream);
    mega_kernel<<<dim3(grid_blocks), dim3(NT), 0, stream>>>(P);
}
```
